# Optimizing an MI355X kernel written in HIP

```python
import jax
import jax.numpy as jnp
from jax import lax
import numpy as np

D_MODEL = 1024
BATCH = 4
SEQ = 8192
DEPTH = 4

GRID_W = 64
CTX_LEN = 256
HEAD_DIM = 64
ROPE_BASE = 10000.0
NORM_EPS = 1e-6
NEG_INF = -1e30
Q_BLOCK = 128

A_HEADS = 8
A_KV_HEADS = 2
A_WINDOW = 128
B_HEADS = 8
B_NOPE = 64
B_ROPE = 32
B_V = 64
B_Q_RANK = 768
B_KV_RANK = 256
C_HEADS = 16
NA_ROWS = 8
NA_COLS = 16

MIX_WIDTH = A_HEADS * HEAD_DIM + B_HEADS * B_V
EVEN_SPLIT = (A_HEADS * HEAD_DIM, A_KV_HEADS * HEAD_DIM, A_KV_HEADS * HEAD_DIM, B_Q_RANK, B_KV_RANK, B_ROPE)
EVEN_IN = sum(EVEN_SPLIT)
ODD_WIDTH = C_HEADS * HEAD_DIM
ODD_IN = 3 * ODD_WIDTH

N_EXPERTS = 32
TOP_K = 4
D_EXPERT = 1024
SWIGLU_LIMIT = 7.0
SWIGLU_ALPHA = 1.702
MOE_BLOCK = 256

N_EVEN = (DEPTH + 1) // 2
N_ODD = DEPTH // 2

kernel_name = 'hybrid_dit_swa_mla_natten_moe'


def _rmsnorm(x, g):
    x32 = x.astype(jnp.float32)
    y = x32 * lax.rsqrt(jnp.mean(x32 * x32, axis=-1, keepdims=True) + NORM_EPS)
    return (y * g.astype(jnp.float32)).astype(x.dtype)


def _modulate(x, g, shift, scale):
    return _rmsnorm(x, g) * (1.0 + scale) + shift


def _split_cols(p, sizes):
    return jnp.split(p, np.cumsum(sizes)[:-1].tolist(), axis=-1)


def _rope_1d(x, pos):
    n = x.shape[-1]
    half = n // 2
    inv_freq = ROPE_BASE ** (-(jnp.arange(half, dtype=jnp.float32) / half))
    ang = pos.astype(jnp.float32)[:, None] * inv_freq
    shape = (ang.shape[0],) + (1,) * (x.ndim - 3) + (half,)
    cos = jnp.cos(ang).reshape(shape).astype(x.dtype)
    sin = jnp.sin(ang).reshape(shape).astype(x.dtype)
    x1, x2 = x[..., :half], x[..., half:]
    return jnp.concatenate([x1 * cos - x2 * sin, x2 * cos + x1 * sin], axis=-1)


def _rope2d(x, rows, cols):
    h = x.shape[-1] // 2
    return jnp.concatenate([_rope_1d(x[..., :h], rows), _rope_1d(x[..., h:], cols)], axis=-1)


def _attend_dense(q, k, v, sink):
    bsz, n, h, d = q.shape
    kv = k.shape[2]
    m = k.shape[1]
    qg = q.reshape(bsz, n, kv, h // kv, d)
    s = jnp.einsum('bqkgd,bmkd->bkgqm', qg, k).astype(jnp.float32) * (d ** -0.5)
    if sink is not None:
        sk = jnp.broadcast_to(sink.astype(jnp.float32).reshape(kv, h // kv, 1, 1), s.shape[:-1] + (1,))
        s = jnp.concatenate([s, sk], axis=-1)
    p = jax.nn.softmax(s, axis=-1).astype(q.dtype)[..., :m]
    return jnp.einsum('bkgqm,bmkd->bqkgd', p, v).reshape(bsz, n, h * d)


def _window_attn_latent(q, k, v, kc, vc, sink):
    bsz, s_len, h, d = q.shape
    kv = k.shape[2]
    g = h // kv
    w = A_WINDOW
    nb = s_len // w
    n_ctx = kc.shape[1]
    qb = jnp.swapaxes(q.reshape(bsz, nb, w, kv, g, d), 0, 1)
    pad = ((0, 0), (w, w), (0, 0), (0, 0))
    kp = jnp.pad(k, pad)
    vp = jnp.pad(v, pad)
    sink_l = sink.astype(jnp.float32).reshape(kv, g, 1, 1)
    band = jnp.abs(jnp.arange(w)[:, None] + w - jnp.arange(3 * w)[None, :]) <= w
    scale = d ** -0.5

    def block(args):
        n, qn = args
        kn = lax.dynamic_slice_in_dim(kp, n * w, 3 * w, axis=1)
        vn = lax.dynamic_slice_in_dim(vp, n * w, 3 * w, axis=1)
        kpos = n * w - w + jnp.arange(3 * w)
        mask = band & ((kpos >= 0) & (kpos < s_len))[None, :]
        sw = jnp.einsum('bqkgd,bskd->bkgqs', qn, kn).astype(jnp.float32) * scale
        sw = jnp.where(mask, sw, NEG_INF)
        sc = jnp.einsum('bqkgd,bckd->bkgqc', qn, kc).astype(jnp.float32) * scale
        sk = jnp.broadcast_to(sink_l, sw.shape[:-1] + (1,))
        p = jax.nn.softmax(jnp.concatenate([sw, sc, sk], axis=-1), axis=-1).astype(q.dtype)
        pw = p[..., :3 * w]
        pc = p[..., 3 * w:3 * w + n_ctx]
        return (jnp.einsum('bkgqs,bskd->bqkgd', pw, vn)
                + jnp.einsum('bkgqc,bckd->bqkgd', pc, vc))

    out = lax.map(block, (jnp.arange(nb, dtype=jnp.int32), qb))
    return jnp.swapaxes(out, 0, 1).reshape(bsz, s_len, h * d)


def _mla_attend(qn, qp, kn, kpe, v):
    s = (jnp.einsum('bqhd,bkhd->bhqk', qn, kn).astype(jnp.float32)
         + jnp.einsum('bqhr,bkr->bhqk', qp, kpe).astype(jnp.float32)) * ((B_NOPE + B_ROPE) ** -0.5)
    p = jax.nn.softmax(s, axis=-1).astype(v.dtype)
    return jnp.einsum('bhqk,bkhd->bqhd', p, v)


def _mla_latent(qn, qp, kn, kpe, v, kn_c, kpe_c, v_c):
    bsz, s_len, h, _ = qn.shape
    nb = s_len // Q_BLOCK
    kn_all = jnp.concatenate([kn, kn_c], axis=1)
    kpe_all = jnp.concatenate([kpe, kpe_c], axis=1)
    v_all = jnp.concatenate([v, v_c], axis=1)
    qn_b = jnp.swapaxes(qn.reshape(bsz, nb, Q_BLOCK, h, -1), 0, 1)
    qp_b = jnp.swapaxes(qp.reshape(bsz, nb, Q_BLOCK, h, -1), 0, 1)
    out = lax.map(lambda a: _mla_attend(a[0], a[1], kn_all, kpe_all, v_all), (qn_b, qp_b))
    return jnp.swapaxes(out, 0, 1).reshape(bsz, s_len, h * B_V)


def _even_heads(h, w_in, q_norm_g, w_uq, kv_norm_g, w_ukv, rows, cols):
    bsz, n, _ = h.shape
    qa, ka, va, cq, ckv, kpe = _split_cols(h @ w_in, EVEN_SPLIT)
    qa = qa.reshape(bsz, n, A_HEADS, HEAD_DIM)
    ka = ka.reshape(bsz, n, A_KV_HEADS, HEAD_DIM)
    va = va.reshape(bsz, n, A_KV_HEADS, HEAD_DIM)
    qb = (_rmsnorm(cq, q_norm_g) @ w_uq).reshape(bsz, n, B_HEADS, B_NOPE + B_ROPE)
    qn, qp = qb[..., :B_NOPE], qb[..., B_NOPE:]
    kvb = (_rmsnorm(ckv, kv_norm_g) @ w_ukv).reshape(bsz, n, B_HEADS, B_NOPE + B_V)
    kn, vb = kvb[..., :B_NOPE], kvb[..., B_NOPE:]
    if rows is not None:
        qa = _rope2d(qa, rows, cols)
        ka = _rope2d(ka, rows, cols)
        qp = _rope2d(qp, rows, cols)
        kpe = _rope2d(kpe, rows, cols)
    return qa, ka, va, qn, qp, kn, kpe, vb


def _even_mixer(hl, hc, rows, cols, w_in, sink, q_norm_g, w_uq, kv_norm_g, w_ukv, w_out, need_ctx):
    qa, ka, va, qn, qp, kn, kpe, vb = _even_heads(hl, w_in, q_norm_g, w_uq, kv_norm_g, w_ukv, rows, cols)
    qa_c, ka_c, va_c, qn_c, qp_c, kn_c, kpe_c, vb_c = _even_heads(hc, w_in, q_norm_g, w_uq, kv_norm_g, w_ukv, None, None)
    oa = _window_attn_latent(qa, ka, va, ka_c, va_c, sink)
    ob = _mla_latent(qn, qp, kn, kpe, vb, kn_c, kpe_c, vb_c)
    out_l = jnp.concatenate([oa, ob], axis=-1) @ w_out
    if not need_ctx:
        return out_l, None
    oa_c = _attend_dense(qa_c, ka_c, va_c, sink)
    ob_c = _mla_attend(qn_c, qp_c, kn_c, kpe_c, vb_c).reshape(hc.shape[0], hc.shape[1], B_HEADS * B_V)
    out_c = jnp.concatenate([oa_c, ob_c], axis=-1) @ w_out
    return out_l, out_c


def _na_latent(q, k, v, kc, vc, rpb):
    bsz, s_len, h, d = q.shape
    n_rows = s_len // GRID_W
    kh = min(NA_ROWS, n_rows)
    kw = NA_COLS
    scale = d ** -0.5
    qg = q.reshape(bsz, n_rows, GRID_W, h, d)
    kg = k.reshape(bsz, n_rows, GRID_W, h, d)
    vg = v.reshape(bsz, n_rows, GRID_W, h, d)
    col = jnp.arange(GRID_W)
    col_idx = jnp.clip(col - kw // 2, 0, GRID_W - kw)[:, None] + jnp.arange(kw)[None, :]
    dc = col_idx - col[:, None] + (NA_COLS - 1)

    def row(args):
        r, qr = args
        r0 = jnp.clip(r - kh // 2, 0, n_rows - kh)
        kb = lax.dynamic_slice_in_dim(kg, r0, kh, axis=1)[:, :, col_idx]
        vb = lax.dynamic_slice_in_dim(vg, r0, kh, axis=1)[:, :, col_idx]
        dr = r0 + jnp.arange(kh) - r + (NA_ROWS - 1)
        bias = jnp.transpose(rpb[:, dr[:, None, None], dc[None, :, :]], (0, 2, 1, 3))
        sn = jnp.einsum('bqhd,biqjhd->bhqij', qr, kb).astype(jnp.float32) * scale + bias.astype(jnp.float32)
        sn = sn.reshape(bsz, h, GRID_W, kh * kw)
        sc = jnp.einsum('bqhd,bchd->bhqc', qr, kc).astype(jnp.float32) * scale
        p = jax.nn.softmax(jnp.concatenate([sn, sc], axis=-1), axis=-1).astype(q.dtype)
        pn = p[..., :kh * kw].reshape(bsz, h, GRID_W, kh, kw)
        pc = p[..., kh * kw:]
        return (jnp.einsum('bhqij,biqjhd->bqhd', pn, vb)
                + jnp.einsum('bhqc,bchd->bqhd', pc, vc))

    out = lax.map(row, (jnp.arange(n_rows, dtype=jnp.int32), jnp.swapaxes(qg, 0, 1)))
    return jnp.swapaxes(out, 0, 1).reshape(bsz, s_len, h * d)


def _odd_heads(h, w_in):
    bsz, n, _ = h.shape
    q, k, v = jnp.split(h @ w_in, 3, axis=-1)
    shp = (bsz, n, C_HEADS, HEAD_DIM)
    return q.reshape(shp), k.reshape(shp), v.reshape(shp)


def _odd_mixer(hl, hc, w_in, rpb, w_out, need_ctx):
    q, k, v = _odd_heads(hl, w_in)
    q_c, k_c, v_c = _odd_heads(hc, w_in)
    out_l = _na_latent(q, k, v, k_c, v_c, rpb) @ w_out
    if not need_ctx:
        return out_l, None
    return out_l, _attend_dense(q_c, k_c, v_c, None) @ w_out


def _clamped_swiglu(u):
    glu, lin = u[..., :D_EXPERT], u[..., D_EXPERT:]
    glu = jnp.minimum(glu, SWIGLU_LIMIT)
    lin = jnp.clip(lin, -SWIGLU_LIMIT, SWIGLU_LIMIT)
    return glu * jax.nn.sigmoid(SWIGLU_ALPHA * glu) * (lin + 1.0)


def _moe(h, router_w, router_b, w1, b1, w2, b2):
    n_tok, d = h.shape
    logits = (h @ router_w + router_b).astype(jnp.float32)
    top_val, top_exp = lax.top_k(logits, TOP_K)
    gates = jax.nn.softmax(top_val, axis=-1)
    n_asg = n_tok * TOP_K
    flat_e = top_exp.reshape(n_asg)
    order = jnp.argsort(flat_e)
    sorted_e = flat_e[order]
    counts = jnp.zeros((N_EXPERTS,), jnp.int32).at[flat_e].add(1)
    padded = (counts + MOE_BLOCK - 1) // MOE_BLOCK * MOE_BLOCK
    pad_end = jnp.cumsum(padded)
    pad_start = pad_end - padded
    grp_start = jnp.cumsum(counts) - counts
    dest = pad_start[sorted_e] + jnp.arange(n_asg, dtype=jnp.int32) - grp_start[sorted_e]
    n_blk = (n_asg + N_EXPERTS * (MOE_BLOCK - 1) + MOE_BLOCK - 1) // MOE_BLOCK
    n_slot = n_blk * MOE_BLOCK
    buf_tok = jnp.full((n_slot,), n_tok, jnp.int32).at[dest].set((order // TOP_K).astype(jnp.int32))
    buf_gate = jnp.zeros((n_slot,), jnp.float32).at[dest].set(gates.reshape(n_asg)[order])
    blk_exp = jnp.minimum(jnp.searchsorted(pad_end, jnp.arange(n_blk, dtype=jnp.int32) * MOE_BLOCK, side='right'), N_EXPERTS - 1)
    h_pad = jnp.concatenate([h, jnp.zeros((1, d), h.dtype)], axis=0)

    def block(args):
        tok, gate, e = args
        u = h_pad[tok] @ w1[e] + b1[e]
        y = _clamped_swiglu(u) @ w2[e] + b2[e]
        return y * gate[:, None].astype(y.dtype)

    ys = lax.map(block, (buf_tok.reshape(n_blk, MOE_BLOCK), buf_gate.reshape(n_blk, MOE_BLOCK), blk_exp))
    return jnp.zeros((n_tok + 1, d), h.dtype).at[buf_tok].add(ys.reshape(n_slot, d))[:n_tok]


def setup_inputs(seed: int = 0) -> dict:
    key = jax.random.key(seed)
    ks = jax.random.split(key, 25)
    d = D_MODEL

    def nrm(k, shape, std):
        return jax.random.normal(k, shape, jnp.float32) * std

    return {
        'x': nrm(ks[0], (BATCH, SEQ, d), 1.0),
        'c': nrm(ks[1], (BATCH, d), 1.0),
        'ctx': nrm(ks[2], (BATCH, CTX_LEN, d), 1.0),
        'c_ctx': nrm(ks[3], (d,), 1.0),
        'ada_w': nrm(ks[4], (DEPTH, d, 6 * d), 0.5 * d ** -0.5),
        'ada_b': nrm(ks[5], (DEPTH, 6 * d), 0.02),
        'norm1_g': 1.0 + nrm(ks[6], (DEPTH, d), 0.05),
        'norm2_g': 1.0 + nrm(ks[7], (DEPTH, d), 0.05),
        'ev_w_in': nrm(ks[8], (N_EVEN, d, EVEN_IN), d ** -0.5),
        'ev_sink': nrm(ks[9], (N_EVEN, A_HEADS), 1.0),
        'ev_q_norm_g': 1.0 + nrm(ks[10], (N_EVEN, B_Q_RANK), 0.05),
        'ev_w_uq': nrm(ks[11], (N_EVEN, B_Q_RANK, B_HEADS * (B_NOPE + B_ROPE)), B_Q_RANK ** -0.5),
        'ev_kv_norm_g': 1.0 + nrm(ks[12], (N_EVEN, B_KV_RANK), 0.05),
        'ev_w_ukv': nrm(ks[13], (N_EVEN, B_KV_RANK, B_HEADS * (B_NOPE + B_V)), B_KV_RANK ** -0.5),
        'ev_w_out': nrm(ks[14], (N_EVEN, MIX_WIDTH, d), MIX_WIDTH ** -0.5),
        'od_w_in': nrm(ks[15], (N_ODD, d, ODD_IN), d ** -0.5),
        'od_rpb': nrm(ks[16], (N_ODD, C_HEADS, 2 * NA_ROWS - 1, 2 * NA_COLS - 1), 0.5),
        'od_w_out': nrm(ks[17], (N_ODD, ODD_WIDTH, d), ODD_WIDTH ** -0.5),
        'router_w': nrm(ks[18], (DEPTH, d, N_EXPERTS), d ** -0.5),
        'router_b': nrm(ks[19], (DEPTH, N_EXPERTS), 0.01),
        'exp_w1': nrm(ks[20], (DEPTH, N_EXPERTS, d, 2 * D_EXPERT), d ** -0.5),
        'exp_b1': nrm(ks[21], (DEPTH, N_EXPERTS, 2 * D_EXPERT), 0.02),
        'exp_w2': nrm(ks[22], (DEPTH, N_EXPERTS, D_EXPERT, d), D_EXPERT ** -0.5),
        'exp_b2': nrm(ks[23], (DEPTH, N_EXPERTS, d), 0.02),
        'final_g': 1.0 + nrm(ks[24], (d,), 0.05),
    }


def reference(x, c, ctx, c_ctx, ada_w, ada_b, norm1_g, norm2_g, ev_w_in, ev_sink, ev_q_norm_g, ev_w_uq,
              ev_kv_norm_g, ev_w_ukv, ev_w_out, od_w_in, od_rpb, od_w_out, router_w, router_b,
              exp_w1, exp_b1, exp_w2, exp_b2, final_g):
    bsz, seq, d = x.shape
    n_ctx = ctx.shape[1]
    t = jnp.arange(seq, dtype=jnp.int32)
    rows, cols = t // GRID_W, t % GRID_W
    silu_c = jax.nn.silu(c)
    silu_cc = jax.nn.silu(c_ctx)[None, :]
    xl, xc = x, ctx
    for layer in range(DEPTH):
        last = layer == DEPTH - 1
        i = layer // 2
        mod_l = jnp.split((silu_c @ ada_w[layer] + ada_b[layer])[:, None, :], 6, axis=-1)
        mod_c = jnp.split((silu_cc @ ada_w[layer] + ada_b[layer])[:, None, :], 6, axis=-1)
        hl = _modulate(xl, norm1_g[layer], mod_l[0], mod_l[1])
        hc = _modulate(xc, norm1_g[layer], mod_c[0], mod_c[1])
        if layer % 2 == 0:
            ml, mc = _even_mixer(hl, hc, rows, cols, ev_w_in[i], ev_sink[i], ev_q_norm_g[i], ev_w_uq[i],
                                 ev_kv_norm_g[i], ev_w_ukv[i], ev_w_out[i], not last)
        else:
            ml, mc = _odd_mixer(hl, hc, od_w_in[i], od_rpb[i], od_w_out[i], not last)
        xl = xl + mod_l[2] * ml
        hl = _modulate(xl, norm2_g[layer], mod_l[3], mod_l[4]).reshape(bsz * seq, d)
        if last:
            y = _moe(hl, router_w[layer], router_b[layer], exp_w1[layer], exp_b1[layer], exp_w2[layer], exp_b2[layer])
            xl = xl + mod_l[5] * y.reshape(bsz, seq, d)
        else:
            xc = xc + mod_c[2] * mc
            hc = _modulate(xc, norm2_g[layer], mod_c[3], mod_c[4]).reshape(bsz * n_ctx, d)
            y = _moe(jnp.concatenate([hl, hc], axis=0), router_w[layer], router_b[layer], exp_w1[layer],
                     exp_b1[layer], exp_w2[layer], exp_b2[layer])
            xl = xl + mod_l[5] * y[:bsz * seq].reshape(bsz, seq, d)
            xc = xc + mod_c[5] * y[bsz * seq:].reshape(bsz, n_ctx, d)
    return _rmsnorm(xl, final_g)
```

```cpp
#include <hip/hip_runtime.h>
#include <cstdio>
#include <cstdint>

#ifndef MK_CHECK
#define MK_CHECK 0
#endif
#ifndef MK_PER_PHASE
#define MK_PER_PHASE MK_CHECK
#endif

#define LAS __attribute__((address_space(3)))
#define GAS __attribute__((address_space(1)))
typedef unsigned short bf16_t;
typedef short bf16x8 __attribute__((ext_vector_type(8)));
typedef short s16x4 __attribute__((ext_vector_type(4)));
typedef float f32x2 __attribute__((ext_vector_type(2)));
typedef float f32x4 __attribute__((ext_vector_type(4)));
typedef float f32x16 __attribute__((ext_vector_type(16)));
typedef unsigned u32x2 __attribute__((ext_vector_type(2)));
typedef unsigned u32x4 __attribute__((ext_vector_type(4)));

constexpr int DM = 1024, NB = 4, SEQ = 8192, TL = NB * SEQ, CTXL = 256, TC = NB * CTXL, TT = TL + TC;
constexpr int EV_LD = 2048, OD_LD = 3072;
constexpr int EV_IN = 1824;
constexpr int NEXP = 32, DEXP = 1024;
constexpr int MAXSLOT = 143360, MAXTILE = 560;
constexpr float NORM_EPS = 1e-6f;
constexpr float LOG2E = 1.4426950408889634f;

constexpr size_t MiB = 1u << 20;
constexpr size_t WS_CTL = 0, CTL_ZERO_BYTES = 1 * MiB;
constexpr size_t WS_MOD = 1 * MiB;
constexpr size_t WS_ROPE64 = 1 * MiB + 512 * 1024;
constexpr size_t WS_ROPE32 = WS_ROPE64 + 16384;
constexpr size_t WS_TOPE = 2 * MiB;
constexpr size_t WS_TOPG = WS_TOPE + 540672;
constexpr size_t WS_SLOT = WS_TOPG + 540672;
constexpr size_t WS_HIST = WS_SLOT + 540672;
constexpr size_t WS_TILEEXP = WS_HIST + 131072;
constexpr size_t WS_GSLOT = WS_TILEEXP + 4096;
constexpr size_t WS_TOKSLOT = WS_GSLOT + (size_t)MAXSLOT * 4;
static_assert(WS_TOKSLOT + (size_t)MAXSLOT * 4 <= 6 * MiB, "route map");
constexpr size_t WS_WINE = 6 * MiB, WS_WUQ = 14 * MiB, WS_WUKV = 17 * MiB, WS_WOUTE = 18 * MiB, WS_WINO = 22 * MiB, WS_WOUTO = 34 * MiB;
constexpr size_t WS_W1 = 38 * MiB, WS_W2 = 550 * MiB;
constexpr size_t WS_XLC = 806 * MiB, WS_HB = 938 * MiB, WS_PB = 1004 * MiB, WS_QB = 1202 * MiB, WS_KVB = 1252 * MiB, WS_AO = 1318 * MiB;
constexpr size_t WS_XG = 1384 * MiB, WS_HA = 1664 * MiB, WS_RWT = 1944 * MiB, WS_LOGIT = 1952 * MiB, WS_END = 1960 * MiB;
constexpr size_t WS_LOGIT12 = WS_XG + 160 * MiB;
constexpr int H3_LD = 3072;
constexpr int CW_BAR = 4096;

constexpr int ARENA_BYTES = 131072;
constexpr int LDSCTL_OFF = ARENA_BYTES;
constexpr int LDS_BYTES = 147456;

__device__ __forceinline__ unsigned f2bf(float f) { unsigned u = __builtin_bit_cast(unsigned, f); return (u + 0x7fffu + ((u >> 16) & 1u)) >> 16; }
__device__ __forceinline__ unsigned pk2(float lo, float hi) { return f2bf(lo) | (f2bf(hi) << 16); }
__device__ __forceinline__ f32x4 xun4(u32x2 w) { return (f32x4){__builtin_bit_cast(float, w.x << 16), __builtin_bit_cast(float, w.x & 0xffff0000u), __builtin_bit_cast(float, w.y << 16), __builtin_bit_cast(float, w.y & 0xffff0000u)}; }
__device__ __forceinline__ u32x2 xpk4(f32x4 v) { return (u32x2){pk2(v.x, v.y), pk2(v.z, v.w)}; }
__device__ __forceinline__ float bflo(unsigned w) { return __builtin_bit_cast(float, w << 16); }
__device__ __forceinline__ float bfhi(unsigned w) { return __builtin_bit_cast(float, w & 0xffff0000u); }
__device__ __forceinline__ float wave_sum(float v) {
#pragma unroll
    for (int o = 1; o < 64; o <<= 1) v += __shfl_xor(v, o);
    return v;
}
#define LDS_WAIT() asm volatile("s_waitcnt lgkmcnt(0)" ::: "memory")
__device__ __forceinline__ unsigned cvt4_fp8(float a, float b, float c, float d) { unsigned w = 0u; w = __builtin_amdgcn_cvt_pk_fp8_f32(a, b, w, false); w = __builtin_amdgcn_cvt_pk_fp8_f32(c, d, w, true); return w; }
__device__ __forceinline__ void swap16(unsigned& a, unsigned& b) { asm volatile("s_nop 1\n\tv_permlane16_swap_b32 %0, %1\n\ts_nop 1" : "+v"(a), "+v"(b)); }
constexpr float YS_SCALE = 16.0f;
constexpr float W8_SCALE = 32.0f;
__device__ __forceinline__ int opaque_tid() { int t = threadIdx.x; asm volatile("" : "+v"(t)); return t; }

#define XB_TMO      128
#define XB_XCNT(j)  (256  + 64 * (j))
#define XB_XSUB(j)  (1280 + 64 * (j))
#define XB_XGEN(j)  (2304 + 64 * (j))
#define XB_TOP      3328
#define XB_TOPGEN   3392
#define XCD_BAR_WORDS 3456
#define XB_SPIN_CAP (1u << 18)

__device__ __forceinline__ unsigned xb_ld(unsigned* p)              { return __hip_atomic_load(p, __ATOMIC_RELAXED, __HIP_MEMORY_SCOPE_AGENT); }
__device__ __forceinline__ unsigned xb_add(unsigned* p, unsigned v) { return __hip_atomic_fetch_add(p, v, __ATOMIC_RELAXED, __HIP_MEMORY_SCOPE_AGENT); }
__device__ __forceinline__ unsigned xb_xcc_id() { return (unsigned)__builtin_amdgcn_s_getreg((3 << 11) | 20) & 0xFu; }
#define XB_SPIN(cond, bar) do { unsigned _sp = 0; while (cond) { __builtin_amdgcn_s_sleep(1); \
    if ((++_sp & 255u) == 0u) { if (xb_ld(&(bar)[XB_TMO])) break; if (_sp > XB_SPIN_CAP) { atomicAdd(&(bar)[XB_TMO], 1u); break; } } } } while (0)

struct XcdBarrier { unsigned* bar; unsigned x; volatile LAS unsigned* st; };

__device__ __forceinline__ XcdBarrier xcd_barrier_post(unsigned* bar, volatile LAS unsigned* st) {
    XcdBarrier b; b.bar = bar; b.x = xb_xcc_id(); b.st = st;
    if (threadIdx.x == 0) (void)xb_add(&bar[XB_XCNT(b.x)], 1u);
    return b;
}
__device__ __forceinline__ void xcd_barrier_complete(unsigned* bar, unsigned x, unsigned& nloc, unsigned& nx) {
    const unsigned G = gridDim.x * gridDim.y * gridDim.z;
    unsigned sum, cnt, mine, sp = 0u;
    for (;;) {
        sum = 0u; cnt = 0u; mine = 0u;
#pragma unroll
        for (unsigned j = 0; j < 16; ++j) { const unsigned c = xb_ld(&bar[XB_XCNT(j)]); sum += c; cnt += (c > 0u) ? 1u : 0u; mine = (j == x) ? c : mine; }
        if (sum == G) break;
        __builtin_amdgcn_s_sleep(1);
        if ((++sp & 255u) == 0u) { if (xb_ld(&bar[XB_TMO])) break; if (sp > XB_SPIN_CAP) { atomicAdd(&bar[XB_TMO], 1u); break; } }
    }
    nloc = mine > 0u ? mine : 1u; nx = cnt > 0u ? cnt : 1u;
}
__device__ __forceinline__ void xcd_barrier(const XcdBarrier& b) {
    asm volatile("s_waitcnt vmcnt(0)" ::: "memory");
    __syncthreads();
    if (threadIdx.x == 0) {
        unsigned* bar = b.bar;
        __builtin_amdgcn_s_waitcnt(0);
        unsigned nloc = b.st[0], nx = b.st[1];
        if (nloc == 0u) { xcd_barrier_complete(bar, b.x, nloc, nx); b.st[0] = nloc; b.st[1] = nx; }
        const unsigned old = xb_add(&bar[XB_XSUB(b.x)], 1u);
        const unsigned gen = old / nloc;
        if (old + 1u == (gen + 1u) * nloc) {
            __builtin_amdgcn_fence(__ATOMIC_RELEASE, "agent");
            asm volatile("s_waitcnt vmcnt(0)" ::: "memory");
            const unsigned og = xb_add(&bar[XB_TOP], 1u);
            const unsigned tg = og / nx;
            if (og + 1u == (tg + 1u) * nx) xb_add(&bar[XB_TOPGEN], 1u);
            else XB_SPIN(xb_ld(&bar[XB_TOPGEN]) == tg, bar);
            __builtin_amdgcn_fence(__ATOMIC_ACQUIRE, "agent");
            xb_add(&bar[XB_XGEN(b.x)], 1u);
            asm volatile("s_waitcnt vmcnt(0)" ::: "memory");
        } else {
            XB_SPIN(xb_ld(&bar[XB_XGEN(b.x)]) == gen, bar);
            __builtin_amdgcn_fence(__ATOMIC_ACQUIRE, "agent");
            asm volatile("s_waitcnt vmcnt(0)" ::: "memory");
        }
    }
    __syncthreads();
}

namespace pg8 {
constexpr int BM = 256, BK = 64, HALF = 128, HTB = HALF * BK * 2, STAGE_BYTES = 8 * HTB, NXCD = 8, WGM = 8;
__host__ __device__ __forceinline__ int lds_byte(int r, int c) { const int st = (r >> 4) * 2 + (c >> 5), rr = r & 15, cc = c & 31, ob = rr * 64 + cc * 2; return st * 1024 + (ob ^ (((ob >> 9) & 1) << 5)); }
__host__ __device__ __forceinline__ void stage_rc(int b, int& R, int& C) { const int st = b / 1024, sb = b % 1024, swz = sb ^ (((sb >> 9) & 1) << 5); R = (st >> 1) * 16 + swz / 64; C = (st & 1) * 32 + (swz % 64) / 2; }
__host__ __device__ __forceinline__ int perm32(int rho) { const int n = rho >> 4, i = rho & 15; return 8 * (i >> 2) + 4 * n + (i & 3); }

typedef int v4i_t __attribute__((ext_vector_type(4)));
typedef int v8i_t __attribute__((ext_vector_type(8)));
struct Unit { unsigned a, b; int pm, pn, aux; };

struct DenseOrder {
    const char* A; const char* Bt; unsigned lda2, ldb2; int nM, nN, nwg, G, c;
    __device__ __forceinline__ const void* baseA() const { return A; }
    __device__ __forceinline__ const void* baseB() const { return Bt; }
    __device__ __forceinline__ const int* gather() const { return nullptr; }
    __device__ __forceinline__ void init(const void* A_, size_t lda_bytes, const void* Bt_, size_t ldb_bytes, int M, int N, int G_, int c_) { A = (const char*)A_; Bt = (const char*)Bt_; lda2 = (unsigned)lda_bytes; ldb2 = (unsigned)ldb_bytes; nM = M / BM; nN = N / BM; nwg = nM * nN; G = G_; c = c_; }
    __device__ __forceinline__ bool next(int i, Unit& u) const {
        const long L = (long)i * G + c; if (L >= nwg) return false;
        int wgid = (int)L; { const int q = nwg / NXCD, r = nwg % NXCD, xcd = wgid % NXCD, off = wgid / NXCD; wgid = (xcd < r ? xcd * (q + 1) : r * (q + 1) + (xcd - r) * q) + off; }
        const int nig = WGM * nN, gid = wgid / nig, fm = gid * WGM, gsz = (nM - fm) < WGM ? (nM - fm) : WGM;
        u.pm = fm + ((wgid % nig) % gsz); u.pn = (wgid % nig) / gsz; u.aux = 0;
        u.a = (unsigned)u.pm * BM * lda2; u.b = (unsigned)u.pn * BM * ldb2; return true;
    }
};
struct RouterOrder {
    const char* A; const char* Bt; unsigned lda2, ldb2; int nM, G, c;
    __device__ __forceinline__ const void* baseA() const { return A; }
    __device__ __forceinline__ const void* baseB() const { return Bt; }
    __device__ __forceinline__ const int* gather() const { return nullptr; }
    __device__ __forceinline__ bool next(int i, Unit& u) const {
        const int L = i * G + c; if (L >= nM * 3) return false;
        u.pm = L / 3; u.aux = L - 3 * u.pm; u.pn = 0;
        u.a = (unsigned)u.pm * BM * lda2 + (u.aux == 1 ? 2048u : 0u); u.b = (unsigned)u.aux * 2048u; return true;
    }
};
struct MoeOrder {
    const char* A; const char* W; const LAS int* tile_exp; const int* tokslot; unsigned lda2, ldb2, wstride; int ntiles, nN, G, c;
    __device__ __forceinline__ const void* baseA() const { return A; }
    __device__ __forceinline__ const void* baseB() const { return W; }
    __device__ __forceinline__ const int* gather() const { return tokslot; }
    __device__ __forceinline__ bool next(int i, Unit& u) const {
        const int tpr = G / nN, tpx = tpr >> 3, x = c & 7, j = c >> 3;
        int tile, pn;
        if ((G & 7) == 0 && tpx * 8 == tpr && tpx > 0) { tile = i * tpr + x * tpx + j / nN; pn = j % nN; }
        else { const long L = (long)i * G + c; tile = (int)(L / nN); pn = (int)(L % nN); }
        if (tile >= ntiles) return false;
        const int e = __builtin_amdgcn_readfirstlane(tile_exp[tile]);
        u.pm = tile; u.pn = pn; u.aux = e; u.a = (unsigned)tile * BM * lda2; u.b = (unsigned)e * wstride + (unsigned)pn * BM * ldb2; return true;
    }
};

__device__ __forceinline__ unsigned cvt_pk_bf16(float lo, float hi) { unsigned r; asm volatile("v_cvt_pk_bf16_f32 %0, %1, %2" : "=v"(r) : "v"(lo), "v"(hi)); return r; }

struct EpiBf16 {
    static constexpr bool PERM = true; static constexpr bool WIDE16 = false;
    bf16_t* O; int ldc; float sc;
    struct Pre {}; static constexpr bool HAS_BIAS = false;
    __device__ __forceinline__ void operator()(const f32x4 (&acc)[2][2][4][2], const Unit& u, int wr, int wc, int fr, int fq, const Pre& pre) const {
        const int row0 = u.pm * BM + wr * 64 + fr, col0 = u.pn * BM + wc * 32 + 8 * fq;
#pragma unroll
        for (int ai = 0; ai < 2; ++ai)
#pragma unroll
            for (int m = 0; m < 4; ++m) { bf16_t* rowp = O + (size_t)(row0 + ai * HALF + m * 16) * ldc + col0;
#pragma unroll
                for (int bj = 0; bj < 2; ++bj) { const f32x4 v0 = acc[ai][bj][m][0] * sc, v1 = acc[ai][bj][m][1] * sc;
                    u32x4 w; w.x = cvt_pk_bf16(v0[0], v0[1]); w.y = cvt_pk_bf16(v0[2], v0[3]); w.z = cvt_pk_bf16(v1[0], v1[1]); w.w = cvt_pk_bf16(v1[2], v1[3]);
                    *(u32x4*)(rowp + bj * HALF) = w; } }
    }
};
struct EpiResid {
    static constexpr bool PERM = true; static constexpr bool WIDE16 = false;
    bf16_t* X; const float* modl; float sc;
    struct Pre {}; static constexpr bool HAS_BIAS = false;
    __device__ __forceinline__ void operator()(const f32x4 (&acc)[2][2][4][2], const Unit& u, int wr, int wc, int fr, int fq, const Pre& pre) const {
        const int row0 = u.pm * BM + wr * 64 + fr, col0 = u.pn * BM + wc * 32 + 8 * fq;
        const int bidx = u.pm < 128 ? (u.pm >> 5) : 4;
        const float* gp = modl + (size_t)bidx * 6144 + col0;
        f32x4 gv[2][2];
#pragma unroll
        for (int bj = 0; bj < 2; ++bj)
#pragma unroll
            for (int n = 0; n < 2; ++n) gv[bj][n] = *(const f32x4*)(gp + bj * HALF + 4 * n) * sc;
        u32x4 xc[2], xn[2];
        { const bf16_t* rowp = X + (size_t)row0 * DM + col0; xc[0] = *(const u32x4*)rowp; xc[1] = *(const u32x4*)(rowp + HALF); xn[0] = xc[0]; xn[1] = xc[1]; }
#pragma unroll
        for (int g = 0; g < 8; ++g) { const int ai = g >> 2, m = g & 3;
            bf16_t* rowp = X + (size_t)(row0 + ai * HALF + m * 16) * DM + col0;
            if (g < 7) { const bf16_t* nrow = X + (size_t)(row0 + ((g + 1) >> 2) * HALF + ((g + 1) & 3) * 16) * DM + col0; xn[0] = *(const u32x4*)nrow; xn[1] = *(const u32x4*)(nrow + HALF); }
            asm volatile("" ::: "memory");
#pragma unroll
            for (int bj = 0; bj < 2; ++bj) { const u32x4 w = xc[bj];
                const f32x4 a = xun4((u32x2){w.x, w.y}) + gv[bj][0] * acc[ai][bj][m][0], b = xun4((u32x2){w.z, w.w}) + gv[bj][1] * acc[ai][bj][m][1];
                const u32x2 pa = xpk4(a), pb = xpk4(b);
                *(u32x4*)(rowp + bj * HALF) = (u32x4){pa.x, pa.y, pb.x, pb.y}; }
            asm volatile("" ::: "memory");
            xc[0] = xn[0]; xc[1] = xn[1]; }
    }
};
struct EpiLogits {
    static constexpr bool PERM = false; static constexpr bool WIDE16 = false;
    float* LG0; float* LG12; const float* rb;
    struct Pre {}; static constexpr bool HAS_BIAS = false;
    __device__ __forceinline__ void operator()(const f32x4 (&acc)[2][2][4][2], const Unit& u, int wr, int wc, int fr, int fq, const Pre& pre) const {
        if (wc != 0) return;
        const int row0 = u.pm * BM + wr * 64 + fr;
        float* LG = u.aux == 0 ? LG0 : LG12 + (size_t)(u.aux - 1) * TT * 32;
        const float bs = u.aux == 0 ? 1.0f : 0.0f;
        const f32x4 b0 = *(const f32x4*)(rb + 4 * fq) * bs, b1 = *(const f32x4*)(rb + 16 + 4 * fq) * bs;
#pragma unroll
        for (int ai = 0; ai < 2; ++ai)
#pragma unroll
            for (int m = 0; m < 4; ++m) { float* rowp = LG + (size_t)(row0 + ai * HALF + m * 16) * 32 + 4 * fq;
                *(f32x4*)rowp = acc[ai][0][m][0] + b0; *(f32x4*)(rowp + 16) = acc[ai][0][m][1] + b1; }
    }
};
struct EpiSwiglu {
    static constexpr bool PERM = true; static constexpr bool WIDE16 = false;
    unsigned char* O; const float* b1l;
    struct Pre { const LAS float* b; };
    static constexpr bool HAS_BIAS = true;
    __device__ __forceinline__ float bias_of(const Unit& u, int i) const { return b1l[(size_t)u.aux * 2048 + (i < 128 ? u.pn * HALF + i : 1024 + u.pn * HALF + (i - 128))]; }
    __device__ __forceinline__ void operator()(const f32x4 (&acc)[2][2][4][2], const Unit& u, int wr, int wc, int fr, int fq, const Pre& pre) const {
        const int row0 = u.pm * BM + wr * 64 + fr, cg = u.pn * HALF + wc * 32 + 8 * fq;
        f32x4 bg[2], bl[2];
#pragma unroll
        for (int n = 0; n < 2; ++n) { bg[n] = *(const LAS f32x4*)(pre.b + wc * 32 + 8 * fq + 4 * n); bl[n] = *(const LAS f32x4*)(pre.b + 128 + wc * 32 + 8 * fq + 4 * n) + 1.0f; }
#pragma unroll
        for (int ai = 0; ai < 2; ++ai)
#pragma unroll
            for (int mp = 0; mp < 2; ++mp) { unsigned wx[2], wy[2];
#pragma unroll
                for (int mm = 0; mm < 2; ++mm) { const int m = 2 * mp + mm; f32x4 r[2];
#pragma unroll
                    for (int n = 0; n < 2; ++n) { const f32x4 k4 = {1.0f / W8_SCALE, 1.0f / W8_SCALE, 1.0f / W8_SCALE, 1.0f / W8_SCALE};
                        f32x4 g = __builtin_elementwise_fma(acc[ai][0][m][n], k4, bg[n]), l = __builtin_elementwise_fma(acc[ai][1][m][n], k4, bl[n]);
#pragma unroll
                        for (int j = 0; j < 4; ++j) { g[j] = fminf(g[j], 7.0f); l[j] = fminf(fmaxf(l[j], -6.0f), 8.0f); }
                        f32x4 t = g * (-1.702f * LOG2E);
#pragma unroll
                        for (int j = 0; j < 4; ++j) t[j] = __builtin_amdgcn_exp2f(t[j]);
                        t = t + 1.0f;
#pragma unroll
                        for (int j = 0; j < 4; ++j) t[j] = __builtin_amdgcn_rcpf(t[j]);
                        r[n] = (g * t) * l; }
                    wx[mm] = cvt4_fp8(r[0][0], r[0][1], r[0][2], r[0][3]); wy[mm] = cvt4_fp8(r[1][0], r[1][1], r[1][2], r[1][3]); }
                swap16(wx[0], wx[1]); swap16(wy[0], wy[1]);
                unsigned char* rowp = O + (size_t)(row0 + ai * HALF + (2 * mp + (fq & 1)) * 16) * DEXP + (cg - 8 * (fq & 1));
                *(u32x4*)rowp = (u32x4){wx[0], wy[0], wx[1], wy[1]}; }
    }
};
struct EpiGate {
    static constexpr bool PERM = true; static constexpr bool WIDE16 = true;
    unsigned char* O; const float* b2l;
    struct Pre { const LAS float* b; };
    static constexpr bool HAS_BIAS = true;
    __device__ __forceinline__ float bias_of(const Unit& u, int i) const { return b2l[(size_t)u.aux * 1024 + u.pn * BM + i]; }
    __device__ __forceinline__ void operator()(const f32x4 (&acc)[2][2][4][2], const Unit& u, int wr, int wc, int fr, int fq, const Pre& pre) const {
        const int row0 = u.pm * BM + wr * 64 + fr, col0 = u.pn * BM + wc * 64 + 16 * fq;
        f32x4 bv[2][2];
#pragma unroll
        for (int bj = 0; bj < 2; ++bj)
#pragma unroll
            for (int n = 0; n < 2; ++n) bv[bj][n] = *(const LAS f32x4*)(pre.b + wc * 64 + 16 * fq + 8 * bj + 4 * n) * YS_SCALE;
#pragma unroll
        for (int ai = 0; ai < 2; ++ai)
#pragma unroll
            for (int m = 0; m < 4; ++m) { unsigned char* rowp = O + (size_t)(row0 + ai * HALF + m * 16) * DM + col0;
                u32x4 w;
                { const f32x4 v = acc[ai][0][m][0] * (YS_SCALE / W8_SCALE) + bv[0][0]; w.x = cvt4_fp8(v[0], v[1], v[2], v[3]); }
                { const f32x4 v = acc[ai][0][m][1] * (YS_SCALE / W8_SCALE) + bv[0][1]; w.y = cvt4_fp8(v[0], v[1], v[2], v[3]); }
                { const f32x4 v = acc[ai][1][m][0] * (YS_SCALE / W8_SCALE) + bv[1][0]; w.z = cvt4_fp8(v[0], v[1], v[2], v[3]); }
                { const f32x4 v = acc[ai][1][m][1] * (YS_SCALE / W8_SCALE) + bv[1][1]; w.w = cvt4_fp8(v[0], v[1], v[2], v[3]); }
                *(u32x4*)rowp = w; }
    }
};

template <class Epi, class Sched, bool FP8 = false, bool GATHER = false>
__device__ __forceinline__ void gemm_phase(LAS unsigned char* lds, const int K, const size_t lda2, const size_t ldb2, const Sched& S, const Epi& E) {
    const int tid = opaque_tid(), wid = __builtin_amdgcn_readfirstlane(tid >> 6), lane = tid & 63, wr = wid >> 2, wc = wid & 3, fr = lane & 15, fq = lane >> 4;
    int nt = K / BK; asm volatile("" : "+s"(nt));
    unsigned voffA[2], voffB[2];
#pragma unroll
    for (int i = 0; i < 2; ++i) { int R, C; stage_rc(tid * 16 + i * 8192, R, C); int Rb = Epi::PERM ? ((R & ~31) + perm32(R & 31)) : R;
        if constexpr (Epi::WIDE16) Rb = (Rb >> 5) * 64 + ((Rb >> 3) & 3) * 16 + (Rb & 7);
        voffA[i] = (unsigned)(R * (unsigned)lda2 + C * 2u); voffB[i] = (unsigned)(Rb * (unsigned)ldb2 + C * 2u); }
    const unsigned kstep = (unsigned)(BK * 2);
    const unsigned hstepA = (unsigned)(HALF * lda2), hstepB = (unsigned)((Epi::WIDE16 ? 8 : HALF) * ldb2);
    const unsigned ldsw = (unsigned)wid * 1024u;
    const int aoff = lds_byte(wr * 64 + fr, fq * 8), boff = lds_byte(wc * 32 + fr, fq * 8);
    const __amdgpu_buffer_rsrc_t rsA = __builtin_amdgcn_make_buffer_rsrc((void*)S.baseA(), 0, 0x7fffffff, 0x00020000);
    const __amdgpu_buffer_rsrc_t rsB = __builtin_amdgcn_make_buffer_rsrc((void*)S.baseB(), 0, 0x7fffffff, 0x00020000);
#define PG8_SA(b, h) (((b) * 2 + (h)) * HTB)
#define PG8_SB(b, h) ((4 + (b) * 2 + (h)) * HTB)
#define PG8_STAGE(bufoff, rs, soff, voff) do { _Pragma("unroll") for (int _i = 0; _i < 2; ++_i) \
        __builtin_amdgcn_raw_ptr_buffer_load_lds(rs, (LAS unsigned*)(lds + (bufoff) + ldsw + _i * 8192), 16, (voff)[_i], (soff), 0, 0); } while (0)
#define PG8_STAGEA(b, h, aoffs, koff, nx) do { if constexpr (GATHER) { _Pragma("unroll") for (int _i = 0; _i < 2; ++_i) \
            __builtin_amdgcn_raw_ptr_buffer_load_lds(rsA, (LAS unsigned*)(lds + PG8_SA(b, h) + ldsw + _i * 8192), 16, (nx) ? ngvo[h][_i] : gvo[h][_i], (koff), 0, 0); } \
        else PG8_STAGE(PG8_SA(b, h), rsA, (aoffs) + (h) * hstepA, voffA); } while (0)
#define PG8_RD8(off) __builtin_shufflevector(*(const LAS v4i_t*)(lds + (off)), *(const LAS v4i_t*)(lds + (off) + 1024), 0, 1, 2, 3, 4, 5, 6, 7)
#define PG8_LDA(dst, b, h) do { if constexpr (FP8) { _Pragma("unroll") for (int m = 0; m < 4; ++m) dst##8[m] = PG8_RD8(PG8_SA(b, h) + aoff + m * 2048); } \
        else { _Pragma("unroll") for (int m = 0; m < 4; ++m) _Pragma("unroll") for (int k = 0; k < 2; ++k) dst[m][k] = *(const LAS bf16x8*)(lds + PG8_SA(b, h) + aoff + m * 2048 + k * 1024); } } while (0)
#define PG8_LDB(dst, b, h) do { if constexpr (FP8) { _Pragma("unroll") for (int n = 0; n < 2; ++n) dst##8[n] = PG8_RD8(PG8_SB(b, h) + boff + n * 2048); } \
        else { _Pragma("unroll") for (int n = 0; n < 2; ++n) _Pragma("unroll") for (int k = 0; k < 2; ++k) dst[n][k] = *(const LAS bf16x8*)(lds + PG8_SB(b, h) + boff + n * 2048 + k * 1024); } } while (0)
#define PG8_MMA(ai, bj, At, Bt) do { __builtin_amdgcn_s_setprio(1); _Pragma("unroll") for (int m = 0; m < 4; ++m) _Pragma("unroll") for (int n = 0; n < 2; ++n) { \
        if constexpr (FP8) asm volatile("s_nop 1\n\tv_mfma_scale_f32_16x16x128_f8f6f4 %0, %1, %2, %0, %3, %3 op_sel_hi:[0,0,0]" : "+v"(acc[ai][bj][m][n]) : "v"(Bt##8[n]), "v"(At##8[m]), "v"(sc1)); \
        else { _Pragma("unroll") for (int k = 0; k < 2; ++k) acc[ai][bj][m][n] = __builtin_amdgcn_mfma_f32_16x16x32_bf16(Bt[n][k], At[m][k], acc[ai][bj][m][n], 0, 0, 0); } } \
        __builtin_amdgcn_s_setprio(0); } while (0)
#define PG8_WAIT_V(n) asm volatile("s_waitcnt vmcnt(" #n ")" ::: "memory")
#define PG8_WAIT_L(n) asm volatile("s_waitcnt lgkmcnt(" #n ")" ::: "memory")
#define PG8_BAR __builtin_amdgcn_s_barrier()
#define PG8_SCHED __builtin_amdgcn_sched_barrier(0)
    Unit cur, nxt; int ui = 0; typename Epi::Pre pre;
    if (!S.next(0, cur)) return;
    f32x4 acc[2][2][4][2];
#pragma unroll
    for (int a = 0; a < 2; ++a)
#pragma unroll
        for (int b = 0; b < 2; ++b)
#pragma unroll
            for (int m = 0; m < 4; ++m)
#pragma unroll
                for (int n = 0; n < 2; ++n) acc[a][b][m][n] = (f32x4){0.f, 0.f, 0.f, 0.f};
    bf16x8 At[4][2], B0[2][2], B1[2][2];
    v8i_t At8[4], B08[2], B18[2];
    int sc1 = 0x7f7f7f7f; asm volatile("" : "+v"(sc1));
    unsigned cA = cur.a, cB = cur.b;
    unsigned gvo[2][2] = {{0u, 0u}, {0u, 0u}}, ngvo[2][2] = {{0u, 0u}, {0u, 0u}};
    int gR[2], gC[2];
#pragma unroll
    for (int i = 0; i < 2; ++i) stage_rc(tid * 16 + i * 8192, gR[i], gC[i]);
#define PG8_GLOAD(dst, pm_) do { if constexpr (GATHER) { const int* tb_ = S.gather() + (pm_) * BM; \
        _Pragma("unroll") for (int h_ = 0; h_ < 2; ++h_) _Pragma("unroll") for (int i_ = 0; i_ < 2; ++i_) dst[h_][i_] = (unsigned)tb_[h_ * HALF + gR[i_]] * (unsigned)lda2 + (unsigned)gC[i_] * 2u; } } while (0)
    PG8_GLOAD(gvo, cur.pm);
    PG8_STAGE(PG8_SB(0, 0), rsB, cB, voffB); PG8_STAGE(PG8_SB(0, 1), rsB, cB + hstepB, voffB); PG8_STAGEA(0, 0, cA, 0u, false); PG8_STAGEA(0, 1, cA, 0u, false);
    if (wr == 1) PG8_BAR;
    PG8_WAIT_V(2); PG8_BAR;
    PG8_STAGE(PG8_SB(1, 0), rsB, cB + kstep, voffB); PG8_STAGEA(1, 0, cA + kstep, kstep, false); PG8_STAGE(PG8_SB(1, 1), rsB, cB + hstepB + kstep, voffB);
    PG8_WAIT_V(6); PG8_BAR;
    for (;;) {
        const bool has_next = S.next(ui + 1, nxt);
        const unsigned nA = has_next ? nxt.a : cA, nB = has_next ? nxt.b : cB;
        LAS int* gl = (LAS int*)(lds + LDSCTL_OFF + 8192) + (ui & 1) * 256;
        for (int t = 0; t < nt; t += 2) {
            const bool last = (t == nt - 2);
            int gstage = 0;
            if constexpr (GATHER) {
                if (t == 0 && has_next) { int tz = threadIdx.x; asm volatile("" : "+v"(tz)); gstage = S.gather()[nxt.pm * BM + (tz & 255)]; }
                if (last) { if (has_next) { _Pragma("unroll") for (int h_ = 0; h_ < 2; ++h_) _Pragma("unroll") for (int i_ = 0; i_ < 2; ++i_) ngvo[h_][i_] = (unsigned)gl[h_ * HALF + gR[i_]] * (unsigned)lda2 + (unsigned)gC[i_] * 2u; }
                            else { _Pragma("unroll") for (int h_ = 0; h_ < 2; ++h_) _Pragma("unroll") for (int i_ = 0; i_ < 2; ++i_) ngvo[h_][i_] = gvo[h_][i_]; } } }
            float bstage = 0.f;
            if constexpr (Epi::HAS_BIAS) { if (last) { int tz = threadIdx.x; asm volatile("" : "+v"(tz)); bstage = E.bias_of(cur, tz & 255); } }
            const unsigned a1 = cA + (unsigned)(t + 1) * kstep, k1 = (unsigned)(t + 1) * kstep;
            const unsigned a2 = last ? nA : cA + (unsigned)(t + 2) * kstep, b2 = last ? nB : cB + (unsigned)(t + 2) * kstep, k2 = last ? 0u : (unsigned)(t + 2) * kstep;
            const unsigned a3 = a2 + kstep, b3 = b2 + kstep, k3 = k2 + kstep;
            PG8_LDB(B0, 0, 0); PG8_LDB(B1, 0, 1); PG8_SCHED; PG8_LDA(At, 0, 0); PG8_STAGEA(1, 1, a1, k1, false);
            PG8_WAIT_V(8); PG8_WAIT_L(0); PG8_BAR; PG8_MMA(0, 0, At, B0); PG8_MMA(0, 1, At, B1); PG8_BAR; PG8_SCHED;
            PG8_LDA(At, 0, 1); PG8_STAGE(PG8_SB(0, 0), rsB, b2, voffB); PG8_STAGE(PG8_SB(0, 1), rsB, b2 + hstepB, voffB); PG8_STAGEA(0, 0, a2, k2, last);
            PG8_WAIT_V(8); PG8_WAIT_L(0); PG8_BAR; PG8_MMA(1, 0, At, B0); PG8_MMA(1, 1, At, B1); PG8_BAR; PG8_SCHED;
            if constexpr (Epi::HAS_BIAS) { if (last) { int tz = threadIdx.x; asm volatile("" : "+v"(tz)); if (tz < 256) ((LAS float*)(lds + LDSCTL_OFF + 2048 + (ui & 1) * 1024))[tz] = bstage; } }
            PG8_LDB(B0, 1, 0); PG8_LDB(B1, 1, 1); PG8_SCHED; PG8_LDA(At, 1, 0); PG8_STAGEA(0, 1, a2, k2, last);
            PG8_WAIT_V(8); PG8_WAIT_L(0); PG8_BAR; PG8_MMA(0, 0, At, B0); PG8_MMA(0, 1, At, B1); PG8_BAR; PG8_SCHED;
            PG8_LDA(At, 1, 1); PG8_STAGE(PG8_SB(1, 0), rsB, b3, voffB); PG8_STAGE(PG8_SB(1, 1), rsB, b3 + hstepB, voffB); PG8_STAGEA(1, 0, a3, k3, last);
            PG8_WAIT_V(8); PG8_WAIT_L(0); PG8_BAR; PG8_MMA(1, 0, At, B0); PG8_MMA(1, 1, At, B1); PG8_BAR; PG8_SCHED;
            if constexpr (GATHER) { if (t == 0 && has_next) { int tz = threadIdx.x; asm volatile("" : "+v"(tz)); if (tz < 256) gl[tz] = gstage; } }
        }
        if constexpr (FP8) asm volatile("s_nop 15\n\ts_nop 7" ::: "memory");
        if (wr == 0) PG8_BAR;
        { int tz = threadIdx.x; asm volatile("" : "+v"(tz)); const int ln = tz & 63;
          if constexpr (Epi::HAS_BIAS) pre.b = (const LAS float*)(lds + LDSCTL_OFF + 2048 + (ui & 1) * 1024);
          E(acc, cur, wr, wc, ln & 15, ln >> 4, pre); }
        if (!has_next) break;
#pragma unroll
        for (int a = 0; a < 2; ++a)
#pragma unroll
            for (int b = 0; b < 2; ++b)
#pragma unroll
                for (int m = 0; m < 4; ++m)
#pragma unroll
                    for (int n = 0; n < 2; ++n) acc[a][b][m][n] = (f32x4){0.f, 0.f, 0.f, 0.f};
        cur = nxt; cA = nA; cB = nB; ++ui;
        if constexpr (GATHER) { _Pragma("unroll") for (int h_ = 0; h_ < 2; ++h_) _Pragma("unroll") for (int i_ = 0; i_ < 2; ++i_) gvo[h_][i_] = ngvo[h_][i_]; }
        if (wr == 1) PG8_BAR;
    }
    PG8_WAIT_V(0);
    PG8_BAR;
#undef PG8_SA
#undef PG8_SB
#undef PG8_STAGE
#undef PG8_STAGEA
#undef PG8_GLOAD
#undef PG8_LDA
#undef PG8_LDB
#undef PG8_MMA
#undef PG8_RD8
#undef PG8_WAIT_V
#undef PG8_WAIT_L
#undef PG8_BAR
#undef PG8_SCHED
}
}

__device__ __forceinline__ u32x4 rope_chunk(u32x4 xw, u32x4 yw, const f32x2* tab, bool first) {
    u32x4 o;
#pragma unroll
    for (int i = 0; i < 4; ++i) {
        const f32x2 cs0 = tab[2 * i], cs1 = tab[2 * i + 1];
        const float x0 = bflo(xw[i]), x1 = bfhi(xw[i]), y0 = bflo(yw[i]), y1 = bfhi(yw[i]);
        const float r0 = first ? x0 * cs0.x - y0 * cs0.y : x0 * cs0.x + y0 * cs0.y;
        const float r1 = first ? x1 * cs1.x - y1 * cs1.y : x1 * cs1.x + y1 * cs1.y;
        o[i] = pk2(r0, r1);
    }
    return o;
}

namespace att {
constexpr int KCS = 1040;
constexpr int KSLOT = 12544, VSLOT = 8192;
constexpr int OFF_K = 0, OFF_V = 4 * KSLOT, OFF_WSF = OFF_V + 4 * VSLOT, OFF_OST = OFF_WSF + 2048, OFF_BIAS = OFF_OST + 32768, ATT_LDS = OFF_BIAS + 2048;
static_assert(ATT_LDS <= ARENA_BYTES, "attention LDS map");
__device__ __forceinline__ int crow(int r, int hi) { return (r & 3) + 8 * (r >> 2) + 4 * hi; }
__device__ __forceinline__ unsigned cvtpk(float lo, float hi) { typedef __bf16 bf16x2_t __attribute__((ext_vector_type(2))); f32x2 v = {lo, hi}; bf16x2_t b = __builtin_convertvector(v, bf16x2_t); return __builtin_bit_cast(unsigned, b); }
__device__ __forceinline__ s16x4 vtr(const LAS unsigned char* p) { return __builtin_bit_cast(s16x4, __builtin_amdgcn_ds_read_tr16_b64_v4i16((LAS s16x4*)p)); }
constexpr float NEGBIG = -1e30f;
__device__ __forceinline__ void pair32(float x, float& a, float& b) {
    unsigned u = __builtin_bit_cast(unsigned, x), v = u;
    asm volatile("s_nop 1\n\tv_permlane32_swap_b32 %0, %1\n\ts_nop 1" : "+v"(u), "+v"(v));
    a = __builtin_bit_cast(float, u); b = __builtin_bit_cast(float, v);
}

__device__ __forceinline__ unsigned xlane32(unsigned x, bool lo) {
    unsigned u = x, v = x;
    asm volatile("s_nop 1\n\tv_permlane32_swap_b32 %0, %1\n\ts_nop 1" : "+v"(u), "+v"(v));
    return lo ? v : u;
}
struct UMla {
    static constexpr int NKC = 12; static constexpr bool PLAIN = true;
    const bf16_t* QB; const bf16_t* KVB; const bf16_t* PB; bf16_t* AO; const f32x2* R32; int b, h, qblk; bool ctxq;
    template <int NKS> __device__ __forceinline__ void qfix(bf16x8 (&qr)[NKS], int wid, int r32, int hi) const {
        if (ctxq) return;
        const int t = 256 * qblk + 32 * wid + r32, prow = t >> 6, pcol = t & 63;
#pragma unroll
        for (int f = 0; f < 2; ++f) { const u32x4 own = __builtin_bit_cast(u32x4, qr[4 + f]); u32x4 oth;
            oth.x = xlane32(own.x, hi == 0); oth.y = xlane32(own.y, hi == 0); oth.z = xlane32(own.z, hi == 0); oth.w = xlane32(own.w, hi == 0);
            qr[4 + f] = __builtin_bit_cast(bf16x8, rope_chunk(own, oth, R32 + (f == 0 ? prow : pcol) * 8, hi == 0)); }
    }
    __device__ __forceinline__ float c2() const { return 0.10206207261596577f * LOG2E; }
    __device__ __forceinline__ int ntiles() const { return ctxq ? 4 : 132; }
    __device__ __forceinline__ bool active(int, int) const { return true; }
    __device__ __forceinline__ size_t krow(int t, int key) const { return ctxq ? (size_t)(TL + b * CTXL + 64 * t + key) : (t < 128 ? (size_t)(b * SEQ + 64 * t + key) : (size_t)(TL + b * CTXL + 64 * (t - 128) + key)); }
    __device__ __forceinline__ unsigned kofs() const { return (unsigned)WS_KVB + 256u * h; }  __device__ __forceinline__ unsigned kpitch() const { return 2048u; }
    __device__ __forceinline__ unsigned k2ofs() const { return (unsigned)WS_PB + 3584u; }     __device__ __forceinline__ unsigned k2pitch() const { return 2u * EV_LD; }
    __device__ __forceinline__ unsigned vofs() const { return (unsigned)WS_KVB + 256u * h + 128u; } __device__ __forceinline__ unsigned vpitch() const { return 2048u; }
    __device__ __forceinline__ unsigned trow(int t) const { return (unsigned)krow(t, 0); }
    __device__ __forceinline__ size_t qrow(int wid, int r) const { return ctxq ? (size_t)(TL + b * CTXL + 32 * wid + r) : (size_t)(b * SEQ + 256 * qblk + 32 * wid + r); }
    __device__ __forceinline__ const bf16_t* qptr(int wid, int r) const { return QB + qrow(wid, r) * 768 + 96 * h; }
    __device__ __forceinline__ unsigned char* optr(int wid, int r) const { return (unsigned char*)AO + qrow(wid, r) * 1024 + 512 + 64 * h; }
    __device__ __forceinline__ float m0(int) const { return NEGBIG; }
    __device__ __forceinline__ float l0() const { return 0.f; }
    __device__ __forceinline__ void prep(LAS unsigned char*) const {}
    __device__ __forceinline__ float adjust(int, int, int, int, float s, const LAS unsigned char*) const { return s; }
};
struct UWin {
    static constexpr int NKC = 8; static constexpr bool PLAIN = false;
    const bf16_t* PB; bf16_t* AO; const float* sink; int b, kvh, j; bool ctxq; int tlo, nlat;
    template <int NKS> __device__ __forceinline__ void qfix(bf16x8 (&)[NKS], int, int, int) const {}
    __device__ __forceinline__ void init() { tlo = j - 2 < 0 ? 0 : j - 2; const int thi = j + 2 > 127 ? 127 : j + 2; nlat = ctxq ? 0 : thi - tlo + 1; }
    __device__ __forceinline__ float c2() const { return 0.125f * LOG2E; }
    __device__ __forceinline__ int ntiles() const { return nlat + 4; }
    __device__ __forceinline__ bool active(int, int) const { return true; }
    __device__ __forceinline__ size_t krow(int t, int key) const { return t < nlat ? (size_t)(b * SEQ + 64 * (tlo + t) + key) : (size_t)(TL + b * CTXL + 64 * (t - nlat) + key); }
    __device__ __forceinline__ unsigned kofs() const { return (unsigned)WS_PB + 2u * (512 + 64 * kvh); }  __device__ __forceinline__ unsigned kpitch() const { return 2u * EV_LD; }
    __device__ __forceinline__ unsigned k2ofs() const { return 0u; }  __device__ __forceinline__ unsigned k2pitch() const { return 0u; }
    __device__ __forceinline__ unsigned vofs() const { return (unsigned)WS_PB + 2u * (640 + 64 * kvh); }  __device__ __forceinline__ unsigned vpitch() const { return 2u * EV_LD; }
    __device__ __forceinline__ unsigned trow(int t) const { return (unsigned)krow(t, 0); }
    __device__ __forceinline__ int qpos(int wid, int r) const { return 64 * j + 32 * (wid >> 2) + r; }
    __device__ __forceinline__ size_t qrow(int wid, int r) const { return ctxq ? (size_t)(TL + b * CTXL + qpos(wid, r)) : (size_t)(b * SEQ + qpos(wid, r)); }
    __device__ __forceinline__ const bf16_t* qptr(int wid, int r) const { return PB + qrow(wid, r) * EV_LD + 64 * (4 * kvh + (wid & 3)); }
    __device__ __forceinline__ unsigned char* optr(int wid, int r) const { return (unsigned char*)AO + qrow(wid, r) * 1024 + 64 * (4 * kvh + (wid & 3)); }
    __device__ __forceinline__ float m0(int wid) const { return sink[4 * kvh + (wid & 3)] * LOG2E; }
    __device__ __forceinline__ float l0() const { return 1.f; }
    __device__ __forceinline__ void prep(LAS unsigned char*) const {}
    __device__ __forceinline__ void adjust_tile(f32x16& P0, f32x16& P1, int t, int wid, int r32, int hi, float c2, const LAS unsigned char*) const {
        if (t >= nlat) {
#pragma unroll
            for (int r = 0; r < 16; ++r) { P0[r] *= c2; P1[r] *= c2; }
        } else { const int dq = qpos(wid, r32) - 64 * (tlo + t) - 4 * hi + 128;
#pragma unroll
            for (int r = 0; r < 16; ++r) { const int k0 = (r & 3) + 8 * (r >> 2);
                P0[r] = ((unsigned)(dq - k0) <= 256u) ? P0[r] * c2 : NEGBIG; P1[r] = ((unsigned)(dq - k0 - 32) <= 256u) ? P1[r] * c2 : NEGBIG; } }
    }
};
struct UNa {
    static constexpr int NKC = 8; static constexpr bool PLAIN = false;
    const bf16_t* PB; bf16_t* AO; const float* rpbh; int b, h, G; bool ctxq; int rlo, nlat;
    template <int NKS> __device__ __forceinline__ void qfix(bf16x8 (&)[NKS], int, int, int) const {}
    __device__ __forceinline__ void init() { int lo = 4 * G - 4; lo = lo < 0 ? 0 : (lo > 120 ? 120 : lo); int hi = 4 * G - 1; hi = hi < 0 ? 0 : (hi > 120 ? 120 : hi); rlo = lo; nlat = ctxq ? 0 : hi + 8 - lo; }
    __device__ __forceinline__ float c2() const { return 0.125f * LOG2E; }
    __device__ __forceinline__ int ntiles() const { return nlat + 4; }
    __device__ __forceinline__ int qgrow(int wid) const { return 4 * G + (wid >> 1); }
    __device__ __forceinline__ int r0w(int wid) const { int r0 = qgrow(wid) - 4; return r0 < 0 ? 0 : (r0 > 120 ? 120 : r0); }
    __device__ __forceinline__ bool active(int t, int wid) const { if (t >= nlat) return true; const int kr = rlo + t, r0 = r0w(wid); return kr >= r0 && kr < r0 + 8; }
    __device__ __forceinline__ size_t krow(int t, int key) const { return t < nlat ? (size_t)(b * SEQ + 64 * (rlo + t) + key) : (size_t)(TL + b * CTXL + 64 * (t - nlat) + key); }
    __device__ __forceinline__ unsigned kofs() const { return (unsigned)WS_PB + 2u * (1024 + 64 * h); }  __device__ __forceinline__ unsigned kpitch() const { return 2u * OD_LD; }
    __device__ __forceinline__ unsigned k2ofs() const { return 0u; }  __device__ __forceinline__ unsigned k2pitch() const { return 0u; }
    __device__ __forceinline__ unsigned vofs() const { return (unsigned)WS_PB + 2u * (2048 + 64 * h); }  __device__ __forceinline__ unsigned vpitch() const { return 2u * OD_LD; }
    __device__ __forceinline__ unsigned trow(int t) const { return (unsigned)krow(t, 0); }
    __device__ __forceinline__ size_t qrow(int wid, int r) const { return ctxq ? (size_t)(TL + b * CTXL + 32 * wid + r) : (size_t)(b * SEQ + 64 * qgrow(wid) + 32 * (wid & 1) + r); }
    __device__ __forceinline__ const bf16_t* qptr(int wid, int r) const { return PB + qrow(wid, r) * OD_LD + 64 * h; }
    __device__ __forceinline__ unsigned char* optr(int wid, int r) const { return (unsigned char*)AO + qrow(wid, r) * 1024 + 64 * h; }
    __device__ __forceinline__ float m0(int) const { return NEGBIG; }
    __device__ __forceinline__ float l0() const { return 0.f; }
    __device__ __forceinline__ void prep(LAS unsigned char* L) const {
        if (!ctxq) { LAS float* bt = (LAS float*)(L + OFF_BIAS); for (int i = opaque_tid(); i < 15 * 31; i += 512) bt[i] = rpbh[i] * LOG2E; }
    }
    __device__ __forceinline__ void adjust_tile(f32x16& P0, f32x16& P1, int t, int wid, int r32, int hi, float c2, const LAS unsigned char* L) const {
        if (t >= nlat) {
#pragma unroll
            for (int r = 0; r < 16; ++r) { P0[r] *= c2; P1[r] *= c2; }
        } else { const int qc = 32 * (wid & 1) + r32; int c0 = qc - 8; c0 = c0 < 0 ? 0 : (c0 > 48 ? 48 : c0);
            const LAS float* bp = (const LAS float*)(L + OFF_BIAS) + (rlo + t - qgrow(wid) + 7) * 31 + (15 - qc + 4 * hi);
            const int kb = 4 * hi - c0;
#pragma unroll
            for (int r = 0; r < 16; ++r) { const int k0 = (r & 3) + 8 * (r >> 2); const float b0 = bp[k0], b1 = bp[k0 + 32];
                P0[r] = ((unsigned)(kb + k0) < 16u) ? P0[r] * c2 + b0 : NEGBIG; P1[r] = ((unsigned)(kb + k0 + 32) < 16u) ? P1[r] * c2 + b1 : NEGBIG; } }
    }
};

__device__ __forceinline__ float fma_s(float a, float b, float c) { float r; asm("v_fma_f32 %0, %1, %2, %3" : "=v"(r) : "v"(a), "v"(b), "v"(c)); return r; }
__device__ __forceinline__ float max3f(float a, float b, float c) { float r; asm("v_max3_f32 %0, %1, %2, %3" : "=v"(r) : "v"(a), "v"(b), "v"(c)); return r; }
template <class U>
__device__ __forceinline__ void attn_unit(LAS unsigned char* L, unsigned char* wsbase, const U& u) {
    constexpr int NKC = U::NKC, NKS = NKC / 2;
    const int tid = opaque_tid(), lane = tid & 63, r32 = lane & 31, hi = lane >> 5; const int wid = __builtin_amdgcn_readfirstlane(tid >> 6);
    bf16x8 qr[NKS];
    float m = u.m0(wid), l = hi == 0 ? u.l0() : 0.f;
    f32x16 o[2];
#pragma unroll
    for (int r = 0; r < 16; ++r) { o[0][r] = 0.f; o[1][r] = 0.f; }
    const float c2 = u.c2();
    const int NT = u.ntiles();
    LAS float* wsf = (LAS float*)(L + OFF_WSF) + wid * 64;
    const LAS unsigned char* kbase = L + OFF_K + hi * KCS + r32 * 16;
    const LAS unsigned char* vbase = L + OFF_V + ((lane >> 4) & 1) * 32 + (lane & 3) * 8 + (4 * hi + ((lane & 15) >> 2)) * 64;
    const __amdgpu_buffer_rsrc_t rs = __builtin_amdgcn_make_buffer_rsrc((void*)wsbase, 0, 0x7fffffff, 0x00020000);
    const unsigned kvo = (unsigned)lane * u.kpitch(), kvo2 = (unsigned)lane * u.k2pitch(), vvo = (unsigned)(lane >> 2) * u.vpitch() + (unsigned)(lane & 3) * 16u;
    const unsigned kso = u.kofs() + 16u * wid, kso2 = u.k2ofs() + 16u * wid, vso = u.vofs() + 16u * (wid & 3) * u.vpitch() + 64u * (wid >> 2);
    const bool two = (NKC == 12) && (wid < 4);
#define ATT_DMAK(t) do { const int tc_ = (t) < NT ? (t) : NT - 1; const unsigned r0_ = u.trow(tc_); LAS unsigned char* kd_ = L + OFF_K + ((t) & 3) * KSLOT; \
        __builtin_amdgcn_raw_ptr_buffer_load_lds(rs, (LAS unsigned*)(kd_ + wid * KCS), 16, kvo, kso + r0_ * u.kpitch(), 0, 0); \
        if (two) __builtin_amdgcn_raw_ptr_buffer_load_lds(rs, (LAS unsigned*)(kd_ + (8 + wid) * KCS), 16, kvo2, kso2 + r0_ * u.k2pitch(), 0, 0); } while (0)
#define ATT_DMAV(t) do { const int tc_ = (t) < NT ? (t) : NT - 1; const unsigned r0_ = u.trow(tc_); \
        __builtin_amdgcn_raw_ptr_buffer_load_lds(rs, (LAS unsigned*)(L + OFF_V + ((t) & 3) * VSLOT + wid * 1024), 16, vvo, vso + r0_ * u.vpitch(), 0, 0); } while (0)
#define ATT_WAIT_BAR() do { if (two) asm volatile("s_waitcnt vmcnt(6)" ::: "memory"); else asm volatile("s_waitcnt vmcnt(4)" ::: "memory"); \
        __builtin_amdgcn_s_barrier(); asm volatile("" ::: "memory"); } while (0)
#define ATT_QKT(S0, S1, t) do { const LAS unsigned char* kb_ = kbase + ((t) & 3) * KSLOT; \
        _Pragma("unroll") for (int r = 0; r < 16; ++r) { S0[r] = 0.f; S1[r] = 0.f; } \
        _Pragma("unroll") for (int kh_ = 0; kh_ < 2; ++kh_) { bf16x8 kf0[NKS / 2], kf1[NKS / 2]; \
            _Pragma("unroll") for (int ks = 0; ks < NKS / 2; ++ks) { kf0[ks] = *(const LAS bf16x8*)(kb_ + (kh_ * (NKS / 2) + ks) * (2 * KCS)); kf1[ks] = *(const LAS bf16x8*)(kb_ + (kh_ * (NKS / 2) + ks) * (2 * KCS) + 512); } \
            _Pragma("unroll") for (int ks = 0; ks < NKS / 2; ++ks) { S0 = __builtin_amdgcn_mfma_f32_32x32x16_bf16(kf0[ks], qr[kh_ * (NKS / 2) + ks], S0, 0, 0, 0); S1 = __builtin_amdgcn_mfma_f32_32x32x16_bf16(kf1[ks], qr[kh_ * (NKS / 2) + ks], S1, 0, 0, 0); } } } while (0)
#define ATT_SOFTMAX(P0, P1, T) do { float rm; \
        if constexpr (U::PLAIN) { float a_ = max3f(P0[0], P1[0], P0[1]), b_ = max3f(P1[1], P0[2], P1[2]); \
            _Pragma("unroll") for (int r = 3; r < 15; r += 2) { a_ = max3f(a_, P0[r], P1[r]); b_ = max3f(b_, P0[r + 1], P1[r + 1]); } \
            rm = max3f(a_, b_, fmaxf(P0[15], P1[15])) * c2; } \
        else { u.adjust_tile(P0, P1, (T), wid, r32, hi, c2, L); \
            float a_ = max3f(P0[0], P1[0], P0[1]), b_ = max3f(P1[1], P0[2], P1[2]); \
            _Pragma("unroll") for (int r = 3; r < 15; r += 2) { a_ = max3f(a_, P0[r], P1[r]); b_ = max3f(b_, P0[r + 1], P1[r + 1]); } \
            rm = max3f(a_, b_, fmaxf(P0[15], P1[15])); } \
        { float ra, rb; pair32(rm, ra, rb); rm = fmaxf(ra, rb); } \
        const float mn = fmaxf(m, rm); alpha = __builtin_amdgcn_exp2f(m - mn); resc = __any(mn > m); m = mn; \
        float lsa = 0.f; const float nmn = -mn;       \
        if constexpr (U::PLAIN) { _Pragma("unroll") for (int r = 0; r < 16; ++r) { P0[r] = __builtin_amdgcn_exp2f(fma_s(P0[r], c2, nmn)); P1[r] = __builtin_amdgcn_exp2f(fma_s(P1[r], c2, nmn)); lsa += P0[r]; lsa += P1[r]; } } \
        else { _Pragma("unroll") for (int r = 0; r < 16; ++r) { P0[r] = __builtin_amdgcn_exp2f(P0[r] - mn); P1[r] = __builtin_amdgcn_exp2f(P1[r] - mn); lsa += P0[r]; lsa += P1[r]; } } \
        l = l * alpha + lsa; \
        _Pragma("unroll") for (int i = 0; i < 4; ++i) { pw[0][i] = cvtpk(P0[2 * i], P0[2 * i + 1]); pw[1][i] = cvtpk(P0[8 + 2 * i], P0[9 + 2 * i]); pw[2][i] = cvtpk(P1[2 * i], P1[2 * i + 1]); pw[3][i] = cvtpk(P1[8 + 2 * i], P1[9 + 2 * i]); } } while (0)
#define ATT_STEP(SC0, SC1, SN0, SN1, T) do { const int t_ = (T); \
        ATT_DMAK(t_ + 3); ATT_DMAV(t_ + 2); \
        ATT_WAIT_BAR(); \
        const bool a_cur = u.active(t_, wid), a_nxt = (t_ + 1 < NT) && u.active(t_ + 1, wid); \
        float alpha = 1.f; bool resc = false; u32x4 pw[4]; \
        if (a_cur && a_nxt) { ATT_QKT(SN0, SN1, t_ + 1); ATT_SOFTMAX(SC0, SC1, t_); } \
        else { if (a_nxt) ATT_QKT(SN0, SN1, t_ + 1); \
               if (a_cur) ATT_SOFTMAX(SC0, SC1, t_); } \
        __builtin_amdgcn_sched_barrier(0); \
        if (a_cur) { \
            const LAS unsigned char* vb_ = vbase + (t_ & 3) * VSLOT; s16x4 vlo[2][4], vhi[2][4]; \
            _Pragma("unroll") for (int dh = 0; dh < 2; ++dh) _Pragma("unroll") for (int ks = 0; ks < 4; ++ks) { vlo[dh][ks] = vtr(vb_ + dh * 4096 + ks * 1024); vhi[dh][ks] = vtr(vb_ + dh * 4096 + ks * 1024 + 512); } \
            if (resc) { if (hi == 0) wsf[r32] = alpha; LDS_WAIT(); \
                _Pragma("unroll") for (int r = 0; r < 16; ++r) { const float f = wsf[crow(r, hi)]; o[0][r] *= f; o[1][r] *= f; } } \
            _Pragma("unroll") for (int dh = 0; dh < 2; ++dh) _Pragma("unroll") for (int ks = 0; ks < 4; ++ks) { \
                const s16x4 lo4 = vlo[dh][ks], hi4 = vhi[dh][ks]; const bf16x8 vf = {lo4[0], lo4[1], lo4[2], lo4[3], hi4[0], hi4[1], hi4[2], hi4[3]}; \
                o[dh] = __builtin_amdgcn_mfma_f32_32x32x16_bf16(__builtin_bit_cast(bf16x8, pw[ks]), vf, o[dh], 0, 0, 0); } } \
        LDS_WAIT(); __builtin_amdgcn_sched_barrier(0); } while (0)

    ATT_DMAK(0); ATT_DMAK(1); ATT_DMAV(0); ATT_DMAK(2); ATT_DMAV(1);
    { const bf16_t* qp = u.qptr(wid, r32);
#pragma unroll
      for (int ks = 0; ks < NKS; ++ks) qr[ks] = *(const bf16x8*)(qp + 16 * ks + 8 * hi); }
    u.prep(L);
    u.template qfix<NKS>(qr, wid, r32, hi);
    ATT_WAIT_BAR();
    f32x16 sA0, sA1, sB0, sB1;
#pragma unroll
    for (int r = 0; r < 16; ++r) { sA0[r] = 0.f; sA1[r] = 0.f; sB0[r] = 0.f; sB1[r] = 0.f; }
    if (u.active(0, wid)) ATT_QKT(sA0, sA1, 0);
    for (int t = 0; t < NT; ++t) { ATT_STEP(sA0, sA1, sB0, sB1, t); sA0 = sB0; sA1 = sB1; }
    asm volatile("s_waitcnt vmcnt(0)" ::: "memory");
#undef ATT_DMAK
#undef ATT_DMAV
#undef ATT_WAIT_BAR
#undef ATT_QKT
#undef ATT_SOFTMAX
#undef ATT_STEP
    { float la, lb; pair32(l, la, lb); l = la + lb; }
    if (hi == 0) wsf[32 + r32] = l;
    LDS_WAIT();
    LAS unsigned char* stg = L + OFF_OST + wid * 2048;
#pragma unroll
    for (int r = 0; r < 16; ++r) { const int orow = crow(r, hi); const float rl = __builtin_amdgcn_rcpf(wsf[32 + orow]);
        const unsigned w = __builtin_amdgcn_cvt_pk_fp8_f32(o[0][r] * rl, o[1][r] * rl, 0u, false);
        stg[orow * 64 + r32] = (unsigned char)(w & 0xffu); stg[orow * 64 + 32 + r32] = (unsigned char)((w >> 8) & 0xffu); }
    LDS_WAIT();
#pragma unroll
    for (int i = 0; i < 2; ++i) { const int row = i * 16 + (lane >> 2), ch = lane & 3; const u32x4 v = *(const LAS u32x4*)(stg + row * 64 + ch * 16); *(u32x4*)(u.optr(wid, row) + ch * 16) = v; }
    __syncthreads();
}
}

struct Args { const float* in[25]; float* out; unsigned char* ws; int ph_lo, ph_hi; };
enum InIdx { I_X = 0, I_C, I_CTX, I_CCTX, I_ADAW, I_ADAB, I_N1G, I_N2G, I_EVWIN, I_EVSINK, I_EVQNG, I_EVWUQ, I_EVKVNG, I_EVWUKV, I_EVWOUT, I_ODWIN, I_ODRPB, I_ODWOUT, I_RW, I_RB, I_W1, I_B1, I_W2, I_B2, I_FG };

struct Frame {
    LAS unsigned char* lds;
    int tid, lane, wave, vcu, G;
    float* out; unsigned char* ws;
};
__device__ __forceinline__ const float* inptr(const Frame& F, int i) {
    const volatile LAS unsigned* p = (const volatile LAS unsigned*)(F.lds + LDSCTL_OFF + 256) + 2 * i;
    const unsigned lo = __builtin_amdgcn_readfirstlane(p[0]), hi = __builtin_amdgcn_readfirstlane(p[1]);
    return (const float*)(const GAS float*)(((unsigned long long)hi << 32) | lo);
}
#define WSP(T, off) ((T*)(F.ws + (off)))
__device__ __forceinline__ void frame_tid(Frame& F) { F.tid = opaque_tid(); F.lane = F.tid & 63; F.wave = __builtin_amdgcn_readfirstlane(F.tid >> 6); }

__device__ __forceinline__ void tr_item(const float* W, int ldw, int K, int k0, int n0, bf16_t* WT, int dst_row0, LAS float* scr, int lane) {
    float wv[32];
#pragma unroll
    for (int i = 0; i < 32; ++i) wv[i] = W[(size_t)(k0 + 2 * i + (lane >> 5)) * ldw + n0 + (lane & 31)];
#pragma unroll
    for (int i = 0; i < 32; ++i) scr[(2 * i + (lane >> 5)) * 33 + (lane & 31)] = wv[i];
    LDS_WAIT(); asm volatile("" ::: "memory");
    const int c = lane & 7;
#pragma unroll
    for (int j = 0; j < 4; ++j) { const int n = (lane >> 3) + 8 * j; const LAS float* s = scr + (8 * c) * 33 + n;
        u32x4 o; o.x = pk2(s[0 * 33], s[1 * 33]); o.y = pk2(s[2 * 33], s[3 * 33]); o.z = pk2(s[4 * 33], s[5 * 33]); o.w = pk2(s[6 * 33], s[7 * 33]);
        *(u32x4*)(WT + (size_t)(dst_row0 + n) * K + k0 + 8 * c) = o; }
    LDS_WAIT(); asm volatile("" ::: "memory");
}

__device__ __forceinline__ void tr_item8(const float* W, int ldw, int K, int k0, int n0, unsigned char* WT8, int dst_row0, LAS float* scr, int lane, float scale) {
    float wv[32];
#pragma unroll
    for (int i = 0; i < 32; ++i) wv[i] = W[(size_t)(k0 + 2 * i + (lane >> 5)) * ldw + n0 + (lane & 31)];
#pragma unroll
    for (int i = 0; i < 32; ++i) scr[(2 * i + (lane >> 5)) * 33 + (lane & 31)] = wv[i] * scale;
    LDS_WAIT(); asm volatile("" ::: "memory");
    const int c = lane & 3;
#pragma unroll
    for (int j = 0; j < 2; ++j) { const int n = (lane >> 2) + 16 * j; const LAS float* s = scr + (16 * c) * 33 + n;
        u32x4 o; o.x = cvt4_fp8(s[0 * 33], s[1 * 33], s[2 * 33], s[3 * 33]); o.y = cvt4_fp8(s[4 * 33], s[5 * 33], s[6 * 33], s[7 * 33]);
        o.z = cvt4_fp8(s[8 * 33], s[9 * 33], s[10 * 33], s[11 * 33]); o.w = cvt4_fp8(s[12 * 33], s[13 * 33], s[14 * 33], s[15 * 33]);
        *(u32x4*)(WT8 + (size_t)(dst_row0 + n) * K + k0 + 16 * c) = o; }
    LDS_WAIT(); asm volatile("" ::: "memory");
}
__device__ __forceinline__ float silu_f(float c) { return c / (1.0f + __expf(-c)); }

__device__ __forceinline__ void pro_a(Frame& F) {
    frame_tid(F);
    const int gwm = F.wave * F.G + F.vcu, NGW = F.G * 8;
    for (int it = gwm; it < 4 * 96; it += NGW) {
        const int l = it / 96, col = (it % 96) * 64 + F.lane;
        float sv[5][16];
#pragma unroll
        for (int j = 0; j < 16; ++j) {
#pragma unroll
            for (int v = 0; v < 4; ++v) sv[v][j] = silu_f(inptr(F, I_C)[v * 1024 + 64 * j + F.lane]);
            sv[4][j] = silu_f(inptr(F, I_CCTX)[64 * j + F.lane]);
        }
        const float* W = inptr(F, I_ADAW) + (size_t)l * 1024 * 6144 + col;
        float acc[5] = {0.f, 0.f, 0.f, 0.f, 0.f};
#pragma unroll
        for (int j = 0; j < 16; ++j) {
            float wl[64];
#pragma unroll
            for (int ln = 0; ln < 64; ++ln) wl[ln] = W[(size_t)(64 * j + ln) * 6144];
#pragma unroll
            for (int ln = 0; ln < 64; ++ln) {
#pragma unroll
                for (int v = 0; v < 5; ++v) acc[v] += __builtin_bit_cast(float, __builtin_amdgcn_readlane(__builtin_bit_cast(int, sv[v][j]), ln)) * wl[ln];
            }
        }
        const float bb = inptr(F, I_ADAB)[l * 6144 + col];
        float* MOD = WSP(float, WS_MOD);
#pragma unroll
        for (int v = 0; v < 5; ++v) MOD[(size_t)(l * 5 + v) * 6144 + col] = acc[v] + bb;
    }
    { const int gt = blockIdx.x * 512 + F.tid;
      if (gt < 128 * 16) { const int pos = gt >> 4, i = gt & 15; const float inv = __builtin_amdgcn_exp2f(-((float)i / 16.0f) * 13.287712379549449f); const float a = (float)pos * inv; WSP(f32x2, WS_ROPE64)[gt] = (f32x2){__cosf(a), __sinf(a)}; }
      else if (gt < 128 * 16 + 128 * 8) { const int g2 = gt - 128 * 16, pos = g2 >> 3, i = g2 & 7; const float inv = __builtin_amdgcn_exp2f(-((float)i / 8.0f) * 13.287712379549449f); const float a = (float)pos * inv; WSP(f32x2, WS_ROPE32)[g2] = (f32x2){__cosf(a), __sinf(a)}; } }
    { const int nchunk = 2 * 224 * 64;
      for (int i = blockIdx.x * 512 + F.tid; i < nchunk; i += F.G * 512) { const int mi = i / (224 * 64), r = (i / 64) % 224, c = i % 64;
          *(u32x4*)(WSP(unsigned char, WS_WINE) + ((size_t)mi * 2048 + 1824 + r) * 1024 + 16 * c) = (u32x4){0u, 0u, 0u, 0u}; } }
    { bf16_t* RWT = WSP(bf16_t, WS_RWT);
      for (int i = blockIdx.x * 512 + F.tid; i < 4 * 32 * 1024; i += F.G * 512) { const int l = i >> 15, e = (i >> 10) & 31, k = i & 1023;
          const float v = inptr(F, I_RW)[((size_t)l * 1024 + k) * 32 + e]; const unsigned hi = f2bf(v); const unsigned lo = f2bf(v - __builtin_bit_cast(float, hi << 16));
          bf16_t* r = RWT + ((size_t)l * 256 + e) * H3_LD; r[k] = (bf16_t)hi; r[1024 + k] = (bf16_t)hi; r[2048 + k] = (bf16_t)lo; }
      const int nz = 4 * 224 * (H3_LD / 8);
      for (int i = blockIdx.x * 512 + F.tid; i < nz; i += F.G * 512) { const int l = i / (224 * (H3_LD / 8)), r = (i / (H3_LD / 8)) % 224, c = i % (H3_LD / 8);
          *(u32x4*)(RWT + ((size_t)l * 256 + 32 + r) * H3_LD + 8 * c) = (u32x4){0u, 0u, 0u, 0u}; } }
    LAS float* scr = (LAS float*)(F.lds + F.wave * 16384);
    constexpr int S0 = 2 * 16 * 57, S1 = S0 + 2 * 12 * 24, S2 = S1 + 2 * 4 * 32, S3 = S2 + 2 * 16 * 32, S4 = S3 + 2 * 16 * 96, S5 = S4 + 2 * 16 * 32, S6 = S5 + 128 * 16 * 64, S7 = S6 + 128 * 16 * 32;
    const int gw = F.vcu * 8 + F.wave;
    for (int it = gw; it < S7; it += NGW) {
        if (it < S0) { const int r = it, mi = r / (16 * 57), q = r % (16 * 57), kb = q / 57, nb = q % 57;
            tr_item8(inptr(F, I_EVWIN) + (size_t)mi * 1024 * EV_IN, EV_IN, 1024, 64 * kb, 32 * nb, WSP(unsigned char, WS_WINE) + (size_t)mi * 2048 * 1024, 32 * nb, scr, F.lane, W8_SCALE); }
        else if (it < S1) { const int r = it - S0, mi = r / (12 * 24), q = r % (12 * 24), kb = q / 24, nb = q % 24;
            tr_item(inptr(F, I_EVWUQ) + (size_t)mi * 768 * 768, 768, 768, 64 * kb, 32 * nb, WSP(bf16_t, WS_WUQ) + (size_t)mi * 768 * 768, 32 * nb, scr, F.lane); }
        else if (it < S2) { const int r = it - S1, mi = r / (4 * 32), q = r % (4 * 32), kb = q / 32, nb = q % 32;
            tr_item(inptr(F, I_EVWUKV) + (size_t)mi * 256 * 1024, 1024, 256, 64 * kb, 32 * nb, WSP(bf16_t, WS_WUKV) + (size_t)mi * 1024 * 256, 32 * nb, scr, F.lane); }
        else if (it < S3) { const int r = it - S2, mi = r / (16 * 32), q = r % (16 * 32), kb = q / 32, nb = q % 32;
            tr_item8(inptr(F, I_EVWOUT) + (size_t)mi * 1024 * 1024, 1024, 1024, 64 * kb, 32 * nb, WSP(unsigned char, WS_WOUTE) + (size_t)mi * 1024 * 1024, 32 * nb, scr, F.lane, W8_SCALE); }
        else if (it < S4) { const int r = it - S3, mi = r / (16 * 96), q = r % (16 * 96), kb = q / 96, nb = q % 96;
            tr_item8(inptr(F, I_ODWIN) + (size_t)mi * 1024 * 3072, 3072, 1024, 64 * kb, 32 * nb, WSP(unsigned char, WS_WINO) + (size_t)mi * 3072 * 1024, 32 * nb, scr, F.lane, W8_SCALE); }
        else if (it < S5) { const int r = it - S4, mi = r / (16 * 32), q = r % (16 * 32), kb = q / 32, nb = q % 32;
            tr_item8(inptr(F, I_ODWOUT) + (size_t)mi * 1024 * 1024, 1024, 1024, 64 * kb, 32 * nb, WSP(unsigned char, WS_WOUTO) + (size_t)mi * 1024 * 1024, 32 * nb, scr, F.lane, W8_SCALE); }
        else if (it < S6) { const int r = it - S5, mi = r / (16 * 64), q = r % (16 * 64), kb = q / 64, nb = q % 64;
            const int c0 = 32 * (nb & 31), drow = (c0 >> 7) * 256 + (nb >= 32 ? 128 : 0) + (c0 & 127);
            tr_item8(inptr(F, I_W1) + (size_t)mi * 1024 * 2048, 2048, 1024, 64 * kb, 32 * nb, WSP(unsigned char, WS_W1) + (size_t)mi * 2048 * 1024, drow, scr, F.lane, W8_SCALE); }
        else { const int r = it - S6, mi = r / (16 * 32), q = r % (16 * 32), kb = q / 32, nb = q % 32;
            tr_item8(inptr(F, I_W2) + (size_t)mi * 1024 * 1024, 1024, 1024, 64 * kb, 32 * nb, WSP(unsigned char, WS_W2) + (size_t)mi * 1024 * 1024, 32 * nb, scr, F.lane, W8_SCALE); }
    }
}

__device__ __forceinline__ int mod_bidx(int row) { return row < TL ? (row >> 13) : 4; }
__device__ __forceinline__ void norm_mod_store(const f32x4 (&v)[4], int lane, const float* g, const float* shift, const float* scale, unsigned char* hrow, f32x4 (*hf)[4] = nullptr) {
    float s = 0.f;
#pragma unroll
    for (int j = 0; j < 4; ++j) s += (v[j].x * v[j].x + v[j].y * v[j].y) + (v[j].z * v[j].z + v[j].w * v[j].w);
    const float rstd = 1.0f / sqrtf(wave_sum(s) * (1.0f / DM) + NORM_EPS);
#pragma unroll
    for (int j = 0; j < 4; ++j) { const int col = 4 * lane + 256 * j;
        const f32x4 gg = *(const f32x4*)(g + col), sh = *(const f32x4*)(shift + col), sc = *(const f32x4*)(scale + col);
        const f32x4 h = (v[j] * rstd) * gg * (sc + 1.0f) + sh;
        if (hf) (*hf)[j] = h;
        *(unsigned*)(hrow + col) = cvt4_fp8(h.x, h.y, h.z, h.w); }
}

__device__ __forceinline__ void norm_mod_store_r(const f32x4 (&v)[4], int lane, const f32x4 (&gg)[4], const f32x4 (&sh)[4], const f32x4 (&sc1)[4], unsigned char* hrow) {
    float s = 0.f;
#pragma unroll
    for (int j = 0; j < 4; ++j) s += (v[j].x * v[j].x + v[j].y * v[j].y) + (v[j].z * v[j].z + v[j].w * v[j].w);
    const float rstd = 1.0f / sqrtf(wave_sum(s) * (1.0f / DM) + NORM_EPS);
#pragma unroll
    for (int j = 0; j < 4; ++j) { const int col = 4 * lane + 256 * j;
        const f32x4 h = (v[j] * rstd) * gg[j] * sc1[j] + sh[j];
        *(unsigned*)(hrow + col) = cvt4_fp8(h.x, h.y, h.z, h.w); }
}

__device__ __forceinline__ void pro_b(Frame& F) {
    frame_tid(F);
    const int gw = F.vcu * 8 + F.wave, NGW = F.G * 8, lane = F.lane;
    const float* MOD = WSP(float, WS_MOD);
    f32x4 gg[4], sh[4], sc1[4], vn[4]; int cb = -1;
#pragma unroll
    for (int j = 0; j < 4; ++j) { gg[j] = *(const f32x4*)(inptr(F, I_N1G) + 4 * lane + 256 * j); sh[j] = gg[j]; sc1[j] = gg[j]; vn[j] = gg[j]; }
#define PB_SRC(r_) ((r_) < TL ? inptr(F, I_X) + (size_t)(r_) * DM : inptr(F, I_CTX) + (size_t)((r_) - TL) * DM)
    if (gw < TT) { const float* src = PB_SRC(gw);
#pragma unroll
        for (int j = 0; j < 4; ++j) vn[j] = *(const f32x4*)(src + 4 * lane + 256 * j); }
    for (int row = gw; row < TT; row += NGW) {
        f32x4 v[4];
#pragma unroll
        for (int j = 0; j < 4; ++j) v[j] = vn[j];
        if (row + NGW < TT) { const float* src = PB_SRC(row + NGW);
#pragma unroll
            for (int j = 0; j < 4; ++j) vn[j] = *(const f32x4*)(src + 4 * lane + 256 * j); }
        const int bi = mod_bidx(row);
        if (bi != cb) { cb = bi; const float* mb = MOD + (size_t)(0 * 5 + bi) * 6144;
#pragma unroll
            for (int j = 0; j < 4; ++j) { sh[j] = *(const f32x4*)(mb + 4 * lane + 256 * j); sc1[j] = *(const f32x4*)(mb + 1024 + 4 * lane + 256 * j) + 1.0f; } }
        bf16_t* xr = WSP(bf16_t, WS_XLC) + (size_t)row * DM;
#pragma unroll
        for (int j = 0; j < 4; ++j) *(u32x2*)(xr + 4 * lane + 256 * j) = xpk4(v[j]);
        norm_mod_store_r(v, lane, gg, sh, sc1, WSP(unsigned char, WS_HB) + (size_t)row * DM);
    }
#undef PB_SRC
}

__device__ __forceinline__ u32x4 shfl_xor4(u32x4 v, int m) { u32x4 r; r.x = __shfl_xor(v.x, m); r.y = __shfl_xor(v.y, m); r.z = __shfl_xor(v.z, m); r.w = __shfl_xor(v.w, m); return r; }
__device__ __forceinline__ float ssq8(u32x4 w) { float s = 0.f;
#pragma unroll
    for (int i = 0; i < 4; ++i) { const float a = bflo(w[i]), b = bfhi(w[i]); s += a * a + b * b; } return s; }
__device__ __forceinline__ u32x4 scale8(u32x4 w, float r, const float* g) { u32x4 o; const f32x4 g0 = *(const f32x4*)g, g1 = *(const f32x4*)(g + 4);
    o.x = pk2(bflo(w.x) * r * g0.x, bfhi(w.x) * r * g0.y); o.y = pk2(bflo(w.y) * r * g0.z, bfhi(w.y) * r * g0.w);
    o.z = pk2(bflo(w.z) * r * g1.x, bfhi(w.z) * r * g1.y); o.w = pk2(bflo(w.w) * r * g1.z, bfhi(w.w) * r * g1.w); return o; }

__device__ __forceinline__ u32x4 rope_chunk_r(u32x4 xw, u32x4 yw, const f32x2 (&tab)[8], bool first) {
    u32x4 o;
#pragma unroll
    for (int i = 0; i < 4; ++i) {
        const f32x2 cs0 = tab[2 * i], cs1 = tab[2 * i + 1];
        const float x0 = bflo(xw[i]), x1 = bfhi(xw[i]), y0 = bflo(yw[i]), y1 = bfhi(yw[i]);
        const float r0 = first ? x0 * cs0.x - y0 * cs0.y : x0 * cs0.x + y0 * cs0.y;
        const float r1 = first ? x1 * cs1.x - y1 * cs1.y : x1 * cs1.x + y1 * cs1.y;
        o[i] = pk2(r0, r1);
    }
    return o;
}
__device__ __forceinline__ u32x4 scale8_r(u32x4 w, float r, f32x4 g0, f32x4 g1) { u32x4 o;
    o.x = pk2(bflo(w.x) * r * g0.x, bfhi(w.x) * r * g0.y); o.y = pk2(bflo(w.y) * r * g0.z, bfhi(w.y) * r * g0.w);
    o.z = pk2(bflo(w.z) * r * g1.x, bfhi(w.z) * r * g1.y); o.w = pk2(bflo(w.w) * r * g1.z, bfhi(w.w) * r * g1.w); return o; }

__device__ __forceinline__ void e2_pass(Frame& F, int li) {
    frame_tid(F);
    const int gw = F.vcu * 8 + F.wave, NGW = F.G * 8, lane = F.lane;
    const float* gq = inptr(F, I_EVQNG) + li * 768; const float* gkv = inptr(F, I_EVKVNG) + li * 256;
    const f32x2* R64 = WSP(f32x2, WS_ROPE64); const f32x2* R32 = WSP(f32x2, WS_ROPE32);
    const int cw = lane & 7, seg = cw >> 1, c4 = (lane >= 32 && lane < 36) ? lane - 32 : 0;
    const float* gq1p = gq + (lane >= 32 ? 8 * (lane + 64) - 768 : 0); const float* gq2p = gq + 8 * (lane + 128) - 768; const float* gkvp = gkv + (lane < 32 ? 8 * lane : 0);
    const f32x4 gq1a = *(const f32x4*)gq1p, gq1b = *(const f32x4*)(gq1p + 4), gq2a = *(const f32x4*)gq2p, gq2b = *(const f32x4*)(gq2p + 4), gkva = *(const f32x4*)gkvp, gkvb = *(const f32x4*)(gkvp + 4);
    u32x4 wn[4]; f32x2 t64n[8], t32n[8];
#define E2_LOAD(r_) do { const bf16_t* pr_ = WSP(bf16_t, WS_PB) + (size_t)(r_) * EV_LD; \
        _Pragma("unroll") for (int j = 0; j < 4; ++j) wn[j] = *(const u32x4*)(pr_ + 8 * (lane + 64 * j)); \
        const int t_ = (r_) & (SEQ - 1), prow_ = t_ >> 6, pcol_ = t_ & 63; \
        const f32x2* a_ = R64 + ((seg < 2) ? prow_ : pcol_) * 16 + (cw & 1) * 8; const f32x2* b_ = R32 + ((c4 < 2) ? prow_ : pcol_) * 8; \
        _Pragma("unroll") for (int i = 0; i < 8; ++i) { t64n[i] = a_[i]; t32n[i] = b_[i]; } } while (0)
#pragma unroll
    for (int j = 0; j < 4; ++j) wn[j] = (u32x4){0u, 0u, 0u, 0u};
#pragma unroll
    for (int i = 0; i < 8; ++i) { t64n[i] = (f32x2){0.f, 0.f}; t32n[i] = (f32x2){0.f, 0.f}; }
    if (gw < TT) E2_LOAD(gw);
    for (int row = gw; row < TT; row += NGW) {
        bf16_t* pr = WSP(bf16_t, WS_PB) + (size_t)row * EV_LD;
        u32x4 w[4]; f32x2 t64[8], t32[8];
#pragma unroll
        for (int j = 0; j < 4; ++j) w[j] = wn[j];
#pragma unroll
        for (int i = 0; i < 8; ++i) { t64[i] = t64n[i]; t32[i] = t32n[i]; }
        if (row + NGW < TT) E2_LOAD(row + NGW);
        float sq = ssq8(w[2]) + (lane >= 32 ? ssq8(w[1]) : 0.f), skv = lane < 32 ? ssq8(w[3]) : 0.f;
        const float rq = 1.0f / sqrtf(wave_sum(sq) * (1.0f / 768.0f) + NORM_EPS), rkv = 1.0f / sqrtf(wave_sum(skv) * (1.0f / 256.0f) + NORM_EPS);
        const bool lat = row < TL;
        const u32x4 y0 = shfl_xor4(w[0], 2), y1 = shfl_xor4(w[1], 2), y3 = shfl_xor4(w[3], 1);
        if (lat) { w[0] = rope_chunk_r(w[0], y0, t64, (seg & 1) == 0); if (lane < 16) w[1] = rope_chunk_r(w[1], y1, t64, (seg & 1) == 0); }
        if (lane >= 32) w[1] = scale8_r(w[1], rq, gq1a, gq1b);
        w[2] = scale8_r(w[2], rq, gq2a, gq2b);
        if (lane < 32) w[3] = scale8_r(w[3], rkv, gkva, gkvb);
        else if (lane < 36 && lat) w[3] = rope_chunk_r(w[3], y3, t32, ((lane - 32) & 1) == 0);
#pragma unroll
        for (int j = 0; j < 4; ++j) *(u32x4*)(pr + 8 * (lane + 64 * j)) = w[j];
    }
#undef E2_LOAD
}
__device__ __forceinline__ void m1a_pass(Frame& F, int layer) {
    frame_tid(F);
    const int gw = F.vcu * 8 + F.wave, NGW = F.G * 8, lane = F.lane;
    const float* MOD = WSP(float, WS_MOD); const float* g2 = inptr(F, I_N2G) + layer * DM;
    f32x4 gg[4], sh[4], sc1[4], vn[4]; int cb = -1;
#pragma unroll
    for (int j = 0; j < 4; ++j) { gg[j] = *(const f32x4*)(g2 + 4 * lane + 256 * j); sh[j] = gg[j]; sc1[j] = gg[j]; vn[j] = gg[j]; }
    if (gw < TT) {
#pragma unroll
        for (int j = 0; j < 4; ++j) vn[j] = xun4(*(const u32x2*)(WSP(bf16_t, WS_XLC) + (size_t)gw * DM + 4 * lane + 256 * j)); }
    for (int row = gw; row < TT; row += NGW) {
        f32x4 v[4];
#pragma unroll
        for (int j = 0; j < 4; ++j) v[j] = vn[j];
        if (row + NGW < TT) {
#pragma unroll
            for (int j = 0; j < 4; ++j) vn[j] = xun4(*(const u32x2*)(WSP(bf16_t, WS_XLC) + (size_t)(row + NGW) * DM + 4 * lane + 256 * j)); }
        const int bi = mod_bidx(row);
        if (bi != cb) { cb = bi; const float* mb = MOD + (size_t)(layer * 5 + bi) * 6144;
#pragma unroll
            for (int j = 0; j < 4; ++j) { sh[j] = *(const f32x4*)(mb + 3 * 1024 + 4 * lane + 256 * j); sc1[j] = *(const f32x4*)(mb + 4 * 1024 + 4 * lane + 256 * j) + 1.0f; } }
        float s = 0.f;
#pragma unroll
        for (int j = 0; j < 4; ++j) s += (v[j].x * v[j].x + v[j].y * v[j].y) + (v[j].z * v[j].z + v[j].w * v[j].w);
        const float rstd = 1.0f / sqrtf(wave_sum(s) * (1.0f / DM) + NORM_EPS);
        bf16_t* hr = WSP(bf16_t, WS_PB) + (size_t)row * H3_LD;
#pragma unroll
        for (int j = 0; j < 4; ++j) { const int col = 4 * lane + 256 * j;
            const f32x4 h = (v[j] * rstd) * gg[j] * sc1[j] + sh[j];
            unsigned hi[4], lo[4];
#pragma unroll
            for (int i = 0; i < 4; ++i) { hi[i] = f2bf(h[i]); lo[i] = f2bf(h[i] - __builtin_bit_cast(float, hi[i] << 16)); }
            const u32x2 wh = {hi[0] | (hi[1] << 16), hi[2] | (hi[3] << 16)}, wl = {lo[0] | (lo[1] << 16), lo[2] | (lo[3] << 16)};
            *(u32x2*)(hr + col) = wh; *(u32x2*)(hr + 1024 + col) = wl;
            *(unsigned*)(WSP(unsigned char, WS_HB) + (size_t)row * DM + col) = cvt4_fp8(h[0], h[1], h[2], h[3]); }
    }
}
__device__ __forceinline__ void m1b_gemm(Frame& F, int layer) {
    pg8::RouterOrder S; S.A = (const char*)WSP(bf16_t, WS_PB); S.Bt = (const char*)(WSP(bf16_t, WS_RWT) + (size_t)layer * 256 * H3_LD); S.lda2 = H3_LD * 2; S.ldb2 = H3_LD * 2; S.nM = TT / 256; S.G = F.G; S.c = blockIdx.x;
    pg8::EpiLogits E{WSP(float, WS_LOGIT), WSP(float, WS_LOGIT12), inptr(F, I_RB) + layer * 32};
    pg8::gemm_phase<pg8::EpiLogits, pg8::RouterOrder>(F.lds, 1024, (size_t)H3_LD * 2, (size_t)H3_LD * 2, S, E);
}
__device__ __forceinline__ void m1c_pass(Frame& F) {
    frame_tid(F);
    const int lane = F.lane, blk = blockIdx.x, CH = (TT + F.G - 1) / F.G;
    const int r0 = blk * CH, r1 = (r0 + CH < TT) ? r0 + CH : TT;
    LAS int* hist = (LAS int*)(F.lds + LDSCTL_OFF + 512);
    if (F.tid < 32) hist[F.tid] = 0;
    __syncthreads();
    const int e = lane & 31, sub = lane >> 5;
    float n0 = 0.f, n1 = 0.f, n2 = 0.f;
    { const int row = r0 + 2 * F.wave + sub; const size_t li_ = (size_t)(row < r1 ? row : r1 - 1) * 32 + e;
      n0 = WSP(float, WS_LOGIT)[li_]; n1 = WSP(float, WS_LOGIT12)[li_]; n2 = WSP(float, WS_LOGIT12)[(size_t)TT * 32 + li_]; }
    for (int rbase = r0 + 2 * F.wave; rbase < r1; rbase += 16) {
        const int row = rbase + sub; const bool ok = row < r1;
        float logit = (n0 + n1) + n2;
        { const int rn = rbase + 16 + sub; const size_t li_ = (size_t)(rn < r1 ? rn : r1 - 1) * 32 + e;
          n0 = WSP(float, WS_LOGIT)[li_]; n1 = WSP(float, WS_LOGIT12)[li_]; n2 = WSP(float, WS_LOGIT12)[(size_t)TT * 32 + li_]; }
        float tv[4]; int ti[4];
#pragma unroll
        for (int k = 0; k < 4; ++k) {
            float bv = logit; int bi = e;
#pragma unroll
            for (int o = 16; o >= 1; o >>= 1) { const float ov = __shfl_xor(bv, o); const int oi = __shfl_xor(bi, o); if (ov > bv || (ov == bv && oi < bi)) { bv = ov; bi = oi; } }
            tv[k] = bv; ti[k] = bi; if (e == bi) logit = -3.0e38f;
        }
        const float w1 = __expf(tv[1] - tv[0]), w2 = __expf(tv[2] - tv[0]), w3 = __expf(tv[3] - tv[0]); const float inv = 1.0f / (1.0f + w1 + w2 + w3);
        if (e == 0 && ok) {
            *(int4*)(WSP(int, WS_TOPE) + (size_t)row * 4) = make_int4(ti[0], ti[1], ti[2], ti[3]);
            *(f32x4*)(WSP(float, WS_TOPG) + (size_t)row * 4) = (f32x4){inv, w1 * inv, w2 * inv, w3 * inv};
            atomicAdd((int*)(hist + ti[0]), 1); atomicAdd((int*)(hist + ti[1]), 1); atomicAdd((int*)(hist + ti[2]), 1); atomicAdd((int*)(hist + ti[3]), 1);
        }
    }
    __syncthreads();
    if (F.tid < 32) WSP(int, WS_HIST)[blk * 32 + F.tid] = hist[F.tid];
    __syncthreads();
}

__device__ __forceinline__ void m2_pass(Frame& F) {
    frame_tid(F);
    const int blk = blockIdx.x, CH = (TT + F.G - 1) / F.G;
    const int r0 = blk * CH, r1 = (r0 + CH < TT) ? r0 + CH : TT, nr = r1 > r0 ? r1 - r0 : 0;
    LAS int* tot = (LAS int*)(F.lds), *bef = tot + 32, *pst = tot + 64, *ntl = tot + 96;
    LAS int* te = (LAS int*)(F.lds + 1024);
    LAS float* tg = (LAS float*)(F.lds + 1024 + 32768);
    const int* HIST = WSP(int, WS_HIST);
    if (F.tid < 64) tot[F.tid] = 0;
    __syncthreads();
    for (int i = F.tid; i < F.G * 32; i += 512) { const int h = HIST[i]; atomicAdd((int*)(tot + (i & 31)), h); if ((i >> 5) < blk) atomicAdd((int*)(bef + (i & 31)), h); }
    for (int i = F.tid; i < nr * 4; i += 512) { te[i] = WSP(int, WS_TOPE)[(size_t)r0 * 4 + i]; tg[i] = WSP(float, WS_TOPG)[(size_t)r0 * 4 + i]; }
    __syncthreads();
    if (F.tid == 0) { int ps = 0; for (int e = 0; e < 32; ++e) { pst[e] = ps; ps += (tot[e] + 255) & ~255; } ntl[0] = ps >> 8; }
    __syncthreads();
    LAS int* cnt = (LAS int*)(F.lds + 1024 + 65536);
    const int nent = nr * 4, nch = (nent + 63) >> 6;
    int myrank[4] = {0, 0, 0, 0}, myex[4] = {-1, -1, -1, -1};
#pragma unroll
    for (int q = 0; q < 4; ++q) { const int c = F.wave + 8 * q;
        if (c < nch) { const int i = 64 * c + F.lane; const int ex = i < nent ? te[i] : -1; myex[q] = ex; int rk = 0, mine = 0;
            for (int e = 0; e < 32; ++e) { const unsigned long long m = __ballot(ex == e); if (ex == e) rk = __popcll(m & ((1ull << F.lane) - 1ull)); if (F.lane == e) mine = __popcll(m); }
            myrank[q] = rk; if (F.lane < 32) cnt[c * 32 + F.lane] = mine; } }
    __syncthreads();
#pragma unroll
    for (int q = 0; q < 4; ++q) { const int c = F.wave + 8 * q; const int i = 64 * c + F.lane;
        if (c < nch && i < nent) { const int ex = myex[q]; int before = 0; for (int c2 = 0; c2 < c; ++c2) before += cnt[c2 * 32 + ex];
            const int sl = pst[ex] + bef[ex] + before + myrank[q];
            WSP(int, WS_SLOT)[(size_t)r0 * 4 + i] = sl; WSP(float, WS_GSLOT)[sl] = tg[i]; WSP(int, WS_TOKSLOT)[sl] = r0 + (i >> 2); } }
    if (blk == 0) { const int nt = ntl[0]; int* TE = WSP(int, WS_TILEEXP);
        for (int tl = F.tid; tl < nt; tl += 512) { int e = 0; for (int q = 1; q < 32; ++q) if (pst[q] <= tl * 256) e = q; TE[tl] = e; }
        if (F.tid == 0) TE[1023] = nt;
        for (int e = 0; e < 32; ++e) { const int p0 = pst[e] + tot[e], p1 = pst[e] + ((tot[e] + 255) & ~255); for (int sidx = p0 + F.tid; sidx < p1; sidx += 512) WSP(int, WS_TOKSLOT)[sidx] = 0; } }
    __syncthreads();
}

__device__ __forceinline__ void m5_pass(Frame& F, int layer) {
    frame_tid(F);
    const int gw = F.vcu * 8 + F.wave, NGW = F.G * 8, lane = F.lane;
    const float* MOD = WSP(float, WS_MOD);
    const bool last = layer == 3; const int RL = last ? TL : TT;
    f32x4 gg[4], g2v[4], sh[4], sc1[4]; int cb = -1;
    { const float* gp = last ? inptr(F, I_FG) : inptr(F, I_N1G) + (layer + 1) * DM;
#pragma unroll
      for (int j = 0; j < 4; ++j) { gg[j] = *(const f32x4*)(gp + 4 * lane + 256 * j); g2v[j] = gg[j]; sh[j] = gg[j]; sc1[j] = gg[j]; } }
    int4 sC = make_int4(0, 0, 0, 0), sN = sC; f32x4 gC = {0.f, 0.f, 0.f, 0.f}, gN = gC;
    unsigned yw[4][4], ywn[4][4]; f32x4 xv[4], xvn[4];
#pragma unroll
    for (int j = 0; j < 4; ++j) { xv[j] = gg[j]; xvn[j] = gg[j];
#pragma unroll
        for (int k = 0; k < 4; ++k) { yw[j][k] = 0u; ywn[j][k] = 0u; } }
#define M5_SLOTS(S_, G_, r_) do { S_ = *(const int4*)(WSP(int, WS_SLOT) + (size_t)(r_) * 4); G_ = *(const f32x4*)(WSP(float, WS_TOPG) + (size_t)(r_) * 4); } while (0)
#define M5_DATA(Y_, X_, S_, r_) do { const int sl_[4] = {S_.x, S_.y, S_.z, S_.w}; \
        _Pragma("unroll") for (int j = 0; j < 4; ++j) { const int col = 4 * lane + 256 * j; \
            _Pragma("unroll") for (int k = 0; k < 4; ++k) Y_[j][k] = *(const unsigned*)(WSP(unsigned char, WS_XG) + (size_t)sl_[k] * DM + col); \
            X_[j] = xun4(*(const u32x2*)(WSP(bf16_t, WS_XLC) + (size_t)(r_) * DM + col)); } } while (0)
    if (gw < RL) { M5_SLOTS(sC, gC, gw); M5_DATA(yw, xv, sC, gw); }
    if (gw + NGW < RL) M5_SLOTS(sN, gN, gw + NGW);
    for (int row = gw; row < RL; row += NGW) {
        const f32x4 gcur = gC;
        if (row + NGW < RL) { M5_DATA(ywn, xvn, sN, row + NGW); gC = gN; }
        if (row + 2 * NGW < RL) M5_SLOTS(sN, gN, row + 2 * NGW);
        const int bi = mod_bidx(row);
        if (bi != cb) { cb = bi; const float* mb = MOD + (size_t)(layer * 5 + bi) * 6144; const float* mn = MOD + (size_t)((last ? layer : layer + 1) * 5 + bi) * 6144;
#pragma unroll
            for (int j = 0; j < 4; ++j) { const int col = 4 * lane + 256 * j; g2v[j] = *(const f32x4*)(mb + 5 * 1024 + col); sh[j] = *(const f32x4*)(mn + col); sc1[j] = *(const f32x4*)(mn + 1024 + col) + 1.0f; } }
        const float gk[4] = {gcur.x * (1.0f / YS_SCALE), gcur.y * (1.0f / YS_SCALE), gcur.z * (1.0f / YS_SCALE), gcur.w * (1.0f / YS_SCALE)};
        bf16_t* xr = WSP(bf16_t, WS_XLC) + (size_t)row * DM;
        f32x4 v[4];
#pragma unroll
        for (int j = 0; j < 4; ++j) { f32x4 y = {0.f, 0.f, 0.f, 0.f};
#pragma unroll
            for (int k = 0; k < 4; ++k) { const unsigned w = yw[j][k];
                y += (f32x4){__builtin_amdgcn_cvt_f32_fp8(w, 0), __builtin_amdgcn_cvt_f32_fp8(w, 1), __builtin_amdgcn_cvt_f32_fp8(w, 2), __builtin_amdgcn_cvt_f32_fp8(w, 3)} * gk[k]; }
            v[j] = xv[j] + g2v[j] * y; }
        if (!last) {
#pragma unroll
            for (int j = 0; j < 4; ++j) *(u32x2*)(xr + 4 * lane + 256 * j) = xpk4(v[j]);
            norm_mod_store_r(v, lane, gg, sh, sc1, WSP(unsigned char, WS_HB) + (size_t)row * DM);
        } else {
            float s = 0.f;
#pragma unroll
            for (int j = 0; j < 4; ++j) s += (v[j].x * v[j].x + v[j].y * v[j].y) + (v[j].z * v[j].z + v[j].w * v[j].w);
            const float rstd = 1.0f / sqrtf(wave_sum(s) * (1.0f / DM) + NORM_EPS);
#pragma unroll
            for (int j = 0; j < 4; ++j) { const int col = 4 * lane + 256 * j; *(f32x4*)(F.out + (size_t)row * DM + col) = (v[j] * rstd) * gg[j]; }
        }
#pragma unroll
        for (int j = 0; j < 4; ++j) { xv[j] = xvn[j];
#pragma unroll
            for (int k = 0; k < 4; ++k) yw[j][k] = ywn[j][k]; }
    }
#undef M5_SLOTS
#undef M5_DATA
}

constexpr int NPH_PAIR = 22, NPH = 2 + 2 * NPH_PAIR;

__device__ __forceinline__ void moe_gemm1(Frame& F, int layer) {
    const int* TE = WSP(int, WS_TILEEXP);
    LAS int* tel = (LAS int*)(F.lds + LDSCTL_OFF + 4096);
    { const int tz = opaque_tid(); tel[tz] = TE[tz]; tel[512 + tz] = TE[512 + tz]; __syncthreads(); }
    pg8::MoeOrder S; S.A = (const char*)WSP(unsigned char, WS_HB); S.W = (const char*)(WSP(unsigned char, WS_W1) + (size_t)layer * 32 * 2048 * 1024); S.tile_exp = tel; S.tokslot = WSP(int, WS_TOKSLOT);
    S.lda2 = 1024; S.ldb2 = 1024; S.wstride = 2048u * 1024u; S.ntiles = __builtin_amdgcn_readfirstlane(TE[1023]); S.nN = 8; S.G = F.G; S.c = blockIdx.x;
    pg8::EpiSwiglu E{WSP(unsigned char, WS_HA), inptr(F, I_B1) + (size_t)layer * 32 * 2048};
    pg8::gemm_phase<pg8::EpiSwiglu, pg8::MoeOrder, true, true>(F.lds, 512, 1024, 1024, S, E);
}
__device__ __forceinline__ void moe_gemm2(Frame& F, int layer) {
    const int* TE = WSP(int, WS_TILEEXP);
    LAS int* tel = (LAS int*)(F.lds + LDSCTL_OFF + 4096);
    { const int tz = opaque_tid(); tel[tz] = TE[tz]; tel[512 + tz] = TE[512 + tz]; __syncthreads(); }
    pg8::MoeOrder S; S.A = (const char*)WSP(unsigned char, WS_HA); S.W = (const char*)(WSP(unsigned char, WS_W2) + (size_t)layer * 32 * 1024 * 1024); S.tile_exp = tel; S.tokslot = nullptr;
    S.lda2 = 1024; S.ldb2 = 1024; S.wstride = 1024u * 1024u; S.ntiles = __builtin_amdgcn_readfirstlane(TE[1023]); S.nN = 4; S.G = F.G; S.c = blockIdx.x;
    pg8::EpiGate E{WSP(unsigned char, WS_XG), inptr(F, I_B2) + (size_t)layer * 32 * 1024};
    pg8::gemm_phase<pg8::EpiGate, pg8::MoeOrder, true>(F.lds, 512, 1024, 1024, S, E);
}
__device__ __forceinline__ void dense_gemm_bf16(Frame& F, const bf16_t* A, size_t lda2, const bf16_t* Bt, int N, int K, bf16_t* O, int ldc) {
    pg8::DenseOrder S; S.init(A, lda2, Bt, (size_t)K * 2, TT, N, F.G, blockIdx.x);
    pg8::EpiBf16 E{O, ldc, 1.0f};
    pg8::gemm_phase<pg8::EpiBf16, pg8::DenseOrder>(F.lds, K, lda2, (size_t)K * 2, S, E);
}
__device__ __forceinline__ void dense_gemm_f8(Frame& F, const unsigned char* A8, const unsigned char* Bt8, int N, int K8, bf16_t* O, int ldc) {
    pg8::DenseOrder S; S.init(A8, (size_t)K8, Bt8, (size_t)K8, TT, N, F.G, blockIdx.x);
    pg8::EpiBf16 E{O, ldc, 1.0f / W8_SCALE};
    pg8::gemm_phase<pg8::EpiBf16, pg8::DenseOrder, true>(F.lds, K8 / 2, (size_t)K8, (size_t)K8, S, E);
}
__device__ __forceinline__ void outproj_gemm(Frame& F, const unsigned char* Bt8, int layer, int nrows) {
    pg8::DenseOrder S; S.init(WSP(unsigned char, WS_AO), 1024, Bt8, 1024, nrows, 1024, F.G, blockIdx.x);
    pg8::EpiResid E{WSP(bf16_t, WS_XLC), WSP(float, WS_MOD) + (size_t)layer * 5 * 6144 + 2 * 1024, 1.0f / W8_SCALE};
    pg8::gemm_phase<pg8::EpiResid, pg8::DenseOrder, true>(F.lds, 512, 1024, 1024, S, E);
}

__global__ void __launch_bounds__(512, 2) fwd(Args args) {
    extern __shared__ __attribute__((aligned(16))) unsigned char lds_raw[];
    Frame F;
    F.lds = (LAS unsigned char*)lds_raw;
    F.tid = threadIdx.x; F.lane = F.tid & 63; F.wave = __builtin_amdgcn_readfirstlane(F.tid >> 6);
    F.G = gridDim.x; { const int bx = blockIdx.x; F.vcu = (F.G % 8 == 0) ? (bx % 8) * (F.G / 8) + bx / 8 : bx; }
    F.out = args.out; F.ws = args.ws;
    volatile LAS unsigned* MISC = (volatile LAS unsigned*)(F.lds + LDSCTL_OFF);
    if (F.tid < 64) MISC[F.tid] = 0u;
    if (F.tid < 25) { const unsigned long long pv = ((const unsigned long long*)__builtin_amdgcn_kernarg_segment_ptr())[F.tid]; MISC[64 + 2 * F.tid] = (unsigned)pv; MISC[65 + 2 * F.tid] = (unsigned)(pv >> 32); }
    __syncthreads();
    unsigned* ctl = (unsigned*)(F.ws + WS_CTL);
#if !MK_PER_PHASE
    XcdBarrier bar = xcd_barrier_post(ctl + CW_BAR, MISC + 8);
#define GRID_BAR() xcd_barrier(bar)
#else
#define GRID_BAR() do { } while (0)
#endif
    const int lo = args.ph_lo, hi = args.ph_hi;
    int pid = 0;
    enum { CNT0 = __COUNTER__ + 1 };
#ifndef PHMASK
#define PHMASK 0xFFFFFFFFull
#endif
#ifndef REPMASK
#define REPMASK 0ull
#endif
#define PHASE_BEGIN { const int site_ = __COUNTER__ - CNT0; const int nrep_ = 1 + (int)(((unsigned long long)REPMASK >> site_) & 1ull); \
    if ((((unsigned long long)PHMASK >> site_) & 1ull) && lo <= pid && pid < hi) { for (int rep_ = 0; rep_ < nrep_; ++rep_) {
#define PHASE_END if (rep_ + 1 < nrep_ || pid + 1 < hi) GRID_BAR(); } } ++pid; }

    PHASE_BEGIN pro_a(F); PHASE_END
    PHASE_BEGIN pro_b(F); PHASE_END

    for (int lp = 0; lp < 2; ++lp) {
        { const int layer = 2 * lp, li = lp;
        PHASE_BEGIN dense_gemm_f8(F, WSP(unsigned char, WS_HB), WSP(unsigned char, WS_WINE) + (size_t)li * 2048 * 1024, 2048, 1024, WSP(bf16_t, WS_PB), EV_LD); PHASE_END
        PHASE_BEGIN e2_pass(F, li); PHASE_END
        PHASE_BEGIN
            dense_gemm_bf16(F, WSP(bf16_t, WS_PB) + 768, (size_t)EV_LD * 2, WSP(bf16_t, WS_WUQ) + (size_t)li * 768 * 768, 768, 768, WSP(bf16_t, WS_QB), 768);
            dense_gemm_bf16(F, WSP(bf16_t, WS_PB) + 1536, (size_t)EV_LD * 2, WSP(bf16_t, WS_WUKV) + (size_t)li * 1024 * 256, 1024, 256, WSP(bf16_t, WS_KVB), 1024);
        PHASE_END
        PHASE_BEGIN
            for (int rr_ = 0; rr_ < 1 + (int)(((unsigned long long)REPMASK >> 40) & 1ull); ++rr_)
            for (int u = F.vcu; u < 1024 + 32; u += F.G) {
                att::UMla U; U.QB = WSP(bf16_t, WS_QB); U.KVB = WSP(bf16_t, WS_KVB); U.PB = WSP(bf16_t, WS_PB); U.AO = WSP(bf16_t, WS_AO); U.R32 = WSP(f32x2, WS_ROPE32);
                if (u < 1024) { const int bh = u >> 5; U.b = bh >> 3; U.h = bh & 7; U.qblk = u & 31; U.ctxq = false; }
                else { const int v = u - 1024; U.b = v >> 3; U.h = v & 7; U.qblk = 0; U.ctxq = true; }
                att::attn_unit<att::UMla>(F.lds, F.ws, U);
            }
            for (int rr_ = 0; rr_ < 1 + (int)(((unsigned long long)REPMASK >> 41) & 1ull); ++rr_)
            for (int u = F.vcu; u < 1024 + 32; u += F.G) {
                att::UWin U; U.PB = WSP(bf16_t, WS_PB); U.AO = WSP(bf16_t, WS_AO); U.sink = inptr(F, I_EVSINK) + li * 8;
                if (u < 1024) { U.b = u >> 8; U.kvh = (u >> 7) & 1; U.j = u & 127; U.ctxq = false; }
                else { const int v = u - 1024; U.b = v >> 3; U.kvh = (v >> 2) & 1; U.j = v & 3; U.ctxq = true; }
                U.init();
                att::attn_unit<att::UWin>(F.lds, F.ws, U);
            }
        PHASE_END
        PHASE_BEGIN outproj_gemm(F, WSP(unsigned char, WS_WOUTE) + (size_t)li * 1024 * 1024, layer, TT); PHASE_END
        PHASE_BEGIN m1a_pass(F, layer); PHASE_END
        PHASE_BEGIN m1b_gemm(F, layer); PHASE_END
        PHASE_BEGIN m1c_pass(F); PHASE_END
        PHASE_BEGIN m2_pass(F); PHASE_END
        PHASE_BEGIN moe_gemm1(F, layer); PHASE_END
        PHASE_BEGIN moe_gemm2(F, layer); PHASE_END
        PHASE_BEGIN m5_pass(F, layer); PHASE_END
        }
        { const int layer = 2 * lp + 1, li = lp;
        PHASE_BEGIN dense_gemm_f8(F, WSP(unsigned char, WS_HB), WSP(unsigned char, WS_WINO) + (size_t)li * 3072 * 1024, 3072, 1024, WSP(bf16_t, WS_PB), OD_LD); PHASE_END
        PHASE_BEGIN
            for (int u = F.vcu; u < 2048 + (layer == 3 ? 0 : 64); u += F.G) {
                att::UNa U; U.PB = WSP(bf16_t, WS_PB); U.AO = WSP(bf16_t, WS_AO);
                if (u < 2048) { U.b = u >> 9; U.h = (u >> 5) & 15; U.G = u & 31; U.ctxq = false; }
                else { const int v = u - 2048; U.b = v >> 4; U.h = v & 15; U.G = 0; U.ctxq = true; }
                U.rpbh = inptr(F, I_ODRPB) + (size_t)(li * 16 + U.h) * 15 * 31;
                U.init();
                att::attn_unit<att::UNa>(F.lds, F.ws, U);
            }
        PHASE_END
        PHASE_BEGIN outproj_gemm(F, WSP(unsigned char, WS_WOUTO) + (size_t)li * 1024 * 1024, layer, layer == 3 ? TL : TT); PHASE_END
        PHASE_BEGIN m1a_pass(F, layer); PHASE_END
        PHASE_BEGIN m1b_gemm(F, layer); PHASE_END
        PHASE_BEGIN m1c_pass(F); PHASE_END
        PHASE_BEGIN m2_pass(F); PHASE_END
        PHASE_BEGIN moe_gemm1(F, layer); PHASE_END
        PHASE_BEGIN moe_gemm2(F, layer); PHASE_END
        PHASE_BEGIN m5_pass(F, layer); PHASE_END
        }
    }
}


#if MK_CHECK
constexpr int CW_CHK = 8192;
constexpr size_t WS_CHK = 1968 * MiB;
constexpr size_t WS_CHK_CNT = WS_CHK + 136 * MiB;
constexpr int IDS_PER_PAIR = 26, ID_PROB = 53, NID = 54;
struct CArgs { const float* in[25]; float* out; unsigned char* ws; int layer, id; };
#define CWS(T, off) ((T*)(A.ws + (off)))
__device__ __forceinline__ unsigned hsh(unsigned x) { x ^= x >> 16; x *= 0x7feb352du; x ^= x >> 15; x *= 0x846ca68bu; x ^= x >> 16; return x; }
__device__ __forceinline__ float bfv(const bf16_t* p) { return __builtin_bit_cast(float, (unsigned)(*p) << 16); }
__device__ __forceinline__ float f8v(const unsigned char* p) { const unsigned b = *p; const unsigned e = (b >> 3) & 15u, m = b & 7u; const float v = e ? __builtin_bit_cast(float, ((e + 120u) << 23) | (m << 20)) : (float)m * 0.001953125f; return (b & 128u) ? -v : v; }
__device__ __forceinline__ float rbf(float a) { return __builtin_bit_cast(float, f2bf(a) << 16); }
__device__ __forceinline__ void chk_acc(const CArgs& A, float e2, float r2) {
    __shared__ float sh[2][8];
    e2 = wave_sum(e2); r2 = wave_sum(r2);
    const int w = threadIdx.x >> 6;
    if ((threadIdx.x & 63) == 0) { sh[0][w] = e2; sh[1][w] = r2; }
    __syncthreads();
    if (threadIdx.x == 0) { float a = 0.f, b = 0.f; for (int i = 0; i < (int)(blockDim.x >> 6); ++i) { a += sh[0][i]; b += sh[1][i]; }
        float* acc = (float*)(A.ws + WS_CTL) + CW_CHK + 2 * A.id; atomicAdd(acc, a); atomicAdd(acc + 1, b); }
    __syncthreads();
}
__device__ __forceinline__ void sincos_d(float a, float& s, float& c) {
    double x = (double)a; const double tp = 6.283185307179586476925; double k = __builtin_rint(x / tp); double r = x - k * tp; double r2 = r * r;
    double sp = r, cp = 1.0, ts = r, tc = 1.0;
#pragma unroll
    for (int i = 1; i < 14; ++i) { tc *= -r2 / (double)((2 * i - 1) * (2 * i)); cp += tc; ts *= -r2 / (double)((2 * i) * (2 * i + 1)); sp += ts; }
    s = (float)sp; c = (float)cp;
}
__device__ __forceinline__ float invfreq(int i, int half) { return __builtin_amdgcn_exp2f(-((float)i / (float)half) * 13.287712379549449f); }
__device__ __forceinline__ float nsilu(float c) { return c / (1.0f + __expf(-c)); }
__device__ float naive_mod(const CArgs& A, int layer, int bidx, int n) {
    const float* cv = bidx < 4 ? A.in[I_C] + bidx * 1024 : A.in[I_CCTX]; const float* W = A.in[I_ADAW] + (size_t)layer * 1024 * 6144 + n;
    float acc = 0.f; for (int k = 0; k < 1024; ++k) acc += nsilu(cv[k]) * W[(size_t)k * 6144];
    return acc + A.in[I_ADAB][layer * 6144 + n];
}
__device__ __forceinline__ int srow(unsigned s) { return (s & 3) == 0 ? TL + (int)(hsh(s * 3 + 1) % TC) : (int)(hsh(s * 3 + 1) % TL); }
__global__ void chk_mark(CArgs A) { if (threadIdx.x == 0) ((float*)(A.ws + WS_CTL))[CW_CHK + 2 * A.id + 1] = 1.0f; }

__global__ void chk_gemm(CArgs A, const bf16_t* X, int ldx, const float* W, int ldw, int K, int ncol, const bf16_t* O, int ldo) {
    const int row = srow(blockIdx.x); const int col = (int)((hsh(blockIdx.x * 977 + 5) + 7u * threadIdx.x) % (unsigned)ncol);
    float ref = 0.f; for (int k = 0; k < K; ++k) ref += (ldx ? bfv(X + (size_t)row * ldx + k) : f8v((const unsigned char*)X + (size_t)row * 1024 + k)) * W[(size_t)k * ldw + col];
    const float got = bfv(O + (size_t)row * ldo + col);
    chk_acc(A, (got - ref) * (got - ref), ref * ref);
}
__global__ void chk_e2(CArgs A) {
    __shared__ float P[EV_IN]; __shared__ float red[2];
    const int li = A.layer >> 1, row = srow(blockIdx.x), t = threadIdx.x;
    const float* W = A.in[I_EVWIN] + (size_t)li * 1024 * EV_IN; const unsigned char* h = CWS(unsigned char, WS_HB) + (size_t)row * DM;
    for (int c = t; c < EV_IN; c += 256) { float a = 0.f; for (int k = 0; k < 1024; ++k) a += f8v(h + k) * W[(size_t)k * EV_IN + c]; P[c] = rbf(a); }
    __syncthreads();
    if (t == 0) { float a = 0.f; for (int c = 768; c < 1536; ++c) a += P[c] * P[c]; red[0] = 1.0f / sqrtf(a / 768.0f + NORM_EPS); float b = 0.f; for (int c = 1536; c < 1792; ++c) b += P[c] * P[c]; red[1] = 1.0f / sqrtf(b / 256.0f + NORM_EPS); }
    __syncthreads();
    const bool lat = row < TL; const int tt = row & (SEQ - 1), prow = tt >> 6, pcol = tt & 63;
    float e2 = 0.f, r2 = 0.f;
    for (int c = t; c < EV_IN; c += 256) {
        float ref = P[c];
        if (c < 640 && lat) { const int d = c & 63, dd = d & 31, i = dd & 15; const bool first = dd < 16; const float y = P[first ? c + 16 : c - 16];
            float sn, cs; sincos_d((float)((d < 32) ? prow : pcol) * invfreq(i, 16), sn, cs); ref = first ? P[c] * cs - y * sn : P[c] * cs + y * sn; }
        else if (c >= 768 && c < 1536) ref = P[c] * red[0] * A.in[I_EVQNG][li * 768 + c - 768];
        else if (c >= 1536 && c < 1792) ref = P[c] * red[1] * A.in[I_EVKVNG][li * 256 + c - 1536];
        else if (c >= 1792 && lat) { const int d = c - 1792, dd = d & 15, i = dd & 7; const bool first = dd < 8; const float y = P[first ? c + 8 : c - 8];
            float sn, cs; sincos_d((float)((d < 16) ? prow : pcol) * invfreq(i, 8), sn, cs); ref = first ? P[c] * cs - y * sn : P[c] * cs + y * sn; }
        const float got = bfv(CWS(bf16_t, WS_PB) + (size_t)row * EV_LD + c);
        e2 += (got - ref) * (got - ref); r2 += ref * ref;
    }
    chk_acc(A, e2, r2);
}
__global__ void chk_e4(CArgs A) {
    __shared__ float Q[768];
    const int li = A.layer >> 1, row = (int)(hsh(blockIdx.x * 3 + 1) % TL), t = threadIdx.x;
    const float* W = A.in[I_EVWUQ] + (size_t)li * 768 * 768; const bf16_t* x = CWS(bf16_t, WS_PB) + (size_t)row * EV_LD + 768;
    for (int c = t; c < 768; c += 256) { float a = 0.f; for (int k = 0; k < 768; ++k) a += bfv(x + k) * W[(size_t)k * 768 + c]; Q[c] = rbf(a); }
    __syncthreads();
    const int tt = row & (SEQ - 1), prow = tt >> 6, pcol = tt & 63;
    float e2 = 0.f, r2 = 0.f;
    for (int c = t; c < 768; c += 256) { const int d = c % 96; float ref = Q[c];
        if (d >= 64) { const int dr = d - 64, dd = dr & 15, i = dd & 7; const bool first = dd < 8; const float y = Q[first ? c + 8 : c - 8];
            float sn, cs; sincos_d((float)((dr < 16) ? prow : pcol) * invfreq(i, 8), sn, cs); ref = first ? Q[c] * cs - y * sn : Q[c] * cs + y * sn; }
        const float got = bfv(CWS(bf16_t, WS_QB) + (size_t)row * 768 + c); e2 += (got - ref) * (got - ref); r2 += ref * ref; }
    chk_acc(A, e2, r2);
}
__global__ void chk_attn(CArgs A, int kind, int ctxq) {
    __shared__ float sc[8448]; __shared__ float redm[4], reds[4], qs[96];
    const int li = A.layer >> 1, t = threadIdx.x; const unsigned s = blockIdx.x;
    const int b = hsh(s * 7 + 1) % NB, head = hsh(s * 7 + 2) % (kind == 2 ? 16 : 8);
    const int pos = ctxq ? hsh(s * 7 + 3) % CTXL : ((s & 7) == 0 ? (hsh(s) % 200) : (s & 7) == 1 ? SEQ - 1 - (hsh(s) % 200) : hsh(s * 7 + 3) % SEQ);
    const size_t qrow = ctxq ? (size_t)(TL + b * CTXL + pos) : (size_t)(b * SEQ + pos);
    int nlat = 0, wlo = 0, r = pos >> 6, c = pos & 63, r0 = 0, c0 = 0;
    if (!ctxq) {
        if (kind == 0) { wlo = pos - 128 < 0 ? 0 : pos - 128; const int whi = pos + 128 > SEQ - 1 ? SEQ - 1 : pos + 128; nlat = whi - wlo + 1; }
        else if (kind == 1) nlat = SEQ;
        else { r0 = r - 4; r0 = r0 < 0 ? 0 : (r0 > 120 ? 120 : r0); c0 = c - 8; c0 = c0 < 0 ? 0 : (c0 > 48 ? 48 : c0); nlat = 128; }
    }
    const int nk = nlat + CTXL;
    const bf16_t* PB = CWS(bf16_t, WS_PB); const bf16_t* KVB = CWS(bf16_t, WS_KVB);
    const int pld = kind == 2 ? OD_LD : EV_LD, dqk = kind == 1 ? 96 : 64;
    const bf16_t* q = kind == 1 ? CWS(bf16_t, WS_QB) + qrow * 768 + 96 * head : PB + qrow * pld + 64 * head;
    const float scale = kind == 1 ? 0.10206207261596577f : 0.125f;
    const bool has_sink = kind == 0; const float sinkv = has_sink ? A.in[I_EVSINK][li * 8 + head] : 0.f;
    const float* rp = A.in[I_ODRPB] + (size_t)(li * 16 + head) * 15 * 31;
    if (t < dqk) qs[t] = bfv(q + t);
    __syncthreads();
    if (kind == 1 && !ctxq) { float rv = 0.f;
        if (t >= 64 && t < 96) { const int dr = t - 64, dd = dr & 15, i = dd & 7; const bool first = dd < 8; const float y = qs[first ? t + 8 : t - 8];
            float sn, cs; sincos_d((float)((dr < 16) ? r : c) * invfreq(i, 8), sn, cs); rv = rbf(first ? qs[t] * cs - y * sn : qs[t] * cs + y * sn); }
        __syncthreads();
        if (t >= 64 && t < 96) qs[t] = rv;
        __syncthreads(); }
#define KROW(i) ((i) >= nlat ? (size_t)(TL + b * CTXL + ((i) - nlat)) : kind == 0 ? (size_t)(b * SEQ + wlo + (i)) : kind == 1 ? (size_t)(b * SEQ + (i)) : (size_t)(b * SEQ + (r0 + ((i) >> 4)) * 64 + c0 + ((i) & 15)))
    float mx = has_sink ? sinkv : -3e38f;
    for (int i = t; i < nk; i += 256) { const size_t kr = KROW(i); float a = 0.f;
        if (kind == 0) { const bf16_t* k = PB + kr * EV_LD + 512 + 64 * (head >> 2); for (int d = 0; d < 64; ++d) a += qs[d] * bfv(k + d); }
        else if (kind == 1) { const bf16_t* k = KVB + kr * 1024 + 128 * head; for (int d = 0; d < 64; ++d) a += qs[d] * bfv(k + d); const bf16_t* k2 = PB + kr * EV_LD + 1792; for (int d = 0; d < 32; ++d) a += qs[64 + d] * bfv(k2 + d); }
        else { const bf16_t* k = PB + kr * OD_LD + 1024 + 64 * head; for (int d = 0; d < 64; ++d) a += qs[d] * bfv(k + d); }
        a *= scale;
        if (kind == 2 && i < nlat) { const int kr_ = r0 + (i >> 4), kc_ = c0 + (i & 15); a += rp[(kr_ - r + 7) * 31 + (kc_ - c + 15)]; }
        sc[i] = a; mx = fmaxf(mx, a); }
    for (int o = 1; o < 64; o <<= 1) mx = fmaxf(mx, __shfl_xor(mx, o));
    if ((t & 63) == 0) redm[t >> 6] = mx;
    __syncthreads();
    mx = fmaxf(fmaxf(redm[0], redm[1]), fmaxf(redm[2], redm[3]));
    float sm = 0.f;
    for (int i = t; i < nk; i += 256) { const float p = __expf(sc[i] - mx); sc[i] = p; sm += p; }
    sm = wave_sum(sm);
    if ((t & 63) == 0) reds[t >> 6] = sm;
    __syncthreads();
    sm = reds[0] + reds[1] + reds[2] + reds[3] + (has_sink ? __expf(sinkv - mx) : 0.f);
    float e2 = 0.f, r2 = 0.f;
    if (t < 64) { float o = 0.f;
        for (int i = 0; i < nk; ++i) { const size_t kr = KROW(i); const bf16_t* v = kind == 0 ? PB + kr * EV_LD + 640 + 64 * (head >> 2) : kind == 1 ? KVB + kr * 1024 + 128 * head + 64 : PB + kr * OD_LD + 2048 + 64 * head; o += sc[i] * bfv(v + t); }
        o /= sm; const unsigned char* got = CWS(unsigned char, WS_AO) + qrow * 1024 + (kind == 1 ? 512 : 0) + 64 * head; const float g = f8v(got + t); e2 = (g - o) * (g - o); r2 = o * o; }
#undef KROW
    chk_acc(A, e2, r2);
}
__global__ void chk_outproj(CArgs A, const float* W) {
    const int row = A.layer == 3 ? (int)(hsh(blockIdx.x * 3 + 1) % TL) : srow(blockIdx.x), c = (int)((hsh(blockIdx.x * 977 + 5) + 7u * threadIdx.x) % 1024u);
    float a = 0.f; for (int k = 0; k < 1024; ++k) a += f8v(CWS(unsigned char, WS_AO) + (size_t)row * 1024 + k) * W[(size_t)k * 1024 + c];
    const float gate = naive_mod(A, A.layer, row < TL ? (row >> 13) : 4, 2 * 1024 + c);
    const float ref = CWS(float, WS_CHK)[(size_t)row * DM + c] + gate * a, got = CWS(float, WS_XLC)[(size_t)row * DM + c];
    chk_acc(A, (got - ref) * (got - ref), (gate * a) * (gate * a));
}
__global__ void chk_norm_router(CArgs A, int which, const bf16_t* hbuf, int hld) {
    __shared__ float hv[1024]; __shared__ float red[4]; __shared__ float lg[32]; __shared__ int ste[4]; __shared__ float stv[4];
    const int row = srow(blockIdx.x), t = threadIdx.x, bidx = row < TL ? (row >> 13) : 4;
    const float* x = CWS(float, WS_XLC) + (size_t)row * DM;
    float s = 0.f; for (int c = t; c < 1024; c += 256) s += x[c] * x[c];
    s = wave_sum(s); if ((t & 63) == 0) red[t >> 6] = s; __syncthreads();
    const float rstd = 1.0f / sqrtf((red[0] + red[1] + red[2] + red[3]) / 1024.0f + NORM_EPS);
    const float* g = (which == 0 ? A.in[I_N1G] : A.in[I_N2G]) + A.layer * DM;
    float e2 = 0.f, r2 = 0.f;
    for (int c = t; c < 1024; c += 256) { const float sh = naive_mod(A, A.layer, bidx, which * 1024 + c), scl = naive_mod(A, A.layer, bidx, (which + 1) * 1024 + c);
        const float h = x[c] * rstd * g[c] * (1.0f + scl) + sh; hv[c] = h; const float got = hld ? bfv(hbuf + (size_t)row * hld + c) : f8v((const unsigned char*)hbuf + (size_t)row * DM + c); e2 += (got - h) * (got - h); r2 += h * h; }
    __syncthreads();
    if (which == 3) {
        if (t < 32) { const float* rw = A.in[I_RW] + (size_t)A.layer * 1024 * 32; float a = 0.f; for (int k = 0; k < 1024; ++k) a += hv[k] * rw[k * 32 + t]; lg[t] = a + A.in[I_RB][A.layer * 32 + t]; }
        __syncthreads();
        if (t == 0) { unsigned used = 0u;
            for (int k = 0; k < 4; ++k) { float bv = -3e38f; int bi = 0; for (int e = 0; e < 32; ++e) if (!((used >> e) & 1u) && lg[e] > bv) { bv = lg[e]; bi = e; } used |= 1u << bi; ste[k] = bi; stv[k] = bv; }
            float den = 0.f; for (int k = 0; k < 4; ++k) den += __expf(stv[k] - stv[0]);
            for (int k = 0; k < 4; ++k) { const float gr = __expf(stv[k] - stv[0]) / den; const int ge = CWS(int, WS_TOPE)[(size_t)row * 4 + k]; const float gg = CWS(float, WS_TOPG)[(size_t)row * 4 + k];
                const float d = (ge == ste[k]) ? (gg - gr) : 1.0f; e2 += 1000.f * d * d; r2 += 1000.f * gr * gr; } }
    }
    chk_acc(A, e2, r2);
}
__global__ void chk_slots_count(CArgs A) {
    const int i = blockIdx.x * 256 + threadIdx.x; if (i < TT * 4) { const int sl = CWS(int, WS_SLOT)[i]; if (sl >= 0 && sl < MAXSLOT) atomicAdd(CWS(int, WS_CHK_CNT) + sl, 1); else atomicAdd((float*)(A.ws + WS_CTL) + CW_CHK + 2 * A.id, 1.0f); }
}
__global__ void chk_slots(CArgs A) {
    const int i = blockIdx.x * 256 + threadIdx.x; float e2 = 0.f, r2 = 0.f;
    if (i < MAXSLOT) { const int c = CWS(int, WS_CHK_CNT)[i]; if (c > 1) e2 += 1.f; }
    if (i < 8192) { const unsigned a = hsh(i * 5 + 3) % (unsigned)(TT * 4); const int row = a >> 2, sl = CWS(int, WS_SLOT)[a], e = CWS(int, WS_TOPE)[a];
        if (CWS(int, WS_TILEEXP)[sl >> 8] != e) e2 += 1.f;
        if (CWS(float, WS_GSLOT)[sl] != CWS(float, WS_TOPG)[a]) e2 += 1.f;
        if (CWS(int, WS_TOKSLOT)[sl] != row) e2 += 1.f; r2 += 1.f; }
    chk_acc(A, e2, r2);
}
__global__ void chk_moe(CArgs A, int which) {
    const unsigned a = hsh(blockIdx.x * 5 + 3) % (unsigned)(TT * 4); const int sl = CWS(int, WS_SLOT)[a], e = CWS(int, WS_TILEEXP)[sl >> 8];
    const int c = (int)((hsh(blockIdx.x * 977 + 5) + 7u * threadIdx.x) % 1024u);
    float ref, got;
    if (which == 0) { const float* W = A.in[I_W1] + ((size_t)A.layer * 32 + e) * 1024 * 2048; const unsigned char* x = CWS(unsigned char, WS_HB) + (size_t)(a >> 2) * DM; float g = 0.f, l = 0.f;
        for (int k = 0; k < 1024; ++k) { const float xv = f8v(x + k); g += xv * W[(size_t)k * 2048 + c]; l += xv * W[(size_t)k * 2048 + 1024 + c]; }
        g += A.in[I_B1][((size_t)A.layer * 32 + e) * 2048 + c]; l += A.in[I_B1][((size_t)A.layer * 32 + e) * 2048 + 1024 + c];
        g = fminf(g, 7.f); l = fminf(fmaxf(l, -7.f), 7.f); ref = g / (1.0f + __expf(-1.702f * g)) * (l + 1.0f); got = f8v(CWS(unsigned char, WS_HA) + (size_t)sl * DM + c); }
    else { const float* W = A.in[I_W2] + ((size_t)A.layer * 32 + e) * 1024 * 1024; const unsigned char* x = CWS(unsigned char, WS_HA) + (size_t)sl * DM; float y = 0.f;
        for (int k = 0; k < 1024; ++k) y += f8v(x + k) * W[(size_t)k * 1024 + c];
        ref = y + A.in[I_B2][((size_t)A.layer * 32 + e) * 1024 + c]; got = f8v(CWS(unsigned char, WS_XG) + (size_t)sl * DM + c) * (1.0f / YS_SCALE); }
    chk_acc(A, (got - ref) * (got - ref), ref * ref);
}
__global__ void chk_combine(CArgs A) {
    const int row = srow(blockIdx.x), c = (int)((hsh(blockIdx.x * 977 + 5) + 7u * threadIdx.x) % 1024u);
    float y = 0.f; for (int k = 0; k < 4; ++k) y += CWS(float, WS_TOPG)[(size_t)row * 4 + k] * (1.0f / YS_SCALE) * f8v(CWS(unsigned char, WS_XG) + (size_t)CWS(int, WS_SLOT)[(size_t)row * 4 + k] * DM + c);
    const float gate = naive_mod(A, A.layer, row < TL ? (row >> 13) : 4, 5 * 1024 + c);
    const float ref = CWS(float, WS_CHK)[(size_t)row * DM + c] + gate * y, got = CWS(float, WS_XLC)[(size_t)row * DM + c];
    chk_acc(A, (got - ref) * (got - ref), (gate * y) * (gate * y));
}
__global__ void chk_report(CArgs A) {
    if (threadIdx.x == 0 && blockIdx.x == 0) { const float* acc = (const float*)(A.ws + WS_CTL) + CW_CHK; int bad = 0, bad2 = 0;
        for (int id = NID - 1; id >= 1; --id) { const int q = (id - 1) % IDS_PER_PAIR + 1; const float tol = (id == ID_PROB || (q >= 6 && q <= 10) || q == 18 || q == 19 || q == 20 || q == 1 || q == 2 || q == 17 || q == 13 || q == 14 || q == 16 || q == 23 || q == 24 || q == 26) ? 0.1f : 0.03f;
            const float e2 = acc[2 * id], r2 = acc[2 * id + 1]; if (r2 <= 0.f || !(e2 <= tol * tol * r2)) { bad2 = bad; bad = id; } }
        if (bad) A.out[0] = 1000.0f * (float)bad;
        if (bad2) A.out[1] = 1000.0f * (float)bad2; }
}
static void chk_before(int p, const Args& a, hipStream_t st) {
    const int q = p < 2 ? -1 : (p - 2) % NPH_PAIR;
    if (q == 8 || q == 18) (void)hipMemsetAsync(a.ws + WS_CHK_CNT, 0, (size_t)MAXSLOT * 4, st);
    if (q == 4 || q == 11 || q == 14 || q == 21) (void)hipMemcpyAsync(a.ws + WS_CHK, a.ws + WS_XLC, (size_t)TT * DM * 4, hipMemcpyDeviceToDevice, st);
}
static void chk_after(int p, const Args& a, hipStream_t st) {
    CArgs A{}; for (int i = 0; i < 25; ++i) A.in[i] = a.in[i]; A.out = a.out; A.ws = a.ws;
    const int lp = p < 2 ? 0 : (p - 2) / NPH_PAIR, q = p < 2 ? -1 : (p - 2) % NPH_PAIR, base = IDS_PER_PAIR * lp;
    unsigned char* ws = a.ws; const int le = 2 * lp, lod = 2 * lp + 1;
#define CK(idv, layerv, kern, grid, ...) do { A.id = base + (idv); A.layer = (layerv); hipLaunchKernelGGL(kern, dim3(grid), dim3(256), 0, st, A, ##__VA_ARGS__); } while (0)
#define CK0(idv, layerv, kern, grid) do { A.id = base + (idv); A.layer = (layerv); hipLaunchKernelGGL(kern, dim3(grid), dim3(256), 0, st, A); } while (0)
    if (p == 1) { A.id = ID_PROB; A.layer = 0; hipLaunchKernelGGL(chk_norm_router, dim3(48), dim3(256), 0, st, A, 0, (const bf16_t*)(ws + WS_HB), 0); }
    if (q == 0) CK(1, le, chk_gemm, 64, (const bf16_t*)(ws + WS_HB), 0, a.in[I_EVWIN] + (size_t)lp * 1024 * EV_IN, (int)EV_IN, 1024, (int)EV_IN, (const bf16_t*)(ws + WS_PB), (int)EV_LD);
    if (q == 1) CK0(2, le, chk_e2, 48);
    if (q == 2) { CK(3, le, chk_gemm, 64, (const bf16_t*)(ws + WS_PB) + 768, (int)EV_LD, a.in[I_EVWUQ] + (size_t)lp * 768 * 768, 768, 768, 768, (const bf16_t*)(ws + WS_QB), 768);
                  CK(4, le, chk_gemm, 64, (const bf16_t*)(ws + WS_PB) + 1536, (int)EV_LD, a.in[I_EVWUKV] + (size_t)lp * 256 * 1024, 1024, 256, 1024, (const bf16_t*)(ws + WS_KVB), 1024);
                  CK0(5, le, chk_mark, 1); }
    if (q == 3) { CK(6, le, chk_attn, 96, 0, 0); CK(7, le, chk_attn, 48, 1, 0); CK(8, le, chk_attn, 32, 0, 1); CK(9, le, chk_attn, 32, 1, 1); }
    if (q == 4) CK(10, le, chk_outproj, 48, a.in[I_EVWOUT] + (size_t)lp * 1024 * 1024);
    if (q == 7) CK(11, le, chk_norm_router, 48, 3, (const bf16_t*)(ws + WS_PB), (int)H3_LD);
    if (q == 8) { CK0(12, le, chk_slots_count, (TT * 4 + 255) / 256); CK0(12, le, chk_slots, MAXSLOT / 256); }
    if (q == 9) CK(13, le, chk_moe, 64, 0);
    if (q == 10) CK(14, le, chk_moe, 64, 1);
    if (q == 11) { CK0(15, le, chk_combine, 64); CK(16, le + 1, chk_norm_router, 48, 0, (const bf16_t*)(ws + WS_HB), 0); }
    if (q == 12) CK(17, lod, chk_gemm, 64, (const bf16_t*)(ws + WS_HB), 0, a.in[I_ODWIN] + (size_t)lp * 1024 * 3072, 3072, 1024, 3072, (const bf16_t*)(ws + WS_PB), (int)OD_LD);
    if (q == 13) { CK(18, lod, chk_attn, 96, 2, 0); CK(19, lod, chk_attn, 32, 2, 1); }
    if (q == 14) CK(20, lod, chk_outproj, 48, a.in[I_ODWOUT] + (size_t)lp * 1024 * 1024);
    if (q == 17) CK(21, lod, chk_norm_router, 48, 3, (const bf16_t*)(ws + WS_PB), (int)H3_LD);
    if (q == 18) { CK0(22, lod, chk_slots_count, (TT * 4 + 255) / 256); CK0(22, lod, chk_slots, MAXSLOT / 256); }
    if (q == 19) CK(23, lod, chk_moe, 64, 0);
    if (q == 20) CK(24, lod, chk_moe, 64, 1);
    if (q == 21) { if (lod != 3) { CK0(25, lod, chk_combine, 64); CK(26, lod + 1, chk_norm_router, 48, 0, (const bf16_t*)(ws + WS_HB), 0); } else { CK0(25, lod, chk_mark, 1); CK0(26, lod, chk_mark, 1); } }
    if (p == NPH - 1) { A.id = 0; hipLaunchKernelGGL(chk_report, dim3(1), dim3(64), 0, st, A); }
#undef CK
#undef CK0
}
#endif

extern "C" void kernel_launch(void* const* d_in, const int* in_sizes, int n_in, void* d_out, int out_size, void* d_ws, size_t ws_size, hipStream_t stream) {
    static int grid = 0;
    if (grid == 0) {
        if (n_in != 25 || out_size != TL * DM || ws_size < WS_END) { fprintf(stderr, "kernel_launch: unexpected shapes (n_in %d, out %d, ws %zu < %zu); nothing launched\n", n_in, out_size, ws_size, (size_t)WS_END); grid = -1; return; }
        int dev = 0, cus = 0, per_cu = 0;
        if (hipGetDevice(&dev) != hipSuccess || hipDeviceGetAttribute(&cus, hipDeviceAttributeMultiprocessorCount, dev) != hipSuccess) { grid = -1; return; }
        if (hipFuncSetAttribute((const void*)fwd, hipFuncAttributeMaxDynamicSharedMemorySize, LDS_BYTES) != hipSuccess) { fprintf(stderr, "kernel_launch: hipFuncSetAttribute failed\n"); grid = -1; return; }
        if (hipOccupancyMaxActiveBlocksPerMultiprocessor(&per_cu, (const void*)fwd, 512, LDS_BYTES) != hipSuccess || per_cu < 1) { fprintf(stderr, "kernel_launch: occupancy query says %d blocks per CU\n", per_cu); }
        (void)hipGetLastError();
        grid = cus;
    }
    if (grid < 0) return;
    (void)hipMemsetAsync((char*)d_ws + WS_CTL, 0, CTL_ZERO_BYTES, stream);
    Args a{};
    for (int i = 0; i < 25; ++i) a.in[i] = (const float*)d_in[i];
    a.out = (float*)d_out; a.ws = (unsigned char*)d_ws;
#if MK_PER_PHASE
    for (int p = 0; p < NPH; ++p) {
#if MK_CHECK
        chk_before(p, a, stream);
#endif
        a.ph_lo = p; a.ph_hi = p + 1; hipLaunchKernelGGL(fwd, dim3(grid), dim3(512), LDS_BYTES, stream, a);
#if MK_CHECK
        chk_after(p, a, stream);
#endif
    }
#else
    a.ph_lo = 0; a.ph_hi = NPH;
    hipLaunchKernelGGL(fwd, dim3(grid), dim3(512), LDS_BYTES, stream, a);
#endif
    const hipError_t le = hipPeekAtLastError();
    if (le != hipSuccess) fprintf(stderr, "kernel_launch: launch failed: %s\n", hipGetErrorName(le));
}
```

```cpp
#include <hip/hip_runtime.h>
#include <cstdio>
#include <cstdint>

#ifndef MK_CHECK
#define MK_CHECK 0
#endif
#ifndef MK_PER_PHASE
#define MK_PER_PHASE MK_CHECK
#endif

#define LAS __attribute__((address_space(3)))
#define GAS __attribute__((address_space(1)))
typedef unsigned short bf16_t;
typedef short bf16x8 __attribute__((ext_vector_type(8)));
typedef short s16x4 __attribute__((ext_vector_type(4)));
typedef float f32x2 __attribute__((ext_vector_type(2)));
typedef float f32x4 __attribute__((ext_vector_type(4)));
typedef float f32x16 __attribute__((ext_vector_type(16)));
typedef unsigned u32x2 __attribute__((ext_vector_type(2)));
typedef unsigned u32x4 __attribute__((ext_vector_type(4)));

constexpr int DM = 1024, NB = 4, SEQ = 8192, TL = NB * SEQ, CTXL = 256, TC = NB * CTXL, TT = TL + TC;
constexpr int EV_LD = 2048, OD_LD = 3072;
constexpr int EV_IN = 1824;
constexpr int NEXP = 32, DEXP = 1024;
constexpr int MAXSLOT = 143360, MAXTILE = 560;
constexpr float NORM_EPS = 1e-6f;
constexpr float LOG2E = 1.4426950408889634f;

constexpr size_t MiB = 1u << 20;
constexpr size_t WS_CTL = 0, CTL_ZERO_BYTES = 1 * MiB;
constexpr size_t WS_MOD = 1 * MiB;
constexpr size_t WS_ROPE64 = 1 * MiB + 512 * 1024;
constexpr size_t WS_ROPE32 = WS_ROPE64 + 16384;
constexpr size_t WS_TOPE = 2 * MiB;
constexpr size_t WS_TOPG = WS_TOPE + 540672;
constexpr size_t WS_SLOT = WS_TOPG + 540672;
constexpr size_t WS_HIST = WS_SLOT + 540672;
constexpr size_t WS_TILEEXP = WS_HIST + 131072;
constexpr size_t WS_GSLOT = WS_TILEEXP + 4096;
constexpr size_t WS_TOKSLOT = WS_GSLOT + (size_t)MAXSLOT * 4;
static_assert(WS_TOKSLOT + (size_t)MAXSLOT * 4 <= 6 * MiB, "route map");
constexpr size_t WS_WINE = 6 * MiB, WS_WUQ = 14 * MiB, WS_WUKV = 17 * MiB, WS_WOUTE = 18 * MiB, WS_WINO = 22 * MiB, WS_WOUTO = 34 * MiB;
constexpr size_t WS_W1 = 38 * MiB, WS_W2 = 550 * MiB;
constexpr size_t WS_XLC = 806 * MiB, WS_HB = 938 * MiB, WS_PB = 1004 * MiB, WS_QB = 1202 * MiB, WS_KVB = 1252 * MiB, WS_AO = 1318 * MiB;
constexpr size_t WS_XG = 1384 * MiB, WS_HA = 1664 * MiB, WS_RWT = 1944 * MiB, WS_LOGIT = 1952 * MiB, WS_END = 1960 * MiB;
constexpr size_t WS_LOGIT12 = WS_XG + 160 * MiB;
constexpr int H3_LD = 3072;
constexpr int CW_BAR = 4096;

constexpr int ARENA_BYTES = 131072;
constexpr int LDSCTL_OFF = ARENA_BYTES;
constexpr int LDS_BYTES = 147456;

__device__ __forceinline__ unsigned f2bf(float f) { unsigned u = __builtin_bit_cast(unsigned, f); return (u + 0x7fffu + ((u >> 16) & 1u)) >> 16; }
__device__ __forceinline__ unsigned pk2(float lo, float hi) { return f2bf(lo) | (f2bf(hi) << 16); }
__device__ __forceinline__ f32x4 xun4(u32x2 w) { return (f32x4){__builtin_bit_cast(float, w.x << 16), __builtin_bit_cast(float, w.x & 0xffff0000u), __builtin_bit_cast(float, w.y << 16), __builtin_bit_cast(float, w.y & 0xffff0000u)}; }
__device__ __forceinline__ u32x2 xpk4(f32x4 v) { return (u32x2){pk2(v.x, v.y), pk2(v.z, v.w)}; }
__device__ __forceinline__ float bflo(unsigned w) { return __builtin_bit_cast(float, w << 16); }
__device__ __forceinline__ float bfhi(unsigned w) { return __builtin_bit_cast(float, w & 0xffff0000u); }
__device__ __forceinline__ float wave_sum(float v) {
#pragma unroll
    for (int o = 1; o < 64; o <<= 1) v += __shfl_xor(v, o);
    return v;
}
#define LDS_WAIT() asm volatile("s_waitcnt lgkmcnt(0)" ::: "memory")
__device__ __forceinline__ unsigned cvt4_fp8(float a, float b, float c, float d) { unsigned w = 0u; w = __builtin_amdgcn_cvt_pk_fp8_f32(a, b, w, false); w = __builtin_amdgcn_cvt_pk_fp8_f32(c, d, w, true); return w; }
__device__ __forceinline__ void swap16(unsigned& a, unsigned& b) { asm volatile("s_nop 1\n\tv_permlane16_swap_b32 %0, %1\n\ts_nop 1" : "+v"(a), "+v"(b)); }
constexpr float YS_SCALE = 16.0f;
constexpr float W8_SCALE = 32.0f;
__device__ __forceinline__ int opaque_tid() { int t = threadIdx.x; asm volatile("" : "+v"(t)); return t; }

#define XB_TMO      128
#define XB_XCNT(j)  (256  + 64 * (j))
#define XB_XSUB(j)  (1280 + 64 * (j))
#define XB_XGEN(j)  (2304 + 64 * (j))
#define XB_TOP      3328
#define XB_TOPGEN   3392
#define XCD_BAR_WORDS 3456
#define XB_SPIN_CAP (1u << 18)

__device__ __forceinline__ unsigned xb_ld(unsigned* p)              { return __hip_atomic_load(p, __ATOMIC_RELAXED, __HIP_MEMORY_SCOPE_AGENT); }
__device__ __forceinline__ unsigned xb_add(unsigned* p, unsigned v) { return __hip_atomic_fetch_add(p, v, __ATOMIC_RELAXED, __HIP_MEMORY_SCOPE_AGENT); }
__device__ __forceinline__ unsigned xb_xcc_id() { return (unsigned)__builtin_amdgcn_s_getreg((3 << 11) | 20) & 0xFu; }
#define XB_SPIN(cond, bar) do { unsigned _sp = 0; while (cond) { __builtin_amdgcn_s_sleep(1); \
    if ((++_sp & 255u) == 0u) { if (xb_ld(&(bar)[XB_TMO])) break; if (_sp > XB_SPIN_CAP) { atomicAdd(&(bar)[XB_TMO], 1u); break; } } } } while (0)

struct XcdBarrier { unsigned* bar; unsigned x; volatile LAS unsigned* st; };

__device__ __forceinline__ XcdBarrier xcd_barrier_post(unsigned* bar, volatile LAS unsigned* st) {
    XcdBarrier b; b.bar = bar; b.x = xb_xcc_id(); b.st = st;
    if (threadIdx.x == 0) (void)xb_add(&bar[XB_XCNT(b.x)], 1u);
    return b;
}
__device__ __forceinline__ void xcd_barrier_complete(unsigned* bar, unsigned x, unsigned& nloc, unsigned& nx) {
    const unsigned G = gridDim.x * gridDim.y * gridDim.z;
    unsigned sum, cnt, mine, sp = 0u;
    for (;;) {
        sum = 0u; cnt = 0u; mine = 0u;
#pragma unroll
        for (unsigned j = 0; j < 16; ++j) { const unsigned c = xb_ld(&bar[XB_XCNT(j)]); sum += c; cnt += (c > 0u) ? 1u : 0u; mine = (j == x) ? c : mine; }
        if (sum == G) break;
        __builtin_amdgcn_s_sleep(1);
        if ((++sp & 255u) == 0u) { if (xb_ld(&bar[XB_TMO])) break; if (sp > XB_SPIN_CAP) { atomicAdd(&bar[XB_TMO], 1u); break; } }
    }
    nloc = mine > 0u ? mine : 1u; nx = cnt > 0u ? cnt : 1u;
}
__device__ __forceinline__ void xcd_barrier(const XcdBarrier& b) {
    asm volatile("s_waitcnt vmcnt(0)" ::: "memory");
    __syncthreads();
    if (threadIdx.x == 0) {
        unsigned* bar = b.bar;
        __builtin_amdgcn_s_waitcnt(0);
        unsigned nloc = b.st[0], nx = b.st[1];
        if (nloc == 0u) { xcd_barrier_complete(bar, b.x, nloc, nx); b.st[0] = nloc; b.st[1] = nx; }
        const unsigned old = xb_add(&bar[XB_XSUB(b.x)], 1u);
        const unsigned gen = old / nloc;
        if (old + 1u == (gen + 1u) * nloc) {
            __builtin_amdgcn_fence(__ATOMIC_RELEASE, "agent");
            asm volatile("s_waitcnt vmcnt(0)" ::: "memory");
            const unsigned og = xb_add(&bar[XB_TOP], 1u);
            const unsigned tg = og / nx;
            if (og + 1u == (tg + 1u) * nx) xb_add(&bar[XB_TOPGEN], 1u);
            else XB_SPIN(xb_ld(&bar[XB_TOPGEN]) == tg, bar);
            __builtin_amdgcn_fence(__ATOMIC_ACQUIRE, "agent");
            xb_add(&bar[XB_XGEN(b.x)], 1u);
            asm volatile("s_waitcnt vmcnt(0)" ::: "memory");
        } else {
            XB_SPIN(xb_ld(&bar[XB_XGEN(b.x)]) == gen, bar);
            __builtin_amdgcn_fence(__ATOMIC_ACQUIRE, "agent");
            asm volatile("s_waitcnt vmcnt(0)" ::: "memory");
        }
    }
    __syncthreads();
}

namespace pg8 {
constexpr int BM = 256, BK = 64, HALF = 128, HTB = HALF * BK * 2, STAGE_BYTES = 8 * HTB, NXCD = 8, WGM = 8;
__host__ __device__ __forceinline__ int lds_byte(int r, int c) { const int st = (r >> 4) * 2 + (c >> 5), rr = r & 15, cc = c & 31, ob = rr * 64 + cc * 2; return st * 1024 + (ob ^ (((ob >> 9) & 1) << 5)); }
__host__ __device__ __forceinline__ void stage_rc(int b, int& R, int& C) { const int st = b / 1024, sb = b % 1024, swz = sb ^ (((sb >> 9) & 1) << 5); R = (st >> 1) * 16 + swz / 64; C = (st & 1) * 32 + (swz % 64) / 2; }
__host__ __device__ __forceinline__ int perm32(int rho) { const int n = rho >> 4, i = rho & 15; return 8 * (i >> 2) + 4 * n + (i & 3); }

typedef int v4i_t __attribute__((ext_vector_type(4)));
typedef int v8i_t __attribute__((ext_vector_type(8)));
struct Unit { unsigned a, b; int pm, pn, aux; };

struct DenseOrder {
    const char* A; const char* Bt; unsigned lda2, ldb2; int nM, nN, nwg, G, c;
    __device__ __forceinline__ const void* baseA() const { return A; }
    __device__ __forceinline__ const void* baseB() const { return Bt; }
    __device__ __forceinline__ const int* gather() const { return nullptr; }
    __device__ __forceinline__ void init(const void* A_, size_t lda_bytes, const void* Bt_, size_t ldb_bytes, int M, int N, int G_, int c_) { A = (const char*)A_; Bt = (const char*)Bt_; lda2 = (unsigned)lda_bytes; ldb2 = (unsigned)ldb_bytes; nM = M / BM; nN = N / BM; nwg = nM * nN; G = G_; c = c_; }
    __device__ __forceinline__ bool next(int i, Unit& u) const {
        const long L = (long)i * G + c; if (L >= nwg) return false;
        int wgid = (int)L; { const int q = nwg / NXCD, r = nwg % NXCD, xcd = wgid % NXCD, off = wgid / NXCD; wgid = (xcd < r ? xcd * (q + 1) : r * (q + 1) + (xcd - r) * q) + off; }
        const int nig = WGM * nN, gid = wgid / nig, fm = gid * WGM, gsz = (nM - fm) < WGM ? (nM - fm) : WGM;
        u.pm = fm + ((wgid % nig) % gsz); u.pn = (wgid % nig) / gsz; u.aux = 0;
        u.a = (unsigned)u.pm * BM * lda2; u.b = (unsigned)u.pn * BM * ldb2; return true;
    }
};
struct RouterOrder {
    const char* A; const char* Bt; unsigned lda2, ldb2; int nM, G, c;
    __device__ __forceinline__ const void* baseA() const { return A; }
    __device__ __forceinline__ const void* baseB() const { return Bt; }
    __device__ __forceinline__ const int* gather() const { return nullptr; }
    __device__ __forceinline__ bool next(int i, Unit& u) const {
        const int L = i * G + c; if (L >= nM * 3) return false;
        u.pm = L / 3; u.aux = L - 3 * u.pm; u.pn = 0;
        u.a = (unsigned)u.pm * BM * lda2 + (u.aux == 1 ? 2048u : 0u); u.b = (unsigned)u.aux * 2048u; return true;
    }
};
struct MoeOrder {
    const char* A; const char* W; const LAS int* tile_exp; const int* tokslot; unsigned lda2, ldb2, wstride; int ntiles, nN, G, c;
    __device__ __forceinline__ const void* baseA() const { return A; }
    __device__ __forceinline__ const void* baseB() const { return W; }
    __device__ __forceinline__ const int* gather() const { return tokslot; }
    __device__ __forceinline__ bool next(int i, Unit& u) const {
        const int tpr = G / nN, tpx = tpr >> 3, x = c & 7, j = c >> 3;
        int tile, pn;
        if ((G & 7) == 0 && tpx * 8 == tpr && tpx > 0) { tile = i * tpr + x * tpx + j / nN; pn = j % nN; }
        else { const long L = (long)i * G + c; tile = (int)(L / nN); pn = (int)(L % nN); }
        if (tile >= ntiles) return false;
        const int e = __builtin_amdgcn_readfirstlane(tile_exp[tile]);
        u.pm = tile; u.pn = pn; u.aux = e; u.a = (unsigned)tile * BM * lda2; u.b = (unsigned)e * wstride + (unsigned)pn * BM * ldb2; return true;
    }
};

__device__ __forceinline__ unsigned cvt_pk_bf16(float lo, float hi) { unsigned r; asm volatile("v_cvt_pk_bf16_f32 %0, %1, %2" : "=v"(r) : "v"(lo), "v"(hi)); return r; }

struct EpiBf16 {
    static constexpr bool PERM = true; static constexpr bool WIDE16 = false;
    bf16_t* O; int ldc; float sc;
    struct Pre {}; static constexpr bool HAS_BIAS = false;
    __device__ __forceinline__ void operator()(const f32x4 (&acc)[2][2][4][2], const Unit& u, int wr, int wc, int fr, int fq, const Pre& pre) const {
        const int row0 = u.pm * BM + wr * 64 + fr, col0 = u.pn * BM + wc * 32 + 8 * fq;
#pragma unroll
        for (int ai = 0; ai < 2; ++ai)
#pragma unroll
            for (int m = 0; m < 4; ++m) { bf16_t* rowp = O + (size_t)(row0 + ai * HALF + m * 16) * ldc + col0;
#pragma unroll
                for (int bj = 0; bj < 2; ++bj) { const f32x4 v0 = acc[ai][bj][m][0] * sc, v1 = acc[ai][bj][m][1] * sc;
                    u32x4 w; w.x = cvt_pk_bf16(v0[0], v0[1]); w.y = cvt_pk_bf16(v0[2], v0[3]); w.z = cvt_pk_bf16(v1[0], v1[1]); w.w = cvt_pk_bf16(v1[2], v1[3]);
                    *(u32x4*)(rowp + bj * HALF) = w; } }
    }
};
struct EpiResid {
    static constexpr bool PERM = true; static constexpr bool WIDE16 = false;
    bf16_t* X; const float* modl; float sc;
    struct Pre {}; static constexpr bool HAS_BIAS = false;
    __device__ __forceinline__ void operator()(const f32x4 (&acc)[2][2][4][2], const Unit& u, int wr, int wc, int fr, int fq, const Pre& pre) const {
        const int row0 = u.pm * BM + wr * 64 + fr, col0 = u.pn * BM + wc * 32 + 8 * fq;
        const int bidx = u.pm < 128 ? (u.pm >> 5) : 4;
        const float* gp = modl + (size_t)bidx * 6144 + col0;
        f32x4 gv[2][2];
#pragma unroll
        for (int bj = 0; bj < 2; ++bj)
#pragma unroll
            for (int n = 0; n < 2; ++n) gv[bj][n] = *(const f32x4*)(gp + bj * HALF + 4 * n) * sc;
        u32x4 xc[2], xn[2];
        { const bf16_t* rowp = X + (size_t)row0 * DM + col0; xc[0] = *(const u32x4*)rowp; xc[1] = *(const u32x4*)(rowp + HALF); xn[0] = xc[0]; xn[1] = xc[1]; }
#pragma unroll
        for (int g = 0; g < 8; ++g) { const int ai = g >> 2, m = g & 3;
            bf16_t* rowp = X + (size_t)(row0 + ai * HALF + m * 16) * DM + col0;
            if (g < 7) { const bf16_t* nrow = X + (size_t)(row0 + ((g + 1) >> 2) * HALF + ((g + 1) & 3) * 16) * DM + col0; xn[0] = *(const u32x4*)nrow; xn[1] = *(const u32x4*)(nrow + HALF); }
            asm volatile("" ::: "memory");
#pragma unroll
            for (int bj = 0; bj < 2; ++bj) { const u32x4 w = xc[bj];
                const f32x4 a = xun4((u32x2){w.x, w.y}) + gv[bj][0] * acc[ai][bj][m][0], b = xun4((u32x2){w.z, w.w}) + gv[bj][1] * acc[ai][bj][m][1];
                const u32x2 pa = xpk4(a), pb = xpk4(b);
                *(u32x4*)(rowp + bj * HALF) = (u32x4){pa.x, pa.y, pb.x, pb.y}; }
            asm volatile("" ::: "memory");
            xc[0] = xn[0]; xc[1] = xn[1]; }
    }
};
struct EpiLogits {
    static constexpr bool PERM = false; static constexpr bool WIDE16 = false;
    float* LG0; float* LG12; const float* rb;
    struct Pre {}; static constexpr bool HAS_BIAS = false;
    __device__ __forceinline__ void operator()(const f32x4 (&acc)[2][2][4][2], const Unit& u, int wr, int wc, int fr, int fq, const Pre& pre) const {
        if (wc != 0) return;
        const int row0 = u.pm * BM + wr * 64 + fr;
        float* LG = u.aux == 0 ? LG0 : LG12 + (size_t)(u.aux - 1) * TT * 32;
        const float bs = u.aux == 0 ? 1.0f : 0.0f;
        const f32x4 b0 = *(const f32x4*)(rb + 4 * fq) * bs, b1 = *(const f32x4*)(rb + 16 + 4 * fq) * bs;
#pragma unroll
        for (int ai = 0; ai < 2; ++ai)
#pragma unroll
            for (int m = 0; m < 4; ++m) { float* rowp = LG + (size_t)(row0 + ai * HALF + m * 16) * 32 + 4 * fq;
                *(f32x4*)rowp = acc[ai][0][m][0] + b0; *(f32x4*)(rowp + 16) = acc[ai][0][m][1] + b1; }
    }
};
struct EpiSwiglu {
    static constexpr bool PERM = true; static constexpr bool WIDE16 = false;
    unsigned char* O; const float* b1l;
    struct Pre { const LAS float* b; };
    static constexpr bool HAS_BIAS = true;
    __device__ __forceinline__ float bias_of(const Unit& u, int i) const { return b1l[(size_t)u.aux * 2048 + (i < 128 ? u.pn * HALF + i : 1024 + u.pn * HALF + (i - 128))]; }
    __device__ __forceinline__ void operator()(const f32x4 (&acc)[2][2][4][2], const Unit& u, int wr, int wc, int fr, int fq, const Pre& pre) const {
        const int row0 = u.pm * BM + wr * 64 + fr, cg = u.pn * HALF + wc * 32 + 8 * fq;
        f32x4 bg[2], bl[2];
#pragma unroll
        for (int n = 0; n < 2; ++n) { bg[n] = *(const LAS f32x4*)(pre.b + wc * 32 + 8 * fq + 4 * n); bl[n] = *(const LAS f32x4*)(pre.b + 128 + wc * 32 + 8 * fq + 4 * n) + 1.0f; }
#pragma unroll
        for (int ai = 0; ai < 2; ++ai)
#pragma unroll
            for (int mp = 0; mp < 2; ++mp) { unsigned wx[2], wy[2];
#pragma unroll
                for (int mm = 0; mm < 2; ++mm) { const int m = 2 * mp + mm; f32x4 r[2];
#pragma unroll
                    for (int n = 0; n < 2; ++n) { const f32x4 k4 = {1.0f / W8_SCALE, 1.0f / W8_SCALE, 1.0f / W8_SCALE, 1.0f / W8_SCALE};
                        f32x4 g = __builtin_elementwise_fma(acc[ai][0][m][n], k4, bg[n]), l = __builtin_elementwise_fma(acc[ai][1][m][n], k4, bl[n]);
#pragma unroll
                        for (int j = 0; j < 4; ++j) { g[j] = fminf(g[j], 7.0f); l[j] = fminf(fmaxf(l[j], -6.0f), 8.0f); }
                        f32x4 t = g * (-1.702f * LOG2E);
#pragma unroll
                        for (int j = 0; j < 4; ++j) t[j] = __builtin_amdgcn_exp2f(t[j]);
                        t = t + 1.0f;
#pragma unroll
                        for (int j = 0; j < 4; ++j) t[j] = __builtin_amdgcn_rcpf(t[j]);
                        r[n] = (g * t) * l; }
                    wx[mm] = cvt4_fp8(r[0][0], r[0][1], r[0][2], r[0][3]); wy[mm] = cvt4_fp8(r[1][0], r[1][1], r[1][2], r[1][3]); }
                swap16(wx[0], wx[1]); swap16(wy[0], wy[1]);
                unsigned char* rowp = O + (size_t)(row0 + ai * HALF + (2 * mp + (fq & 1)) * 16) * DEXP + (cg - 8 * (fq & 1));
                *(u32x4*)rowp = (u32x4){wx[0], wy[0], wx[1], wy[1]}; }
    }
};
struct EpiGate {
    static constexpr bool PERM = true; static constexpr bool WIDE16 = true;
    unsigned char* O; const float* b2l;
    struct Pre { const LAS float* b; };
    static constexpr bool HAS_BIAS = true;
    __device__ __forceinline__ float bias_of(const Unit& u, int i) const { return b2l[(size_t)u.aux * 1024 + u.pn * BM + i]; }
    __device__ __forceinline__ void operator()(const f32x4 (&acc)[2][2][4][2], const Unit& u, int wr, int wc, int fr, int fq, const Pre& pre) const {
        const int row0 = u.pm * BM + wr * 64 + fr, col0 = u.pn * BM + wc * 64 + 16 * fq;
        f32x4 bv[2][2];
#pragma unroll
        for (int bj = 0; bj < 2; ++bj)
#pragma unroll
            for (int n = 0; n < 2; ++n) bv[bj][n] = *(const LAS f32x4*)(pre.b + wc * 64 + 16 * fq + 8 * bj + 4 * n) * YS_SCALE;
#pragma unroll
        for (int ai = 0; ai < 2; ++ai)
#pragma unroll
            for (int m = 0; m < 4; ++m) { unsigned char* rowp = O + (size_t)(row0 + ai * HALF + m * 16) * DM + col0;
                u32x4 w;
                { const f32x4 v = acc[ai][0][m][0] * (YS_SCALE / W8_SCALE) + bv[0][0]; w.x = cvt4_fp8(v[0], v[1], v[2], v[3]); }
                { const f32x4 v = acc[ai][0][m][1] * (YS_SCALE / W8_SCALE) + bv[0][1]; w.y = cvt4_fp8(v[0], v[1], v[2], v[3]); }
                { const f32x4 v = acc[ai][1][m][0] * (YS_SCALE / W8_SCALE) + bv[1][0]; w.z = cvt4_fp8(v[0], v[1], v[2], v[3]); }
                { const f32x4 v = acc[ai][1][m][1] * (YS_SCALE / W8_SCALE) + bv[1][1]; w.w = cvt4_fp8(v[0], v[1], v[2], v[3]); }
                *(u32x4*)rowp = w; }
    }
};

template <class Epi, class Sched, bool FP8 = false, bool GATHER = false>
__device__ __forceinline__ void gemm_phase(LAS unsigned char* lds, const int K, const size_t lda2, const size_t ldb2, const Sched& S, const Epi& E) {
    const int tid = opaque_tid(), wid = __builtin_amdgcn_readfirstlane(tid >> 6), lane = tid & 63, wr = wid >> 2, wc = wid & 3, fr = lane & 15, fq = lane >> 4;
    int nt = K / BK; asm volatile("" : "+s"(nt));
    unsigned voffA[2], voffB[2];
#pragma unroll
    for (int i = 0; i < 2; ++i) { int R, C; stage_rc(tid * 16 + i * 8192, R, C); int Rb = Epi::PERM ? ((R & ~31) + perm32(R & 31)) : R;
        if constexpr (Epi::WIDE16) Rb = (Rb >> 5) * 64 + ((Rb >> 3) & 3) * 16 + (Rb & 7);
        voffA[i] = (unsigned)(R * (unsigned)lda2 + C * 2u); voffB[i] = (unsigned)(Rb * (unsigned)ldb2 + C * 2u); }
    const unsigned kstep = (unsigned)(BK * 2);
    const unsigned hstepA = (unsigned)(HALF * lda2), hstepB = (unsigned)((Epi::WIDE16 ? 8 : HALF) * ldb2);
    const unsigned ldsw = (unsigned)wid * 1024u;
    const int aoff = lds_byte(wr * 64 + fr, fq * 8), boff = lds_byte(wc * 32 + fr, fq * 8);
    const __amdgpu_buffer_rsrc_t rsA = __builtin_amdgcn_make_buffer_rsrc((void*)S.baseA(), 0, 0x7fffffff, 0x00020000);
    const __amdgpu_buffer_rsrc_t rsB = __builtin_amdgcn_make_buffer_rsrc((void*)S.baseB(), 0, 0x7fffffff, 0x00020000);
#define PG8_SA(b, h) (((b) * 2 + (h)) * HTB)
#define PG8_SB(b, h) ((4 + (b) * 2 + (h)) * HTB)
#define PG8_STAGE(bufoff, rs, soff, voff) do { _Pragma("unroll") for (int _i = 0; _i < 2; ++_i) \
        __builtin_amdgcn_raw_ptr_buffer_load_lds(rs, (LAS unsigned*)(lds + (bufoff) + ldsw + _i * 8192), 16, (voff)[_i], (soff), 0, 0); } while (0)
#define PG8_STAGEA(b, h, aoffs, koff, nx) do { if constexpr (GATHER) { _Pragma("unroll") for (int _i = 0; _i < 2; ++_i) \
            __builtin_amdgcn_raw_ptr_buffer_load_lds(rsA, (LAS unsigned*)(lds + PG8_SA(b, h) + ldsw + _i * 8192), 16, (nx) ? ngvo[h][_i] : gvo[h][_i], (koff), 0, 0); } \
        else PG8_STAGE(PG8_SA(b, h), rsA, (aoffs) + (h) * hstepA, voffA); } while (0)
#define PG8_RD8(off) __builtin_shufflevector(*(const LAS v4i_t*)(lds + (off)), *(const LAS v4i_t*)(lds + (off) + 1024), 0, 1, 2, 3, 4, 5, 6, 7)
#define PG8_LDA(dst, b, h) do { if constexpr (FP8) { _Pragma("unroll") for (int m = 0; m < 4; ++m) dst##8[m] = PG8_RD8(PG8_SA(b, h) + aoff + m * 2048); } \
        else { _Pragma("unroll") for (int m = 0; m < 4; ++m) _Pragma("unroll") for (int k = 0; k < 2; ++k) dst[m][k] = *(const LAS bf16x8*)(lds + PG8_SA(b, h) + aoff + m * 2048 + k * 1024); } } while (0)
#define PG8_LDB(dst, b, h) do { if constexpr (FP8) { _Pragma("unroll") for (int n = 0; n < 2; ++n) dst##8[n] = PG8_RD8(PG8_SB(b, h) + boff + n * 2048); } \
        else { _Pragma("unroll") for (int n = 0; n < 2; ++n) _Pragma("unroll") for (int k = 0; k < 2; ++k) dst[n][k] = *(const LAS bf16x8*)(lds + PG8_SB(b, h) + boff + n * 2048 + k * 1024); } } while (0)
#define PG8_MMA(ai, bj, At, Bt) do { __builtin_amdgcn_s_setprio(1); _Pragma("unroll") for (int m = 0; m < 4; ++m) _Pragma("unroll") for (int n = 0; n < 2; ++n) { \
        if constexpr (FP8) asm volatile("s_nop 1\n\tv_mfma_scale_f32_16x16x128_f8f6f4 %0, %1, %2, %0, %3, %3 op_sel_hi:[0,0,0]" : "+v"(acc[ai][bj][m][n]) : "v"(Bt##8[n]), "v"(At##8[m]), "v"(sc1)); \
        else { _Pragma("unroll") for (int k = 0; k < 2; ++k) acc[ai][bj][m][n] = __builtin_amdgcn_mfma_f32_16x16x32_bf16(Bt[n][k], At[m][k], acc[ai][bj][m][n], 0, 0, 0); } } \
        __builtin_amdgcn_s_setprio(0); } while (0)
#define PG8_WAIT_V(n) asm volatile("s_waitcnt vmcnt(" #n ")" ::: "memory")
#define PG8_WAIT_L(n) asm volatile("s_waitcnt lgkmcnt(" #n ")" ::: "memory")
#define PG8_BAR __builtin_amdgcn_s_barrier()
#define PG8_SCHED __builtin_amdgcn_sched_barrier(0)
    Unit cur, nxt; int ui = 0; typename Epi::Pre pre;
    if (!S.next(0, cur)) return;
    f32x4 acc[2][2][4][2];
#pragma unroll
    for (int a = 0; a < 2; ++a)
#pragma unroll
        for (int b = 0; b < 2; ++b)
#pragma unroll
            for (int m = 0; m < 4; ++m)
#pragma unroll
                for (int n = 0; n < 2; ++n) acc[a][b][m][n] = (f32x4){0.f, 0.f, 0.f, 0.f};
    bf16x8 At[4][2], B0[2][2], B1[2][2];
    v8i_t At8[4], B08[2], B18[2];
    int sc1 = 0x7f7f7f7f; asm volatile("" : "+v"(sc1));
    unsigned cA = cur.a, cB = cur.b;
    unsigned gvo[2][2] = {{0u, 0u}, {0u, 0u}}, ngvo[2][2] = {{0u, 0u}, {0u, 0u}};
    int gR[2], gC[2];
#pragma unroll
    for (int i = 0; i < 2; ++i) stage_rc(tid * 16 + i * 8192, gR[i], gC[i]);
#define PG8_GLOAD(dst, pm_) do { if constexpr (GATHER) { const int* tb_ = S.gather() + (pm_) * BM; \
        _Pragma("unroll") for (int h_ = 0; h_ < 2; ++h_) _Pragma("unroll") for (int i_ = 0; i_ < 2; ++i_) dst[h_][i_] = (unsigned)tb_[h_ * HALF + gR[i_]] * (unsigned)lda2 + (unsigned)gC[i_] * 2u; } } while (0)
    PG8_GLOAD(gvo, cur.pm);
    PG8_STAGE(PG8_SB(0, 0), rsB, cB, voffB); PG8_STAGE(PG8_SB(0, 1), rsB, cB + hstepB, voffB); PG8_STAGEA(0, 0, cA, 0u, false); PG8_STAGEA(0, 1, cA, 0u, false);
    if (wr == 1) PG8_BAR;
    PG8_WAIT_V(2); PG8_BAR;
    PG8_STAGE(PG8_SB(1, 0), rsB, cB + kstep, voffB); PG8_STAGEA(1, 0, cA + kstep, kstep, false); PG8_STAGE(PG8_SB(1, 1), rsB, cB + hstepB + kstep, voffB);
    PG8_WAIT_V(6); PG8_BAR;
    for (;;) {
        const bool has_next = S.next(ui + 1, nxt);
        const unsigned nA = has_next ? nxt.a : cA, nB = has_next ? nxt.b : cB;
        LAS int* gl = (LAS int*)(lds + LDSCTL_OFF + 8192) + (ui & 1) * 256;
        for (int t = 0; t < nt; t += 2) {
            const bool last = (t == nt - 2);
            int gstage = 0;
            if constexpr (GATHER) {
                if (t == 0 && has_next) { int tz = threadIdx.x; asm volatile("" : "+v"(tz)); gstage = S.gather()[nxt.pm * BM + (tz & 255)]; }
                if (last) { if (has_next) { _Pragma("unroll") for (int h_ = 0; h_ < 2; ++h_) _Pragma("unroll") for (int i_ = 0; i_ < 2; ++i_) ngvo[h_][i_] = (unsigned)gl[h_ * HALF + gR[i_]] * (unsigned)lda2 + (unsigned)gC[i_] * 2u; }
                            else { _Pragma("unroll") for (int h_ = 0; h_ < 2; ++h_) _Pragma("unroll") for (int i_ = 0; i_ < 2; ++i_) ngvo[h_][i_] = gvo[h_][i_]; } } }
            float bstage = 0.f;
            if constexpr (Epi::HAS_BIAS) { if (last) { int tz = threadIdx.x; asm volatile("" : "+v"(tz)); bstage = E.bias_of(cur, tz & 255); } }
            const unsigned a1 = cA + (unsigned)(t + 1) * kstep, k1 = (unsigned)(t + 1) * kstep;
            const unsigned a2 = last ? nA : cA + (unsigned)(t + 2) * kstep, b2 = last ? nB : cB + (unsigned)(t + 2) * kstep, k2 = last ? 0u : (unsigned)(t + 2) * kstep;
            const unsigned a3 = a2 + kstep, b3 = b2 + kstep, k3 = k2 + kstep;
            PG8_LDB(B0, 0, 0); PG8_LDB(B1, 0, 1); PG8_SCHED; PG8_LDA(At, 0, 0); PG8_STAGEA(1, 1, a1, k1, false);
            PG8_WAIT_V(8); PG8_WAIT_L(0); PG8_BAR; PG8_MMA(0, 0, At, B0); PG8_MMA(0, 1, At, B1); PG8_BAR; PG8_SCHED;
            PG8_LDA(At, 0, 1); PG8_STAGE(PG8_SB(0, 0), rsB, b2, voffB); PG8_STAGE(PG8_SB(0, 1), rsB, b2 + hstepB, voffB); PG8_STAGEA(0, 0, a2, k2, last);
            PG8_WAIT_V(8); PG8_WAIT_L(0); PG8_BAR; PG8_MMA(1, 0, At, B0); PG8_MMA(1, 1, At, B1); PG8_BAR; PG8_SCHED;
            if constexpr (Epi::HAS_BIAS) { if (last) { int tz = threadIdx.x; asm volatile("" : "+v"(tz)); if (tz < 256) ((LAS float*)(lds + LDSCTL_OFF + 2048 + (ui & 1) * 1024))[tz] = bstage; } }
            PG8_LDB(B0, 1, 0); PG8_LDB(B1, 1, 1); PG8_SCHED; PG8_LDA(At, 1, 0); PG8_STAGEA(0, 1, a2, k2, last);
            PG8_WAIT_V(8); PG8_WAIT_L(0); PG8_BAR; PG8_MMA(0, 0, At, B0); PG8_MMA(0, 1, At, B1); PG8_BAR; PG8_SCHED;
            PG8_LDA(At, 1, 1); PG8_STAGE(PG8_SB(1, 0), rsB, b3, voffB); PG8_STAGE(PG8_SB(1, 1), rsB, b3 + hstepB, voffB); PG8_STAGEA(1, 0, a3, k3, last);
            PG8_WAIT_V(8); PG8_WAIT_L(0); PG8_BAR; PG8_MMA(1, 0, At, B0); PG8_MMA(1, 1, At, B1); PG8_BAR; PG8_SCHED;
            if constexpr (GATHER) { if (t == 0 && has_next) { int tz = threadIdx.x; asm volatile("" : "+v"(tz)); if (tz < 256) gl[tz] = gstage; } }
        }
        if constexpr (FP8) asm volatile("s_nop 15\n\ts_nop 7" ::: "memory");
        if (wr == 0) PG8_BAR;
        { int tz = threadIdx.x; asm volatile("" : "+v"(tz)); const int ln = tz & 63;
          if constexpr (Epi::HAS_BIAS) pre.b = (const LAS float*)(lds + LDSCTL_OFF + 2048 + (ui & 1) * 1024);
          E(acc, cur, wr, wc, ln & 15, ln >> 4, pre); }
        if (!has_next) break;
#pragma unroll
        for (int a = 0; a < 2; ++a)
#pragma unroll
            for (int b = 0; b < 2; ++b)
#pragma unroll
                for (int m = 0; m < 4; ++m)
#pragma unroll
                    for (int n = 0; n < 2; ++n) acc[a][b][m][n] = (f32x4){0.f, 0.f, 0.f, 0.f};
        cur = nxt; cA = nA; cB = nB; ++ui;
        if constexpr (GATHER) { _Pragma("unroll") for (int h_ = 0; h_ < 2; ++h_) _Pragma("unroll") for (int i_ = 0; i_ < 2; ++i_) gvo[h_][i_] = ngvo[h_][i_]; }
        if (wr == 1) PG8_BAR;
    }
    PG8_WAIT_V(0);
    PG8_BAR;
#undef PG8_SA
#undef PG8_SB
#undef PG8_STAGE
#undef PG8_STAGEA
#undef PG8_GLOAD
#undef PG8_LDA
#undef PG8_LDB
#undef PG8_MMA
#undef PG8_RD8
#undef PG8_WAIT_V
#undef PG8_WAIT_L
#undef PG8_BAR
#undef PG8_SCHED
}
}

__device__ __forceinline__ u32x4 rope_chunk(u32x4 xw, u32x4 yw, const f32x2* tab, bool first) {
    u32x4 o;
#pragma unroll
    for (int i = 0; i < 4; ++i) {
        const f32x2 cs0 = tab[2 * i], cs1 = tab[2 * i + 1];
        const float x0 = bflo(xw[i]), x1 = bfhi(xw[i]), y0 = bflo(yw[i]), y1 = bfhi(yw[i]);
        const float r0 = first ? x0 * cs0.x - y0 * cs0.y : x0 * cs0.x + y0 * cs0.y;
        const float r1 = first ? x1 * cs1.x - y1 * cs1.y : x1 * cs1.x + y1 * cs1.y;
        o[i] = pk2(r0, r1);
    }
    return o;
}

namespace att {
constexpr int KCS = 1040;
constexpr int KSLOT = 12544, VSLOT = 8192;
constexpr int OFF_K = 0, OFF_V = 4 * KSLOT, OFF_WSF = OFF_V + 4 * VSLOT, OFF_OST = OFF_WSF + 2048, OFF_BIAS = OFF_OST + 32768, ATT_LDS = OFF_BIAS + 2048;
static_assert(ATT_LDS <= ARENA_BYTES, "attention LDS map");
__device__ __forceinline__ int crow(int r, int hi) { return (r & 3) + 8 * (r >> 2) + 4 * hi; }
__device__ __forceinline__ unsigned cvtpk(float lo, float hi) { typedef __bf16 bf16x2_t __attribute__((ext_vector_type(2))); f32x2 v = {lo, hi}; bf16x2_t b = __builtin_convertvector(v, bf16x2_t); return __builtin_bit_cast(unsigned, b); }
__device__ __forceinline__ s16x4 vtr(const LAS unsigned char* p) { return __builtin_bit_cast(s16x4, __builtin_amdgcn_ds_read_tr16_b64_v4i16((LAS s16x4*)p)); }
constexpr float NEGBIG = -1e30f;
__device__ __forceinline__ void pair32(float x, float& a, float& b) {
    unsigned u = __builtin_bit_cast(unsigned, x), v = u;
    asm volatile("s_nop 1\n\tv_permlane32_swap_b32 %0, %1\n\ts_nop 1" : "+v"(u), "+v"(v));
    a = __builtin_bit_cast(float, u); b = __builtin_bit_cast(float, v);
}

__device__ __forceinline__ unsigned xlane32(unsigned x, bool lo) {
    unsigned u = x, v = x;
    asm volatile("s_nop 1\n\tv_permlane32_swap_b32 %0, %1\n\ts_nop 1" : "+v"(u), "+v"(v));
    return lo ? v : u;
}
struct UMla {
    static constexpr int NKC = 12; static constexpr bool PLAIN = true; static constexpr bool SIDED = false;
    const bf16_t* QB; const bf16_t* KVB; const bf16_t* PB; bf16_t* AO; const f32x2* R32; int b, h, qblk; bool ctxq;
    template <int NKS> __device__ __forceinline__ void qfix(bf16x8 (&qr)[NKS], int wid, int r32, int hi) const {
        if (ctxq) return;
        const int t = 256 * qblk + 32 * wid + r32, prow = t >> 6, pcol = t & 63;
#pragma unroll
        for (int f = 0; f < 2; ++f) { const u32x4 own = __builtin_bit_cast(u32x4, qr[4 + f]); u32x4 oth;
            oth.x = xlane32(own.x, hi == 0); oth.y = xlane32(own.y, hi == 0); oth.z = xlane32(own.z, hi == 0); oth.w = xlane32(own.w, hi == 0);
            qr[4 + f] = __builtin_bit_cast(bf16x8, rope_chunk(own, oth, R32 + (f == 0 ? prow : pcol) * 8, hi == 0)); }
    }
    __device__ __forceinline__ float c2() const { return 0.10206207261596577f * LOG2E; }
    __device__ __forceinline__ int ntiles() const { return ctxq ? 4 : 132; }
    __device__ __forceinline__ bool active(int, int) const { return true; }
    __device__ __forceinline__ size_t krow(int t, int key) const { return ctxq ? (size_t)(TL + b * CTXL + 64 * t + key) : (t < 128 ? (size_t)(b * SEQ + 64 * t + key) : (size_t)(TL + b * CTXL + 64 * (t - 128) + key)); }
    __device__ __forceinline__ unsigned kofs() const { return (unsigned)WS_KVB + 256u * h; }  __device__ __forceinline__ unsigned kpitch() const { return 2048u; }
    __device__ __forceinline__ unsigned k2ofs() const { return (unsigned)WS_PB + 3584u; }     __device__ __forceinline__ unsigned k2pitch() const { return 2u * EV_LD; }
    __device__ __forceinline__ unsigned vofs() const { return (unsigned)WS_KVB + 256u * h + 128u; } __device__ __forceinline__ unsigned vpitch() const { return 2048u; }
    __device__ __forceinline__ unsigned trow(int t) const { return (unsigned)krow(t, 0); }
    __device__ __forceinline__ size_t qrow(int wid, int r) const { return ctxq ? (size_t)(TL + b * CTXL + 32 * wid + r) : (size_t)(b * SEQ + 256 * qblk + 32 * wid + r); }
    __device__ __forceinline__ const bf16_t* qptr(int wid, int r) const { return QB + qrow(wid, r) * 768 + 96 * h; }
    __device__ __forceinline__ unsigned char* optr(int wid, int r) const { return (unsigned char*)AO + qrow(wid, r) * 1024 + 512 + 64 * h; }
    __device__ __forceinline__ float m0(int) const { return NEGBIG; }
    __device__ __forceinline__ float l0() const { return 0.f; }
    __device__ __forceinline__ void prep(LAS unsigned char*) const {}
    __device__ __forceinline__ float adjust(int, int, int, int, float s, const LAS unsigned char*) const { return s; }
};
struct UWin {
    static constexpr int NKC = 8; static constexpr bool PLAIN = false; static constexpr bool SIDED = false;
    const bf16_t* PB; bf16_t* AO; const float* sink; int b, kvh, j; bool ctxq; int tlo, nlat;
    template <int NKS> __device__ __forceinline__ void qfix(bf16x8 (&)[NKS], int, int, int) const {}
    __device__ __forceinline__ void init() { tlo = j - 2 < 0 ? 0 : j - 2; const int thi = j + 2 > 127 ? 127 : j + 2; nlat = ctxq ? 0 : thi - tlo + 1; }
    __device__ __forceinline__ float c2() const { return 0.125f * LOG2E; }
    __device__ __forceinline__ int ntiles() const { return nlat + 4; }
    __device__ __forceinline__ bool active(int, int) const { return true; }
    __device__ __forceinline__ size_t krow(int t, int key) const { return t < nlat ? (size_t)(b * SEQ + 64 * (tlo + t) + key) : (size_t)(TL + b * CTXL + 64 * (t - nlat) + key); }
    __device__ __forceinline__ unsigned kofs() const { return (unsigned)WS_PB + 2u * (512 + 64 * kvh); }  __device__ __forceinline__ unsigned kpitch() const { return 2u * EV_LD; }
    __device__ __forceinline__ unsigned k2ofs() const { return 0u; }  __device__ __forceinline__ unsigned k2pitch() const { return 0u; }
    __device__ __forceinline__ unsigned vofs() const { return (unsigned)WS_PB + 2u * (640 + 64 * kvh); }  __device__ __forceinline__ unsigned vpitch() const { return 2u * EV_LD; }
    __device__ __forceinline__ unsigned trow(int t) const { return (unsigned)krow(t, 0); }
    __device__ __forceinline__ int qpos(int wid, int r) const { return 64 * j + 32 * (wid >> 2) + r; }
    __device__ __forceinline__ size_t qrow(int wid, int r) const { return ctxq ? (size_t)(TL + b * CTXL + qpos(wid, r)) : (size_t)(b * SEQ + qpos(wid, r)); }
    __device__ __forceinline__ const bf16_t* qptr(int wid, int r) const { return PB + qrow(wid, r) * EV_LD + 64 * (4 * kvh + (wid & 3)); }
    __device__ __forceinline__ unsigned char* optr(int wid, int r) const { return (unsigned char*)AO + qrow(wid, r) * 1024 + 64 * (4 * kvh + (wid & 3)); }
    __device__ __forceinline__ float m0(int wid) const { return sink[4 * kvh + (wid & 3)] * LOG2E; }
    __device__ __forceinline__ float l0() const { return 1.f; }
    __device__ __forceinline__ void prep(LAS unsigned char*) const {}
    __device__ __forceinline__ void adjust_tile(f32x16& P0, f32x16& P1, int t, int wid, int r32, int hi, float c2, const LAS unsigned char*, int) const {
        if (t >= nlat) {
#pragma unroll
            for (int r = 0; r < 16; ++r) { P0[r] *= c2; P1[r] *= c2; }
        } else { const int dq = qpos(wid, r32) - 64 * (tlo + t) - 4 * hi + 128;
#pragma unroll
            for (int r = 0; r < 16; ++r) { const int k0 = (r & 3) + 8 * (r >> 2);
                P0[r] = ((unsigned)(dq - k0) <= 256u) ? P0[r] * c2 : NEGBIG; P1[r] = ((unsigned)(dq - k0 - 32) <= 256u) ? P1[r] * c2 : NEGBIG; } }
    }
};
struct UNa {
    static constexpr int NKC = 8; static constexpr bool PLAIN = false; static constexpr bool SIDED = true;
    const bf16_t* PB; bf16_t* AO; const float* rpbh; int b, h, G; bool ctxq; int rlo, nlat;
    template <int NKS> __device__ __forceinline__ void qfix(bf16x8 (&)[NKS], int, int, int) const {}
    __device__ __forceinline__ void init() { int lo = 4 * G - 4; lo = lo < 0 ? 0 : (lo > 120 ? 120 : lo); int hi = 4 * G - 1; hi = hi < 0 ? 0 : (hi > 120 ? 120 : hi); rlo = lo; nlat = ctxq ? 0 : hi + 8 - lo; }
    __device__ __forceinline__ float c2() const { return 0.125f * LOG2E; }
    __device__ __forceinline__ int ntiles() const { return nlat + 4; }
    __device__ __forceinline__ int qgrow(int wid) const { return 4 * G + (wid >> 1); }
    __device__ __forceinline__ int r0w(int wid) const { int r0 = qgrow(wid) - 4; return r0 < 0 ? 0 : (r0 > 120 ? 120 : r0); }
    __device__ __forceinline__ bool active(int t, int wid) const { if (t >= nlat) return true; const int kr = rlo + t, r0 = r0w(wid); return kr >= r0 && kr < r0 + 8; }
    __device__ __forceinline__ size_t krow(int t, int key) const { return t < nlat ? (size_t)(b * SEQ + 64 * (rlo + t) + key) : (size_t)(TL + b * CTXL + 64 * (t - nlat) + key); }
    __device__ __forceinline__ unsigned kofs() const { return (unsigned)WS_PB + 2u * (1024 + 64 * h); }  __device__ __forceinline__ unsigned kpitch() const { return 2u * OD_LD; }
    __device__ __forceinline__ unsigned k2ofs() const { return 0u; }  __device__ __forceinline__ unsigned k2pitch() const { return 0u; }
    __device__ __forceinline__ unsigned vofs() const { return (unsigned)WS_PB + 2u * (2048 + 64 * h); }  __device__ __forceinline__ unsigned vpitch() const { return 2u * OD_LD; }
    __device__ __forceinline__ unsigned trow(int t) const { return (unsigned)krow(t, 0); }
    __device__ __forceinline__ size_t qrow(int wid, int r) const { return ctxq ? (size_t)(TL + b * CTXL + 32 * wid + r) : (size_t)(b * SEQ + 64 * qgrow(wid) + 32 * (wid & 1) + r); }
    __device__ __forceinline__ const bf16_t* qptr(int wid, int r) const { return PB + qrow(wid, r) * OD_LD + 64 * h; }
    __device__ __forceinline__ unsigned char* optr(int wid, int r) const { return (unsigned char*)AO + qrow(wid, r) * 1024 + 64 * h; }
    __device__ __forceinline__ float m0(int) const { return NEGBIG; }
    __device__ __forceinline__ float l0() const { return 0.f; }
    __device__ __forceinline__ void prep(LAS unsigned char* L) const {
        if (!ctxq) { LAS float* bt = (LAS float*)(L + OFF_BIAS); for (int i = opaque_tid(); i < 15 * 31; i += 512) bt[i] = rpbh[i] * LOG2E; }
    }
    __device__ __forceinline__ void adjust_tile(f32x16& P0, f32x16& P1, int t, int wid, int r32, int hi, float c2, const LAS unsigned char* L, int side) const {
        if (t >= nlat) {
#pragma unroll
            for (int r = 0; r < 16; ++r) { P0[r] *= c2; P1[r] *= c2; }
        } else { const int qc = 32 * (wid & 1) + r32; int c0 = qc - 8; c0 = c0 < 0 ? 0 : (c0 > 48 ? 48 : c0);
            const LAS float* bp = (const LAS float*)(L + OFF_BIAS) + (rlo + t - qgrow(wid) + 7) * 31 + (15 - qc + 4 * hi);
            const int kb = 4 * hi - c0;
#pragma unroll
            for (int r = 0; r < 16; ++r) { const int k0 = (r & 3) + 8 * (r >> 2);
                if (!(side == 2 && r < 12)) { const float b0 = bp[k0]; P0[r] = ((unsigned)(kb + k0) < 16u) ? P0[r] * c2 + b0 : NEGBIG; }
                if (!(side == 1 && r >= 4)) { const float b1 = bp[k0 + 32]; P1[r] = ((unsigned)(kb + k0 + 32) < 16u) ? P1[r] * c2 + b1 : NEGBIG; } } }
    }
};

__device__ __forceinline__ float fma_s(float a, float b, float c) { float r; asm("v_fma_f32 %0, %1, %2, %3" : "=v"(r) : "v"(a), "v"(b), "v"(c)); return r; }
__device__ __forceinline__ float max3f(float a, float b, float c) { float r; asm("v_max3_f32 %0, %1, %2, %3" : "=v"(r) : "v"(a), "v"(b), "v"(c)); return r; }
template <class U>
__device__ __forceinline__ void attn_unit(LAS unsigned char* L, unsigned char* wsbase, const U& u) {
    constexpr int NKC = U::NKC, NKS = NKC / 2;
    const int tid = opaque_tid(), lane = tid & 63, r32 = lane & 31, hi = lane >> 5; const int wid = __builtin_amdgcn_readfirstlane(tid >> 6);
    bf16x8 qr[NKS];
    float m = u.m0(wid), l = hi == 0 ? u.l0() : 0.f;
    f32x16 o[2];
#pragma unroll
    for (int r = 0; r < 16; ++r) { o[0][r] = 0.f; o[1][r] = 0.f; }
    const float c2 = u.c2();
    const int NT = u.ntiles();
    LAS float* wsf = (LAS float*)(L + OFF_WSF) + wid * 64;
    const LAS unsigned char* kbase = L + OFF_K + hi * KCS + r32 * 16;
    const LAS unsigned char* vbase = L + OFF_V + ((lane >> 4) & 1) * 32 + (lane & 3) * 8 + (4 * hi + ((lane & 15) >> 2)) * 64;
    const __amdgpu_buffer_rsrc_t rs = __builtin_amdgcn_make_buffer_rsrc((void*)wsbase, 0, 0x7fffffff, 0x00020000);
    const unsigned kvo = (unsigned)lane * u.kpitch(), kvo2 = (unsigned)lane * u.k2pitch(), vvo = (unsigned)(lane >> 2) * u.vpitch() + (unsigned)(lane & 3) * 16u;
    const unsigned kso = u.kofs() + 16u * wid, kso2 = u.k2ofs() + 16u * wid, vso = u.vofs() + 16u * (wid & 3) * u.vpitch() + 64u * (wid >> 2);
    const bool two = (NKC == 12) && (wid < 4);
#define ATT_DMAK(t) do { const int tc_ = (t) < NT ? (t) : NT - 1; const unsigned r0_ = u.trow(tc_); LAS unsigned char* kd_ = L + OFF_K + ((t) & 3) * KSLOT; \
        __builtin_amdgcn_raw_ptr_buffer_load_lds(rs, (LAS unsigned*)(kd_ + wid * KCS), 16, kvo, kso + r0_ * u.kpitch(), 0, 0); \
        if (two) __builtin_amdgcn_raw_ptr_buffer_load_lds(rs, (LAS unsigned*)(kd_ + (8 + wid) * KCS), 16, kvo2, kso2 + r0_ * u.k2pitch(), 0, 0); } while (0)
#define ATT_DMAV(t) do { const int tc_ = (t) < NT ? (t) : NT - 1; const unsigned r0_ = u.trow(tc_); \
        __builtin_amdgcn_raw_ptr_buffer_load_lds(rs, (LAS unsigned*)(L + OFF_V + ((t) & 3) * VSLOT + wid * 1024), 16, vvo, vso + r0_ * u.vpitch(), 0, 0); } while (0)
#define ATT_WAIT_BAR() do { if (two) asm volatile("s_waitcnt vmcnt(6)" ::: "memory"); else asm volatile("s_waitcnt vmcnt(4)" ::: "memory"); \
        __builtin_amdgcn_s_barrier(); asm volatile("" ::: "memory"); } while (0)
#define ATT_QKT(S0, S1, t) do { const LAS unsigned char* kb_ = kbase + ((t) & 3) * KSLOT; \
        _Pragma("unroll") for (int r = 0; r < 16; ++r) { S0[r] = 0.f; S1[r] = 0.f; } \
        _Pragma("unroll") for (int kh_ = 0; kh_ < 2; ++kh_) { bf16x8 kf0[NKS / 2], kf1[NKS / 2]; \
            _Pragma("unroll") for (int ks = 0; ks < NKS / 2; ++ks) { kf0[ks] = *(const LAS bf16x8*)(kb_ + (kh_ * (NKS / 2) + ks) * (2 * KCS)); kf1[ks] = *(const LAS bf16x8*)(kb_ + (kh_ * (NKS / 2) + ks) * (2 * KCS) + 512); } \
            _Pragma("unroll") for (int ks = 0; ks < NKS / 2; ++ks) { S0 = __builtin_amdgcn_mfma_f32_32x32x16_bf16(kf0[ks], qr[kh_ * (NKS / 2) + ks], S0, 0, 0, 0); S1 = __builtin_amdgcn_mfma_f32_32x32x16_bf16(kf1[ks], qr[kh_ * (NKS / 2) + ks], S1, 0, 0, 0); } } } while (0)
#define ATT_LIVE0(r, SIDE) (!((SIDE) == 2 && (r) < 12))
#define ATT_LIVE1(r, SIDE) (!((SIDE) == 1 && (r) >= 4))
#define ATT_SOFTMAX(P0, P1, T, SIDE) do { float rm; \
        if constexpr (U::PLAIN) { float a_ = max3f(P0[0], P1[0], P0[1]), b_ = max3f(P1[1], P0[2], P1[2]); \
            _Pragma("unroll") for (int r = 3; r < 15; r += 2) { a_ = max3f(a_, P0[r], P1[r]); b_ = max3f(b_, P0[r + 1], P1[r + 1]); } \
            rm = max3f(a_, b_, fmaxf(P0[15], P1[15])) * c2; } \
        else { u.adjust_tile(P0, P1, (T), wid, r32, hi, c2, L, (SIDE)); \
            if ((SIDE) == 0) { float a_ = max3f(P0[0], P1[0], P0[1]), b_ = max3f(P1[1], P0[2], P1[2]); \
                _Pragma("unroll") for (int r = 3; r < 15; r += 2) { a_ = max3f(a_, P0[r], P1[r]); b_ = max3f(b_, P0[r + 1], P1[r + 1]); } \
                rm = max3f(a_, b_, fmaxf(P0[15], P1[15])); } \
            else { float a_ = NEGBIG, b_ = NEGBIG; \
                _Pragma("unroll") for (int r = 0; r < 16; ++r) { if (ATT_LIVE0(r, SIDE)) a_ = fmaxf(a_, P0[r]); if (ATT_LIVE1(r, SIDE)) b_ = fmaxf(b_, P1[r]); } \
                rm = fmaxf(a_, b_); } } \
        { float ra, rb; pair32(rm, ra, rb); rm = fmaxf(ra, rb); } \
        const float mn = fmaxf(m, rm); alpha = __builtin_amdgcn_exp2f(m - mn); resc = __any(mn > m); m = mn; \
        float lsa = 0.f; const float nmn = -mn;       \
        if constexpr (U::PLAIN) { _Pragma("unroll") for (int r = 0; r < 16; ++r) { P0[r] = __builtin_amdgcn_exp2f(fma_s(P0[r], c2, nmn)); P1[r] = __builtin_amdgcn_exp2f(fma_s(P1[r], c2, nmn)); lsa += P0[r]; lsa += P1[r]; } } \
        else { _Pragma("unroll") for (int r = 0; r < 16; ++r) { \
                if (ATT_LIVE0(r, SIDE)) { P0[r] = __builtin_amdgcn_exp2f(P0[r] - mn); lsa += P0[r]; } else P0[r] = 0.f; \
                if (ATT_LIVE1(r, SIDE)) { P1[r] = __builtin_amdgcn_exp2f(P1[r] - mn); lsa += P1[r]; } else P1[r] = 0.f; } } \
        l = l * alpha + lsa; \
        _Pragma("unroll") for (int i = 0; i < 4; ++i) { if ((SIDE) != 2) pw[0][i] = cvtpk(P0[2 * i], P0[2 * i + 1]); pw[1][i] = cvtpk(P0[8 + 2 * i], P0[9 + 2 * i]); pw[2][i] = cvtpk(P1[2 * i], P1[2 * i + 1]); if ((SIDE) != 1) pw[3][i] = cvtpk(P1[8 + 2 * i], P1[9 + 2 * i]); } } while (0)
#define ATT_STEP(SC0, SC1, SN0, SN1, T, SIDE) do { const int t_ = (T); \
        ATT_DMAK(t_ + 3); ATT_DMAV(t_ + 2); \
        ATT_WAIT_BAR(); \
        const bool a_cur = u.active(t_, wid), a_nxt = (t_ + 1 < NT) && u.active(t_ + 1, wid); \
        float alpha = 1.f; bool resc = false; u32x4 pw[4]; \
        if (a_cur && a_nxt) { ATT_QKT(SN0, SN1, t_ + 1); ATT_SOFTMAX(SC0, SC1, t_, SIDE); } \
        else { if (a_nxt) ATT_QKT(SN0, SN1, t_ + 1); \
               if (a_cur) ATT_SOFTMAX(SC0, SC1, t_, SIDE); } \
        __builtin_amdgcn_sched_barrier(0); \
        if (a_cur) { \
            const LAS unsigned char* vb_ = vbase + (t_ & 3) * VSLOT; s16x4 vlo[2][4], vhi[2][4]; \
            _Pragma("unroll") for (int dh = 0; dh < 2; ++dh) _Pragma("unroll") for (int ks = 0; ks < 4; ++ks) { if (((SIDE) == 1 && ks == 3) || ((SIDE) == 2 && ks == 0)) continue; vlo[dh][ks] = vtr(vb_ + dh * 4096 + ks * 1024); vhi[dh][ks] = vtr(vb_ + dh * 4096 + ks * 1024 + 512); } \
            if (resc) { if (hi == 0) wsf[r32] = alpha; LDS_WAIT(); \
                _Pragma("unroll") for (int r = 0; r < 16; ++r) { const float f = wsf[crow(r, hi)]; o[0][r] *= f; o[1][r] *= f; } } \
            _Pragma("unroll") for (int dh = 0; dh < 2; ++dh) _Pragma("unroll") for (int ks = 0; ks < 4; ++ks) { if (((SIDE) == 1 && ks == 3) || ((SIDE) == 2 && ks == 0)) continue; \
                const s16x4 lo4 = vlo[dh][ks], hi4 = vhi[dh][ks]; const bf16x8 vf = {lo4[0], lo4[1], lo4[2], lo4[3], hi4[0], hi4[1], hi4[2], hi4[3]}; \
                o[dh] = __builtin_amdgcn_mfma_f32_32x32x16_bf16(__builtin_bit_cast(bf16x8, pw[ks]), vf, o[dh], 0, 0, 0); } } \
        LDS_WAIT(); __builtin_amdgcn_sched_barrier(0); } while (0)

    ATT_DMAK(0); ATT_DMAK(1); ATT_DMAV(0); ATT_DMAK(2); ATT_DMAV(1);
    { const bf16_t* qp = u.qptr(wid, r32);
#pragma unroll
      for (int ks = 0; ks < NKS; ++ks) qr[ks] = *(const bf16x8*)(qp + 16 * ks + 8 * hi); }
    u.prep(L);
    u.template qfix<NKS>(qr, wid, r32, hi);
    ATT_WAIT_BAR();
    f32x16 sA0, sA1, sB0, sB1;
#pragma unroll
    for (int r = 0; r < 16; ++r) { sA0[r] = 0.f; sA1[r] = 0.f; sB0[r] = 0.f; sB1[r] = 0.f; }
    if (u.active(0, wid)) ATT_QKT(sA0, sA1, 0);
    if constexpr (U::SIDED) { const int nl = u.nlat; int t = 0;
        if (wid & 1) { for (; t < nl; ++t) { ATT_STEP(sA0, sA1, sB0, sB1, t, 2); sA0 = sB0; sA1 = sB1; } }
        else { for (; t < nl; ++t) { ATT_STEP(sA0, sA1, sB0, sB1, t, 1); sA0 = sB0; sA1 = sB1; } }
        for (; t < NT; ++t) { ATT_STEP(sA0, sA1, sB0, sB1, t, 0); sA0 = sB0; sA1 = sB1; } }
    else { for (int t = 0; t < NT; ++t) { ATT_STEP(sA0, sA1, sB0, sB1, t, 0); sA0 = sB0; sA1 = sB1; } }
    asm volatile("s_waitcnt vmcnt(0)" ::: "memory");
#undef ATT_DMAK
#undef ATT_DMAV
#undef ATT_WAIT_BAR
#undef ATT_QKT
#undef ATT_SOFTMAX
#undef ATT_LIVE0
#undef ATT_LIVE1
#undef ATT_STEP
    { float la, lb; pair32(l, la, lb); l = la + lb; }
    if (hi == 0) wsf[32 + r32] = l;
    LDS_WAIT();
    LAS unsigned char* stg = L + OFF_OST + wid * 2048;
#pragma unroll
    for (int r = 0; r < 16; ++r) { const int orow = crow(r, hi); const float rl = __builtin_amdgcn_rcpf(wsf[32 + orow]);
        const unsigned w = __builtin_amdgcn_cvt_pk_fp8_f32(o[0][r] * rl, o[1][r] * rl, 0u, false);
        stg[orow * 64 + r32] = (unsigned char)(w & 0xffu); stg[orow * 64 + 32 + r32] = (unsigned char)((w >> 8) & 0xffu); }
    LDS_WAIT();
#pragma unroll
    for (int i = 0; i < 2; ++i) { const int row = i * 16 + (lane >> 2), ch = lane & 3; const u32x4 v = *(const LAS u32x4*)(stg + row * 64 + ch * 16); *(u32x4*)(u.optr(wid, row) + ch * 16) = v; }
    __syncthreads();
}
}

struct Args { const float* in[25]; float* out; unsigned char* ws; int ph_lo, ph_hi; };
enum InIdx { I_X = 0, I_C, I_CTX, I_CCTX, I_ADAW, I_ADAB, I_N1G, I_N2G, I_EVWIN, I_EVSINK, I_EVQNG, I_EVWUQ, I_EVKVNG, I_EVWUKV, I_EVWOUT, I_ODWIN, I_ODRPB, I_ODWOUT, I_RW, I_RB, I_W1, I_B1, I_W2, I_B2, I_FG };

struct Frame {
    LAS unsigned char* lds;
    int tid, lane, wave, vcu, G;
    float* out; unsigned char* ws;
};
__device__ __forceinline__ const float* inptr(const Frame& F, int i) {
    const volatile LAS unsigned* p = (const volatile LAS unsigned*)(F.lds + LDSCTL_OFF + 256) + 2 * i;
    const unsigned lo = __builtin_amdgcn_readfirstlane(p[0]), hi = __builtin_amdgcn_readfirstlane(p[1]);
    return (const float*)(const GAS float*)(((unsigned long long)hi << 32) | lo);
}
#define WSP(T, off) ((T*)(F.ws + (off)))
__device__ __forceinline__ void frame_tid(Frame& F) { F.tid = opaque_tid(); F.lane = F.tid & 63; F.wave = __builtin_amdgcn_readfirstlane(F.tid >> 6); }

__device__ __forceinline__ void tr_item(const float* W, int ldw, int K, int k0, int n0, bf16_t* WT, int dst_row0, LAS float* scr, int lane) {
    float wv[32];
#pragma unroll
    for (int i = 0; i < 32; ++i) wv[i] = W[(size_t)(k0 + 2 * i + (lane >> 5)) * ldw + n0 + (lane & 31)];
#pragma unroll
    for (int i = 0; i < 32; ++i) scr[(2 * i + (lane >> 5)) * 33 + (lane & 31)] = wv[i];
    LDS_WAIT(); asm volatile("" ::: "memory");
    const int c = lane & 7;
#pragma unroll
    for (int j = 0; j < 4; ++j) { const int n = (lane >> 3) + 8 * j; const LAS float* s = scr + (8 * c) * 33 + n;
        u32x4 o; o.x = pk2(s[0 * 33], s[1 * 33]); o.y = pk2(s[2 * 33], s[3 * 33]); o.z = pk2(s[4 * 33], s[5 * 33]); o.w = pk2(s[6 * 33], s[7 * 33]);
        *(u32x4*)(WT + (size_t)(dst_row0 + n) * K + k0 + 8 * c) = o; }
    LDS_WAIT(); asm volatile("" ::: "memory");
}

__device__ __forceinline__ void tr_item8(const float* W, int ldw, int K, int k0, int n0, unsigned char* WT8, int dst_row0, LAS float* scr, int lane, float scale) {
    float wv[32];
#pragma unroll
    for (int i = 0; i < 32; ++i) wv[i] = W[(size_t)(k0 + 2 * i + (lane >> 5)) * ldw + n0 + (lane & 31)];
#pragma unroll
    for (int i = 0; i < 32; ++i) scr[(2 * i + (lane >> 5)) * 33 + (lane & 31)] = wv[i] * scale;
    LDS_WAIT(); asm volatile("" ::: "memory");
    const int c = lane & 3;
#pragma unroll
    for (int j = 0; j < 2; ++j) { const int n = (lane >> 2) + 16 * j; const LAS float* s = scr + (16 * c) * 33 + n;
        u32x4 o; o.x = cvt4_fp8(s[0 * 33], s[1 * 33], s[2 * 33], s[3 * 33]); o.y = cvt4_fp8(s[4 * 33], s[5 * 33], s[6 * 33], s[7 * 33]);
        o.z = cvt4_fp8(s[8 * 33], s[9 * 33], s[10 * 33], s[11 * 33]); o.w = cvt4_fp8(s[12 * 33], s[13 * 33], s[14 * 33], s[15 * 33]);
        *(u32x4*)(WT8 + (size_t)(dst_row0 + n) * K + k0 + 16 * c) = o; }
    LDS_WAIT(); asm volatile("" ::: "memory");
}
__device__ __forceinline__ float silu_f(float c) { return c / (1.0f + __expf(-c)); }

__device__ __forceinline__ void pro_a(Frame& F) {
    frame_tid(F);
    const int gwm = F.wave * F.G + F.vcu, NGW = F.G * 8;
    for (int it = gwm; it < 4 * 96; it += NGW) {
        const int l = it / 96, col = (it % 96) * 64 + F.lane;
        float sv[5][16];
#pragma unroll
        for (int j = 0; j < 16; ++j) {
#pragma unroll
            for (int v = 0; v < 4; ++v) sv[v][j] = silu_f(inptr(F, I_C)[v * 1024 + 64 * j + F.lane]);
            sv[4][j] = silu_f(inptr(F, I_CCTX)[64 * j + F.lane]);
        }
        const float* W = inptr(F, I_ADAW) + (size_t)l * 1024 * 6144 + col;
        float acc[5] = {0.f, 0.f, 0.f, 0.f, 0.f};
#pragma unroll
        for (int j = 0; j < 16; ++j) {
            float wl[64];
#pragma unroll
            for (int ln = 0; ln < 64; ++ln) wl[ln] = W[(size_t)(64 * j + ln) * 6144];
#pragma unroll
            for (int ln = 0; ln < 64; ++ln) {
#pragma unroll
                for (int v = 0; v < 5; ++v) acc[v] += __builtin_bit_cast(float, __builtin_amdgcn_readlane(__builtin_bit_cast(int, sv[v][j]), ln)) * wl[ln];
            }
        }
        const float bb = inptr(F, I_ADAB)[l * 6144 + col];
        float* MOD = WSP(float, WS_MOD);
#pragma unroll
        for (int v = 0; v < 5; ++v) MOD[(size_t)(l * 5 + v) * 6144 + col] = acc[v] + bb;
    }
    { const int gt = blockIdx.x * 512 + F.tid;
      if (gt < 128 * 16) { const int pos = gt >> 4, i = gt & 15; const float inv = __builtin_amdgcn_exp2f(-((float)i / 16.0f) * 13.287712379549449f); const float a = (float)pos * inv; WSP(f32x2, WS_ROPE64)[gt] = (f32x2){__cosf(a), __sinf(a)}; }
      else if (gt < 128 * 16 + 128 * 8) { const int g2 = gt - 128 * 16, pos = g2 >> 3, i = g2 & 7; const float inv = __builtin_amdgcn_exp2f(-((float)i / 8.0f) * 13.287712379549449f); const float a = (float)pos * inv; WSP(f32x2, WS_ROPE32)[g2] = (f32x2){__cosf(a), __sinf(a)}; } }
    { const int nchunk = 2 * 224 * 64;
      for (int i = blockIdx.x * 512 + F.tid; i < nchunk; i += F.G * 512) { const int mi = i / (224 * 64), r = (i / 64) % 224, c = i % 64;
          *(u32x4*)(WSP(unsigned char, WS_WINE) + ((size_t)mi * 2048 + 1824 + r) * 1024 + 16 * c) = (u32x4){0u, 0u, 0u, 0u}; } }
    { bf16_t* RWT = WSP(bf16_t, WS_RWT);
      for (int i = blockIdx.x * 512 + F.tid; i < 4 * 32 * 1024; i += F.G * 512) { const int l = i >> 15, e = (i >> 10) & 31, k = i & 1023;
          const float v = inptr(F, I_RW)[((size_t)l * 1024 + k) * 32 + e]; const unsigned hi = f2bf(v); const unsigned lo = f2bf(v - __builtin_bit_cast(float, hi << 16));
          bf16_t* r = RWT + ((size_t)l * 256 + e) * H3_LD; r[k] = (bf16_t)hi; r[1024 + k] = (bf16_t)hi; r[2048 + k] = (bf16_t)lo; }
      const int nz = 4 * 224 * (H3_LD / 8);
      for (int i = blockIdx.x * 512 + F.tid; i < nz; i += F.G * 512) { const int l = i / (224 * (H3_LD / 8)), r = (i / (H3_LD / 8)) % 224, c = i % (H3_LD / 8);
          *(u32x4*)(RWT + ((size_t)l * 256 + 32 + r) * H3_LD + 8 * c) = (u32x4){0u, 0u, 0u, 0u}; } }
    LAS float* scr = (LAS float*)(F.lds + F.wave * 16384);
    constexpr int S0 = 2 * 16 * 57, S1 = S0 + 2 * 12 * 24, S2 = S1 + 2 * 4 * 32, S3 = S2 + 2 * 16 * 32, S4 = S3 + 2 * 16 * 96, S5 = S4 + 2 * 16 * 32, S6 = S5 + 128 * 16 * 64, S7 = S6 + 128 * 16 * 32;
    const int gw = F.vcu * 8 + F.wave;
    for (int it = gw; it < S7; it += NGW) {
        if (it < S0) { const int r = it, mi = r / (16 * 57), q = r % (16 * 57), kb = q / 57, nb = q % 57;
            tr_item8(inptr(F, I_EVWIN) + (size_t)mi * 1024 * EV_IN, EV_IN, 1024, 64 * kb, 32 * nb, WSP(unsigned char, WS_WINE) + (size_t)mi * 2048 * 1024, 32 * nb, scr, F.lane, W8_SCALE); }
        else if (it < S1) { const int r = it - S0, mi = r / (12 * 24), q = r % (12 * 24), kb = q / 24, nb = q % 24;
            tr_item(inptr(F, I_EVWUQ) + (size_t)mi * 768 * 768, 768, 768, 64 * kb, 32 * nb, WSP(bf16_t, WS_WUQ) + (size_t)mi * 768 * 768, 32 * nb, scr, F.lane); }
        else if (it < S2) { const int r = it - S1, mi = r / (4 * 32), q = r % (4 * 32), kb = q / 32, nb = q % 32;
            tr_item(inptr(F, I_EVWUKV) + (size_t)mi * 256 * 1024, 1024, 256, 64 * kb, 32 * nb, WSP(bf16_t, WS_WUKV) + (size_t)mi * 1024 * 256, 32 * nb, scr, F.lane); }
        else if (it < S3) { const int r = it - S2, mi = r / (16 * 32), q = r % (16 * 32), kb = q / 32, nb = q % 32;
            tr_item8(inptr(F, I_EVWOUT) + (size_t)mi * 1024 * 1024, 1024, 1024, 64 * kb, 32 * nb, WSP(unsigned char, WS_WOUTE) + (size_t)mi * 1024 * 1024, 32 * nb, scr, F.lane, W8_SCALE); }
        else if (it < S4) { const int r = it - S3, mi = r / (16 * 96), q = r % (16 * 96), kb = q / 96, nb = q % 96;
            tr_item8(inptr(F, I_ODWIN) + (size_t)mi * 1024 * 3072, 3072, 1024, 64 * kb, 32 * nb, WSP(unsigned char, WS_WINO) + (size_t)mi * 3072 * 1024, 32 * nb, scr, F.lane, W8_SCALE); }
        else if (it < S5) { const int r = it - S4, mi = r / (16 * 32), q = r % (16 * 32), kb = q / 32, nb = q % 32;
            tr_item8(inptr(F, I_ODWOUT) + (size_t)mi * 1024 * 1024, 1024, 1024, 64 * kb, 32 * nb, WSP(unsigned char, WS_WOUTO) + (size_t)mi * 1024 * 1024, 32 * nb, scr, F.lane, W8_SCALE); }
        else if (it < S6) { const int r = it - S5, mi = r / (16 * 64), q = r % (16 * 64), kb = q / 64, nb = q % 64;
            const int c0 = 32 * (nb & 31), drow = (c0 >> 7) * 256 + (nb >= 32 ? 128 : 0) + (c0 & 127);
            tr_item8(inptr(F, I_W1) + (size_t)mi * 1024 * 2048, 2048, 1024, 64 * kb, 32 * nb, WSP(unsigned char, WS_W1) + (size_t)mi * 2048 * 1024, drow, scr, F.lane, W8_SCALE); }
        else { const int r = it - S6, mi = r / (16 * 32), q = r % (16 * 32), kb = q / 32, nb = q % 32;
            tr_item8(inptr(F, I_W2) + (size_t)mi * 1024 * 1024, 1024, 1024, 64 * kb, 32 * nb, WSP(unsigned char, WS_W2) + (size_t)mi * 1024 * 1024, 32 * nb, scr, F.lane, W8_SCALE); }
    }
}

__device__ __forceinline__ int mod_bidx(int row) { return row < TL ? (row >> 13) : 4; }
__device__ __forceinline__ void norm_mod_store(const f32x4 (&v)[4], int lane, const float* g, const float* shift, const float* scale, unsigned char* hrow, f32x4 (*hf)[4] = nullptr) {
    float s = 0.f;
#pragma unroll
    for (int j = 0; j < 4; ++j) s += (v[j].x * v[j].x + v[j].y * v[j].y) + (v[j].z * v[j].z + v[j].w * v[j].w);
    const float rstd = 1.0f / sqrtf(wave_sum(s) * (1.0f / DM) + NORM_EPS);
#pragma unroll
    for (int j = 0; j < 4; ++j) { const int col = 4 * lane + 256 * j;
        const f32x4 gg = *(const f32x4*)(g + col), sh = *(const f32x4*)(shift + col), sc = *(const f32x4*)(scale + col);
        const f32x4 h = (v[j] * rstd) * gg * (sc + 1.0f) + sh;
        if (hf) (*hf)[j] = h;
        *(unsigned*)(hrow + col) = cvt4_fp8(h.x, h.y, h.z, h.w); }
}

__device__ __forceinline__ void norm_mod_store_r(const f32x4 (&v)[4], int lane, const f32x4 (&gg)[4], const f32x4 (&sh)[4], const f32x4 (&sc1)[4], unsigned char* hrow) {
    float s = 0.f;
#pragma unroll
    for (int j = 0; j < 4; ++j) s += (v[j].x * v[j].x + v[j].y * v[j].y) + (v[j].z * v[j].z + v[j].w * v[j].w);
    const float rstd = 1.0f / sqrtf(wave_sum(s) * (1.0f / DM) + NORM_EPS);
#pragma unroll
    for (int j = 0; j < 4; ++j) { const int col = 4 * lane + 256 * j;
        const f32x4 h = (v[j] * rstd) * gg[j] * sc1[j] + sh[j];
        *(unsigned*)(hrow + col) = cvt4_fp8(h.x, h.y, h.z, h.w); }
}

__device__ __forceinline__ void pro_b(Frame& F) {
    frame_tid(F);
    const int gw = F.vcu * 8 + F.wave, NGW = F.G * 8, lane = F.lane;
    const float* MOD = WSP(float, WS_MOD);
    f32x4 gg[4], sh[4], sc1[4], vn[4]; int cb = -1;
#pragma unroll
    for (int j = 0; j < 4; ++j) { gg[j] = *(const f32x4*)(inptr(F, I_N1G) + 4 * lane + 256 * j); sh[j] = gg[j]; sc1[j] = gg[j]; vn[j] = gg[j]; }
#define PB_SRC(r_) ((r_) < TL ? inptr(F, I_X) + (size_t)(r_) * DM : inptr(F, I_CTX) + (size_t)((r_) - TL) * DM)
    if (gw < TT) { const float* src = PB_SRC(gw);
#pragma unroll
        for (int j = 0; j < 4; ++j) vn[j] = *(const f32x4*)(src + 4 * lane + 256 * j); }
    for (int row = gw; row < TT; row += NGW) {
        f32x4 v[4];
#pragma unroll
        for (int j = 0; j < 4; ++j) v[j] = vn[j];
        if (row + NGW < TT) { const float* src = PB_SRC(row + NGW);
#pragma unroll
            for (int j = 0; j < 4; ++j) vn[j] = *(const f32x4*)(src + 4 * lane + 256 * j); }
        const int bi = mod_bidx(row);
        if (bi != cb) { cb = bi; const float* mb = MOD + (size_t)(0 * 5 + bi) * 6144;
#pragma unroll
            for (int j = 0; j < 4; ++j) { sh[j] = *(const f32x4*)(mb + 4 * lane + 256 * j); sc1[j] = *(const f32x4*)(mb + 1024 + 4 * lane + 256 * j) + 1.0f; } }
        bf16_t* xr = WSP(bf16_t, WS_XLC) + (size_t)row * DM;
#pragma unroll
        for (int j = 0; j < 4; ++j) *(u32x2*)(xr + 4 * lane + 256 * j) = xpk4(v[j]);
        norm_mod_store_r(v, lane, gg, sh, sc1, WSP(unsigned char, WS_HB) + (size_t)row * DM);
    }
#undef PB_SRC
}

__device__ __forceinline__ u32x4 shfl_xor4(u32x4 v, int m) { u32x4 r; r.x = __shfl_xor(v.x, m); r.y = __shfl_xor(v.y, m); r.z = __shfl_xor(v.z, m); r.w = __shfl_xor(v.w, m); return r; }
__device__ __forceinline__ float ssq8(u32x4 w) { float s = 0.f;
#pragma unroll
    for (int i = 0; i < 4; ++i) { const float a = bflo(w[i]), b = bfhi(w[i]); s += a * a + b * b; } return s; }
__device__ __forceinline__ u32x4 scale8(u32x4 w, float r, const float* g) { u32x4 o; const f32x4 g0 = *(const f32x4*)g, g1 = *(const f32x4*)(g + 4);
    o.x = pk2(bflo(w.x) * r * g0.x, bfhi(w.x) * r * g0.y); o.y = pk2(bflo(w.y) * r * g0.z, bfhi(w.y) * r * g0.w);
    o.z = pk2(bflo(w.z) * r * g1.x, bfhi(w.z) * r * g1.y); o.w = pk2(bflo(w.w) * r * g1.z, bfhi(w.w) * r * g1.w); return o; }

__device__ __forceinline__ u32x4 rope_chunk_r(u32x4 xw, u32x4 yw, const f32x2 (&tab)[8], bool first) {
    u32x4 o;
#pragma unroll
    for (int i = 0; i < 4; ++i) {
        const f32x2 cs0 = tab[2 * i], cs1 = tab[2 * i + 1];
        const float x0 = bflo(xw[i]), x1 = bfhi(xw[i]), y0 = bflo(yw[i]), y1 = bfhi(yw[i]);
        const float r0 = first ? x0 * cs0.x - y0 * cs0.y : x0 * cs0.x + y0 * cs0.y;
        const float r1 = first ? x1 * cs1.x - y1 * cs1.y : x1 * cs1.x + y1 * cs1.y;
        o[i] = pk2(r0, r1);
    }
    return o;
}
__device__ __forceinline__ u32x4 scale8_r(u32x4 w, float r, f32x4 g0, f32x4 g1) { u32x4 o;
    o.x = pk2(bflo(w.x) * r * g0.x, bfhi(w.x) * r * g0.y); o.y = pk2(bflo(w.y) * r * g0.z, bfhi(w.y) * r * g0.w);
    o.z = pk2(bflo(w.z) * r * g1.x, bfhi(w.z) * r * g1.y); o.w = pk2(bflo(w.w) * r * g1.z, bfhi(w.w) * r * g1.w); return o; }

__device__ __forceinline__ void e2_pass(Frame& F, int li) {
    frame_tid(F);
    const int gw = F.vcu * 8 + F.wave, NGW = F.G * 8, lane = F.lane;
    const float* gq = inptr(F, I_EVQNG) + li * 768; const float* gkv = inptr(F, I_EVKVNG) + li * 256;
    const f32x2* R64 = WSP(f32x2, WS_ROPE64); const f32x2* R32 = WSP(f32x2, WS_ROPE32);
    const int cw = lane & 7, seg = cw >> 1, c4 = (lane >= 32 && lane < 36) ? lane - 32 : 0;
    const float* gq1p = gq + (lane >= 32 ? 8 * (lane + 64) - 768 : 0); const float* gq2p = gq + 8 * (lane + 128) - 768; const float* gkvp = gkv + (lane < 32 ? 8 * lane : 0);
    const f32x4 gq1a = *(const f32x4*)gq1p, gq1b = *(const f32x4*)(gq1p + 4), gq2a = *(const f32x4*)gq2p, gq2b = *(const f32x4*)(gq2p + 4), gkva = *(const f32x4*)gkvp, gkvb = *(const f32x4*)(gkvp + 4);
    u32x4 wn[4]; f32x2 t64n[8], t32n[8];
#define E2_LOAD(r_) do { const bf16_t* pr_ = WSP(bf16_t, WS_PB) + (size_t)(r_) * EV_LD; \
        _Pragma("unroll") for (int j = 0; j < 4; ++j) wn[j] = *(const u32x4*)(pr_ + 8 * (lane + 64 * j)); \
        const int t_ = (r_) & (SEQ - 1), prow_ = t_ >> 6, pcol_ = t_ & 63; \
        const f32x2* a_ = R64 + ((seg < 2) ? prow_ : pcol_) * 16 + (cw & 1) * 8; const f32x2* b_ = R32 + ((c4 < 2) ? prow_ : pcol_) * 8; \
        _Pragma("unroll") for (int i = 0; i < 8; ++i) { t64n[i] = a_[i]; t32n[i] = b_[i]; } } while (0)
#pragma unroll
    for (int j = 0; j < 4; ++j) wn[j] = (u32x4){0u, 0u, 0u, 0u};
#pragma unroll
    for (int i = 0; i < 8; ++i) { t64n[i] = (f32x2){0.f, 0.f}; t32n[i] = (f32x2){0.f, 0.f}; }
    if (gw < TT) E2_LOAD(gw);
    for (int row = gw; row < TT; row += NGW) {
        bf16_t* pr = WSP(bf16_t, WS_PB) + (size_t)row * EV_LD;
        u32x4 w[4]; f32x2 t64[8], t32[8];
#pragma unroll
        for (int j = 0; j < 4; ++j) w[j] = wn[j];
#pragma unroll
        for (int i = 0; i < 8; ++i) { t64[i] = t64n[i]; t32[i] = t32n[i]; }
        if (row + NGW < TT) E2_LOAD(row + NGW);
        float sq = ssq8(w[2]) + (lane >= 32 ? ssq8(w[1]) : 0.f), skv = lane < 32 ? ssq8(w[3]) : 0.f;
        const float rq = 1.0f / sqrtf(wave_sum(sq) * (1.0f / 768.0f) + NORM_EPS), rkv = 1.0f / sqrtf(wave_sum(skv) * (1.0f / 256.0f) + NORM_EPS);
        const bool lat = row < TL;
        const u32x4 y0 = shfl_xor4(w[0], 2), y1 = shfl_xor4(w[1], 2), y3 = shfl_xor4(w[3], 1);
        if (lat) { w[0] = rope_chunk_r(w[0], y0, t64, (seg & 1) == 0); if (lane < 16) w[1] = rope_chunk_r(w[1], y1, t64, (seg & 1) == 0); }
        if (lane >= 32) w[1] = scale8_r(w[1], rq, gq1a, gq1b);
        w[2] = scale8_r(w[2], rq, gq2a, gq2b);
        if (lane < 32) w[3] = scale8_r(w[3], rkv, gkva, gkvb);
        else if (lane < 36 && lat) w[3] = rope_chunk_r(w[3], y3, t32, ((lane - 32) & 1) == 0);
#pragma unroll
        for (int j = 0; j < 4; ++j) *(u32x4*)(pr + 8 * (lane + 64 * j)) = w[j];
    }
#undef E2_LOAD
}
__device__ __forceinline__ void m1a_pass(Frame& F, int layer) {
    frame_tid(F);
    const int gw = F.vcu * 8 + F.wave, NGW = F.G * 8, lane = F.lane;
    const float* MOD = WSP(float, WS_MOD); const float* g2 = inptr(F, I_N2G) + layer * DM;
    f32x4 gg[4], sh[4], sc1[4], vn[4]; int cb = -1;
#pragma unroll
    for (int j = 0; j < 4; ++j) { gg[j] = *(const f32x4*)(g2 + 4 * lane + 256 * j); sh[j] = gg[j]; sc1[j] = gg[j]; vn[j] = gg[j]; }
    if (gw < TT) {
#pragma unroll
        for (int j = 0; j < 4; ++j) vn[j] = xun4(*(const u32x2*)(WSP(bf16_t, WS_XLC) + (size_t)gw * DM + 4 * lane + 256 * j)); }
    for (int row = gw; row < TT; row += NGW) {
        f32x4 v[4];
#pragma unroll
        for (int j = 0; j < 4; ++j) v[j] = vn[j];
        if (row + NGW < TT) {
#pragma unroll
            for (int j = 0; j < 4; ++j) vn[j] = xun4(*(const u32x2*)(WSP(bf16_t, WS_XLC) + (size_t)(row + NGW) * DM + 4 * lane + 256 * j)); }
        const int bi = mod_bidx(row);
        if (bi != cb) { cb = bi; const float* mb = MOD + (size_t)(layer * 5 + bi) * 6144;
#pragma unroll
            for (int j = 0; j < 4; ++j) { sh[j] = *(const f32x4*)(mb + 3 * 1024 + 4 * lane + 256 * j); sc1[j] = *(const f32x4*)(mb + 4 * 1024 + 4 * lane + 256 * j) + 1.0f; } }
        float s = 0.f;
#pragma unroll
        for (int j = 0; j < 4; ++j) s += (v[j].x * v[j].x + v[j].y * v[j].y) + (v[j].z * v[j].z + v[j].w * v[j].w);
        const float rstd = 1.0f / sqrtf(wave_sum(s) * (1.0f / DM) + NORM_EPS);
        bf16_t* hr = WSP(bf16_t, WS_PB) + (size_t)row * H3_LD;
#pragma unroll
        for (int j = 0; j < 4; ++j) { const int col = 4 * lane + 256 * j;
            const f32x4 h = (v[j] * rstd) * gg[j] * sc1[j] + sh[j];
            unsigned hi[4], lo[4];
#pragma unroll
            for (int i = 0; i < 4; ++i) { hi[i] = f2bf(h[i]); lo[i] = f2bf(h[i] - __builtin_bit_cast(float, hi[i] << 16)); }
            const u32x2 wh = {hi[0] | (hi[1] << 16), hi[2] | (hi[3] << 16)}, wl = {lo[0] | (lo[1] << 16), lo[2] | (lo[3] << 16)};
            *(u32x2*)(hr + col) = wh; *(u32x2*)(hr + 1024 + col) = wl;
            *(unsigned*)(WSP(unsigned char, WS_HB) + (size_t)row * DM + col) = cvt4_fp8(h[0], h[1], h[2], h[3]); }
    }
}
__device__ __forceinline__ void m1b_gemm(Frame& F, int layer) {
    pg8::RouterOrder S; S.A = (const char*)WSP(bf16_t, WS_PB); S.Bt = (const char*)(WSP(bf16_t, WS_RWT) + (size_t)layer * 256 * H3_LD); S.lda2 = H3_LD * 2; S.ldb2 = H3_LD * 2; S.nM = TT / 256; S.G = F.G; S.c = blockIdx.x;
    pg8::EpiLogits E{WSP(float, WS_LOGIT), WSP(float, WS_LOGIT12), inptr(F, I_RB) + layer * 32};
    pg8::gemm_phase<pg8::EpiLogits, pg8::RouterOrder>(F.lds, 1024, (size_t)H3_LD * 2, (size_t)H3_LD * 2, S, E);
}
__device__ __forceinline__ void m1c_pass(Frame& F) {
    frame_tid(F);
    const int lane = F.lane, blk = blockIdx.x, CH = (TT + F.G - 1) / F.G;
    const int r0 = blk * CH, r1 = (r0 + CH < TT) ? r0 + CH : TT;
    LAS int* hist = (LAS int*)(F.lds + LDSCTL_OFF + 512);
    if (F.tid < 32) hist[F.tid] = 0;
    __syncthreads();
    const int e = lane & 31, sub = lane >> 5;
    float n0 = 0.f, n1 = 0.f, n2 = 0.f;
    { const int row = r0 + 2 * F.wave + sub; const size_t li_ = (size_t)(row < r1 ? row : r1 - 1) * 32 + e;
      n0 = WSP(float, WS_LOGIT)[li_]; n1 = WSP(float, WS_LOGIT12)[li_]; n2 = WSP(float, WS_LOGIT12)[(size_t)TT * 32 + li_]; }
    for (int rbase = r0 + 2 * F.wave; rbase < r1; rbase += 16) {
        const int row = rbase + sub; const bool ok = row < r1;
        float logit = (n0 + n1) + n2;
        { const int rn = rbase + 16 + sub; const size_t li_ = (size_t)(rn < r1 ? rn : r1 - 1) * 32 + e;
          n0 = WSP(float, WS_LOGIT)[li_]; n1 = WSP(float, WS_LOGIT12)[li_]; n2 = WSP(float, WS_LOGIT12)[(size_t)TT * 32 + li_]; }
        float tv[4]; int ti[4];
#pragma unroll
        for (int k = 0; k < 4; ++k) {
            float bv = logit; int bi = e;
#pragma unroll
            for (int o = 16; o >= 1; o >>= 1) { const float ov = __shfl_xor(bv, o); const int oi = __shfl_xor(bi, o); if (ov > bv || (ov == bv && oi < bi)) { bv = ov; bi = oi; } }
            tv[k] = bv; ti[k] = bi; if (e == bi) logit = -3.0e38f;
        }
        const float w1 = __expf(tv[1] - tv[0]), w2 = __expf(tv[2] - tv[0]), w3 = __expf(tv[3] - tv[0]); const float inv = 1.0f / (1.0f + w1 + w2 + w3);
        if (e == 0 && ok) {
            *(int4*)(WSP(int, WS_TOPE) + (size_t)row * 4) = make_int4(ti[0], ti[1], ti[2], ti[3]);
            *(f32x4*)(WSP(float, WS_TOPG) + (size_t)row * 4) = (f32x4){inv, w1 * inv, w2 * inv, w3 * inv};
            atomicAdd((int*)(hist + ti[0]), 1); atomicAdd((int*)(hist + ti[1]), 1); atomicAdd((int*)(hist + ti[2]), 1); atomicAdd((int*)(hist + ti[3]), 1);
        }
    }
    __syncthreads();
    if (F.tid < 32) WSP(int, WS_HIST)[blk * 32 + F.tid] = hist[F.tid];
    __syncthreads();
}

__device__ __forceinline__ void m2_pass(Frame& F) {
    frame_tid(F);
    const int blk = blockIdx.x, CH = (TT + F.G - 1) / F.G;
    const int r0 = blk * CH, r1 = (r0 + CH < TT) ? r0 + CH : TT, nr = r1 > r0 ? r1 - r0 : 0;
    LAS int* tot = (LAS int*)(F.lds), *bef = tot + 32, *pst = tot + 64, *ntl = tot + 96;
    LAS int* te = (LAS int*)(F.lds + 1024);
    LAS float* tg = (LAS float*)(F.lds + 1024 + 32768);
    const int* HIST = WSP(int, WS_HIST);
    if (F.tid < 64) tot[F.tid] = 0;
    __syncthreads();
    for (int i = F.tid; i < F.G * 32; i += 512) { const int h = HIST[i]; atomicAdd((int*)(tot + (i & 31)), h); if ((i >> 5) < blk) atomicAdd((int*)(bef + (i & 31)), h); }
    for (int i = F.tid; i < nr * 4; i += 512) { te[i] = WSP(int, WS_TOPE)[(size_t)r0 * 4 + i]; tg[i] = WSP(float, WS_TOPG)[(size_t)r0 * 4 + i]; }
    __syncthreads();
    if (F.tid == 0) { int ps = 0; for (int e = 0; e < 32; ++e) { pst[e] = ps; ps += (tot[e] + 255) & ~255; } ntl[0] = ps >> 8; }
    __syncthreads();
    LAS int* cnt = (LAS int*)(F.lds + 1024 + 65536);
    const int nent = nr * 4, nch = (nent + 63) >> 6;
    int myrank[4] = {0, 0, 0, 0}, myex[4] = {-1, -1, -1, -1};
#pragma unroll
    for (int q = 0; q < 4; ++q) { const int c = F.wave + 8 * q;
        if (c < nch) { const int i = 64 * c + F.lane; const int ex = i < nent ? te[i] : -1; myex[q] = ex; int rk = 0, mine = 0;
            for (int e = 0; e < 32; ++e) { const unsigned long long m = __ballot(ex == e); if (ex == e) rk = __popcll(m & ((1ull << F.lane) - 1ull)); if (F.lane == e) mine = __popcll(m); }
            myrank[q] = rk; if (F.lane < 32) cnt[c * 32 + F.lane] = mine; } }
    __syncthreads();
#pragma unroll
    for (int q = 0; q < 4; ++q) { const int c = F.wave + 8 * q; const int i = 64 * c + F.lane;
        if (c < nch && i < nent) { const int ex = myex[q]; int before = 0; for (int c2 = 0; c2 < c; ++c2) before += cnt[c2 * 32 + ex];
            const int sl = pst[ex] + bef[ex] + before + myrank[q];
            WSP(int, WS_SLOT)[(size_t)r0 * 4 + i] = sl; WSP(float, WS_GSLOT)[sl] = tg[i]; WSP(int, WS_TOKSLOT)[sl] = r0 + (i >> 2); } }
    if (blk == 0) { const int nt = ntl[0]; int* TE = WSP(int, WS_TILEEXP);
        for (int tl = F.tid; tl < nt; tl += 512) { int e = 0; for (int q = 1; q < 32; ++q) if (pst[q] <= tl * 256) e = q; TE[tl] = e; }
        if (F.tid == 0) TE[1023] = nt;
        for (int e = 0; e < 32; ++e) { const int p0 = pst[e] + tot[e], p1 = pst[e] + ((tot[e] + 255) & ~255); for (int sidx = p0 + F.tid; sidx < p1; sidx += 512) WSP(int, WS_TOKSLOT)[sidx] = 0; } }
    __syncthreads();
}

__device__ __forceinline__ void m5_pass(Frame& F, int layer) {
    frame_tid(F);
    const int gw = F.vcu * 8 + F.wave, NGW = F.G * 8, lane = F.lane;
    const float* MOD = WSP(float, WS_MOD);
    const bool last = layer == 3; const int RL = last ? TL : TT;
    f32x4 gg[4], g2v[4], sh[4], sc1[4]; int cb = -1;
    { const float* gp = last ? inptr(F, I_FG) : inptr(F, I_N1G) + (layer + 1) * DM;
#pragma unroll
      for (int j = 0; j < 4; ++j) { gg[j] = *(const f32x4*)(gp + 4 * lane + 256 * j); g2v[j] = gg[j]; sh[j] = gg[j]; sc1[j] = gg[j]; } }
    int4 sC = make_int4(0, 0, 0, 0), sN = sC; f32x4 gC = {0.f, 0.f, 0.f, 0.f}, gN = gC;
    unsigned yw[4][4], ywn[4][4]; f32x4 xv[4], xvn[4];
#pragma unroll
    for (int j = 0; j < 4; ++j) { xv[j] = gg[j]; xvn[j] = gg[j];
#pragma unroll
        for (int k = 0; k < 4; ++k) { yw[j][k] = 0u; ywn[j][k] = 0u; } }
#define M5_SLOTS(S_, G_, r_) do { S_ = *(const int4*)(WSP(int, WS_SLOT) + (size_t)(r_) * 4); G_ = *(const f32x4*)(WSP(float, WS_TOPG) + (size_t)(r_) * 4); } while (0)
#define M5_DATA(Y_, X_, S_, r_) do { const int sl_[4] = {S_.x, S_.y, S_.z, S_.w}; \
        _Pragma("unroll") for (int j = 0; j < 4; ++j) { const int col = 4 * lane + 256 * j; \
            _Pragma("unroll") for (int k = 0; k < 4; ++k) Y_[j][k] = *(const unsigned*)(WSP(unsigned char, WS_XG) + (size_t)sl_[k] * DM + col); \
            X_[j] = xun4(*(const u32x2*)(WSP(bf16_t, WS_XLC) + (size_t)(r_) * DM + col)); } } while (0)
    if (gw < RL) { M5_SLOTS(sC, gC, gw); M5_DATA(yw, xv, sC, gw); }
    if (gw + NGW < RL) M5_SLOTS(sN, gN, gw + NGW);
    for (int row = gw; row < RL; row += NGW) {
        const f32x4 gcur = gC;
        if (row + NGW < RL) { M5_DATA(ywn, xvn, sN, row + NGW); gC = gN; }
        if (row + 2 * NGW < RL) M5_SLOTS(sN, gN, row + 2 * NGW);
        const int bi = mod_bidx(row);
        if (bi != cb) { cb = bi; const float* mb = MOD + (size_t)(layer * 5 + bi) * 6144; const float* mn = MOD + (size_t)((last ? layer : layer + 1) * 5 + bi) * 6144;
#pragma unroll
            for (int j = 0; j < 4; ++j) { const int col = 4 * lane + 256 * j; g2v[j] = *(const f32x4*)(mb + 5 * 1024 + col); sh[j] = *(const f32x4*)(mn + col); sc1[j] = *(const f32x4*)(mn + 1024 + col) + 1.0f; } }
        const float gk[4] = {gcur.x * (1.0f / YS_SCALE), gcur.y * (1.0f / YS_SCALE), gcur.z * (1.0f / YS_SCALE), gcur.w * (1.0f / YS_SCALE)};
        bf16_t* xr = WSP(bf16_t, WS_XLC) + (size_t)row * DM;
        f32x4 v[4];
#pragma unroll
        for (int j = 0; j < 4; ++j) { f32x4 y = {0.f, 0.f, 0.f, 0.f};
#pragma unroll
            for (int k = 0; k < 4; ++k) { const unsigned w = yw[j][k];
                y += (f32x4){__builtin_amdgcn_cvt_f32_fp8(w, 0), __builtin_amdgcn_cvt_f32_fp8(w, 1), __builtin_amdgcn_cvt_f32_fp8(w, 2), __builtin_amdgcn_cvt_f32_fp8(w, 3)} * gk[k]; }
            v[j] = xv[j] + g2v[j] * y; }
        if (!last) {
#pragma unroll
            for (int j = 0; j < 4; ++j) *(u32x2*)(xr + 4 * lane + 256 * j) = xpk4(v[j]);
            norm_mod_store_r(v, lane, gg, sh, sc1, WSP(unsigned char, WS_HB) + (size_t)row * DM);
        } else {
            float s = 0.f;
#pragma unroll
            for (int j = 0; j < 4; ++j) s += (v[j].x * v[j].x + v[j].y * v[j].y) + (v[j].z * v[j].z + v[j].w * v[j].w);
            const float rstd = 1.0f / sqrtf(wave_sum(s) * (1.0f / DM) + NORM_EPS);
#pragma unroll
            for (int j = 0; j < 4; ++j) { const int col = 4 * lane + 256 * j; *(f32x4*)(F.out + (size_t)row * DM + col) = (v[j] * rstd) * gg[j]; }
        }
#pragma unroll
        for (int j = 0; j < 4; ++j) { xv[j] = xvn[j];
#pragma unroll
            for (int k = 0; k < 4; ++k) yw[j][k] = ywn[j][k]; }
    }
#undef M5_SLOTS
#undef M5_DATA
}

constexpr int NPH_PAIR = 22, NPH = 2 + 2 * NPH_PAIR;

__device__ __forceinline__ void moe_gemm1(Frame& F, int layer) {
    const int* TE = WSP(int, WS_TILEEXP);
    LAS int* tel = (LAS int*)(F.lds + LDSCTL_OFF + 4096);
    { const int tz = opaque_tid(); tel[tz] = TE[tz]; tel[512 + tz] = TE[512 + tz]; __syncthreads(); }
    pg8::MoeOrder S; S.A = (const char*)WSP(unsigned char, WS_HB); S.W = (const char*)(WSP(unsigned char, WS_W1) + (size_t)layer * 32 * 2048 * 1024); S.tile_exp = tel; S.tokslot = WSP(int, WS_TOKSLOT);
    S.lda2 = 1024; S.ldb2 = 1024; S.wstride = 2048u * 1024u; S.ntiles = __builtin_amdgcn_readfirstlane(TE[1023]); S.nN = 8; S.G = F.G; S.c = blockIdx.x;
    pg8::EpiSwiglu E{WSP(unsigned char, WS_HA), inptr(F, I_B1) + (size_t)layer * 32 * 2048};
    pg8::gemm_phase<pg8::EpiSwiglu, pg8::MoeOrder, true, true>(F.lds, 512, 1024, 1024, S, E);
}
__device__ __forceinline__ void moe_gemm2(Frame& F, int layer) {
    const int* TE = WSP(int, WS_TILEEXP);
    LAS int* tel = (LAS int*)(F.lds + LDSCTL_OFF + 4096);
    { const int tz = opaque_tid(); tel[tz] = TE[tz]; tel[512 + tz] = TE[512 + tz]; __syncthreads(); }
    pg8::MoeOrder S; S.A = (const char*)WSP(unsigned char, WS_HA); S.W = (const char*)(WSP(unsigned char, WS_W2) + (size_t)layer * 32 * 1024 * 1024); S.tile_exp = tel; S.tokslot = nullptr;
    S.lda2 = 1024; S.ldb2 = 1024; S.wstride = 1024u * 1024u; S.ntiles = __builtin_amdgcn_readfirstlane(TE[1023]); S.nN = 4; S.G = F.G; S.c = blockIdx.x;
    pg8::EpiGate E{WSP(unsigned char, WS_XG), inptr(F, I_B2) + (size_t)layer * 32 * 1024};
    pg8::gemm_phase<pg8::EpiGate, pg8::MoeOrder, true>(F.lds, 512, 1024, 1024, S, E);
}
__device__ __forceinline__ void dense_gemm_bf16(Frame& F, const bf16_t* A, size_t lda2, const bf16_t* Bt, int N, int K, bf16_t* O, int ldc) {
    pg8::DenseOrder S; S.init(A, lda2, Bt, (size_t)K * 2, TT, N, F.G, blockIdx.x);
    pg8::EpiBf16 E{O, ldc, 1.0f};
    pg8::gemm_phase<pg8::EpiBf16, pg8::DenseOrder>(F.lds, K, lda2, (size_t)K * 2, S, E);
}
__device__ __forceinline__ void dense_gemm_f8(Frame& F, const unsigned char* A8, const unsigned char* Bt8, int N, int K8, bf16_t* O, int ldc) {
    pg8::DenseOrder S; S.init(A8, (size_t)K8, Bt8, (size_t)K8, TT, N, F.G, blockIdx.x);
    pg8::EpiBf16 E{O, ldc, 1.0f / W8_SCALE};
    pg8::gemm_phase<pg8::EpiBf16, pg8::DenseOrder, true>(F.lds, K8 / 2, (size_t)K8, (size_t)K8, S, E);
}
__device__ __forceinline__ void outproj_gemm(Frame& F, const unsigned char* Bt8, int layer, int nrows) {
    pg8::DenseOrder S; S.init(WSP(unsigned char, WS_AO), 1024, Bt8, 1024, nrows, 1024, F.G, blockIdx.x);
    pg8::EpiResid E{WSP(bf16_t, WS_XLC), WSP(float, WS_MOD) + (size_t)layer * 5 * 6144 + 2 * 1024, 1.0f / W8_SCALE};
    pg8::gemm_phase<pg8::EpiResid, pg8::DenseOrder, true>(F.lds, 512, 1024, 1024, S, E);
}

__global__ void __launch_bounds__(512, 2) fwd(Args args) {
    extern __shared__ __attribute__((aligned(16))) unsigned char lds_raw[];
    Frame F;
    F.lds = (LAS unsigned char*)lds_raw;
    F.tid = threadIdx.x; F.lane = F.tid & 63; F.wave = __builtin_amdgcn_readfirstlane(F.tid >> 6);
    F.G = gridDim.x; { const int bx = blockIdx.x; F.vcu = (F.G % 8 == 0) ? (bx % 8) * (F.G / 8) + bx / 8 : bx; }
    F.out = args.out; F.ws = args.ws;
    volatile LAS unsigned* MISC = (volatile LAS unsigned*)(F.lds + LDSCTL_OFF);
    if (F.tid < 64) MISC[F.tid] = 0u;
    if (F.tid < 25) { const unsigned long long pv = ((const unsigned long long*)__builtin_amdgcn_kernarg_segment_ptr())[F.tid]; MISC[64 + 2 * F.tid] = (unsigned)pv; MISC[65 + 2 * F.tid] = (unsigned)(pv >> 32); }
    __syncthreads();
    unsigned* ctl = (unsigned*)(F.ws + WS_CTL);
#if !MK_PER_PHASE
    XcdBarrier bar = xcd_barrier_post(ctl + CW_BAR, MISC + 8);
#define GRID_BAR() xcd_barrier(bar)
#else
#define GRID_BAR() do { } while (0)
#endif
    const int lo = args.ph_lo, hi = args.ph_hi;
    int pid = 0;
    enum { CNT0 = __COUNTER__ + 1 };
#ifndef PHMASK
#define PHMASK 0xFFFFFFFFull
#endif
#ifndef REPMASK
#define REPMASK 0ull
#endif
#define PHASE_BEGIN { const int site_ = __COUNTER__ - CNT0; const int nrep_ = 1 + (int)(((unsigned long long)REPMASK >> site_) & 1ull); \
    if ((((unsigned long long)PHMASK >> site_) & 1ull) && lo <= pid && pid < hi) { for (int rep_ = 0; rep_ < nrep_; ++rep_) {
#define PHASE_END if (rep_ + 1 < nrep_ || pid + 1 < hi) GRID_BAR(); } } ++pid; }

    PHASE_BEGIN pro_a(F); PHASE_END
    PHASE_BEGIN pro_b(F); PHASE_END

    for (int lp = 0; lp < 2; ++lp) {
        { const int layer = 2 * lp, li = lp;
        PHASE_BEGIN dense_gemm_f8(F, WSP(unsigned char, WS_HB), WSP(unsigned char, WS_WINE) + (size_t)li * 2048 * 1024, 2048, 1024, WSP(bf16_t, WS_PB), EV_LD); PHASE_END
        PHASE_BEGIN e2_pass(F, li); PHASE_END
        PHASE_BEGIN
            dense_gemm_bf16(F, WSP(bf16_t, WS_PB) + 768, (size_t)EV_LD * 2, WSP(bf16_t, WS_WUQ) + (size_t)li * 768 * 768, 768, 768, WSP(bf16_t, WS_QB), 768);
            dense_gemm_bf16(F, WSP(bf16_t, WS_PB) + 1536, (size_t)EV_LD * 2, WSP(bf16_t, WS_WUKV) + (size_t)li * 1024 * 256, 1024, 256, WSP(bf16_t, WS_KVB), 1024);
        PHASE_END
        PHASE_BEGIN
            for (int rr_ = 0; rr_ < 1 + (int)(((unsigned long long)REPMASK >> 40) & 1ull); ++rr_)
            for (int u = F.vcu; u < 1024 + 32; u += F.G) {
                att::UMla U; U.QB = WSP(bf16_t, WS_QB); U.KVB = WSP(bf16_t, WS_KVB); U.PB = WSP(bf16_t, WS_PB); U.AO = WSP(bf16_t, WS_AO); U.R32 = WSP(f32x2, WS_ROPE32);
                if (u < 1024) { const int bh = u >> 5; U.b = bh >> 3; U.h = bh & 7; U.qblk = u & 31; U.ctxq = false; }
                else { const int v = u - 1024; U.b = v >> 3; U.h = v & 7; U.qblk = 0; U.ctxq = true; }
                att::attn_unit<att::UMla>(F.lds, F.ws, U);
            }
            for (int rr_ = 0; rr_ < 1 + (int)(((unsigned long long)REPMASK >> 41) & 1ull); ++rr_)
            for (int u = F.vcu; u < 1024 + 32; u += F.G) {
                att::UWin U; U.PB = WSP(bf16_t, WS_PB); U.AO = WSP(bf16_t, WS_AO); U.sink = inptr(F, I_EVSINK) + li * 8;
                if (u < 1024) { U.b = u >> 8; U.kvh = (u >> 7) & 1; U.j = u & 127; U.ctxq = false; }
                else { const int v = u - 1024; U.b = v >> 3; U.kvh = (v >> 2) & 1; U.j = v & 3; U.ctxq = true; }
                U.init();
                att::attn_unit<att::UWin>(F.lds, F.ws, U);
            }
        PHASE_END
        PHASE_BEGIN outproj_gemm(F, WSP(unsigned char, WS_WOUTE) + (size_t)li * 1024 * 1024, layer, TT); PHASE_END
        PHASE_BEGIN m1a_pass(F, layer); PHASE_END
        PHASE_BEGIN m1b_gemm(F, layer); PHASE_END
        PHASE_BEGIN m1c_pass(F); PHASE_END
        PHASE_BEGIN m2_pass(F); PHASE_END
        PHASE_BEGIN moe_gemm1(F, layer); PHASE_END
        PHASE_BEGIN moe_gemm2(F, layer); PHASE_END
        PHASE_BEGIN m5_pass(F, layer); PHASE_END
        }
        { const int layer = 2 * lp + 1, li = lp;
        PHASE_BEGIN dense_gemm_f8(F, WSP(unsigned char, WS_HB), WSP(unsigned char, WS_WINO) + (size_t)li * 3072 * 1024, 3072, 1024, WSP(bf16_t, WS_PB), OD_LD); PHASE_END
        PHASE_BEGIN
            for (int u = F.vcu; u < 2048 + (layer == 3 ? 0 : 64); u += F.G) {
                att::UNa U; U.PB = WSP(bf16_t, WS_PB); U.AO = WSP(bf16_t, WS_AO);
                if (u < 2048) { U.b = u >> 9; U.h = (u >> 5) & 15; U.G = u & 31; U.ctxq = false; }
                else { const int v = u - 2048; U.b = v >> 4; U.h = v & 15; U.G = 0; U.ctxq = true; }
                U.rpbh = inptr(F, I_ODRPB) + (size_t)(li * 16 + U.h) * 15 * 31;
                U.init();
                att::attn_unit<att::UNa>(F.lds, F.ws, U);
            }
        PHASE_END
        PHASE_BEGIN outproj_gemm(F, WSP(unsigned char, WS_WOUTO) + (size_t)li * 1024 * 1024, layer, layer == 3 ? TL : TT); PHASE_END
        PHASE_BEGIN m1a_pass(F, layer); PHASE_END
        PHASE_BEGIN m1b_gemm(F, layer); PHASE_END
        PHASE_BEGIN m1c_pass(F); PHASE_END
        PHASE_BEGIN m2_pass(F); PHASE_END
        PHASE_BEGIN moe_gemm1(F, layer); PHASE_END
        PHASE_BEGIN moe_gemm2(F, layer); PHASE_END
        PHASE_BEGIN m5_pass(F, layer); PHASE_END
        }
    }
}


#if MK_CHECK
constexpr int CW_CHK = 8192;
constexpr size_t WS_CHK = 1968 * MiB;
constexpr size_t WS_CHK_CNT = WS_CHK + 136 * MiB;
constexpr int IDS_PER_PAIR = 26, ID_PROB = 53, NID = 54;
struct CArgs { const float* in[25]; float* out; unsigned char* ws; int layer, id; };
#define CWS(T, off) ((T*)(A.ws + (off)))
__device__ __forceinline__ unsigned hsh(unsigned x) { x ^= x >> 16; x *= 0x7feb352du; x ^= x >> 15; x *= 0x846ca68bu; x ^= x >> 16; return x; }
__device__ __forceinline__ float bfv(const bf16_t* p) { return __builtin_bit_cast(float, (unsigned)(*p) << 16); }
__device__ __forceinline__ float f8v(const unsigned char* p) { const unsigned b = *p; const unsigned e = (b >> 3) & 15u, m = b & 7u; const float v = e ? __builtin_bit_cast(float, ((e + 120u) << 23) | (m << 20)) : (float)m * 0.001953125f; return (b & 128u) ? -v : v; }
__device__ __forceinline__ float rbf(float a) { return __builtin_bit_cast(float, f2bf(a) << 16); }
__device__ __forceinline__ void chk_acc(const CArgs& A, float e2, float r2) {
    __shared__ float sh[2][8];
    e2 = wave_sum(e2); r2 = wave_sum(r2);
    const int w = threadIdx.x >> 6;
    if ((threadIdx.x & 63) == 0) { sh[0][w] = e2; sh[1][w] = r2; }
    __syncthreads();
    if (threadIdx.x == 0) { float a = 0.f, b = 0.f; for (int i = 0; i < (int)(blockDim.x >> 6); ++i) { a += sh[0][i]; b += sh[1][i]; }
        float* acc = (float*)(A.ws + WS_CTL) + CW_CHK + 2 * A.id; atomicAdd(acc, a); atomicAdd(acc + 1, b); }
    __syncthreads();
}
__device__ __forceinline__ void sincos_d(float a, float& s, float& c) {
    double x = (double)a; const double tp = 6.283185307179586476925; double k = __builtin_rint(x / tp); double r = x - k * tp; double r2 = r * r;
    double sp = r, cp = 1.0, ts = r, tc = 1.0;
#pragma unroll
    for (int i = 1; i < 14; ++i) { tc *= -r2 / (double)((2 * i - 1) * (2 * i)); cp += tc; ts *= -r2 / (double)((2 * i) * (2 * i + 1)); sp += ts; }
    s = (float)sp; c = (float)cp;
}
__device__ __forceinline__ float invfreq(int i, int half) { return __builtin_amdgcn_exp2f(-((float)i / (float)half) * 13.287712379549449f); }
__device__ __forceinline__ float nsilu(float c) { return c / (1.0f + __expf(-c)); }
__device__ float naive_mod(const CArgs& A, int layer, int bidx, int n) {
    const float* cv = bidx < 4 ? A.in[I_C] + bidx * 1024 : A.in[I_CCTX]; const float* W = A.in[I_ADAW] + (size_t)layer * 1024 * 6144 + n;
    float acc = 0.f; for (int k = 0; k < 1024; ++k) acc += nsilu(cv[k]) * W[(size_t)k * 6144];
    return acc + A.in[I_ADAB][layer * 6144 + n];
}
__device__ __forceinline__ int srow(unsigned s) { return (s & 3) == 0 ? TL + (int)(hsh(s * 3 + 1) % TC) : (int)(hsh(s * 3 + 1) % TL); }
__global__ void chk_mark(CArgs A) { if (threadIdx.x == 0) ((float*)(A.ws + WS_CTL))[CW_CHK + 2 * A.id + 1] = 1.0f; }

__global__ void chk_gemm(CArgs A, const bf16_t* X, int ldx, const float* W, int ldw, int K, int ncol, const bf16_t* O, int ldo) {
    const int row = srow(blockIdx.x); const int col = (int)((hsh(blockIdx.x * 977 + 5) + 7u * threadIdx.x) % (unsigned)ncol);
    float ref = 0.f; for (int k = 0; k < K; ++k) ref += (ldx ? bfv(X + (size_t)row * ldx + k) : f8v((const unsigned char*)X + (size_t)row * 1024 + k)) * W[(size_t)k * ldw + col];
    const float got = bfv(O + (size_t)row * ldo + col);
    chk_acc(A, (got - ref) * (got - ref), ref * ref);
}
__global__ void chk_e2(CArgs A) {
    __shared__ float P[EV_IN]; __shared__ float red[2];
    const int li = A.layer >> 1, row = srow(blockIdx.x), t = threadIdx.x;
    const float* W = A.in[I_EVWIN] + (size_t)li * 1024 * EV_IN; const unsigned char* h = CWS(unsigned char, WS_HB) + (size_t)row * DM;
    for (int c = t; c < EV_IN; c += 256) { float a = 0.f; for (int k = 0; k < 1024; ++k) a += f8v(h + k) * W[(size_t)k * EV_IN + c]; P[c] = rbf(a); }
    __syncthreads();
    if (t == 0) { float a = 0.f; for (int c = 768; c < 1536; ++c) a += P[c] * P[c]; red[0] = 1.0f / sqrtf(a / 768.0f + NORM_EPS); float b = 0.f; for (int c = 1536; c < 1792; ++c) b += P[c] * P[c]; red[1] = 1.0f / sqrtf(b / 256.0f + NORM_EPS); }
    __syncthreads();
    const bool lat = row < TL; const int tt = row & (SEQ - 1), prow = tt >> 6, pcol = tt & 63;
    float e2 = 0.f, r2 = 0.f;
    for (int c = t; c < EV_IN; c += 256) {
        float ref = P[c];
        if (c < 640 && lat) { const int d = c & 63, dd = d & 31, i = dd & 15; const bool first = dd < 16; const float y = P[first ? c + 16 : c - 16];
            float sn, cs; sincos_d((float)((d < 32) ? prow : pcol) * invfreq(i, 16), sn, cs); ref = first ? P[c] * cs - y * sn : P[c] * cs + y * sn; }
        else if (c >= 768 && c < 1536) ref = P[c] * red[0] * A.in[I_EVQNG][li * 768 + c - 768];
        else if (c >= 1536 && c < 1792) ref = P[c] * red[1] * A.in[I_EVKVNG][li * 256 + c - 1536];
        else if (c >= 1792 && lat) { const int d = c - 1792, dd = d & 15, i = dd & 7; const bool first = dd < 8; const float y = P[first ? c + 8 : c - 8];
            float sn, cs; sincos_d((float)((d < 16) ? prow : pcol) * invfreq(i, 8), sn, cs); ref = first ? P[c] * cs - y * sn : P[c] * cs + y * sn; }
        const float got = bfv(CWS(bf16_t, WS_PB) + (size_t)row * EV_LD + c);
        e2 += (got - ref) * (got - ref); r2 += ref * ref;
    }
    chk_acc(A, e2, r2);
}
__global__ void chk_e4(CArgs A) {
    __shared__ float Q[768];
    const int li = A.layer >> 1, row = (int)(hsh(blockIdx.x * 3 + 1) % TL), t = threadIdx.x;
    const float* W = A.in[I_EVWUQ] + (size_t)li * 768 * 768; const bf16_t* x = CWS(bf16_t, WS_PB) + (size_t)row * EV_LD + 768;
    for (int c = t; c < 768; c += 256) { float a = 0.f; for (int k = 0; k < 768; ++k) a += bfv(x + k) * W[(size_t)k * 768 + c]; Q[c] = rbf(a); }
    __syncthreads();
    const int tt = row & (SEQ - 1), prow = tt >> 6, pcol = tt & 63;
    float e2 = 0.f, r2 = 0.f;
    for (int c = t; c < 768; c += 256) { const int d = c % 96; float ref = Q[c];
        if (d >= 64) { const int dr = d - 64, dd = dr & 15, i = dd & 7; const bool first = dd < 8; const float y = Q[first ? c + 8 : c - 8];
            float sn, cs; sincos_d((float)((dr < 16) ? prow : pcol) * invfreq(i, 8), sn, cs); ref = first ? Q[c] * cs - y * sn : Q[c] * cs + y * sn; }
        const float got = bfv(CWS(bf16_t, WS_QB) + (size_t)row * 768 + c); e2 += (got - ref) * (got - ref); r2 += ref * ref; }
    chk_acc(A, e2, r2);
}
__global__ void chk_attn(CArgs A, int kind, int ctxq) {
    __shared__ float sc[8448]; __shared__ float redm[4], reds[4], qs[96];
    const int li = A.layer >> 1, t = threadIdx.x; const unsigned s = blockIdx.x;
    const int b = hsh(s * 7 + 1) % NB, head = hsh(s * 7 + 2) % (kind == 2 ? 16 : 8);
    const int pos = ctxq ? hsh(s * 7 + 3) % CTXL : ((s & 7) == 0 ? (hsh(s) % 200) : (s & 7) == 1 ? SEQ - 1 - (hsh(s) % 200) : hsh(s * 7 + 3) % SEQ);
    const size_t qrow = ctxq ? (size_t)(TL + b * CTXL + pos) : (size_t)(b * SEQ + pos);
    int nlat = 0, wlo = 0, r = pos >> 6, c = pos & 63, r0 = 0, c0 = 0;
    if (!ctxq) {
        if (kind == 0) { wlo = pos - 128 < 0 ? 0 : pos - 128; const int whi = pos + 128 > SEQ - 1 ? SEQ - 1 : pos + 128; nlat = whi - wlo + 1; }
        else if (kind == 1) nlat = SEQ;
        else { r0 = r - 4; r0 = r0 < 0 ? 0 : (r0 > 120 ? 120 : r0); c0 = c - 8; c0 = c0 < 0 ? 0 : (c0 > 48 ? 48 : c0); nlat = 128; }
    }
    const int nk = nlat + CTXL;
    const bf16_t* PB = CWS(bf16_t, WS_PB); const bf16_t* KVB = CWS(bf16_t, WS_KVB);
    const int pld = kind == 2 ? OD_LD : EV_LD, dqk = kind == 1 ? 96 : 64;
    const bf16_t* q = kind == 1 ? CWS(bf16_t, WS_QB) + qrow * 768 + 96 * head : PB + qrow * pld + 64 * head;
    const float scale = kind == 1 ? 0.10206207261596577f : 0.125f;
    const bool has_sink = kind == 0; const float sinkv = has_sink ? A.in[I_EVSINK][li * 8 + head] : 0.f;
    const float* rp = A.in[I_ODRPB] + (size_t)(li * 16 + head) * 15 * 31;
    if (t < dqk) qs[t] = bfv(q + t);
    __syncthreads();
    if (kind == 1 && !ctxq) { float rv = 0.f;
        if (t >= 64 && t < 96) { const int dr = t - 64, dd = dr & 15, i = dd & 7; const bool first = dd < 8; const float y = qs[first ? t + 8 : t - 8];
            float sn, cs; sincos_d((float)((dr < 16) ? r : c) * invfreq(i, 8), sn, cs); rv = rbf(first ? qs[t] * cs - y * sn : qs[t] * cs + y * sn); }
        __syncthreads();
        if (t >= 64 && t < 96) qs[t] = rv;
        __syncthreads(); }
#define KROW(i) ((i) >= nlat ? (size_t)(TL + b * CTXL + ((i) - nlat)) : kind == 0 ? (size_t)(b * SEQ + wlo + (i)) : kind == 1 ? (size_t)(b * SEQ + (i)) : (size_t)(b * SEQ + (r0 + ((i) >> 4)) * 64 + c0 + ((i) & 15)))
    float mx = has_sink ? sinkv : -3e38f;
    for (int i = t; i < nk; i += 256) { const size_t kr = KROW(i); float a = 0.f;
        if (kind == 0) { const bf16_t* k = PB + kr * EV_LD + 512 + 64 * (head >> 2); for (int d = 0; d < 64; ++d) a += qs[d] * bfv(k + d); }
        else if (kind == 1) { const bf16_t* k = KVB + kr * 1024 + 128 * head; for (int d = 0; d < 64; ++d) a += qs[d] * bfv(k + d); const bf16_t* k2 = PB + kr * EV_LD + 1792; for (int d = 0; d < 32; ++d) a += qs[64 + d] * bfv(k2 + d); }
        else { const bf16_t* k = PB + kr * OD_LD + 1024 + 64 * head; for (int d = 0; d < 64; ++d) a += qs[d] * bfv(k + d); }
        a *= scale;
        if (kind == 2 && i < nlat) { const int kr_ = r0 + (i >> 4), kc_ = c0 + (i & 15); a += rp[(kr_ - r + 7) * 31 + (kc_ - c + 15)]; }
        sc[i] = a; mx = fmaxf(mx, a); }
    for (int o = 1; o < 64; o <<= 1) mx = fmaxf(mx, __shfl_xor(mx, o));
    if ((t & 63) == 0) redm[t >> 6] = mx;
    __syncthreads();
    mx = fmaxf(fmaxf(redm[0], redm[1]), fmaxf(redm[2], redm[3]));
    float sm = 0.f;
    for (int i = t; i < nk; i += 256) { const float p = __expf(sc[i] - mx); sc[i] = p; sm += p; }
    sm = wave_sum(sm);
    if ((t & 63) == 0) reds[t >> 6] = sm;
    __syncthreads();
    sm = reds[0] + reds[1] + reds[2] + reds[3] + (has_sink ? __expf(sinkv - mx) : 0.f);
    float e2 = 0.f, r2 = 0.f;
    if (t < 64) { float o = 0.f;
        for (int i = 0; i < nk; ++i) { const size_t kr = KROW(i); const bf16_t* v = kind == 0 ? PB + kr * EV_LD + 640 + 64 * (head >> 2) : kind == 1 ? KVB + kr * 1024 + 128 * head + 64 : PB + kr * OD_LD + 2048 + 64 * head; o += sc[i] * bfv(v + t); }
        o /= sm; const unsigned char* got = CWS(unsigned char, WS_AO) + qrow * 1024 + (kind == 1 ? 512 : 0) + 64 * head; const float g = f8v(got + t); e2 = (g - o) * (g - o); r2 = o * o; }
#undef KROW
    chk_acc(A, e2, r2);
}
__global__ void chk_outproj(CArgs A, const float* W) {
    const int row = A.layer == 3 ? (int)(hsh(blockIdx.x * 3 + 1) % TL) : srow(blockIdx.x), c = (int)((hsh(blockIdx.x * 977 + 5) + 7u * threadIdx.x) % 1024u);
    float a = 0.f; for (int k = 0; k < 1024; ++k) a += f8v(CWS(unsigned char, WS_AO) + (size_t)row * 1024 + k) * W[(size_t)k * 1024 + c];
    const float gate = naive_mod(A, A.layer, row < TL ? (row >> 13) : 4, 2 * 1024 + c);
    const float ref = CWS(float, WS_CHK)[(size_t)row * DM + c] + gate * a, got = CWS(float, WS_XLC)[(size_t)row * DM + c];
    chk_acc(A, (got - ref) * (got - ref), (gate * a) * (gate * a));
}
__global__ void chk_norm_router(CArgs A, int which, const bf16_t* hbuf, int hld) {
    __shared__ float hv[1024]; __shared__ float red[4]; __shared__ float lg[32]; __shared__ int ste[4]; __shared__ float stv[4];
    const int row = srow(blockIdx.x), t = threadIdx.x, bidx = row < TL ? (row >> 13) : 4;
    const float* x = CWS(float, WS_XLC) + (size_t)row * DM;
    float s = 0.f; for (int c = t; c < 1024; c += 256) s += x[c] * x[c];
    s = wave_sum(s); if ((t & 63) == 0) red[t >> 6] = s; __syncthreads();
    const float rstd = 1.0f / sqrtf((red[0] + red[1] + red[2] + red[3]) / 1024.0f + NORM_EPS);
    const float* g = (which == 0 ? A.in[I_N1G] : A.in[I_N2G]) + A.layer * DM;
    float e2 = 0.f, r2 = 0.f;
    for (int c = t; c < 1024; c += 256) { const float sh = naive_mod(A, A.layer, bidx, which * 1024 + c), scl = naive_mod(A, A.layer, bidx, (which + 1) * 1024 + c);
        const float h = x[c] * rstd * g[c] * (1.0f + scl) + sh; hv[c] = h; const float got = hld ? bfv(hbuf + (size_t)row * hld + c) : f8v((const unsigned char*)hbuf + (size_t)row * DM + c); e2 += (got - h) * (got - h); r2 += h * h; }
    __syncthreads();
    if (which == 3) {
        if (t < 32) { const float* rw = A.in[I_RW] + (size_t)A.layer * 1024 * 32; float a = 0.f; for (int k = 0; k < 1024; ++k) a += hv[k] * rw[k * 32 + t]; lg[t] = a + A.in[I_RB][A.layer * 32 + t]; }
        __syncthreads();
        if (t == 0) { unsigned used = 0u;
            for (int k = 0; k < 4; ++k) { float bv = -3e38f; int bi = 0; for (int e = 0; e < 32; ++e) if (!((used >> e) & 1u) && lg[e] > bv) { bv = lg[e]; bi = e; } used |= 1u << bi; ste[k] = bi; stv[k] = bv; }
            float den = 0.f; for (int k = 0; k < 4; ++k) den += __expf(stv[k] - stv[0]);
            for (int k = 0; k < 4; ++k) { const float gr = __expf(stv[k] - stv[0]) / den; const int ge = CWS(int, WS_TOPE)[(size_t)row * 4 + k]; const float gg = CWS(float, WS_TOPG)[(size_t)row * 4 + k];
                const float d = (ge == ste[k]) ? (gg - gr) : 1.0f; e2 += 1000.f * d * d; r2 += 1000.f * gr * gr; } }
    }
    chk_acc(A, e2, r2);
}
__global__ void chk_slots_count(CArgs A) {
    const int i = blockIdx.x * 256 + threadIdx.x; if (i < TT * 4) { const int sl = CWS(int, WS_SLOT)[i]; if (sl >= 0 && sl < MAXSLOT) atomicAdd(CWS(int, WS_CHK_CNT) + sl, 1); else atomicAdd((float*)(A.ws + WS_CTL) + CW_CHK + 2 * A.id, 1.0f); }
}
__global__ void chk_slots(CArgs A) {
    const int i = blockIdx.x * 256 + threadIdx.x; float e2 = 0.f, r2 = 0.f;
    if (i < MAXSLOT) { const int c = CWS(int, WS_CHK_CNT)[i]; if (c > 1) e2 += 1.f; }
    if (i < 8192) { const unsigned a = hsh(i * 5 + 3) % (unsigned)(TT * 4); const int row = a >> 2, sl = CWS(int, WS_SLOT)[a], e = CWS(int, WS_TOPE)[a];
        if (CWS(int, WS_TILEEXP)[sl >> 8] != e) e2 += 1.f;
        if (CWS(float, WS_GSLOT)[sl] != CWS(float, WS_TOPG)[a]) e2 += 1.f;
        if (CWS(int, WS_TOKSLOT)[sl] != row) e2 += 1.f; r2 += 1.f; }
    chk_acc(A, e2, r2);
}
__global__ void chk_moe(CArgs A, int which) {
    const unsigned a = hsh(blockIdx.x * 5 + 3) % (unsigned)(TT * 4); const int sl = CWS(int, WS_SLOT)[a], e = CWS(int, WS_TILEEXP)[sl >> 8];
    const int c = (int)((hsh(blockIdx.x * 977 + 5) + 7u * threadIdx.x) % 1024u);
    float ref, got;
    if (which == 0) { const float* W = A.in[I_W1] + ((size_t)A.layer * 32 + e) * 1024 * 2048; const unsigned char* x = CWS(unsigned char, WS_HB) + (size_t)(a >> 2) * DM; float g = 0.f, l = 0.f;
        for (int k = 0; k < 1024; ++k) { const float xv = f8v(x + k); g += xv * W[(size_t)k * 2048 + c]; l += xv * W[(size_t)k * 2048 + 1024 + c]; }
        g += A.in[I_B1][((size_t)A.layer * 32 + e) * 2048 + c]; l += A.in[I_B1][((size_t)A.layer * 32 + e) * 2048 + 1024 + c];
        g = fminf(g, 7.f); l = fminf(fmaxf(l, -7.f), 7.f); ref = g / (1.0f + __expf(-1.702f * g)) * (l + 1.0f); got = f8v(CWS(unsigned char, WS_HA) + (size_t)sl * DM + c); }
    else { const float* W = A.in[I_W2] + ((size_t)A.layer * 32 + e) * 1024 * 1024; const unsigned char* x = CWS(unsigned char, WS_HA) + (size_t)sl * DM; float y = 0.f;
        for (int k = 0; k < 1024; ++k) y += f8v(x + k) * W[(size_t)k * 1024 + c];
        ref = y + A.in[I_B2][((size_t)A.layer * 32 + e) * 1024 + c]; got = f8v(CWS(unsigned char, WS_XG) + (size_t)sl * DM + c) * (1.0f / YS_SCALE); }
    chk_acc(A, (got - ref) * (got - ref), ref * ref);
}
__global__ void chk_combine(CArgs A) {
    const int row = srow(blockIdx.x), c = (int)((hsh(blockIdx.x * 977 + 5) + 7u * threadIdx.x) % 1024u);
    float y = 0.f; for (int k = 0; k < 4; ++k) y += CWS(float, WS_TOPG)[(size_t)row * 4 + k] * (1.0f / YS_SCALE) * f8v(CWS(unsigned char, WS_XG) + (size_t)CWS(int, WS_SLOT)[(size_t)row * 4 + k] * DM + c);
    const float gate = naive_mod(A, A.layer, row < TL ? (row >> 13) : 4, 5 * 1024 + c);
    const float ref = CWS(float, WS_CHK)[(size_t)row * DM + c] + gate * y, got = CWS(float, WS_XLC)[(size_t)row * DM + c];
    chk_acc(A, (got - ref) * (got - ref), (gate * y) * (gate * y));
}
__global__ void chk_report(CArgs A) {
    if (threadIdx.x == 0 && blockIdx.x == 0) { const float* acc = (const float*)(A.ws + WS_CTL) + CW_CHK; int bad = 0, bad2 = 0;
        for (int id = NID - 1; id >= 1; --id) { const int q = (id - 1) % IDS_PER_PAIR + 1; const float tol = (id == ID_PROB || (q >= 6 && q <= 10) || q == 18 || q == 19 || q == 20 || q == 1 || q == 2 || q == 17 || q == 13 || q == 14 || q == 16 || q == 23 || q == 24 || q == 26) ? 0.1f : 0.03f;
            const float e2 = acc[2 * id], r2 = acc[2 * id + 1]; if (r2 <= 0.f || !(e2 <= tol * tol * r2)) { bad2 = bad; bad = id; } }
        if (bad) A.out[0] = 1000.0f * (float)bad;
        if (bad2) A.out[1] = 1000.0f * (float)bad2; }
}
static void chk_before(int p, const Args& a, hipStream_t st) {
    const int q = p < 2 ? -1 : (p - 2) % NPH_PAIR;
    if (q == 8 || q == 18) (void)hipMemsetAsync(a.ws + WS_CHK_CNT, 0, (size_t)MAXSLOT * 4, st);
    if (q == 4 || q == 11 || q == 14 || q == 21) (void)hipMemcpyAsync(a.ws + WS_CHK, a.ws + WS_XLC, (size_t)TT * DM * 4, hipMemcpyDeviceToDevice, st);
}
static void chk_after(int p, const Args& a, hipStream_t st) {
    CArgs A{}; for (int i = 0; i < 25; ++i) A.in[i] = a.in[i]; A.out = a.out; A.ws = a.ws;
    const int lp = p < 2 ? 0 : (p - 2) / NPH_PAIR, q = p < 2 ? -1 : (p - 2) % NPH_PAIR, base = IDS_PER_PAIR * lp;
    unsigned char* ws = a.ws; const int le = 2 * lp, lod = 2 * lp + 1;
#define CK(idv, layerv, kern, grid, ...) do { A.id = base + (idv); A.layer = (layerv); hipLaunchKernelGGL(kern, dim3(grid), dim3(256), 0, st, A, ##__VA_ARGS__); } while (0)
#define CK0(idv, layerv, kern, grid) do { A.id = base + (idv); A.layer = (layerv); hipLaunchKernelGGL(kern, dim3(grid), dim3(256), 0, st, A); } while (0)
    if (p == 1) { A.id = ID_PROB; A.layer = 0; hipLaunchKernelGGL(chk_norm_router, dim3(48), dim3(256), 0, st, A, 0, (const bf16_t*)(ws + WS_HB), 0); }
    if (q == 0) CK(1, le, chk_gemm, 64, (const bf16_t*)(ws + WS_HB), 0, a.in[I_EVWIN] + (size_t)lp * 1024 * EV_IN, (int)EV_IN, 1024, (int)EV_IN, (const bf16_t*)(ws + WS_PB), (int)EV_LD);
    if (q == 1) CK0(2, le, chk_e2, 48);
    if (q == 2) { CK(3, le, chk_gemm, 64, (const bf16_t*)(ws + WS_PB) + 768, (int)EV_LD, a.in[I_EVWUQ] + (size_t)lp * 768 * 768, 768, 768, 768, (const bf16_t*)(ws + WS_QB), 768);
                  CK(4, le, chk_gemm, 64, (const bf16_t*)(ws + WS_PB) + 1536, (int)EV_LD, a.in[I_EVWUKV] + (size_t)lp * 256 * 1024, 1024, 256, 1024, (const bf16_t*)(ws + WS_KVB), 1024);
                  CK0(5, le, chk_mark, 1); }
    if (q == 3) { CK(6, le, chk_attn, 96, 0, 0); CK(7, le, chk_attn, 48, 1, 0); CK(8, le, chk_attn, 32, 0, 1); CK(9, le, chk_attn, 32, 1, 1); }
    if (q == 4) CK(10, le, chk_outproj, 48, a.in[I_EVWOUT] + (size_t)lp * 1024 * 1024);
    if (q == 7) CK(11, le, chk_norm_router, 48, 3, (const bf16_t*)(ws + WS_PB), (int)H3_LD);
    if (q == 8) { CK0(12, le, chk_slots_count, (TT * 4 + 255) / 256); CK0(12, le, chk_slots, MAXSLOT / 256); }
    if (q == 9) CK(13, le, chk_moe, 64, 0);
    if (q == 10) CK(14, le, chk_moe, 64, 1);
    if (q == 11) { CK0(15, le, chk_combine, 64); CK(16, le + 1, chk_norm_router, 48, 0, (const bf16_t*)(ws + WS_HB), 0); }
    if (q == 12) CK(17, lod, chk_gemm, 64, (const bf16_t*)(ws + WS_HB), 0, a.in[I_ODWIN] + (size_t)lp * 1024 * 3072, 3072, 1024, 3072, (const bf16_t*)(ws + WS_PB), (int)OD_LD);
    if (q == 13) { CK(18, lod, chk_attn, 96, 2, 0); CK(19, lod, chk_attn, 32, 2, 1); }
    if (q == 14) CK(20, lod, chk_outproj, 48, a.in[I_ODWOUT] + (size_t)lp * 1024 * 1024);
    if (q == 17) CK(21, lod, chk_norm_router, 48, 3, (const bf16_t*)(ws + WS_PB), (int)H3_LD);
    if (q == 18) { CK0(22, lod, chk_slots_count, (TT * 4 + 255) / 256); CK0(22, lod, chk_slots, MAXSLOT / 256); }
    if (q == 19) CK(23, lod, chk_moe, 64, 0);
    if (q == 20) CK(24, lod, chk_moe, 64, 1);
    if (q == 21) { if (lod != 3) { CK0(25, lod, chk_combine, 64); CK(26, lod + 1, chk_norm_router, 48, 0, (const bf16_t*)(ws + WS_HB), 0); } else { CK0(25, lod, chk_mark, 1); CK0(26, lod, chk_mark, 1); } }
    if (p == NPH - 1) { A.id = 0; hipLaunchKernelGGL(chk_report, dim3(1), dim3(64), 0, st, A); }
#undef CK
#undef CK0
}
#endif

extern "C" void kernel_launch(void* const* d_in, const int* in_sizes, int n_in, void* d_out, int out_size, void* d_ws, size_t ws_size, hipStream_t stream) {
    static int grid = 0;
    if (grid == 0) {
        if (n_in != 25 || out_size != TL * DM || ws_size < WS_END) { fprintf(stderr, "kernel_launch: unexpected shapes (n_in %d, out %d, ws %zu < %zu); nothing launched\n", n_in, out_size, ws_size, (size_t)WS_END); grid = -1; return; }
        int dev = 0, cus = 0, per_cu = 0;
        if (hipGetDevice(&dev) != hipSuccess || hipDeviceGetAttribute(&cus, hipDeviceAttributeMultiprocessorCount, dev) != hipSuccess) { grid = -1; return; }
        if (hipFuncSetAttribute((const void*)fwd, hipFuncAttributeMaxDynamicSharedMemorySize, LDS_BYTES) != hipSuccess) { fprintf(stderr, "kernel_launch: hipFuncSetAttribute failed\n"); grid = -1; return; }
        if (hipOccupancyMaxActiveBlocksPerMultiprocessor(&per_cu, (const void*)fwd, 512, LDS_BYTES) != hipSuccess || per_cu < 1) { fprintf(stderr, "kernel_launch: occupancy query says %d blocks per CU\n", per_cu); }
        (void)hipGetLastError();
        grid = cus;
    }
    if (grid < 0) return;
    (void)hipMemsetAsync((char*)d_ws + WS_CTL, 0, CTL_ZERO_BYTES, stream);
    Args a{};
    for (int i = 0; i < 25; ++i) a.in[i] = (const float*)d_in[i];
    a.out = (float*)d_out; a.ws = (unsigned char*)d_ws;
#if MK_PER_PHASE
    for (int p = 0; p < NPH; ++p) {
#if MK_CHECK
        chk_before(p, a, stream);
#endif
        a.ph_lo = p; a.ph_hi = p + 1; hipLaunchKernelGGL(fwd, dim3(grid), dim3(512), LDS_BYTES, stream, a);
#if MK_CHECK
        chk_after(p, a, stream);
#endif
    }
#else
    a.ph_lo = 0; a.ph_hi = NPH;
    hipLaunchKernelGGL(fwd, dim3(grid), dim3(512), LDS_BYTES, stream, a);
#endif
    const hipError_t le = hipPeekAtLastError();
    if (le != hipSuccess) fprintf(stderr, "kernel_launch: launch failed: %s\n", hipGetErrorName(le));
}
```

```cpp
#include <hip/hip_runtime.h>
#include <cstdio>
#include <cstdint>

#ifndef MK_CHECK
#define MK_CHECK 0
#endif
#ifndef MK_PER_PHASE
#define MK_PER_PHASE MK_CHECK
#endif

#define LAS __attribute__((address_space(3)))
#define GAS __attribute__((address_space(1)))
typedef unsigned short bf16_t;
typedef short bf16x8 __attribute__((ext_vector_type(8)));
typedef short s16x4 __attribute__((ext_vector_type(4)));
typedef float f32x2 __attribute__((ext_vector_type(2)));
typedef float f32x4 __attribute__((ext_vector_type(4)));
typedef float f32x16 __attribute__((ext_vector_type(16)));
typedef unsigned u32x2 __attribute__((ext_vector_type(2)));
typedef unsigned u32x4 __attribute__((ext_vector_type(4)));

constexpr int DM = 1024, NB = 4, SEQ = 8192, TL = NB * SEQ, CTXL = 256, TC = NB * CTXL, TT = TL + TC;
constexpr int EV_LD = 2048, OD_LD = 3072;
constexpr int EV_IN = 1824;
constexpr int NEXP = 32, DEXP = 1024;
constexpr int MAXSLOT = 143360, MAXTILE = 560;
constexpr float NORM_EPS = 1e-6f;
constexpr float LOG2E = 1.4426950408889634f;

constexpr size_t MiB = 1u << 20;
constexpr size_t WS_CTL = 0, CTL_ZERO_BYTES = 1 * MiB;
constexpr size_t WS_MOD = 1 * MiB;
constexpr size_t WS_ROPE64 = 1 * MiB + 512 * 1024;
constexpr size_t WS_ROPE32 = WS_ROPE64 + 16384;
constexpr size_t WS_TOPE = 2 * MiB;
constexpr size_t WS_TOPG = WS_TOPE + 540672;
constexpr size_t WS_SLOT = WS_TOPG + 540672;
constexpr size_t WS_HIST = WS_SLOT + 540672;
constexpr size_t WS_TILEEXP = WS_HIST + 131072;
constexpr size_t WS_GSLOT = WS_TILEEXP + 4096;
constexpr size_t WS_TOKSLOT = WS_GSLOT + (size_t)MAXSLOT * 4;
static_assert(WS_TOKSLOT + (size_t)MAXSLOT * 4 <= 6 * MiB, "route map");
constexpr size_t WS_WINE = 6 * MiB, WS_WUQ = 14 * MiB, WS_WUKV = 17 * MiB, WS_WOUTE = 18 * MiB, WS_WINO = 22 * MiB, WS_WOUTO = 34 * MiB;
constexpr size_t WS_W1 = 38 * MiB, WS_W2 = 550 * MiB;
constexpr size_t WS_XLC = 806 * MiB, WS_HB = 938 * MiB, WS_PB = 1004 * MiB, WS_QB = 1202 * MiB, WS_KVB = 1252 * MiB, WS_AO = 1318 * MiB;
constexpr size_t WS_XG = 1384 * MiB, WS_HA = 1664 * MiB, WS_RWT = 1944 * MiB, WS_LOGIT = 1952 * MiB, WS_END = 1960 * MiB;
constexpr size_t WS_LOGIT12 = WS_XG + 160 * MiB;
constexpr int H3_LD = 3072;
constexpr int CW_BAR = 4096;

constexpr int ARENA_BYTES = 131072;
constexpr int LDSCTL_OFF = ARENA_BYTES;
constexpr int LDS_BYTES = 147456;

__device__ __forceinline__ unsigned f2bf(float f) { unsigned u = __builtin_bit_cast(unsigned, f); return (u + 0x7fffu + ((u >> 16) & 1u)) >> 16; }
__device__ __forceinline__ unsigned pk2(float lo, float hi) { return f2bf(lo) | (f2bf(hi) << 16); }
__device__ __forceinline__ f32x4 xun4(u32x2 w) { return (f32x4){__builtin_bit_cast(float, w.x << 16), __builtin_bit_cast(float, w.x & 0xffff0000u), __builtin_bit_cast(float, w.y << 16), __builtin_bit_cast(float, w.y & 0xffff0000u)}; }
__device__ __forceinline__ u32x2 xpk4(f32x4 v) { return (u32x2){pk2(v.x, v.y), pk2(v.z, v.w)}; }
__device__ __forceinline__ float bflo(unsigned w) { return __builtin_bit_cast(float, w << 16); }
__device__ __forceinline__ float bfhi(unsigned w) { return __builtin_bit_cast(float, w & 0xffff0000u); }
__device__ __forceinline__ float wave_sum(float v) {
#pragma unroll
    for (int o = 1; o < 64; o <<= 1) v += __shfl_xor(v, o);
    return v;
}
#define LDS_WAIT() asm volatile("s_waitcnt lgkmcnt(0)" ::: "memory")
__device__ __forceinline__ unsigned cvt4_fp8(float a, float b, float c, float d) { unsigned w = 0u; w = __builtin_amdgcn_cvt_pk_fp8_f32(a, b, w, false); w = __builtin_amdgcn_cvt_pk_fp8_f32(c, d, w, true); return w; }
__device__ __forceinline__ void swap16(unsigned& a, unsigned& b) { asm volatile("s_nop 1\n\tv_permlane16_swap_b32 %0, %1\n\ts_nop 1" : "+v"(a), "+v"(b)); }
constexpr float YS_SCALE = 16.0f;
constexpr float W8_SCALE = 32.0f;
__device__ __forceinline__ int opaque_tid() { int t = threadIdx.x; asm volatile("" : "+v"(t)); return t; }

#define XB_TMO      128
#define XB_XCNT(j)  (256  + 64 * (j))
#define XB_XSUB(j)  (1280 + 64 * (j))
#define XB_XGEN(j)  (2304 + 64 * (j))
#define XB_TOP      3328
#define XB_TOPGEN   3392
#define XCD_BAR_WORDS 3456
#define XB_SPIN_CAP (1u << 18)

__device__ __forceinline__ unsigned xb_ld(unsigned* p)              { return __hip_atomic_load(p, __ATOMIC_RELAXED, __HIP_MEMORY_SCOPE_AGENT); }
__device__ __forceinline__ unsigned xb_add(unsigned* p, unsigned v) { return __hip_atomic_fetch_add(p, v, __ATOMIC_RELAXED, __HIP_MEMORY_SCOPE_AGENT); }
__device__ __forceinline__ unsigned xb_xcc_id() { return (unsigned)__builtin_amdgcn_s_getreg((3 << 11) | 20) & 0xFu; }
#define XB_SPIN(cond, bar) do { unsigned _sp = 0; while (cond) { __builtin_amdgcn_s_sleep(1); \
    if ((++_sp & 255u) == 0u) { if (xb_ld(&(bar)[XB_TMO])) break; if (_sp > XB_SPIN_CAP) { atomicAdd(&(bar)[XB_TMO], 1u); break; } } } } while (0)

struct XcdBarrier { unsigned* bar; unsigned x; volatile LAS unsigned* st; };

__device__ __forceinline__ XcdBarrier xcd_barrier_post(unsigned* bar, volatile LAS unsigned* st) {
    XcdBarrier b; b.bar = bar; b.x = xb_xcc_id(); b.st = st;
    if (threadIdx.x == 0) (void)xb_add(&bar[XB_XCNT(b.x)], 1u);
    return b;
}
__device__ __forceinline__ void xcd_barrier_complete(unsigned* bar, unsigned x, unsigned& nloc, unsigned& nx) {
    const unsigned G = gridDim.x * gridDim.y * gridDim.z;
    unsigned sum, cnt, mine, sp = 0u;
    for (;;) {
        sum = 0u; cnt = 0u; mine = 0u;
#pragma unroll
        for (unsigned j = 0; j < 16; ++j) { const unsigned c = xb_ld(&bar[XB_XCNT(j)]); sum += c; cnt += (c > 0u) ? 1u : 0u; mine = (j == x) ? c : mine; }
        if (sum == G) break;
        __builtin_amdgcn_s_sleep(1);
        if ((++sp & 255u) == 0u) { if (xb_ld(&bar[XB_TMO])) break; if (sp > XB_SPIN_CAP) { atomicAdd(&bar[XB_TMO], 1u); break; } }
    }
    nloc = mine > 0u ? mine : 1u; nx = cnt > 0u ? cnt : 1u;
}
__device__ __forceinline__ void xcd_barrier(const XcdBarrier& b) {
    asm volatile("s_waitcnt vmcnt(0)" ::: "memory");
    __syncthreads();
    if (threadIdx.x == 0) {
        unsigned* bar = b.bar;
        __builtin_amdgcn_s_waitcnt(0);
        unsigned nloc = b.st[0], nx = b.st[1];
        if (nloc == 0u) { xcd_barrier_complete(bar, b.x, nloc, nx); b.st[0] = nloc; b.st[1] = nx; }
        const unsigned old = xb_add(&bar[XB_XSUB(b.x)], 1u);
        const unsigned gen = old / nloc;
        if (old + 1u == (gen + 1u) * nloc) {
            __builtin_amdgcn_fence(__ATOMIC_RELEASE, "agent");
            asm volatile("s_waitcnt vmcnt(0)" ::: "memory");
            const unsigned og = xb_add(&bar[XB_TOP], 1u);
            const unsigned tg = og / nx;
            if (og + 1u == (tg + 1u) * nx) xb_add(&bar[XB_TOPGEN], 1u);
            else XB_SPIN(xb_ld(&bar[XB_TOPGEN]) == tg, bar);
            __builtin_amdgcn_fence(__ATOMIC_ACQUIRE, "agent");
            xb_add(&bar[XB_XGEN(b.x)], 1u);
            asm volatile("s_waitcnt vmcnt(0)" ::: "memory");
        } else {
            XB_SPIN(xb_ld(&bar[XB_XGEN(b.x)]) == gen, bar);
            __builtin_amdgcn_fence(__ATOMIC_ACQUIRE, "agent");
            asm volatile("s_waitcnt vmcnt(0)" ::: "memory");
        }
    }
    __syncthreads();
}

namespace pg8 {
constexpr int BM = 256, BK = 64, HALF = 128, HTB = HALF * BK * 2, STAGE_BYTES = 8 * HTB, NXCD = 8, WGM = 8;
__host__ __device__ __forceinline__ int lds_byte(int r, int c) { const int st = (r >> 4) * 2 + (c >> 5), rr = r & 15, cc = c & 31, ob = rr * 64 + cc * 2; return st * 1024 + (ob ^ (((ob >> 9) & 1) << 5)); }
__host__ __device__ __forceinline__ void stage_rc(int b, int& R, int& C) { const int st = b / 1024, sb = b % 1024, swz = sb ^ (((sb >> 9) & 1) << 5); R = (st >> 1) * 16 + swz / 64; C = (st & 1) * 32 + (swz % 64) / 2; }
__host__ __device__ __forceinline__ int perm32(int rho) { const int n = rho >> 4, i = rho & 15; return 8 * (i >> 2) + 4 * n + (i & 3); }

typedef int v4i_t __attribute__((ext_vector_type(4)));
typedef int v8i_t __attribute__((ext_vector_type(8)));
struct Unit { unsigned a, b; int pm, pn, aux; };

struct DenseOrder {
    const char* A; const char* Bt; unsigned lda2, ldb2; int nM, nN, nwg, G, c;
    __device__ __forceinline__ const void* baseA() const { return A; }
    __device__ __forceinline__ const void* baseB() const { return Bt; }
    __device__ __forceinline__ const int* gather() const { return nullptr; }
    __device__ __forceinline__ void init(const void* A_, size_t lda_bytes, const void* Bt_, size_t ldb_bytes, int M, int N, int G_, int c_) { A = (const char*)A_; Bt = (const char*)Bt_; lda2 = (unsigned)lda_bytes; ldb2 = (unsigned)ldb_bytes; nM = M / BM; nN = N / BM; nwg = nM * nN; G = G_; c = c_; }
    __device__ __forceinline__ bool next(int i, Unit& u) const {
        const long L = (long)i * G + c; if (L >= nwg) return false;
        int wgid = (int)L; { const int q = nwg / NXCD, r = nwg % NXCD, xcd = wgid % NXCD, off = wgid / NXCD; wgid = (xcd < r ? xcd * (q + 1) : r * (q + 1) + (xcd - r) * q) + off; }
        const int nig = WGM * nN, gid = wgid / nig, fm = gid * WGM, gsz = (nM - fm) < WGM ? (nM - fm) : WGM;
        u.pm = fm + ((wgid % nig) % gsz); u.pn = (wgid % nig) / gsz; u.aux = 0;
        u.a = (unsigned)u.pm * BM * lda2; u.b = (unsigned)u.pn * BM * ldb2; return true;
    }
};
struct RouterOrder {
    const char* A; const char* Bt; unsigned lda2, ldb2; int nM, G, c;
    __device__ __forceinline__ const void* baseA() const { return A; }
    __device__ __forceinline__ const void* baseB() const { return Bt; }
    __device__ __forceinline__ const int* gather() const { return nullptr; }
    __device__ __forceinline__ bool next(int i, Unit& u) const {
        const int L = i * G + c; if (L >= nM * 3) return false;
        u.pm = L / 3; u.aux = L - 3 * u.pm; u.pn = 0;
        u.a = (unsigned)u.pm * BM * lda2 + (u.aux == 1 ? 2048u : 0u); u.b = (unsigned)u.aux * 2048u; return true;
    }
};
struct MoeOrder {
    const char* A; const char* W; const LAS int* tile_exp; const int* tokslot; unsigned lda2, ldb2, wstride; int ntiles, nN, G, c;
    __device__ __forceinline__ const void* baseA() const { return A; }
    __device__ __forceinline__ const void* baseB() const { return W; }
    __device__ __forceinline__ const int* gather() const { return tokslot; }
    __device__ __forceinline__ bool next(int i, Unit& u) const {
        const int tpr = G / nN, tpx = tpr >> 3, x = c & 7, j = c >> 3;
        int tile, pn;
        if ((G & 7) == 0 && tpx * 8 == tpr && tpx > 0) { tile = i * tpr + x * tpx + j / nN; pn = j % nN; }
        else { const long L = (long)i * G + c; tile = (int)(L / nN); pn = (int)(L % nN); }
        if (tile >= ntiles) return false;
        const int e = __builtin_amdgcn_readfirstlane(tile_exp[tile]);
        u.pm = tile; u.pn = pn; u.aux = e; u.a = (unsigned)tile * BM * lda2; u.b = (unsigned)e * wstride + (unsigned)pn * BM * ldb2; return true;
    }
};

__device__ __forceinline__ unsigned cvt_pk_bf16(float lo, float hi) { unsigned r; asm volatile("v_cvt_pk_bf16_f32 %0, %1, %2" : "=v"(r) : "v"(lo), "v"(hi)); return r; }

struct EpiBf16 {
    static constexpr bool PERM = true; static constexpr bool WIDE16 = false;
    bf16_t* O; int ldc; float sc;
    struct Pre {}; static constexpr bool HAS_BIAS = false;
    __device__ __forceinline__ void operator()(const f32x4 (&acc)[2][2][4][2], const Unit& u, int wr, int wc, int fr, int fq, const Pre& pre) const {
        const int row0 = u.pm * BM + wr * 64 + fr, col0 = u.pn * BM + wc * 32 + 8 * fq;
#pragma unroll
        for (int ai = 0; ai < 2; ++ai)
#pragma unroll
            for (int m = 0; m < 4; ++m) { bf16_t* rowp = O + (size_t)(row0 + ai * HALF + m * 16) * ldc + col0;
#pragma unroll
                for (int bj = 0; bj < 2; ++bj) { const f32x4 v0 = acc[ai][bj][m][0] * sc, v1 = acc[ai][bj][m][1] * sc;
                    u32x4 w; w.x = cvt_pk_bf16(v0[0], v0[1]); w.y = cvt_pk_bf16(v0[2], v0[3]); w.z = cvt_pk_bf16(v1[0], v1[1]); w.w = cvt_pk_bf16(v1[2], v1[3]);
                    *(u32x4*)(rowp + bj * HALF) = w; } }
    }
};
struct EpiResid {
    static constexpr bool PERM = true; static constexpr bool WIDE16 = false;
    bf16_t* X; const float* modl; float sc;
    struct Pre {}; static constexpr bool HAS_BIAS = false;
    __device__ __forceinline__ void operator()(const f32x4 (&acc)[2][2][4][2], const Unit& u, int wr, int wc, int fr, int fq, const Pre& pre) const {
        const int row0 = u.pm * BM + wr * 64 + fr, col0 = u.pn * BM + wc * 32 + 8 * fq;
        const int bidx = u.pm < 128 ? (u.pm >> 5) : 4;
        const float* gp = modl + (size_t)bidx * 6144 + col0;
        f32x4 gv[2][2];
#pragma unroll
        for (int bj = 0; bj < 2; ++bj)
#pragma unroll
            for (int n = 0; n < 2; ++n) gv[bj][n] = *(const f32x4*)(gp + bj * HALF + 4 * n) * sc;
        u32x4 xc[2], xn[2];
        { const bf16_t* rowp = X + (size_t)row0 * DM + col0; xc[0] = *(const u32x4*)rowp; xc[1] = *(const u32x4*)(rowp + HALF); xn[0] = xc[0]; xn[1] = xc[1]; }
#pragma unroll
        for (int g = 0; g < 8; ++g) { const int ai = g >> 2, m = g & 3;
            bf16_t* rowp = X + (size_t)(row0 + ai * HALF + m * 16) * DM + col0;
            if (g < 7) { const bf16_t* nrow = X + (size_t)(row0 + ((g + 1) >> 2) * HALF + ((g + 1) & 3) * 16) * DM + col0; xn[0] = *(const u32x4*)nrow; xn[1] = *(const u32x4*)(nrow + HALF); }
            asm volatile("" ::: "memory");
#pragma unroll
            for (int bj = 0; bj < 2; ++bj) { const u32x4 w = xc[bj];
                const f32x4 a = xun4((u32x2){w.x, w.y}) + gv[bj][0] * acc[ai][bj][m][0], b = xun4((u32x2){w.z, w.w}) + gv[bj][1] * acc[ai][bj][m][1];
                const u32x2 pa = xpk4(a), pb = xpk4(b);
                *(u32x4*)(rowp + bj * HALF) = (u32x4){pa.x, pa.y, pb.x, pb.y}; }
            asm volatile("" ::: "memory");
            xc[0] = xn[0]; xc[1] = xn[1]; }
    }
};
struct EpiLogits {
    static constexpr bool PERM = false; static constexpr bool WIDE16 = false;
    float* LG0; float* LG12; const float* rb;
    struct Pre {}; static constexpr bool HAS_BIAS = false;
    __device__ __forceinline__ void operator()(const f32x4 (&acc)[2][2][4][2], const Unit& u, int wr, int wc, int fr, int fq, const Pre& pre) const {
        if (wc != 0) return;
        const int row0 = u.pm * BM + wr * 64 + fr;
        float* LG = u.aux == 0 ? LG0 : LG12 + (size_t)(u.aux - 1) * TT * 32;
        const float bs = u.aux == 0 ? 1.0f : 0.0f;
        const f32x4 b0 = *(const f32x4*)(rb + 4 * fq) * bs, b1 = *(const f32x4*)(rb + 16 + 4 * fq) * bs;
#pragma unroll
        for (int ai = 0; ai < 2; ++ai)
#pragma unroll
            for (int m = 0; m < 4; ++m) { float* rowp = LG + (size_t)(row0 + ai * HALF + m * 16) * 32 + 4 * fq;
                *(f32x4*)rowp = acc[ai][0][m][0] + b0; *(f32x4*)(rowp + 16) = acc[ai][0][m][1] + b1; }
    }
};
struct EpiSwiglu {
    static constexpr bool PERM = true; static constexpr bool WIDE16 = false;
    unsigned char* O; const float* b1l;
    struct Pre { const LAS float* b; };
    static constexpr bool HAS_BIAS = true;
    __device__ __forceinline__ float bias_of(const Unit& u, int i) const { return b1l[(size_t)u.aux * 2048 + (i < 128 ? u.pn * HALF + i : 1024 + u.pn * HALF + (i - 128))]; }
    __device__ __forceinline__ void operator()(const f32x4 (&acc)[2][2][4][2], const Unit& u, int wr, int wc, int fr, int fq, const Pre& pre) const {
        const int row0 = u.pm * BM + wr * 64 + fr, cg = u.pn * HALF + wc * 32 + 8 * fq;
        f32x4 bg[2], bl[2];
#pragma unroll
        for (int n = 0; n < 2; ++n) { bg[n] = *(const LAS f32x4*)(pre.b + wc * 32 + 8 * fq + 4 * n); bl[n] = *(const LAS f32x4*)(pre.b + 128 + wc * 32 + 8 * fq + 4 * n) + 1.0f; }
#pragma unroll
        for (int ai = 0; ai < 2; ++ai)
#pragma unroll
            for (int mp = 0; mp < 2; ++mp) { unsigned wx[2], wy[2];
#pragma unroll
                for (int mm = 0; mm < 2; ++mm) { const int m = 2 * mp + mm; f32x4 r[2];
#pragma unroll
                    for (int n = 0; n < 2; ++n) { const f32x4 k4 = {1.0f / W8_SCALE, 1.0f / W8_SCALE, 1.0f / W8_SCALE, 1.0f / W8_SCALE};
                        f32x4 g = __builtin_elementwise_fma(acc[ai][0][m][n], k4, bg[n]), l = __builtin_elementwise_fma(acc[ai][1][m][n], k4, bl[n]);
#pragma unroll
                        for (int j = 0; j < 4; ++j) { g[j] = fminf(g[j], 7.0f); l[j] = fminf(fmaxf(l[j], -6.0f), 8.0f); }
                        f32x4 t = g * (-1.702f * LOG2E);
#pragma unroll
                        for (int j = 0; j < 4; ++j) t[j] = __builtin_amdgcn_exp2f(t[j]);
                        t = t + 1.0f;
#pragma unroll
                        for (int j = 0; j < 4; ++j) t[j] = __builtin_amdgcn_rcpf(t[j]);
                        r[n] = (g * t) * l; }
                    wx[mm] = cvt4_fp8(r[0][0], r[0][1], r[0][2], r[0][3]); wy[mm] = cvt4_fp8(r[1][0], r[1][1], r[1][2], r[1][3]); }
                swap16(wx[0], wx[1]); swap16(wy[0], wy[1]);
                unsigned char* rowp = O + (size_t)(row0 + ai * HALF + (2 * mp + (fq & 1)) * 16) * DEXP + (cg - 8 * (fq & 1));
                *(u32x4*)rowp = (u32x4){wx[0], wy[0], wx[1], wy[1]}; }
    }
};
struct EpiGate {
    static constexpr bool PERM = true; static constexpr bool WIDE16 = true;
    unsigned char* O; const float* b2l;
    struct Pre { const LAS float* b; };
    static constexpr bool HAS_BIAS = true;
    __device__ __forceinline__ float bias_of(const Unit& u, int i) const { return b2l[(size_t)u.aux * 1024 + u.pn * BM + i]; }
    __device__ __forceinline__ void operator()(const f32x4 (&acc)[2][2][4][2], const Unit& u, int wr, int wc, int fr, int fq, const Pre& pre) const {
        const int row0 = u.pm * BM + wr * 64 + fr, col0 = u.pn * BM + wc * 64 + 16 * fq;
        f32x4 bv[2][2];
#pragma unroll
        for (int bj = 0; bj < 2; ++bj)
#pragma unroll
            for (int n = 0; n < 2; ++n) bv[bj][n] = *(const LAS f32x4*)(pre.b + wc * 64 + 16 * fq + 8 * bj + 4 * n) * YS_SCALE;
#pragma unroll
        for (int ai = 0; ai < 2; ++ai)
#pragma unroll
            for (int m = 0; m < 4; ++m) { unsigned char* rowp = O + (size_t)(col0 >> 6) * ((size_t)MAXSLOT * 64) + (size_t)(row0 + ai * HALF + m * 16) * 64 + (col0 & 63);
                u32x4 w;
                { const f32x4 v = acc[ai][0][m][0] * (YS_SCALE / W8_SCALE) + bv[0][0]; w.x = cvt4_fp8(v[0], v[1], v[2], v[3]); }
                { const f32x4 v = acc[ai][0][m][1] * (YS_SCALE / W8_SCALE) + bv[0][1]; w.y = cvt4_fp8(v[0], v[1], v[2], v[3]); }
                { const f32x4 v = acc[ai][1][m][0] * (YS_SCALE / W8_SCALE) + bv[1][0]; w.z = cvt4_fp8(v[0], v[1], v[2], v[3]); }
                { const f32x4 v = acc[ai][1][m][1] * (YS_SCALE / W8_SCALE) + bv[1][1]; w.w = cvt4_fp8(v[0], v[1], v[2], v[3]); }
                *(u32x4*)rowp = w; }
    }
};

template <class Epi, class Sched, bool FP8 = false, bool GATHER = false>
__device__ __forceinline__ void gemm_phase(LAS unsigned char* lds, const int K, const size_t lda2, const size_t ldb2, const Sched& S, const Epi& E) {
    const int tid = opaque_tid(), wid = __builtin_amdgcn_readfirstlane(tid >> 6), lane = tid & 63, wr = wid >> 2, wc = wid & 3, fr = lane & 15, fq = lane >> 4;
    int nt = K / BK; asm volatile("" : "+s"(nt));
    unsigned voffA[2], voffB[2];
#pragma unroll
    for (int i = 0; i < 2; ++i) { int R, C; stage_rc(tid * 16 + i * 8192, R, C); int Rb = Epi::PERM ? ((R & ~31) + perm32(R & 31)) : R;
        if constexpr (Epi::WIDE16) Rb = (Rb >> 5) * 64 + ((Rb >> 3) & 3) * 16 + (Rb & 7);
        voffA[i] = (unsigned)(R * (unsigned)lda2 + C * 2u); voffB[i] = (unsigned)(Rb * (unsigned)ldb2 + C * 2u); }
    const unsigned kstep = (unsigned)(BK * 2);
    const unsigned hstepA = (unsigned)(HALF * lda2), hstepB = (unsigned)((Epi::WIDE16 ? 8 : HALF) * ldb2);
    const unsigned ldsw = (unsigned)wid * 1024u;
    const int aoff = lds_byte(wr * 64 + fr, fq * 8), boff = lds_byte(wc * 32 + fr, fq * 8);
    const __amdgpu_buffer_rsrc_t rsA = __builtin_amdgcn_make_buffer_rsrc((void*)S.baseA(), 0, 0x7fffffff, 0x00020000);
    const __amdgpu_buffer_rsrc_t rsB = __builtin_amdgcn_make_buffer_rsrc((void*)S.baseB(), 0, 0x7fffffff, 0x00020000);
#define PG8_SA(b, h) (((b) * 2 + (h)) * HTB)
#define PG8_SB(b, h) ((4 + (b) * 2 + (h)) * HTB)
#define PG8_STAGE(bufoff, rs, soff, voff) do { _Pragma("unroll") for (int _i = 0; _i < 2; ++_i) \
        __builtin_amdgcn_raw_ptr_buffer_load_lds(rs, (LAS unsigned*)(lds + (bufoff) + ldsw + _i * 8192), 16, (voff)[_i], (soff), 0, 0); } while (0)
#define PG8_STAGEA(b, h, aoffs, koff, nx) do { if constexpr (GATHER) { _Pragma("unroll") for (int _i = 0; _i < 2; ++_i) \
            __builtin_amdgcn_raw_ptr_buffer_load_lds(rsA, (LAS unsigned*)(lds + PG8_SA(b, h) + ldsw + _i * 8192), 16, (nx) ? ngvo[h][_i] : gvo[h][_i], (koff), 0, 0); } \
        else PG8_STAGE(PG8_SA(b, h), rsA, (aoffs) + (h) * hstepA, voffA); } while (0)
#define PG8_RD8(off) __builtin_shufflevector(*(const LAS v4i_t*)(lds + (off)), *(const LAS v4i_t*)(lds + (off) + 1024), 0, 1, 2, 3, 4, 5, 6, 7)
#define PG8_LDA(dst, b, h) do { if constexpr (FP8) { _Pragma("unroll") for (int m = 0; m < 4; ++m) dst##8[m] = PG8_RD8(PG8_SA(b, h) + aoff + m * 2048); } \
        else { _Pragma("unroll") for (int m = 0; m < 4; ++m) _Pragma("unroll") for (int k = 0; k < 2; ++k) dst[m][k] = *(const LAS bf16x8*)(lds + PG8_SA(b, h) + aoff + m * 2048 + k * 1024); } } while (0)
#define PG8_LDB(dst, b, h) do { if constexpr (FP8) { _Pragma("unroll") for (int n = 0; n < 2; ++n) dst##8[n] = PG8_RD8(PG8_SB(b, h) + boff + n * 2048); } \
        else { _Pragma("unroll") for (int n = 0; n < 2; ++n) _Pragma("unroll") for (int k = 0; k < 2; ++k) dst[n][k] = *(const LAS bf16x8*)(lds + PG8_SB(b, h) + boff + n * 2048 + k * 1024); } } while (0)
#define PG8_MMA(ai, bj, At, Bt) do { __builtin_amdgcn_s_setprio(1); _Pragma("unroll") for (int m = 0; m < 4; ++m) _Pragma("unroll") for (int n = 0; n < 2; ++n) { \
        if constexpr (FP8) asm volatile("s_nop 1\n\tv_mfma_scale_f32_16x16x128_f8f6f4 %0, %1, %2, %0, %3, %3 op_sel_hi:[0,0,0]" : "+v"(acc[ai][bj][m][n]) : "v"(Bt##8[n]), "v"(At##8[m]), "v"(sc1)); \
        else { _Pragma("unroll") for (int k = 0; k < 2; ++k) acc[ai][bj][m][n] = __builtin_amdgcn_mfma_f32_16x16x32_bf16(Bt[n][k], At[m][k], acc[ai][bj][m][n], 0, 0, 0); } } \
        __builtin_amdgcn_s_setprio(0); } while (0)
#define PG8_WAIT_V(n) asm volatile("s_waitcnt vmcnt(" #n ")" ::: "memory")
#define PG8_WAIT_L(n) asm volatile("s_waitcnt lgkmcnt(" #n ")" ::: "memory")
#define PG8_BAR __builtin_amdgcn_s_barrier()
#define PG8_SCHED __builtin_amdgcn_sched_barrier(0)
    Unit cur, nxt; int ui = 0; typename Epi::Pre pre;
    if (!S.next(0, cur)) return;
    f32x4 acc[2][2][4][2];
#pragma unroll
    for (int a = 0; a < 2; ++a)
#pragma unroll
        for (int b = 0; b < 2; ++b)
#pragma unroll
            for (int m = 0; m < 4; ++m)
#pragma unroll
                for (int n = 0; n < 2; ++n) acc[a][b][m][n] = (f32x4){0.f, 0.f, 0.f, 0.f};
    bf16x8 At[4][2], B0[2][2], B1[2][2];
    v8i_t At8[4], B08[2], B18[2];
    int sc1 = 0x7f7f7f7f; asm volatile("" : "+v"(sc1));
    unsigned cA = cur.a, cB = cur.b;
    unsigned gvo[2][2] = {{0u, 0u}, {0u, 0u}}, ngvo[2][2] = {{0u, 0u}, {0u, 0u}};
    int gR[2], gC[2];
#pragma unroll
    for (int i = 0; i < 2; ++i) stage_rc(tid * 16 + i * 8192, gR[i], gC[i]);
#define PG8_GLOAD(dst, pm_) do { if constexpr (GATHER) { const int* tb_ = S.gather() + (pm_) * BM; \
        _Pragma("unroll") for (int h_ = 0; h_ < 2; ++h_) _Pragma("unroll") for (int i_ = 0; i_ < 2; ++i_) dst[h_][i_] = (unsigned)tb_[h_ * HALF + gR[i_]] * (unsigned)lda2 + (unsigned)gC[i_] * 2u; } } while (0)
    PG8_GLOAD(gvo, cur.pm);
    PG8_STAGE(PG8_SB(0, 0), rsB, cB, voffB); PG8_STAGE(PG8_SB(0, 1), rsB, cB + hstepB, voffB); PG8_STAGEA(0, 0, cA, 0u, false); PG8_STAGEA(0, 1, cA, 0u, false);
    if (wr == 1) PG8_BAR;
    PG8_WAIT_V(2); PG8_BAR;
    PG8_STAGE(PG8_SB(1, 0), rsB, cB + kstep, voffB); PG8_STAGEA(1, 0, cA + kstep, kstep, false); PG8_STAGE(PG8_SB(1, 1), rsB, cB + hstepB + kstep, voffB);
    PG8_WAIT_V(6); PG8_BAR;
    for (;;) {
        const bool has_next = S.next(ui + 1, nxt);
        const unsigned nA = has_next ? nxt.a : cA, nB = has_next ? nxt.b : cB;
        LAS int* gl = (LAS int*)(lds + LDSCTL_OFF + 8192) + (ui & 1) * 256;
        for (int t = 0; t < nt; t += 2) {
            const bool last = (t == nt - 2);
            int gstage = 0;
            if constexpr (GATHER) {
                if (t == 0 && has_next) { int tz = threadIdx.x; asm volatile("" : "+v"(tz)); gstage = S.gather()[nxt.pm * BM + (tz & 255)]; }
                if (last) { if (has_next) { _Pragma("unroll") for (int h_ = 0; h_ < 2; ++h_) _Pragma("unroll") for (int i_ = 0; i_ < 2; ++i_) ngvo[h_][i_] = (unsigned)gl[h_ * HALF + gR[i_]] * (unsigned)lda2 + (unsigned)gC[i_] * 2u; }
                            else { _Pragma("unroll") for (int h_ = 0; h_ < 2; ++h_) _Pragma("unroll") for (int i_ = 0; i_ < 2; ++i_) ngvo[h_][i_] = gvo[h_][i_]; } } }
            float bstage = 0.f;
            if constexpr (Epi::HAS_BIAS) { if (last) { int tz = threadIdx.x; asm volatile("" : "+v"(tz)); bstage = E.bias_of(cur, tz & 255); } }
            const unsigned a1 = cA + (unsigned)(t + 1) * kstep, k1 = (unsigned)(t + 1) * kstep;
            const unsigned a2 = last ? nA : cA + (unsigned)(t + 2) * kstep, b2 = last ? nB : cB + (unsigned)(t + 2) * kstep, k2 = last ? 0u : (unsigned)(t + 2) * kstep;
            const unsigned a3 = a2 + kstep, b3 = b2 + kstep, k3 = k2 + kstep;
            PG8_LDB(B0, 0, 0); PG8_LDB(B1, 0, 1); PG8_SCHED; PG8_LDA(At, 0, 0); PG8_STAGEA(1, 1, a1, k1, false);
            PG8_WAIT_V(8); PG8_WAIT_L(0); PG8_BAR; PG8_MMA(0, 0, At, B0); PG8_MMA(0, 1, At, B1); PG8_BAR; PG8_SCHED;
            PG8_LDA(At, 0, 1); PG8_STAGE(PG8_SB(0, 0), rsB, b2, voffB); PG8_STAGE(PG8_SB(0, 1), rsB, b2 + hstepB, voffB); PG8_STAGEA(0, 0, a2, k2, last);
            PG8_WAIT_V(8); PG8_WAIT_L(0); PG8_BAR; PG8_MMA(1, 0, At, B0); PG8_MMA(1, 1, At, B1); PG8_BAR; PG8_SCHED;
            if constexpr (Epi::HAS_BIAS) { if (last) { int tz = threadIdx.x; asm volatile("" : "+v"(tz)); if (tz < 256) ((LAS float*)(lds + LDSCTL_OFF + 2048 + (ui & 1) * 1024))[tz] = bstage; } }
            PG8_LDB(B0, 1, 0); PG8_LDB(B1, 1, 1); PG8_SCHED; PG8_LDA(At, 1, 0); PG8_STAGEA(0, 1, a2, k2, last);
            PG8_WAIT_V(8); PG8_WAIT_L(0); PG8_BAR; PG8_MMA(0, 0, At, B0); PG8_MMA(0, 1, At, B1); PG8_BAR; PG8_SCHED;
            PG8_LDA(At, 1, 1); PG8_STAGE(PG8_SB(1, 0), rsB, b3, voffB); PG8_STAGE(PG8_SB(1, 1), rsB, b3 + hstepB, voffB); PG8_STAGEA(1, 0, a3, k3, last);
            PG8_WAIT_V(8); PG8_WAIT_L(0); PG8_BAR; PG8_MMA(1, 0, At, B0); PG8_MMA(1, 1, At, B1); PG8_BAR; PG8_SCHED;
            if constexpr (GATHER) { if (t == 0 && has_next) { int tz = threadIdx.x; asm volatile("" : "+v"(tz)); if (tz < 256) gl[tz] = gstage; } }
        }
        if constexpr (FP8) asm volatile("s_nop 15\n\ts_nop 7" ::: "memory");
        if (wr == 0) PG8_BAR;
        { int tz = threadIdx.x; asm volatile("" : "+v"(tz)); const int ln = tz & 63;
          if constexpr (Epi::HAS_BIAS) pre.b = (const LAS float*)(lds + LDSCTL_OFF + 2048 + (ui & 1) * 1024);
          E(acc, cur, wr, wc, ln & 15, ln >> 4, pre); }
        if (!has_next) break;
#pragma unroll
        for (int a = 0; a < 2; ++a)
#pragma unroll
            for (int b = 0; b < 2; ++b)
#pragma unroll
                for (int m = 0; m < 4; ++m)
#pragma unroll
                    for (int n = 0; n < 2; ++n) acc[a][b][m][n] = (f32x4){0.f, 0.f, 0.f, 0.f};
        cur = nxt; cA = nA; cB = nB; ++ui;
        if constexpr (GATHER) { _Pragma("unroll") for (int h_ = 0; h_ < 2; ++h_) _Pragma("unroll") for (int i_ = 0; i_ < 2; ++i_) gvo[h_][i_] = ngvo[h_][i_]; }
        if (wr == 1) PG8_BAR;
    }
    PG8_WAIT_V(0);
    PG8_BAR;
#undef PG8_SA
#undef PG8_SB
#undef PG8_STAGE
#undef PG8_STAGEA
#undef PG8_GLOAD
#undef PG8_LDA
#undef PG8_LDB
#undef PG8_MMA
#undef PG8_RD8
#undef PG8_WAIT_V
#undef PG8_WAIT_L
#undef PG8_BAR
#undef PG8_SCHED
}
}

__device__ __forceinline__ u32x4 rope_chunk(u32x4 xw, u32x4 yw, const f32x2* tab, bool first) {
    u32x4 o;
#pragma unroll
    for (int i = 0; i < 4; ++i) {
        const f32x2 cs0 = tab[2 * i], cs1 = tab[2 * i + 1];
        const float x0 = bflo(xw[i]), x1 = bfhi(xw[i]), y0 = bflo(yw[i]), y1 = bfhi(yw[i]);
        const float r0 = first ? x0 * cs0.x - y0 * cs0.y : x0 * cs0.x + y0 * cs0.y;
        const float r1 = first ? x1 * cs1.x - y1 * cs1.y : x1 * cs1.x + y1 * cs1.y;
        o[i] = pk2(r0, r1);
    }
    return o;
}

namespace att {
constexpr int KCS = 1040;
constexpr int KSLOT = 12544, VSLOT = 8192;
constexpr int OFF_K = 0, OFF_V = 4 * KSLOT, OFF_WSF = OFF_V + 4 * VSLOT, OFF_OST = OFF_WSF + 2048, OFF_BIAS = OFF_OST + 32768, ATT_LDS = OFF_BIAS + 2048;
static_assert(ATT_LDS <= ARENA_BYTES, "attention LDS map");
__device__ __forceinline__ int crow(int r, int hi) { return (r & 3) + 8 * (r >> 2) + 4 * hi; }
__device__ __forceinline__ unsigned cvtpk(float lo, float hi) { typedef __bf16 bf16x2_t __attribute__((ext_vector_type(2))); f32x2 v = {lo, hi}; bf16x2_t b = __builtin_convertvector(v, bf16x2_t); return __builtin_bit_cast(unsigned, b); }
__device__ __forceinline__ s16x4 vtr(const LAS unsigned char* p) { return __builtin_bit_cast(s16x4, __builtin_amdgcn_ds_read_tr16_b64_v4i16((LAS s16x4*)p)); }
constexpr float NEGBIG = -1e30f;
__device__ __forceinline__ void pair32(float x, float& a, float& b) {
    unsigned u = __builtin_bit_cast(unsigned, x), v = u;
    asm volatile("s_nop 1\n\tv_permlane32_swap_b32 %0, %1\n\ts_nop 1" : "+v"(u), "+v"(v));
    a = __builtin_bit_cast(float, u); b = __builtin_bit_cast(float, v);
}

__device__ __forceinline__ unsigned xlane32(unsigned x, bool lo) {
    unsigned u = x, v = x;
    asm volatile("s_nop 1\n\tv_permlane32_swap_b32 %0, %1\n\ts_nop 1" : "+v"(u), "+v"(v));
    return lo ? v : u;
}
struct UMla {
    static constexpr int NKC = 12; static constexpr bool PLAIN = true; static constexpr bool SIDED = false;
    const bf16_t* QB; const bf16_t* KVB; const bf16_t* PB; bf16_t* AO; const f32x2* R32; int b, h, qblk; bool ctxq;
    template <int NKS> __device__ __forceinline__ void qfix(bf16x8 (&qr)[NKS], int wid, int r32, int hi) const {
        if (ctxq) return;
        const int t = 256 * qblk + 32 * wid + r32, prow = t >> 6, pcol = t & 63;
#pragma unroll
        for (int f = 0; f < 2; ++f) { const u32x4 own = __builtin_bit_cast(u32x4, qr[4 + f]); u32x4 oth;
            oth.x = xlane32(own.x, hi == 0); oth.y = xlane32(own.y, hi == 0); oth.z = xlane32(own.z, hi == 0); oth.w = xlane32(own.w, hi == 0);
            qr[4 + f] = __builtin_bit_cast(bf16x8, rope_chunk(own, oth, R32 + (f == 0 ? prow : pcol) * 8, hi == 0)); }
    }
    __device__ __forceinline__ float c2() const { return 0.10206207261596577f * LOG2E; }
    __device__ __forceinline__ int ntiles() const { return ctxq ? 4 : 132; }
    __device__ __forceinline__ bool active(int, int) const { return true; }
    __device__ __forceinline__ size_t krow(int t, int key) const { return ctxq ? (size_t)(TL + b * CTXL + 64 * t + key) : (t < 128 ? (size_t)(b * SEQ + 64 * t + key) : (size_t)(TL + b * CTXL + 64 * (t - 128) + key)); }
    __device__ __forceinline__ unsigned kofs() const { return (unsigned)WS_KVB + 256u * h; }  __device__ __forceinline__ unsigned kpitch() const { return 2048u; }
    __device__ __forceinline__ unsigned k2ofs() const { return (unsigned)WS_PB + 3584u; }     __device__ __forceinline__ unsigned k2pitch() const { return 2u * EV_LD; }
    __device__ __forceinline__ unsigned vofs() const { return (unsigned)WS_KVB + 256u * h + 128u; } __device__ __forceinline__ unsigned vpitch() const { return 2048u; }
    __device__ __forceinline__ unsigned trow(int t) const { return (unsigned)krow(t, 0); }
    __device__ __forceinline__ size_t qrow(int wid, int r) const { return ctxq ? (size_t)(TL + b * CTXL + 32 * wid + r) : (size_t)(b * SEQ + 256 * qblk + 32 * wid + r); }
    __device__ __forceinline__ const bf16_t* qptr(int wid, int r) const { return QB + qrow(wid, r) * 768 + 96 * h; }
    __device__ __forceinline__ unsigned char* optr(int wid, int r) const { return (unsigned char*)AO + qrow(wid, r) * 1024 + 512 + 64 * h; }
    __device__ __forceinline__ float m0(int) const { return NEGBIG; }
    __device__ __forceinline__ float l0() const { return 0.f; }
    __device__ __forceinline__ void prep(LAS unsigned char*) const {}
    __device__ __forceinline__ float adjust(int, int, int, int, float s, const LAS unsigned char*) const { return s; }
};
struct UWin {
    static constexpr int NKC = 8; static constexpr bool PLAIN = false; static constexpr bool SIDED = false;
    const bf16_t* PB; bf16_t* AO; const float* sink; int b, kvh, j; bool ctxq; int tlo, nlat;
    template <int NKS> __device__ __forceinline__ void qfix(bf16x8 (&)[NKS], int, int, int) const {}
    __device__ __forceinline__ void init() { tlo = j - 2 < 0 ? 0 : j - 2; const int thi = j + 2 > 127 ? 127 : j + 2; nlat = ctxq ? 0 : thi - tlo + 1; }
    __device__ __forceinline__ float c2() const { return 0.125f * LOG2E; }
    __device__ __forceinline__ int ntiles() const { return nlat + 4; }
    __device__ __forceinline__ bool active(int, int) const { return true; }
    __device__ __forceinline__ size_t krow(int t, int key) const { return t < nlat ? (size_t)(b * SEQ + 64 * (tlo + t) + key) : (size_t)(TL + b * CTXL + 64 * (t - nlat) + key); }
    __device__ __forceinline__ unsigned kofs() const { return (unsigned)WS_PB + 2u * (512 + 64 * kvh); }  __device__ __forceinline__ unsigned kpitch() const { return 2u * EV_LD; }
    __device__ __forceinline__ unsigned k2ofs() const { return 0u; }  __device__ __forceinline__ unsigned k2pitch() const { return 0u; }
    __device__ __forceinline__ unsigned vofs() const { return (unsigned)WS_PB + 2u * (640 + 64 * kvh); }  __device__ __forceinline__ unsigned vpitch() const { return 2u * EV_LD; }
    __device__ __forceinline__ unsigned trow(int t) const { return (unsigned)krow(t, 0); }
    __device__ __forceinline__ int qpos(int wid, int r) const { return 64 * j + 32 * (wid >> 2) + r; }
    __device__ __forceinline__ size_t qrow(int wid, int r) const { return ctxq ? (size_t)(TL + b * CTXL + qpos(wid, r)) : (size_t)(b * SEQ + qpos(wid, r)); }
    __device__ __forceinline__ const bf16_t* qptr(int wid, int r) const { return PB + qrow(wid, r) * EV_LD + 64 * (4 * kvh + (wid & 3)); }
    __device__ __forceinline__ unsigned char* optr(int wid, int r) const { return (unsigned char*)AO + qrow(wid, r) * 1024 + 64 * (4 * kvh + (wid & 3)); }
    __device__ __forceinline__ float m0(int wid) const { return sink[4 * kvh + (wid & 3)] * LOG2E; }
    __device__ __forceinline__ float l0() const { return 1.f; }
    __device__ __forceinline__ void prep(LAS unsigned char*) const {}
    __device__ __forceinline__ void adjust_tile(f32x16& P0, f32x16& P1, int t, int wid, int r32, int hi, float c2, const LAS unsigned char*, int) const {
        if (t >= nlat) {
#pragma unroll
            for (int r = 0; r < 16; ++r) { P0[r] *= c2; P1[r] *= c2; }
        } else { const int dq = qpos(wid, r32) - 64 * (tlo + t) - 4 * hi + 128;
#pragma unroll
            for (int r = 0; r < 16; ++r) { const int k0 = (r & 3) + 8 * (r >> 2);
                P0[r] = ((unsigned)(dq - k0) <= 256u) ? P0[r] * c2 : NEGBIG; P1[r] = ((unsigned)(dq - k0 - 32) <= 256u) ? P1[r] * c2 : NEGBIG; } }
    }
};
struct UNa {
    static constexpr int NKC = 8; static constexpr bool PLAIN = false; static constexpr bool SIDED = true;
    const bf16_t* PB; bf16_t* AO; const float* rpbh; int b, h, G; bool ctxq; int rlo, nlat;
    template <int NKS> __device__ __forceinline__ void qfix(bf16x8 (&)[NKS], int, int, int) const {}
    __device__ __forceinline__ void init() { int lo = 4 * G - 4; lo = lo < 0 ? 0 : (lo > 120 ? 120 : lo); int hi = 4 * G - 1; hi = hi < 0 ? 0 : (hi > 120 ? 120 : hi); rlo = lo; nlat = ctxq ? 0 : hi + 8 - lo; }
    __device__ __forceinline__ float c2() const { return 0.125f * LOG2E; }
    __device__ __forceinline__ int ntiles() const { return nlat + 4; }
    __device__ __forceinline__ int qgrow(int wid) const { return 4 * G + (wid >> 1); }
    __device__ __forceinline__ int r0w(int wid) const { int r0 = qgrow(wid) - 4; return r0 < 0 ? 0 : (r0 > 120 ? 120 : r0); }
    __device__ __forceinline__ bool active(int t, int wid) const { if (t >= nlat) return true; const int kr = rlo + t, r0 = r0w(wid); return kr >= r0 && kr < r0 + 8; }
    __device__ __forceinline__ size_t krow(int t, int key) const { return t < nlat ? (size_t)(b * SEQ + 64 * (rlo + t) + key) : (size_t)(TL + b * CTXL + 64 * (t - nlat) + key); }
    __device__ __forceinline__ unsigned kofs() const { return (unsigned)WS_PB + 2u * (1024 + 64 * h); }  __device__ __forceinline__ unsigned kpitch() const { return 2u * OD_LD; }
    __device__ __forceinline__ unsigned k2ofs() const { return 0u; }  __device__ __forceinline__ unsigned k2pitch() const { return 0u; }
    __device__ __forceinline__ unsigned vofs() const { return (unsigned)WS_PB + 2u * (2048 + 64 * h); }  __device__ __forceinline__ unsigned vpitch() const { return 2u * OD_LD; }
    __device__ __forceinline__ unsigned trow(int t) const { return (unsigned)krow(t, 0); }
    __device__ __forceinline__ size_t qrow(int wid, int r) const { return ctxq ? (size_t)(TL + b * CTXL + 32 * wid + r) : (size_t)(b * SEQ + 64 * qgrow(wid) + 32 * (wid & 1) + r); }
    __device__ __forceinline__ const bf16_t* qptr(int wid, int r) const { return PB + qrow(wid, r) * OD_LD + 64 * h; }
    __device__ __forceinline__ unsigned char* optr(int wid, int r) const { return (unsigned char*)AO + qrow(wid, r) * 1024 + 64 * h; }
    __device__ __forceinline__ float m0(int) const { return NEGBIG; }
    __device__ __forceinline__ float l0() const { return 0.f; }
    __device__ __forceinline__ void prep(LAS unsigned char* L) const {
        if (!ctxq) { LAS float* bt = (LAS float*)(L + OFF_BIAS); for (int i = opaque_tid(); i < 15 * 31; i += 512) bt[i] = rpbh[i] * LOG2E; }
    }
    __device__ __forceinline__ void adjust_tile(f32x16& P0, f32x16& P1, int t, int wid, int r32, int hi, float c2, const LAS unsigned char* L, int side) const {
        if (t >= nlat) {
#pragma unroll
            for (int r = 0; r < 16; ++r) { P0[r] *= c2; P1[r] *= c2; }
        } else { const int qc = 32 * (wid & 1) + r32; int c0 = qc - 8; c0 = c0 < 0 ? 0 : (c0 > 48 ? 48 : c0);
            const LAS float* bp = (const LAS float*)(L + OFF_BIAS) + (rlo + t - qgrow(wid) + 7) * 31 + (15 - qc + 4 * hi);
            const int kb = 4 * hi - c0;
#pragma unroll
            for (int r = 0; r < 16; ++r) { const int k0 = (r & 3) + 8 * (r >> 2);
                if (!(side == 2 && r < 12)) { const float b0 = bp[k0]; P0[r] = ((unsigned)(kb + k0) < 16u) ? P0[r] * c2 + b0 : NEGBIG; }
                if (!(side == 1 && r >= 4)) { const float b1 = bp[k0 + 32]; P1[r] = ((unsigned)(kb + k0 + 32) < 16u) ? P1[r] * c2 + b1 : NEGBIG; } } }
    }
};

__device__ __forceinline__ float fma_s(float a, float b, float c) { float r; asm("v_fma_f32 %0, %1, %2, %3" : "=v"(r) : "v"(a), "v"(b), "v"(c)); return r; }
__device__ __forceinline__ float max3f(float a, float b, float c) { float r; asm("v_max3_f32 %0, %1, %2, %3" : "=v"(r) : "v"(a), "v"(b), "v"(c)); return r; }
template <class U>
__device__ __forceinline__ void attn_unit(LAS unsigned char* L, unsigned char* wsbase, const U& u) {
    constexpr int NKC = U::NKC, NKS = NKC / 2;
    const int tid = opaque_tid(), lane = tid & 63, r32 = lane & 31, hi = lane >> 5; const int wid = __builtin_amdgcn_readfirstlane(tid >> 6);
    bf16x8 qr[NKS];
    float m = u.m0(wid), l = hi == 0 ? u.l0() : 0.f;
    f32x16 o[2];
#pragma unroll
    for (int r = 0; r < 16; ++r) { o[0][r] = 0.f; o[1][r] = 0.f; }
    const float c2 = u.c2();
    const int NT = u.ntiles();
    LAS float* wsf = (LAS float*)(L + OFF_WSF) + wid * 64;
    const LAS unsigned char* kbase = L + OFF_K + hi * KCS + r32 * 16;
    const LAS unsigned char* vbase = L + OFF_V + ((lane >> 4) & 1) * 32 + (lane & 3) * 8 + (4 * hi + ((lane & 15) >> 2)) * 64;
    const __amdgpu_buffer_rsrc_t rs = __builtin_amdgcn_make_buffer_rsrc((void*)wsbase, 0, 0x7fffffff, 0x00020000);
    const unsigned kvo = (unsigned)lane * u.kpitch(), kvo2 = (unsigned)lane * u.k2pitch(), vvo = (unsigned)(lane >> 2) * u.vpitch() + (unsigned)(lane & 3) * 16u;
    const unsigned kso = u.kofs() + 16u * wid, kso2 = u.k2ofs() + 16u * wid, vso = u.vofs() + 16u * (wid & 3) * u.vpitch() + 64u * (wid >> 2);
    const bool two = (NKC == 12) && (wid < 4);
#define ATT_DMAK(t) do { const int tc_ = (t) < NT ? (t) : NT - 1; const unsigned r0_ = u.trow(tc_); LAS unsigned char* kd_ = L + OFF_K + ((t) & 3) * KSLOT; \
        __builtin_amdgcn_raw_ptr_buffer_load_lds(rs, (LAS unsigned*)(kd_ + wid * KCS), 16, kvo, kso + r0_ * u.kpitch(), 0, 0); \
        if (two) __builtin_amdgcn_raw_ptr_buffer_load_lds(rs, (LAS unsigned*)(kd_ + (8 + wid) * KCS), 16, kvo2, kso2 + r0_ * u.k2pitch(), 0, 0); } while (0)
#define ATT_DMAV(t) do { const int tc_ = (t) < NT ? (t) : NT - 1; const unsigned r0_ = u.trow(tc_); \
        __builtin_amdgcn_raw_ptr_buffer_load_lds(rs, (LAS unsigned*)(L + OFF_V + ((t) & 3) * VSLOT + wid * 1024), 16, vvo, vso + r0_ * u.vpitch(), 0, 0); } while (0)
#define ATT_WAIT_BAR() do { if (two) asm volatile("s_waitcnt vmcnt(6)" ::: "memory"); else asm volatile("s_waitcnt vmcnt(4)" ::: "memory"); \
        __builtin_amdgcn_s_barrier(); asm volatile("" ::: "memory"); } while (0)
#define ATT_QKT(S0, S1, t) do { const LAS unsigned char* kb_ = kbase + ((t) & 3) * KSLOT; \
        _Pragma("unroll") for (int r = 0; r < 16; ++r) { S0[r] = 0.f; S1[r] = 0.f; } \
        _Pragma("unroll") for (int kh_ = 0; kh_ < 2; ++kh_) { bf16x8 kf0[NKS / 2], kf1[NKS / 2]; \
            _Pragma("unroll") for (int ks = 0; ks < NKS / 2; ++ks) { kf0[ks] = *(const LAS bf16x8*)(kb_ + (kh_ * (NKS / 2) + ks) * (2 * KCS)); kf1[ks] = *(const LAS bf16x8*)(kb_ + (kh_ * (NKS / 2) + ks) * (2 * KCS) + 512); } \
            _Pragma("unroll") for (int ks = 0; ks < NKS / 2; ++ks) { S0 = __builtin_amdgcn_mfma_f32_32x32x16_bf16(kf0[ks], qr[kh_ * (NKS / 2) + ks], S0, 0, 0, 0); S1 = __builtin_amdgcn_mfma_f32_32x32x16_bf16(kf1[ks], qr[kh_ * (NKS / 2) + ks], S1, 0, 0, 0); } } } while (0)
#define ATT_LIVE0(r, SIDE) (!((SIDE) == 2 && (r) < 12))
#define ATT_LIVE1(r, SIDE) (!((SIDE) == 1 && (r) >= 4))
#define ATT_SOFTMAX(P0, P1, T, SIDE) do { float rm; \
        if constexpr (U::PLAIN) { float a_ = max3f(P0[0], P1[0], P0[1]), b_ = max3f(P1[1], P0[2], P1[2]); \
            _Pragma("unroll") for (int r = 3; r < 15; r += 2) { a_ = max3f(a_, P0[r], P1[r]); b_ = max3f(b_, P0[r + 1], P1[r + 1]); } \
            rm = max3f(a_, b_, fmaxf(P0[15], P1[15])) * c2; } \
        else { u.adjust_tile(P0, P1, (T), wid, r32, hi, c2, L, (SIDE)); \
            if ((SIDE) == 0) { float a_ = max3f(P0[0], P1[0], P0[1]), b_ = max3f(P1[1], P0[2], P1[2]); \
                _Pragma("unroll") for (int r = 3; r < 15; r += 2) { a_ = max3f(a_, P0[r], P1[r]); b_ = max3f(b_, P0[r + 1], P1[r + 1]); } \
                rm = max3f(a_, b_, fmaxf(P0[15], P1[15])); } \
            else { float a_ = NEGBIG, b_ = NEGBIG; \
                _Pragma("unroll") for (int r = 0; r < 16; ++r) { if (ATT_LIVE0(r, SIDE)) a_ = fmaxf(a_, P0[r]); if (ATT_LIVE1(r, SIDE)) b_ = fmaxf(b_, P1[r]); } \
                rm = fmaxf(a_, b_); } } \
        { float ra, rb; pair32(rm, ra, rb); rm = fmaxf(ra, rb); } \
        const float mn = fmaxf(m, rm); alpha = __builtin_amdgcn_exp2f(m - mn); resc = __any(mn > m); m = mn; \
        float lsa = 0.f; const float nmn = -mn;       \
        if constexpr (U::PLAIN) { _Pragma("unroll") for (int r = 0; r < 16; ++r) { P0[r] = __builtin_amdgcn_exp2f(fma_s(P0[r], c2, nmn)); P1[r] = __builtin_amdgcn_exp2f(fma_s(P1[r], c2, nmn)); lsa += P0[r]; lsa += P1[r]; } } \
        else { _Pragma("unroll") for (int r = 0; r < 16; ++r) { \
                if (ATT_LIVE0(r, SIDE)) { P0[r] = __builtin_amdgcn_exp2f(P0[r] - mn); lsa += P0[r]; } else P0[r] = 0.f; \
                if (ATT_LIVE1(r, SIDE)) { P1[r] = __builtin_amdgcn_exp2f(P1[r] - mn); lsa += P1[r]; } else P1[r] = 0.f; } } \
        l = l * alpha + lsa; \
        _Pragma("unroll") for (int i = 0; i < 4; ++i) { if ((SIDE) != 2) pw[0][i] = cvtpk(P0[2 * i], P0[2 * i + 1]); pw[1][i] = cvtpk(P0[8 + 2 * i], P0[9 + 2 * i]); pw[2][i] = cvtpk(P1[2 * i], P1[2 * i + 1]); if ((SIDE) != 1) pw[3][i] = cvtpk(P1[8 + 2 * i], P1[9 + 2 * i]); } } while (0)
#define ATT_STEP(SC0, SC1, SN0, SN1, T, SIDE) do { const int t_ = (T); \
        ATT_DMAK(t_ + 3); ATT_DMAV(t_ + 2); \
        ATT_WAIT_BAR(); \
        const bool a_cur = u.active(t_, wid), a_nxt = (t_ + 1 < NT) && u.active(t_ + 1, wid); \
        float alpha = 1.f; bool resc = false; u32x4 pw[4]; \
        if (a_cur && a_nxt) { ATT_QKT(SN0, SN1, t_ + 1); ATT_SOFTMAX(SC0, SC1, t_, SIDE); } \
        else { if (a_nxt) ATT_QKT(SN0, SN1, t_ + 1); \
               if (a_cur) ATT_SOFTMAX(SC0, SC1, t_, SIDE); } \
        __builtin_amdgcn_sched_barrier(0); \
        if (a_cur) { \
            const LAS unsigned char* vb_ = vbase + (t_ & 3) * VSLOT; s16x4 vlo[2][4], vhi[2][4]; \
            _Pragma("unroll") for (int dh = 0; dh < 2; ++dh) _Pragma("unroll") for (int ks = 0; ks < 4; ++ks) { if (((SIDE) == 1 && ks == 3) || ((SIDE) == 2 && ks == 0)) continue; vlo[dh][ks] = vtr(vb_ + dh * 4096 + ks * 1024); vhi[dh][ks] = vtr(vb_ + dh * 4096 + ks * 1024 + 512); } \
            if (resc) { if (hi == 0) wsf[r32] = alpha; LDS_WAIT(); \
                _Pragma("unroll") for (int r = 0; r < 16; ++r) { const float f = wsf[crow(r, hi)]; o[0][r] *= f; o[1][r] *= f; } } \
            _Pragma("unroll") for (int dh = 0; dh < 2; ++dh) _Pragma("unroll") for (int ks = 0; ks < 4; ++ks) { if (((SIDE) == 1 && ks == 3) || ((SIDE) == 2 && ks == 0)) continue; \
                const s16x4 lo4 = vlo[dh][ks], hi4 = vhi[dh][ks]; const bf16x8 vf = {lo4[0], lo4[1], lo4[2], lo4[3], hi4[0], hi4[1], hi4[2], hi4[3]}; \
                o[dh] = __builtin_amdgcn_mfma_f32_32x32x16_bf16(__builtin_bit_cast(bf16x8, pw[ks]), vf, o[dh], 0, 0, 0); } } \
        LDS_WAIT(); __builtin_amdgcn_sched_barrier(0); } while (0)

    ATT_DMAK(0); ATT_DMAK(1); ATT_DMAV(0); ATT_DMAK(2); ATT_DMAV(1);
    { const bf16_t* qp = u.qptr(wid, r32);
#pragma unroll
      for (int ks = 0; ks < NKS; ++ks) qr[ks] = *(const bf16x8*)(qp + 16 * ks + 8 * hi); }
    u.prep(L);
    u.template qfix<NKS>(qr, wid, r32, hi);
    ATT_WAIT_BAR();
    f32x16 sA0, sA1, sB0, sB1;
#pragma unroll
    for (int r = 0; r < 16; ++r) { sA0[r] = 0.f; sA1[r] = 0.f; sB0[r] = 0.f; sB1[r] = 0.f; }
    if (u.active(0, wid)) ATT_QKT(sA0, sA1, 0);
    if constexpr (U::SIDED) { const int nl = u.nlat; int t = 0;
        if (wid & 1) { for (; t < nl; ++t) { ATT_STEP(sA0, sA1, sB0, sB1, t, 2); sA0 = sB0; sA1 = sB1; } }
        else { for (; t < nl; ++t) { ATT_STEP(sA0, sA1, sB0, sB1, t, 1); sA0 = sB0; sA1 = sB1; } }
        for (; t < NT; ++t) { ATT_STEP(sA0, sA1, sB0, sB1, t, 0); sA0 = sB0; sA1 = sB1; } }
    else { for (int t = 0; t < NT; ++t) { ATT_STEP(sA0, sA1, sB0, sB1, t, 0); sA0 = sB0; sA1 = sB1; } }
    asm volatile("s_waitcnt vmcnt(0)" ::: "memory");
#undef ATT_DMAK
#undef ATT_DMAV
#undef ATT_WAIT_BAR
#undef ATT_QKT
#undef ATT_SOFTMAX
#undef ATT_LIVE0
#undef ATT_LIVE1
#undef ATT_STEP
    { float la, lb; pair32(l, la, lb); l = la + lb; }
    if (hi == 0) wsf[32 + r32] = l;
    LDS_WAIT();
    LAS unsigned char* stg = L + OFF_OST + wid * 2048;
#pragma unroll
    for (int r = 0; r < 16; ++r) { const int orow = crow(r, hi); const float rl = __builtin_amdgcn_rcpf(wsf[32 + orow]);
        const unsigned w = __builtin_amdgcn_cvt_pk_fp8_f32(o[0][r] * rl, o[1][r] * rl, 0u, false);
        stg[orow * 64 + r32] = (unsigned char)(w & 0xffu); stg[orow * 64 + 32 + r32] = (unsigned char)((w >> 8) & 0xffu); }
    LDS_WAIT();
#pragma unroll
    for (int i = 0; i < 2; ++i) { const int row = i * 16 + (lane >> 2), ch = lane & 3; const u32x4 v = *(const LAS u32x4*)(stg + row * 64 + ch * 16); *(u32x4*)(u.optr(wid, row) + ch * 16) = v; }
    __syncthreads();
}
}

struct Args { const float* in[25]; float* out; unsigned char* ws; int ph_lo, ph_hi; };
enum InIdx { I_X = 0, I_C, I_CTX, I_CCTX, I_ADAW, I_ADAB, I_N1G, I_N2G, I_EVWIN, I_EVSINK, I_EVQNG, I_EVWUQ, I_EVKVNG, I_EVWUKV, I_EVWOUT, I_ODWIN, I_ODRPB, I_ODWOUT, I_RW, I_RB, I_W1, I_B1, I_W2, I_B2, I_FG };

struct Frame {
    LAS unsigned char* lds;
    int tid, lane, wave, vcu, G;
    float* out; unsigned char* ws;
};
__device__ __forceinline__ const float* inptr(const Frame& F, int i) {
    const volatile LAS unsigned* p = (const volatile LAS unsigned*)(F.lds + LDSCTL_OFF + 256) + 2 * i;
    const unsigned lo = __builtin_amdgcn_readfirstlane(p[0]), hi = __builtin_amdgcn_readfirstlane(p[1]);
    return (const float*)(const GAS float*)(((unsigned long long)hi << 32) | lo);
}
#define WSP(T, off) ((T*)(F.ws + (off)))
__device__ __forceinline__ void frame_tid(Frame& F) { F.tid = opaque_tid(); F.lane = F.tid & 63; F.wave = __builtin_amdgcn_readfirstlane(F.tid >> 6); }

__device__ __forceinline__ void tr_item(const float* W, int ldw, int K, int k0, int n0, bf16_t* WT, int dst_row0, LAS float* scr, int lane) {
    float wv[32];
#pragma unroll
    for (int i = 0; i < 32; ++i) wv[i] = W[(size_t)(k0 + 2 * i + (lane >> 5)) * ldw + n0 + (lane & 31)];
#pragma unroll
    for (int i = 0; i < 32; ++i) scr[(2 * i + (lane >> 5)) * 33 + (lane & 31)] = wv[i];
    LDS_WAIT(); asm volatile("" ::: "memory");
    const int c = lane & 7;
#pragma unroll
    for (int j = 0; j < 4; ++j) { const int n = (lane >> 3) + 8 * j; const LAS float* s = scr + (8 * c) * 33 + n;
        u32x4 o; o.x = pk2(s[0 * 33], s[1 * 33]); o.y = pk2(s[2 * 33], s[3 * 33]); o.z = pk2(s[4 * 33], s[5 * 33]); o.w = pk2(s[6 * 33], s[7 * 33]);
        *(u32x4*)(WT + (size_t)(dst_row0 + n) * K + k0 + 8 * c) = o; }
    LDS_WAIT(); asm volatile("" ::: "memory");
}

__device__ __forceinline__ void tr_item8(const float* W, int ldw, int K, int k0, int n0, unsigned char* WT8, int dst_row0, LAS float* scr, int lane, float scale) {
    float wv[32];
#pragma unroll
    for (int i = 0; i < 32; ++i) wv[i] = W[(size_t)(k0 + 2 * i + (lane >> 5)) * ldw + n0 + (lane & 31)];
#pragma unroll
    for (int i = 0; i < 32; ++i) scr[(2 * i + (lane >> 5)) * 33 + (lane & 31)] = wv[i] * scale;
    LDS_WAIT(); asm volatile("" ::: "memory");
    const int c = lane & 3;
#pragma unroll
    for (int j = 0; j < 2; ++j) { const int n = (lane >> 2) + 16 * j; const LAS float* s = scr + (16 * c) * 33 + n;
        u32x4 o; o.x = cvt4_fp8(s[0 * 33], s[1 * 33], s[2 * 33], s[3 * 33]); o.y = cvt4_fp8(s[4 * 33], s[5 * 33], s[6 * 33], s[7 * 33]);
        o.z = cvt4_fp8(s[8 * 33], s[9 * 33], s[10 * 33], s[11 * 33]); o.w = cvt4_fp8(s[12 * 33], s[13 * 33], s[14 * 33], s[15 * 33]);
        *(u32x4*)(WT8 + (size_t)(dst_row0 + n) * K + k0 + 16 * c) = o; }
    LDS_WAIT(); asm volatile("" ::: "memory");
}
__device__ __forceinline__ float silu_f(float c) { return c / (1.0f + __expf(-c)); }

__device__ __forceinline__ void pro_a(Frame& F) {
    frame_tid(F);
    const int gwm = F.wave * F.G + F.vcu, NGW = F.G * 8;
    for (int it = gwm; it < 4 * 96; it += NGW) {
        const int l = it / 96, col = (it % 96) * 64 + F.lane;
        float sv[5][16];
#pragma unroll
        for (int j = 0; j < 16; ++j) {
#pragma unroll
            for (int v = 0; v < 4; ++v) sv[v][j] = silu_f(inptr(F, I_C)[v * 1024 + 64 * j + F.lane]);
            sv[4][j] = silu_f(inptr(F, I_CCTX)[64 * j + F.lane]);
        }
        const float* W = inptr(F, I_ADAW) + (size_t)l * 1024 * 6144 + col;
        float acc[5] = {0.f, 0.f, 0.f, 0.f, 0.f};
#pragma unroll
        for (int j = 0; j < 16; ++j) {
            float wl[64];
#pragma unroll
            for (int ln = 0; ln < 64; ++ln) wl[ln] = W[(size_t)(64 * j + ln) * 6144];
#pragma unroll
            for (int ln = 0; ln < 64; ++ln) {
#pragma unroll
                for (int v = 0; v < 5; ++v) acc[v] += __builtin_bit_cast(float, __builtin_amdgcn_readlane(__builtin_bit_cast(int, sv[v][j]), ln)) * wl[ln];
            }
        }
        const float bb = inptr(F, I_ADAB)[l * 6144 + col];
        float* MOD = WSP(float, WS_MOD);
#pragma unroll
        for (int v = 0; v < 5; ++v) MOD[(size_t)(l * 5 + v) * 6144 + col] = acc[v] + bb;
    }
    { const int gt = blockIdx.x * 512 + F.tid;
      if (gt < 128 * 16) { const int pos = gt >> 4, i = gt & 15; const float inv = __builtin_amdgcn_exp2f(-((float)i / 16.0f) * 13.287712379549449f); const float a = (float)pos * inv; WSP(f32x2, WS_ROPE64)[gt] = (f32x2){__cosf(a), __sinf(a)}; }
      else if (gt < 128 * 16 + 128 * 8) { const int g2 = gt - 128 * 16, pos = g2 >> 3, i = g2 & 7; const float inv = __builtin_amdgcn_exp2f(-((float)i / 8.0f) * 13.287712379549449f); const float a = (float)pos * inv; WSP(f32x2, WS_ROPE32)[g2] = (f32x2){__cosf(a), __sinf(a)}; } }
    { const int nchunk = 2 * 224 * 64;
      for (int i = blockIdx.x * 512 + F.tid; i < nchunk; i += F.G * 512) { const int mi = i / (224 * 64), r = (i / 64) % 224, c = i % 64;
          *(u32x4*)(WSP(unsigned char, WS_WINE) + ((size_t)mi * 2048 + 1824 + r) * 1024 + 16 * c) = (u32x4){0u, 0u, 0u, 0u}; } }
    { bf16_t* RWT = WSP(bf16_t, WS_RWT);
      for (int i = blockIdx.x * 512 + F.tid; i < 4 * 32 * 1024; i += F.G * 512) { const int l = i >> 15, e = (i >> 10) & 31, k = i & 1023;
          const float v = inptr(F, I_RW)[((size_t)l * 1024 + k) * 32 + e]; const unsigned hi = f2bf(v); const unsigned lo = f2bf(v - __builtin_bit_cast(float, hi << 16));
          bf16_t* r = RWT + ((size_t)l * 256 + e) * H3_LD; r[k] = (bf16_t)hi; r[1024 + k] = (bf16_t)hi; r[2048 + k] = (bf16_t)lo; }
      const int nz = 4 * 224 * (H3_LD / 8);
      for (int i = blockIdx.x * 512 + F.tid; i < nz; i += F.G * 512) { const int l = i / (224 * (H3_LD / 8)), r = (i / (H3_LD / 8)) % 224, c = i % (H3_LD / 8);
          *(u32x4*)(RWT + ((size_t)l * 256 + 32 + r) * H3_LD + 8 * c) = (u32x4){0u, 0u, 0u, 0u}; } }
    LAS float* scr = (LAS float*)(F.lds + F.wave * 16384);
    constexpr int S0 = 2 * 16 * 57, S1 = S0 + 2 * 12 * 24, S2 = S1 + 2 * 4 * 32, S3 = S2 + 2 * 16 * 32, S4 = S3 + 2 * 16 * 96, S5 = S4 + 2 * 16 * 32, S6 = S5 + 128 * 16 * 64, S7 = S6 + 128 * 16 * 32;
    const int gw = F.vcu * 8 + F.wave;
    for (int it = gw; it < S7; it += NGW) {
        if (it < S0) { const int r = it, mi = r / (16 * 57), q = r % (16 * 57), kb = q / 57, nb = q % 57;
            tr_item8(inptr(F, I_EVWIN) + (size_t)mi * 1024 * EV_IN, EV_IN, 1024, 64 * kb, 32 * nb, WSP(unsigned char, WS_WINE) + (size_t)mi * 2048 * 1024, 32 * nb, scr, F.lane, W8_SCALE); }
        else if (it < S1) { const int r = it - S0, mi = r / (12 * 24), q = r % (12 * 24), kb = q / 24, nb = q % 24;
            tr_item(inptr(F, I_EVWUQ) + (size_t)mi * 768 * 768, 768, 768, 64 * kb, 32 * nb, WSP(bf16_t, WS_WUQ) + (size_t)mi * 768 * 768, 32 * nb, scr, F.lane); }
        else if (it < S2) { const int r = it - S1, mi = r / (4 * 32), q = r % (4 * 32), kb = q / 32, nb = q % 32;
            tr_item(inptr(F, I_EVWUKV) + (size_t)mi * 256 * 1024, 1024, 256, 64 * kb, 32 * nb, WSP(bf16_t, WS_WUKV) + (size_t)mi * 1024 * 256, 32 * nb, scr, F.lane); }
        else if (it < S3) { const int r = it - S2, mi = r / (16 * 32), q = r % (16 * 32), kb = q / 32, nb = q % 32;
            tr_item8(inptr(F, I_EVWOUT) + (size_t)mi * 1024 * 1024, 1024, 1024, 64 * kb, 32 * nb, WSP(unsigned char, WS_WOUTE) + (size_t)mi * 1024 * 1024, 32 * nb, scr, F.lane, W8_SCALE); }
        else if (it < S4) { const int r = it - S3, mi = r / (16 * 96), q = r % (16 * 96), kb = q / 96, nb = q % 96;
            tr_item8(inptr(F, I_ODWIN) + (size_t)mi * 1024 * 3072, 3072, 1024, 64 * kb, 32 * nb, WSP(unsigned char, WS_WINO) + (size_t)mi * 3072 * 1024, 32 * nb, scr, F.lane, W8_SCALE); }
        else if (it < S5) { const int r = it - S4, mi = r / (16 * 32), q = r % (16 * 32), kb = q / 32, nb = q % 32;
            tr_item8(inptr(F, I_ODWOUT) + (size_t)mi * 1024 * 1024, 1024, 1024, 64 * kb, 32 * nb, WSP(unsigned char, WS_WOUTO) + (size_t)mi * 1024 * 1024, 32 * nb, scr, F.lane, W8_SCALE); }
        else if (it < S6) { const int r = it - S5, mi = r / (16 * 64), q = r % (16 * 64), kb = q / 64, nb = q % 64;
            const int c0 = 32 * (nb & 31), drow = (c0 >> 7) * 256 + (nb >= 32 ? 128 : 0) + (c0 & 127);
            tr_item8(inptr(F, I_W1) + (size_t)mi * 1024 * 2048, 2048, 1024, 64 * kb, 32 * nb, WSP(unsigned char, WS_W1) + (size_t)mi * 2048 * 1024, drow, scr, F.lane, W8_SCALE); }
        else { const int r = it - S6, mi = r / (16 * 32), q = r % (16 * 32), kb = q / 32, nb = q % 32;
            tr_item8(inptr(F, I_W2) + (size_t)mi * 1024 * 1024, 1024, 1024, 64 * kb, 32 * nb, WSP(unsigned char, WS_W2) + (size_t)mi * 1024 * 1024, 32 * nb, scr, F.lane, W8_SCALE); }
    }
}

__device__ __forceinline__ int mod_bidx(int row) { return row < TL ? (row >> 13) : 4; }
__device__ __forceinline__ void norm_mod_store(const f32x4 (&v)[4], int lane, const float* g, const float* shift, const float* scale, unsigned char* hrow, f32x4 (*hf)[4] = nullptr) {
    float s = 0.f;
#pragma unroll
    for (int j = 0; j < 4; ++j) s += (v[j].x * v[j].x + v[j].y * v[j].y) + (v[j].z * v[j].z + v[j].w * v[j].w);
    const float rstd = 1.0f / sqrtf(wave_sum(s) * (1.0f / DM) + NORM_EPS);
#pragma unroll
    for (int j = 0; j < 4; ++j) { const int col = 4 * lane + 256 * j;
        const f32x4 gg = *(const f32x4*)(g + col), sh = *(const f32x4*)(shift + col), sc = *(const f32x4*)(scale + col);
        const f32x4 h = (v[j] * rstd) * gg * (sc + 1.0f) + sh;
        if (hf) (*hf)[j] = h;
        *(unsigned*)(hrow + col) = cvt4_fp8(h.x, h.y, h.z, h.w); }
}

__device__ __forceinline__ void norm_mod_store_r(const f32x4 (&v)[4], int lane, const f32x4 (&gg)[4], const f32x4 (&sh)[4], const f32x4 (&sc1)[4], unsigned char* hrow) {
    float s = 0.f;
#pragma unroll
    for (int j = 0; j < 4; ++j) s += (v[j].x * v[j].x + v[j].y * v[j].y) + (v[j].z * v[j].z + v[j].w * v[j].w);
    const float rstd = 1.0f / sqrtf(wave_sum(s) * (1.0f / DM) + NORM_EPS);
#pragma unroll
    for (int j = 0; j < 4; ++j) { const int col = 4 * lane + 256 * j;
        const f32x4 h = (v[j] * rstd) * gg[j] * sc1[j] + sh[j];
        *(unsigned*)(hrow + col) = cvt4_fp8(h.x, h.y, h.z, h.w); }
}

__device__ __forceinline__ void pro_b(Frame& F) {
    frame_tid(F);
    const int gw = F.vcu * 8 + F.wave, NGW = F.G * 8, lane = F.lane;
    const float* MOD = WSP(float, WS_MOD);
    f32x4 gg[4], sh[4], sc1[4], vn[4]; int cb = -1;
#pragma unroll
    for (int j = 0; j < 4; ++j) { gg[j] = *(const f32x4*)(inptr(F, I_N1G) + 4 * lane + 256 * j); sh[j] = gg[j]; sc1[j] = gg[j]; vn[j] = gg[j]; }
#define PB_SRC(r_) ((r_) < TL ? inptr(F, I_X) + (size_t)(r_) * DM : inptr(F, I_CTX) + (size_t)((r_) - TL) * DM)
    if (gw < TT) { const float* src = PB_SRC(gw);
#pragma unroll
        for (int j = 0; j < 4; ++j) vn[j] = *(const f32x4*)(src + 4 * lane + 256 * j); }
    for (int row = gw; row < TT; row += NGW) {
        f32x4 v[4];
#pragma unroll
        for (int j = 0; j < 4; ++j) v[j] = vn[j];
        if (row + NGW < TT) { const float* src = PB_SRC(row + NGW);
#pragma unroll
            for (int j = 0; j < 4; ++j) vn[j] = *(const f32x4*)(src + 4 * lane + 256 * j); }
        const int bi = mod_bidx(row);
        if (bi != cb) { cb = bi; const float* mb = MOD + (size_t)(0 * 5 + bi) * 6144;
#pragma unroll
            for (int j = 0; j < 4; ++j) { sh[j] = *(const f32x4*)(mb + 4 * lane + 256 * j); sc1[j] = *(const f32x4*)(mb + 1024 + 4 * lane + 256 * j) + 1.0f; } }
        bf16_t* xr = WSP(bf16_t, WS_XLC) + (size_t)row * DM;
#pragma unroll
        for (int j = 0; j < 4; ++j) *(u32x2*)(xr + 4 * lane + 256 * j) = xpk4(v[j]);
        norm_mod_store_r(v, lane, gg, sh, sc1, WSP(unsigned char, WS_HB) + (size_t)row * DM);
    }
#undef PB_SRC
}

__device__ __forceinline__ u32x4 shfl_xor4(u32x4 v, int m) { u32x4 r; r.x = __shfl_xor(v.x, m); r.y = __shfl_xor(v.y, m); r.z = __shfl_xor(v.z, m); r.w = __shfl_xor(v.w, m); return r; }
__device__ __forceinline__ float ssq8(u32x4 w) { float s = 0.f;
#pragma unroll
    for (int i = 0; i < 4; ++i) { const float a = bflo(w[i]), b = bfhi(w[i]); s += a * a + b * b; } return s; }
__device__ __forceinline__ u32x4 scale8(u32x4 w, float r, const float* g) { u32x4 o; const f32x4 g0 = *(const f32x4*)g, g1 = *(const f32x4*)(g + 4);
    o.x = pk2(bflo(w.x) * r * g0.x, bfhi(w.x) * r * g0.y); o.y = pk2(bflo(w.y) * r * g0.z, bfhi(w.y) * r * g0.w);
    o.z = pk2(bflo(w.z) * r * g1.x, bfhi(w.z) * r * g1.y); o.w = pk2(bflo(w.w) * r * g1.z, bfhi(w.w) * r * g1.w); return o; }

__device__ __forceinline__ u32x4 rope_chunk_r(u32x4 xw, u32x4 yw, const f32x2 (&tab)[8], bool first) {
    u32x4 o;
#pragma unroll
    for (int i = 0; i < 4; ++i) {
        const f32x2 cs0 = tab[2 * i], cs1 = tab[2 * i + 1];
        const float x0 = bflo(xw[i]), x1 = bfhi(xw[i]), y0 = bflo(yw[i]), y1 = bfhi(yw[i]);
        const float r0 = first ? x0 * cs0.x - y0 * cs0.y : x0 * cs0.x + y0 * cs0.y;
        const float r1 = first ? x1 * cs1.x - y1 * cs1.y : x1 * cs1.x + y1 * cs1.y;
        o[i] = pk2(r0, r1);
    }
    return o;
}
__device__ __forceinline__ u32x4 scale8_r(u32x4 w, float r, f32x4 g0, f32x4 g1) { u32x4 o;
    o.x = pk2(bflo(w.x) * r * g0.x, bfhi(w.x) * r * g0.y); o.y = pk2(bflo(w.y) * r * g0.z, bfhi(w.y) * r * g0.w);
    o.z = pk2(bflo(w.z) * r * g1.x, bfhi(w.z) * r * g1.y); o.w = pk2(bflo(w.w) * r * g1.z, bfhi(w.w) * r * g1.w); return o; }

__device__ __forceinline__ void e2_pass(Frame& F, int li) {
    frame_tid(F);
    const int gw = F.vcu * 8 + F.wave, NGW = F.G * 8, lane = F.lane;
    const float* gq = inptr(F, I_EVQNG) + li * 768; const float* gkv = inptr(F, I_EVKVNG) + li * 256;
    const f32x2* R64 = WSP(f32x2, WS_ROPE64); const f32x2* R32 = WSP(f32x2, WS_ROPE32);
    const int cw = lane & 7, seg = cw >> 1, c4 = (lane >= 32 && lane < 36) ? lane - 32 : 0;
    const float* gq1p = gq + (lane >= 32 ? 8 * (lane + 64) - 768 : 0); const float* gq2p = gq + 8 * (lane + 128) - 768; const float* gkvp = gkv + (lane < 32 ? 8 * lane : 0);
    const f32x4 gq1a = *(const f32x4*)gq1p, gq1b = *(const f32x4*)(gq1p + 4), gq2a = *(const f32x4*)gq2p, gq2b = *(const f32x4*)(gq2p + 4), gkva = *(const f32x4*)gkvp, gkvb = *(const f32x4*)(gkvp + 4);
    u32x4 wn[4]; f32x2 t64n[8], t32n[8];
#define E2_LOAD(r_) do { const bf16_t* pr_ = WSP(bf16_t, WS_PB) + (size_t)(r_) * EV_LD; \
        _Pragma("unroll") for (int j = 0; j < 4; ++j) wn[j] = *(const u32x4*)(pr_ + 8 * (lane + 64 * j)); \
        const int t_ = (r_) & (SEQ - 1), prow_ = t_ >> 6, pcol_ = t_ & 63; \
        const f32x2* a_ = R64 + ((seg < 2) ? prow_ : pcol_) * 16 + (cw & 1) * 8; const f32x2* b_ = R32 + ((c4 < 2) ? prow_ : pcol_) * 8; \
        _Pragma("unroll") for (int i = 0; i < 8; ++i) { t64n[i] = a_[i]; t32n[i] = b_[i]; } } while (0)
#pragma unroll
    for (int j = 0; j < 4; ++j) wn[j] = (u32x4){0u, 0u, 0u, 0u};
#pragma unroll
    for (int i = 0; i < 8; ++i) { t64n[i] = (f32x2){0.f, 0.f}; t32n[i] = (f32x2){0.f, 0.f}; }
    if (gw < TT) E2_LOAD(gw);
    for (int row = gw; row < TT; row += NGW) {
        bf16_t* pr = WSP(bf16_t, WS_PB) + (size_t)row * EV_LD;
        u32x4 w[4]; f32x2 t64[8], t32[8];
#pragma unroll
        for (int j = 0; j < 4; ++j) w[j] = wn[j];
#pragma unroll
        for (int i = 0; i < 8; ++i) { t64[i] = t64n[i]; t32[i] = t32n[i]; }
        if (row + NGW < TT) E2_LOAD(row + NGW);
        float sq = ssq8(w[2]) + (lane >= 32 ? ssq8(w[1]) : 0.f), skv = lane < 32 ? ssq8(w[3]) : 0.f;
        const float rq = 1.0f / sqrtf(wave_sum(sq) * (1.0f / 768.0f) + NORM_EPS), rkv = 1.0f / sqrtf(wave_sum(skv) * (1.0f / 256.0f) + NORM_EPS);
        const bool lat = row < TL;
        const u32x4 y0 = shfl_xor4(w[0], 2), y1 = shfl_xor4(w[1], 2), y3 = shfl_xor4(w[3], 1);
        if (lat) { w[0] = rope_chunk_r(w[0], y0, t64, (seg & 1) == 0); if (lane < 16) w[1] = rope_chunk_r(w[1], y1, t64, (seg & 1) == 0); }
        if (lane >= 32) w[1] = scale8_r(w[1], rq, gq1a, gq1b);
        w[2] = scale8_r(w[2], rq, gq2a, gq2b);
        if (lane < 32) w[3] = scale8_r(w[3], rkv, gkva, gkvb);
        else if (lane < 36 && lat) w[3] = rope_chunk_r(w[3], y3, t32, ((lane - 32) & 1) == 0);
#pragma unroll
        for (int j = 0; j < 4; ++j) *(u32x4*)(pr + 8 * (lane + 64 * j)) = w[j];
    }
#undef E2_LOAD
}
__device__ __forceinline__ void m1a_pass(Frame& F, int layer) {
    frame_tid(F);
    const int gw = F.vcu * 8 + F.wave, NGW = F.G * 8, lane = F.lane;
    const float* MOD = WSP(float, WS_MOD); const float* g2 = inptr(F, I_N2G) + layer * DM;
    f32x4 gg[4], sh[4], sc1[4], vn[4]; int cb = -1;
#pragma unroll
    for (int j = 0; j < 4; ++j) { gg[j] = *(const f32x4*)(g2 + 4 * lane + 256 * j); sh[j] = gg[j]; sc1[j] = gg[j]; vn[j] = gg[j]; }
    if (gw < TT) {
#pragma unroll
        for (int j = 0; j < 4; ++j) vn[j] = xun4(*(const u32x2*)(WSP(bf16_t, WS_XLC) + (size_t)gw * DM + 4 * lane + 256 * j)); }
    for (int row = gw; row < TT; row += NGW) {
        f32x4 v[4];
#pragma unroll
        for (int j = 0; j < 4; ++j) v[j] = vn[j];
        if (row + NGW < TT) {
#pragma unroll
            for (int j = 0; j < 4; ++j) vn[j] = xun4(*(const u32x2*)(WSP(bf16_t, WS_XLC) + (size_t)(row + NGW) * DM + 4 * lane + 256 * j)); }
        const int bi = mod_bidx(row);
        if (bi != cb) { cb = bi; const float* mb = MOD + (size_t)(layer * 5 + bi) * 6144;
#pragma unroll
            for (int j = 0; j < 4; ++j) { sh[j] = *(const f32x4*)(mb + 3 * 1024 + 4 * lane + 256 * j); sc1[j] = *(const f32x4*)(mb + 4 * 1024 + 4 * lane + 256 * j) + 1.0f; } }
        float s = 0.f;
#pragma unroll
        for (int j = 0; j < 4; ++j) s += (v[j].x * v[j].x + v[j].y * v[j].y) + (v[j].z * v[j].z + v[j].w * v[j].w);
        const float rstd = 1.0f / sqrtf(wave_sum(s) * (1.0f / DM) + NORM_EPS);
        bf16_t* hr = WSP(bf16_t, WS_PB) + (size_t)row * H3_LD;
#pragma unroll
        for (int j = 0; j < 4; ++j) { const int col = 4 * lane + 256 * j;
            const f32x4 h = (v[j] * rstd) * gg[j] * sc1[j] + sh[j];
            unsigned hi[4], lo[4];
#pragma unroll
            for (int i = 0; i < 4; ++i) { hi[i] = f2bf(h[i]); lo[i] = f2bf(h[i] - __builtin_bit_cast(float, hi[i] << 16)); }
            const u32x2 wh = {hi[0] | (hi[1] << 16), hi[2] | (hi[3] << 16)}, wl = {lo[0] | (lo[1] << 16), lo[2] | (lo[3] << 16)};
            *(u32x2*)(hr + col) = wh; *(u32x2*)(hr + 1024 + col) = wl;
            *(unsigned*)(WSP(unsigned char, WS_HB) + (size_t)row * DM + col) = cvt4_fp8(h[0], h[1], h[2], h[3]); }
    }
}
__device__ __forceinline__ void m1b_gemm(Frame& F, int layer) {
    pg8::RouterOrder S; S.A = (const char*)WSP(bf16_t, WS_PB); S.Bt = (const char*)(WSP(bf16_t, WS_RWT) + (size_t)layer * 256 * H3_LD); S.lda2 = H3_LD * 2; S.ldb2 = H3_LD * 2; S.nM = TT / 256; S.G = F.G; S.c = blockIdx.x;
    pg8::EpiLogits E{WSP(float, WS_LOGIT), WSP(float, WS_LOGIT12), inptr(F, I_RB) + layer * 32};
    pg8::gemm_phase<pg8::EpiLogits, pg8::RouterOrder>(F.lds, 1024, (size_t)H3_LD * 2, (size_t)H3_LD * 2, S, E);
}
__device__ __forceinline__ void m1c_pass(Frame& F) {
    frame_tid(F);
    const int lane = F.lane, blk = blockIdx.x, CH = (TT + F.G - 1) / F.G;
    const int r0 = blk * CH, r1 = (r0 + CH < TT) ? r0 + CH : TT;
    LAS int* hist = (LAS int*)(F.lds + LDSCTL_OFF + 512);
    if (F.tid < 32) hist[F.tid] = 0;
    __syncthreads();
    const int e = lane & 31, sub = lane >> 5;
    float n0 = 0.f, n1 = 0.f, n2 = 0.f;
    { const int row = r0 + 2 * F.wave + sub; const size_t li_ = (size_t)(row < r1 ? row : r1 - 1) * 32 + e;
      n0 = WSP(float, WS_LOGIT)[li_]; n1 = WSP(float, WS_LOGIT12)[li_]; n2 = WSP(float, WS_LOGIT12)[(size_t)TT * 32 + li_]; }
    for (int rbase = r0 + 2 * F.wave; rbase < r1; rbase += 16) {
        const int row = rbase + sub; const bool ok = row < r1;
        float logit = (n0 + n1) + n2;
        { const int rn = rbase + 16 + sub; const size_t li_ = (size_t)(rn < r1 ? rn : r1 - 1) * 32 + e;
          n0 = WSP(float, WS_LOGIT)[li_]; n1 = WSP(float, WS_LOGIT12)[li_]; n2 = WSP(float, WS_LOGIT12)[(size_t)TT * 32 + li_]; }
        float tv[4]; int ti[4];
#pragma unroll
        for (int k = 0; k < 4; ++k) {
            float bv = logit; int bi = e;
#pragma unroll
            for (int o = 16; o >= 1; o >>= 1) { const float ov = __shfl_xor(bv, o); const int oi = __shfl_xor(bi, o); if (ov > bv || (ov == bv && oi < bi)) { bv = ov; bi = oi; } }
            tv[k] = bv; ti[k] = bi; if (e == bi) logit = -3.0e38f;
        }
        const float w1 = __expf(tv[1] - tv[0]), w2 = __expf(tv[2] - tv[0]), w3 = __expf(tv[3] - tv[0]); const float inv = 1.0f / (1.0f + w1 + w2 + w3);
        if (e == 0 && ok) {
            *(int4*)(WSP(int, WS_TOPE) + (size_t)row * 4) = make_int4(ti[0], ti[1], ti[2], ti[3]);
            *(f32x4*)(WSP(float, WS_TOPG) + (size_t)row * 4) = (f32x4){inv, w1 * inv, w2 * inv, w3 * inv};
            atomicAdd((int*)(hist + ti[0]), 1); atomicAdd((int*)(hist + ti[1]), 1); atomicAdd((int*)(hist + ti[2]), 1); atomicAdd((int*)(hist + ti[3]), 1);
        }
    }
    __syncthreads();
    if (F.tid < 32) WSP(int, WS_HIST)[blk * 32 + F.tid] = hist[F.tid];
    __syncthreads();
}

__device__ __forceinline__ void m2_pass(Frame& F) {
    frame_tid(F);
    const int blk = blockIdx.x, CH = (TT + F.G - 1) / F.G;
    const int r0 = blk * CH, r1 = (r0 + CH < TT) ? r0 + CH : TT, nr = r1 > r0 ? r1 - r0 : 0;
    LAS int* tot = (LAS int*)(F.lds), *bef = tot + 32, *pst = tot + 64, *ntl = tot + 96;
    LAS int* te = (LAS int*)(F.lds + 1024);
    LAS float* tg = (LAS float*)(F.lds + 1024 + 32768);
    const int* HIST = WSP(int, WS_HIST);
    if (F.tid < 64) tot[F.tid] = 0;
    __syncthreads();
    for (int i = F.tid; i < F.G * 32; i += 512) { const int h = HIST[i]; atomicAdd((int*)(tot + (i & 31)), h); if ((i >> 5) < blk) atomicAdd((int*)(bef + (i & 31)), h); }
    for (int i = F.tid; i < nr * 4; i += 512) { te[i] = WSP(int, WS_TOPE)[(size_t)r0 * 4 + i]; tg[i] = WSP(float, WS_TOPG)[(size_t)r0 * 4 + i]; }
    __syncthreads();
    if (F.tid == 0) { int ps = 0; for (int e = 0; e < 32; ++e) { pst[e] = ps; ps += (tot[e] + 255) & ~255; } ntl[0] = ps >> 8; }
    __syncthreads();
    LAS int* cnt = (LAS int*)(F.lds + 1024 + 65536);
    const int nent = nr * 4, nch = (nent + 63) >> 6;
    int myrank[4] = {0, 0, 0, 0}, myex[4] = {-1, -1, -1, -1};
#pragma unroll
    for (int q = 0; q < 4; ++q) { const int c = F.wave + 8 * q;
        if (c < nch) { const int i = 64 * c + F.lane; const int ex = i < nent ? te[i] : -1; myex[q] = ex; int rk = 0, mine = 0;
            for (int e = 0; e < 32; ++e) { const unsigned long long m = __ballot(ex == e); if (ex == e) rk = __popcll(m & ((1ull << F.lane) - 1ull)); if (F.lane == e) mine = __popcll(m); }
            myrank[q] = rk; if (F.lane < 32) cnt[c * 32 + F.lane] = mine; } }
    __syncthreads();
#pragma unroll
    for (int q = 0; q < 4; ++q) { const int c = F.wave + 8 * q; const int i = 64 * c + F.lane;
        if (c < nch && i < nent) { const int ex = myex[q]; int before = 0; for (int c2 = 0; c2 < c; ++c2) before += cnt[c2 * 32 + ex];
            const int sl = pst[ex] + bef[ex] + before + myrank[q];
            WSP(int, WS_SLOT)[(size_t)r0 * 4 + i] = sl; WSP(float, WS_GSLOT)[sl] = tg[i]; WSP(int, WS_TOKSLOT)[sl] = r0 + (i >> 2); } }
    if (blk == 0) { const int nt = ntl[0]; int* TE = WSP(int, WS_TILEEXP);
        for (int tl = F.tid; tl < nt; tl += 512) { int e = 0; for (int q = 1; q < 32; ++q) if (pst[q] <= tl * 256) e = q; TE[tl] = e; }
        if (F.tid == 0) TE[1023] = nt;
        for (int e = 0; e < 32; ++e) { const int p0 = pst[e] + tot[e], p1 = pst[e] + ((tot[e] + 255) & ~255); for (int sidx = p0 + F.tid; sidx < p1; sidx += 512) WSP(int, WS_TOKSLOT)[sidx] = 0; } }
    __syncthreads();
}

__device__ __forceinline__ void m5_pass(Frame& F, int layer) {
    frame_tid(F);
    const int gw = F.vcu * 8 + F.wave, NGW = F.G * 8, lane = F.lane;
    const float* MOD = WSP(float, WS_MOD);
    const bool last = layer == 3; const int RL = last ? TL : TT;
    f32x4 gg[4], g2v[4], sh[4], sc1[4]; int cb = -1;
    { const float* gp = last ? inptr(F, I_FG) : inptr(F, I_N1G) + (layer + 1) * DM;
#pragma unroll
      for (int j = 0; j < 4; ++j) { gg[j] = *(const f32x4*)(gp + 4 * lane + 256 * j); g2v[j] = gg[j]; sh[j] = gg[j]; sc1[j] = gg[j]; } }
    int4 sC = make_int4(0, 0, 0, 0), sN = sC; f32x4 gC = {0.f, 0.f, 0.f, 0.f}, gN = gC;
    unsigned yw[4][4], ywn[4][4]; f32x4 xv[4], xvn[4];
#pragma unroll
    for (int j = 0; j < 4; ++j) { xv[j] = gg[j]; xvn[j] = gg[j];
#pragma unroll
        for (int k = 0; k < 4; ++k) { yw[j][k] = 0u; ywn[j][k] = 0u; } }
#define M5_SLOTS(S_, G_, r_) do { S_ = *(const int4*)(WSP(int, WS_SLOT) + (size_t)(r_) * 4); G_ = *(const f32x4*)(WSP(float, WS_TOPG) + (size_t)(r_) * 4); } while (0)
#define M5_DATA(Y_, X_, S_, r_) do { const int sl_[4] = {S_.x, S_.y, S_.z, S_.w}; \
        _Pragma("unroll") for (int j = 0; j < 4; ++j) { const int col = 4 * lane + 256 * j; \
            _Pragma("unroll") for (int k = 0; k < 4; ++k) Y_[j][k] = *(const unsigned*)(WSP(unsigned char, WS_XG) + (size_t)(col >> 6) * ((size_t)MAXSLOT * 64) + (size_t)sl_[k] * 64 + (col & 63)); \
            X_[j] = xun4(*(const u32x2*)(WSP(bf16_t, WS_XLC) + (size_t)(r_) * DM + col)); } } while (0)
    if (gw < RL) { M5_SLOTS(sC, gC, gw); M5_DATA(yw, xv, sC, gw); }
    if (gw + NGW < RL) M5_SLOTS(sN, gN, gw + NGW);
    for (int row = gw; row < RL; row += NGW) {
        const f32x4 gcur = gC;
        if (row + NGW < RL) { M5_DATA(ywn, xvn, sN, row + NGW); gC = gN; }
        if (row + 2 * NGW < RL) M5_SLOTS(sN, gN, row + 2 * NGW);
        const int bi = mod_bidx(row);
        if (bi != cb) { cb = bi; const float* mb = MOD + (size_t)(layer * 5 + bi) * 6144; const float* mn = MOD + (size_t)((last ? layer : layer + 1) * 5 + bi) * 6144;
#pragma unroll
            for (int j = 0; j < 4; ++j) { const int col = 4 * lane + 256 * j; g2v[j] = *(const f32x4*)(mb + 5 * 1024 + col); sh[j] = *(const f32x4*)(mn + col); sc1[j] = *(const f32x4*)(mn + 1024 + col) + 1.0f; } }
        const float gk[4] = {gcur.x * (1.0f / YS_SCALE), gcur.y * (1.0f / YS_SCALE), gcur.z * (1.0f / YS_SCALE), gcur.w * (1.0f / YS_SCALE)};
        bf16_t* xr = WSP(bf16_t, WS_XLC) + (size_t)row * DM;
        f32x4 v[4];
#pragma unroll
        for (int j = 0; j < 4; ++j) { f32x4 y = {0.f, 0.f, 0.f, 0.f};
#pragma unroll
            for (int k = 0; k < 4; ++k) { const unsigned w = yw[j][k];
                y += (f32x4){__builtin_amdgcn_cvt_f32_fp8(w, 0), __builtin_amdgcn_cvt_f32_fp8(w, 1), __builtin_amdgcn_cvt_f32_fp8(w, 2), __builtin_amdgcn_cvt_f32_fp8(w, 3)} * gk[k]; }
            v[j] = xv[j] + g2v[j] * y; }
        if (!last) {
#pragma unroll
            for (int j = 0; j < 4; ++j) *(u32x2*)(xr + 4 * lane + 256 * j) = xpk4(v[j]);
            norm_mod_store_r(v, lane, gg, sh, sc1, WSP(unsigned char, WS_HB) + (size_t)row * DM);
        } else {
            float s = 0.f;
#pragma unroll
            for (int j = 0; j < 4; ++j) s += (v[j].x * v[j].x + v[j].y * v[j].y) + (v[j].z * v[j].z + v[j].w * v[j].w);
            const float rstd = 1.0f / sqrtf(wave_sum(s) * (1.0f / DM) + NORM_EPS);
#pragma unroll
            for (int j = 0; j < 4; ++j) { const int col = 4 * lane + 256 * j; *(f32x4*)(F.out + (size_t)row * DM + col) = (v[j] * rstd) * gg[j]; }
        }
#pragma unroll
        for (int j = 0; j < 4; ++j) { xv[j] = xvn[j];
#pragma unroll
            for (int k = 0; k < 4; ++k) yw[j][k] = ywn[j][k]; }
    }
#undef M5_SLOTS
#undef M5_DATA
}

constexpr int NPH_PAIR = 22, NPH = 2 + 2 * NPH_PAIR;

__device__ __forceinline__ void moe_gemm1(Frame& F, int layer) {
    const int* TE = WSP(int, WS_TILEEXP);
    LAS int* tel = (LAS int*)(F.lds + LDSCTL_OFF + 4096);
    { const int tz = opaque_tid(); tel[tz] = TE[tz]; tel[512 + tz] = TE[512 + tz]; __syncthreads(); }
    pg8::MoeOrder S; S.A = (const char*)WSP(unsigned char, WS_HB); S.W = (const char*)(WSP(unsigned char, WS_W1) + (size_t)layer * 32 * 2048 * 1024); S.tile_exp = tel; S.tokslot = WSP(int, WS_TOKSLOT);
    S.lda2 = 1024; S.ldb2 = 1024; S.wstride = 2048u * 1024u; S.ntiles = __builtin_amdgcn_readfirstlane(TE[1023]); S.nN = 8; S.G = F.G; S.c = blockIdx.x;
    pg8::EpiSwiglu E{WSP(unsigned char, WS_HA), inptr(F, I_B1) + (size_t)layer * 32 * 2048};
    pg8::gemm_phase<pg8::EpiSwiglu, pg8::MoeOrder, true, true>(F.lds, 512, 1024, 1024, S, E);
}
__device__ __forceinline__ void moe_gemm2(Frame& F, int layer) {
    const int* TE = WSP(int, WS_TILEEXP);
    LAS int* tel = (LAS int*)(F.lds + LDSCTL_OFF + 4096);
    { const int tz = opaque_tid(); tel[tz] = TE[tz]; tel[512 + tz] = TE[512 + tz]; __syncthreads(); }
    pg8::MoeOrder S; S.A = (const char*)WSP(unsigned char, WS_HA); S.W = (const char*)(WSP(unsigned char, WS_W2) + (size_t)layer * 32 * 1024 * 1024); S.tile_exp = tel; S.tokslot = nullptr;
    S.lda2 = 1024; S.ldb2 = 1024; S.wstride = 1024u * 1024u; S.ntiles = __builtin_amdgcn_readfirstlane(TE[1023]); S.nN = 4; S.G = F.G; S.c = blockIdx.x;
    pg8::EpiGate E{WSP(unsigned char, WS_XG), inptr(F, I_B2) + (size_t)layer * 32 * 1024};
    pg8::gemm_phase<pg8::EpiGate, pg8::MoeOrder, true>(F.lds, 512, 1024, 1024, S, E);
}
__device__ __forceinline__ void dense_gemm_bf16(Frame& F, const bf16_t* A, size_t lda2, const bf16_t* Bt, int N, int K, bf16_t* O, int ldc) {
    pg8::DenseOrder S; S.init(A, lda2, Bt, (size_t)K * 2, TT, N, F.G, blockIdx.x);
    pg8::EpiBf16 E{O, ldc, 1.0f};
    pg8::gemm_phase<pg8::EpiBf16, pg8::DenseOrder>(F.lds, K, lda2, (size_t)K * 2, S, E);
}
__device__ __forceinline__ void dense_gemm_f8(Frame& F, const unsigned char* A8, const unsigned char* Bt8, int N, int K8, bf16_t* O, int ldc) {
    pg8::DenseOrder S; S.init(A8, (size_t)K8, Bt8, (size_t)K8, TT, N, F.G, blockIdx.x);
    pg8::EpiBf16 E{O, ldc, 1.0f / W8_SCALE};
    pg8::gemm_phase<pg8::EpiBf16, pg8::DenseOrder, true>(F.lds, K8 / 2, (size_t)K8, (size_t)K8, S, E);
}
__device__ __forceinline__ void outproj_gemm(Frame& F, const unsigned char* Bt8, int layer, int nrows) {
    pg8::DenseOrder S; S.init(WSP(unsigned char, WS_AO), 1024, Bt8, 1024, nrows, 1024, F.G, blockIdx.x);
    pg8::EpiResid E{WSP(bf16_t, WS_XLC), WSP(float, WS_MOD) + (size_t)layer * 5 * 6144 + 2 * 1024, 1.0f / W8_SCALE};
    pg8::gemm_phase<pg8::EpiResid, pg8::DenseOrder, true>(F.lds, 512, 1024, 1024, S, E);
}

__global__ void __launch_bounds__(512, 2) fwd(Args args) {
    extern __shared__ __attribute__((aligned(16))) unsigned char lds_raw[];
    Frame F;
    F.lds = (LAS unsigned char*)lds_raw;
    F.tid = threadIdx.x; F.lane = F.tid & 63; F.wave = __builtin_amdgcn_readfirstlane(F.tid >> 6);
    F.G = gridDim.x; { const int bx = blockIdx.x; F.vcu = (F.G % 8 == 0) ? (bx % 8) * (F.G / 8) + bx / 8 : bx; }
    F.out = args.out; F.ws = args.ws;
    volatile LAS unsigned* MISC = (volatile LAS unsigned*)(F.lds + LDSCTL_OFF);
    if (F.tid < 64) MISC[F.tid] = 0u;
    if (F.tid < 25) { const unsigned long long pv = ((const unsigned long long*)__builtin_amdgcn_kernarg_segment_ptr())[F.tid]; MISC[64 + 2 * F.tid] = (unsigned)pv; MISC[65 + 2 * F.tid] = (unsigned)(pv >> 32); }
    __syncthreads();
    unsigned* ctl = (unsigned*)(F.ws + WS_CTL);
#if !MK_PER_PHASE
    XcdBarrier bar = xcd_barrier_post(ctl + CW_BAR, MISC + 8);
#define GRID_BAR() xcd_barrier(bar)
#else
#define GRID_BAR() do { } while (0)
#endif
    const int lo = args.ph_lo, hi = args.ph_hi;
    int pid = 0;
    enum { CNT0 = __COUNTER__ + 1 };
#ifndef PHMASK
#define PHMASK 0xFFFFFFFFull
#endif
#ifndef REPMASK
#define REPMASK 0ull
#endif
#define PHASE_BEGIN { const int site_ = __COUNTER__ - CNT0; const int nrep_ = 1 + (int)(((unsigned long long)REPMASK >> site_) & 1ull); \
    if ((((unsigned long long)PHMASK >> site_) & 1ull) && lo <= pid && pid < hi) { for (int rep_ = 0; rep_ < nrep_; ++rep_) {
#define PHASE_END if (rep_ + 1 < nrep_ || pid + 1 < hi) GRID_BAR(); } } ++pid; }

    PHASE_BEGIN pro_a(F); PHASE_END
    PHASE_BEGIN pro_b(F); PHASE_END

    for (int lp = 0; lp < 2; ++lp) {
        { const int layer = 2 * lp, li = lp;
        PHASE_BEGIN dense_gemm_f8(F, WSP(unsigned char, WS_HB), WSP(unsigned char, WS_WINE) + (size_t)li * 2048 * 1024, 2048, 1024, WSP(bf16_t, WS_PB), EV_LD); PHASE_END
        PHASE_BEGIN e2_pass(F, li); PHASE_END
        PHASE_BEGIN
            dense_gemm_bf16(F, WSP(bf16_t, WS_PB) + 768, (size_t)EV_LD * 2, WSP(bf16_t, WS_WUQ) + (size_t)li * 768 * 768, 768, 768, WSP(bf16_t, WS_QB), 768);
            dense_gemm_bf16(F, WSP(bf16_t, WS_PB) + 1536, (size_t)EV_LD * 2, WSP(bf16_t, WS_WUKV) + (size_t)li * 1024 * 256, 1024, 256, WSP(bf16_t, WS_KVB), 1024);
        PHASE_END
        PHASE_BEGIN
            for (int rr_ = 0; rr_ < 1 + (int)(((unsigned long long)REPMASK >> 40) & 1ull); ++rr_)
            for (int u = F.vcu; u < 1024 + 32; u += F.G) {
                att::UMla U; U.QB = WSP(bf16_t, WS_QB); U.KVB = WSP(bf16_t, WS_KVB); U.PB = WSP(bf16_t, WS_PB); U.AO = WSP(bf16_t, WS_AO); U.R32 = WSP(f32x2, WS_ROPE32);
                if (u < 1024) { const int bh = u >> 5; U.b = bh >> 3; U.h = bh & 7; U.qblk = u & 31; U.ctxq = false; }
                else { const int v = u - 1024; U.b = v >> 3; U.h = v & 7; U.qblk = 0; U.ctxq = true; }
                att::attn_unit<att::UMla>(F.lds, F.ws, U);
            }
            for (int rr_ = 0; rr_ < 1 + (int)(((unsigned long long)REPMASK >> 41) & 1ull); ++rr_)
            for (int u = F.vcu; u < 1024 + 32; u += F.G) {
                att::UWin U; U.PB = WSP(bf16_t, WS_PB); U.AO = WSP(bf16_t, WS_AO); U.sink = inptr(F, I_EVSINK) + li * 8;
                if (u < 1024) { U.b = u >> 8; U.kvh = (u >> 7) & 1; U.j = u & 127; U.ctxq = false; }
                else { const int v = u - 1024; U.b = v >> 3; U.kvh = (v >> 2) & 1; U.j = v & 3; U.ctxq = true; }
                U.init();
                att::attn_unit<att::UWin>(F.lds, F.ws, U);
            }
        PHASE_END
        PHASE_BEGIN outproj_gemm(F, WSP(unsigned char, WS_WOUTE) + (size_t)li * 1024 * 1024, layer, TT); PHASE_END
        PHASE_BEGIN m1a_pass(F, layer); PHASE_END
        PHASE_BEGIN m1b_gemm(F, layer); PHASE_END
        PHASE_BEGIN m1c_pass(F); PHASE_END
        PHASE_BEGIN m2_pass(F); PHASE_END
        PHASE_BEGIN moe_gemm1(F, layer); PHASE_END
        PHASE_BEGIN moe_gemm2(F, layer); PHASE_END
        PHASE_BEGIN m5_pass(F, layer); PHASE_END
        }
        { const int layer = 2 * lp + 1, li = lp;
        PHASE_BEGIN dense_gemm_f8(F, WSP(unsigned char, WS_HB), WSP(unsigned char, WS_WINO) + (size_t)li * 3072 * 1024, 3072, 1024, WSP(bf16_t, WS_PB), OD_LD); PHASE_END
        PHASE_BEGIN
            for (int u = F.vcu; u < 2048 + (layer == 3 ? 0 : 64); u += F.G) {
                att::UNa U; U.PB = WSP(bf16_t, WS_PB); U.AO = WSP(bf16_t, WS_AO);
                if (u < 2048) { U.b = u >> 9; U.h = (u >> 5) & 15; U.G = u & 31; U.ctxq = false; }
                else { const int v = u - 2048; U.b = v >> 4; U.h = v & 15; U.G = 0; U.ctxq = true; }
                U.rpbh = inptr(F, I_ODRPB) + (size_t)(li * 16 + U.h) * 15 * 31;
                U.init();
                att::attn_unit<att::UNa>(F.lds, F.ws, U);
            }
        PHASE_END
        PHASE_BEGIN outproj_gemm(F, WSP(unsigned char, WS_WOUTO) + (size_t)li * 1024 * 1024, layer, layer == 3 ? TL : TT); PHASE_END
        PHASE_BEGIN m1a_pass(F, layer); PHASE_END
        PHASE_BEGIN m1b_gemm(F, layer); PHASE_END
        PHASE_BEGIN m1c_pass(F); PHASE_END
        PHASE_BEGIN m2_pass(F); PHASE_END
        PHASE_BEGIN moe_gemm1(F, layer); PHASE_END
        PHASE_BEGIN moe_gemm2(F, layer); PHASE_END
        PHASE_BEGIN m5_pass(F, layer); PHASE_END
        }
    }
}


#if MK_CHECK
constexpr int CW_CHK = 8192;
constexpr size_t WS_CHK = 1968 * MiB;
constexpr size_t WS_CHK_CNT = WS_CHK + 136 * MiB;
constexpr int IDS_PER_PAIR = 26, ID_PROB = 53, NID = 54;
struct CArgs { const float* in[25]; float* out; unsigned char* ws; int layer, id; };
#define CWS(T, off) ((T*)(A.ws + (off)))
__device__ __forceinline__ unsigned hsh(unsigned x) { x ^= x >> 16; x *= 0x7feb352du; x ^= x >> 15; x *= 0x846ca68bu; x ^= x >> 16; return x; }
__device__ __forceinline__ float bfv(const bf16_t* p) { return __builtin_bit_cast(float, (unsigned)(*p) << 16); }
__device__ __forceinline__ float f8v(const unsigned char* p) { const unsigned b = *p; const unsigned e = (b >> 3) & 15u, m = b & 7u; const float v = e ? __builtin_bit_cast(float, ((e + 120u) << 23) | (m << 20)) : (float)m * 0.001953125f; return (b & 128u) ? -v : v; }
__device__ __forceinline__ float rbf(float a) { return __builtin_bit_cast(float, f2bf(a) << 16); }
__device__ __forceinline__ void chk_acc(const CArgs& A, float e2, float r2) {
    __shared__ float sh[2][8];
    e2 = wave_sum(e2); r2 = wave_sum(r2);
    const int w = threadIdx.x >> 6;
    if ((threadIdx.x & 63) == 0) { sh[0][w] = e2; sh[1][w] = r2; }
    __syncthreads();
    if (threadIdx.x == 0) { float a = 0.f, b = 0.f; for (int i = 0; i < (int)(blockDim.x >> 6); ++i) { a += sh[0][i]; b += sh[1][i]; }
        float* acc = (float*)(A.ws + WS_CTL) + CW_CHK + 2 * A.id; atomicAdd(acc, a); atomicAdd(acc + 1, b); }
    __syncthreads();
}
__device__ __forceinline__ void sincos_d(float a, float& s, float& c) {
    double x = (double)a; const double tp = 6.283185307179586476925; double k = __builtin_rint(x / tp); double r = x - k * tp; double r2 = r * r;
    double sp = r, cp = 1.0, ts = r, tc = 1.0;
#pragma unroll
    for (int i = 1; i < 14; ++i) { tc *= -r2 / (double)((2 * i - 1) * (2 * i)); cp += tc; ts *= -r2 / (double)((2 * i) * (2 * i + 1)); sp += ts; }
    s = (float)sp; c = (float)cp;
}
__device__ __forceinline__ float invfreq(int i, int half) { return __builtin_amdgcn_exp2f(-((float)i / (float)half) * 13.287712379549449f); }
__device__ __forceinline__ float nsilu(float c) { return c / (1.0f + __expf(-c)); }
__device__ float naive_mod(const CArgs& A, int layer, int bidx, int n) {
    const float* cv = bidx < 4 ? A.in[I_C] + bidx * 1024 : A.in[I_CCTX]; const float* W = A.in[I_ADAW] + (size_t)layer * 1024 * 6144 + n;
    float acc = 0.f; for (int k = 0; k < 1024; ++k) acc += nsilu(cv[k]) * W[(size_t)k * 6144];
    return acc + A.in[I_ADAB][layer * 6144 + n];
}
__device__ __forceinline__ int srow(unsigned s) { return (s & 3) == 0 ? TL + (int)(hsh(s * 3 + 1) % TC) : (int)(hsh(s * 3 + 1) % TL); }
__global__ void chk_mark(CArgs A) { if (threadIdx.x == 0) ((float*)(A.ws + WS_CTL))[CW_CHK + 2 * A.id + 1] = 1.0f; }

__global__ void chk_gemm(CArgs A, const bf16_t* X, int ldx, const float* W, int ldw, int K, int ncol, const bf16_t* O, int ldo) {
    const int row = srow(blockIdx.x); const int col = (int)((hsh(blockIdx.x * 977 + 5) + 7u * threadIdx.x) % (unsigned)ncol);
    float ref = 0.f; for (int k = 0; k < K; ++k) ref += (ldx ? bfv(X + (size_t)row * ldx + k) : f8v((const unsigned char*)X + (size_t)row * 1024 + k)) * W[(size_t)k * ldw + col];
    const float got = bfv(O + (size_t)row * ldo + col);
    chk_acc(A, (got - ref) * (got - ref), ref * ref);
}
__global__ void chk_e2(CArgs A) {
    __shared__ float P[EV_IN]; __shared__ float red[2];
    const int li = A.layer >> 1, row = srow(blockIdx.x), t = threadIdx.x;
    const float* W = A.in[I_EVWIN] + (size_t)li * 1024 * EV_IN; const unsigned char* h = CWS(unsigned char, WS_HB) + (size_t)row * DM;
    for (int c = t; c < EV_IN; c += 256) { float a = 0.f; for (int k = 0; k < 1024; ++k) a += f8v(h + k) * W[(size_t)k * EV_IN + c]; P[c] = rbf(a); }
    __syncthreads();
    if (t == 0) { float a = 0.f; for (int c = 768; c < 1536; ++c) a += P[c] * P[c]; red[0] = 1.0f / sqrtf(a / 768.0f + NORM_EPS); float b = 0.f; for (int c = 1536; c < 1792; ++c) b += P[c] * P[c]; red[1] = 1.0f / sqrtf(b / 256.0f + NORM_EPS); }
    __syncthreads();
    const bool lat = row < TL; const int tt = row & (SEQ - 1), prow = tt >> 6, pcol = tt & 63;
    float e2 = 0.f, r2 = 0.f;
    for (int c = t; c < EV_IN; c += 256) {
        float ref = P[c];
        if (c < 640 && lat) { const int d = c & 63, dd = d & 31, i = dd & 15; const bool first = dd < 16; const float y = P[first ? c + 16 : c - 16];
            float sn, cs; sincos_d((float)((d < 32) ? prow : pcol) * invfreq(i, 16), sn, cs); ref = first ? P[c] * cs - y * sn : P[c] * cs + y * sn; }
        else if (c >= 768 && c < 1536) ref = P[c] * red[0] * A.in[I_EVQNG][li * 768 + c - 768];
        else if (c >= 1536 && c < 1792) ref = P[c] * red[1] * A.in[I_EVKVNG][li * 256 + c - 1536];
        else if (c >= 1792 && lat) { const int d = c - 1792, dd = d & 15, i = dd & 7; const bool first = dd < 8; const float y = P[first ? c + 8 : c - 8];
            float sn, cs; sincos_d((float)((d < 16) ? prow : pcol) * invfreq(i, 8), sn, cs); ref = first ? P[c] * cs - y * sn : P[c] * cs + y * sn; }
        const float got = bfv(CWS(bf16_t, WS_PB) + (size_t)row * EV_LD + c);
        e2 += (got - ref) * (got - ref); r2 += ref * ref;
    }
    chk_acc(A, e2, r2);
}
__global__ void chk_e4(CArgs A) {
    __shared__ float Q[768];
    const int li = A.layer >> 1, row = (int)(hsh(blockIdx.x * 3 + 1) % TL), t = threadIdx.x;
    const float* W = A.in[I_EVWUQ] + (size_t)li * 768 * 768; const bf16_t* x = CWS(bf16_t, WS_PB) + (size_t)row * EV_LD + 768;
    for (int c = t; c < 768; c += 256) { float a = 0.f; for (int k = 0; k < 768; ++k) a += bfv(x + k) * W[(size_t)k * 768 + c]; Q[c] = rbf(a); }
    __syncthreads();
    const int tt = row & (SEQ - 1), prow = tt >> 6, pcol = tt & 63;
    float e2 = 0.f, r2 = 0.f;
    for (int c = t; c < 768; c += 256) { const int d = c % 96; float ref = Q[c];
        if (d >= 64) { const int dr = d - 64, dd = dr & 15, i = dd & 7; const bool first = dd < 8; const float y = Q[first ? c + 8 : c - 8];
            float sn, cs; sincos_d((float)((dr < 16) ? prow : pcol) * invfreq(i, 8), sn, cs); ref = first ? Q[c] * cs - y * sn : Q[c] * cs + y * sn; }
        const float got = bfv(CWS(bf16_t, WS_QB) + (size_t)row * 768 + c); e2 += (got - ref) * (got - ref); r2 += ref * ref; }
    chk_acc(A, e2, r2);
}
__global__ void chk_attn(CArgs A, int kind, int ctxq) {
    __shared__ float sc[8448]; __shared__ float redm[4], reds[4], qs[96];
    const int li = A.layer >> 1, t = threadIdx.x; const unsigned s = blockIdx.x;
    const int b = hsh(s * 7 + 1) % NB, head = hsh(s * 7 + 2) % (kind == 2 ? 16 : 8);
    const int pos = ctxq ? hsh(s * 7 + 3) % CTXL : ((s & 7) == 0 ? (hsh(s) % 200) : (s & 7) == 1 ? SEQ - 1 - (hsh(s) % 200) : hsh(s * 7 + 3) % SEQ);
    const size_t qrow = ctxq ? (size_t)(TL + b * CTXL + pos) : (size_t)(b * SEQ + pos);
    int nlat = 0, wlo = 0, r = pos >> 6, c = pos & 63, r0 = 0, c0 = 0;
    if (!ctxq) {
        if (kind == 0) { wlo = pos - 128 < 0 ? 0 : pos - 128; const int whi = pos + 128 > SEQ - 1 ? SEQ - 1 : pos + 128; nlat = whi - wlo + 1; }
        else if (kind == 1) nlat = SEQ;
        else { r0 = r - 4; r0 = r0 < 0 ? 0 : (r0 > 120 ? 120 : r0); c0 = c - 8; c0 = c0 < 0 ? 0 : (c0 > 48 ? 48 : c0); nlat = 128; }
    }
    const int nk = nlat + CTXL;
    const bf16_t* PB = CWS(bf16_t, WS_PB); const bf16_t* KVB = CWS(bf16_t, WS_KVB);
    const int pld = kind == 2 ? OD_LD : EV_LD, dqk = kind == 1 ? 96 : 64;
    const bf16_t* q = kind == 1 ? CWS(bf16_t, WS_QB) + qrow * 768 + 96 * head : PB + qrow * pld + 64 * head;
    const float scale = kind == 1 ? 0.10206207261596577f : 0.125f;
    const bool has_sink = kind == 0; const float sinkv = has_sink ? A.in[I_EVSINK][li * 8 + head] : 0.f;
    const float* rp = A.in[I_ODRPB] + (size_t)(li * 16 + head) * 15 * 31;
    if (t < dqk) qs[t] = bfv(q + t);
    __syncthreads();
    if (kind == 1 && !ctxq) { float rv = 0.f;
        if (t >= 64 && t < 96) { const int dr = t - 64, dd = dr & 15, i = dd & 7; const bool first = dd < 8; const float y = qs[first ? t + 8 : t - 8];
            float sn, cs; sincos_d((float)((dr < 16) ? r : c) * invfreq(i, 8), sn, cs); rv = rbf(first ? qs[t] * cs - y * sn : qs[t] * cs + y * sn); }
        __syncthreads();
        if (t >= 64 && t < 96) qs[t] = rv;
        __syncthreads(); }
#define KROW(i) ((i) >= nlat ? (size_t)(TL + b * CTXL + ((i) - nlat)) : kind == 0 ? (size_t)(b * SEQ + wlo + (i)) : kind == 1 ? (size_t)(b * SEQ + (i)) : (size_t)(b * SEQ + (r0 + ((i) >> 4)) * 64 + c0 + ((i) & 15)))
    float mx = has_sink ? sinkv : -3e38f;
    for (int i = t; i < nk; i += 256) { const size_t kr = KROW(i); float a = 0.f;
        if (kind == 0) { const bf16_t* k = PB + kr * EV_LD + 512 + 64 * (head >> 2); for (int d = 0; d < 64; ++d) a += qs[d] * bfv(k + d); }
        else if (kind == 1) { const bf16_t* k = KVB + kr * 1024 + 128 * head; for (int d = 0; d < 64; ++d) a += qs[d] * bfv(k + d); const bf16_t* k2 = PB + kr * EV_LD + 1792; for (int d = 0; d < 32; ++d) a += qs[64 + d] * bfv(k2 + d); }
        else { const bf16_t* k = PB + kr * OD_LD + 1024 + 64 * head; for (int d = 0; d < 64; ++d) a += qs[d] * bfv(k + d); }
        a *= scale;
        if (kind == 2 && i < nlat) { const int kr_ = r0 + (i >> 4), kc_ = c0 + (i & 15); a += rp[(kr_ - r + 7) * 31 + (kc_ - c + 15)]; }
        sc[i] = a; mx = fmaxf(mx, a); }
    for (int o = 1; o < 64; o <<= 1) mx = fmaxf(mx, __shfl_xor(mx, o));
    if ((t & 63) == 0) redm[t >> 6] = mx;
    __syncthreads();
    mx = fmaxf(fmaxf(redm[0], redm[1]), fmaxf(redm[2], redm[3]));
    float sm = 0.f;
    for (int i = t; i < nk; i += 256) { const float p = __expf(sc[i] - mx); sc[i] = p; sm += p; }
    sm = wave_sum(sm);
    if ((t & 63) == 0) reds[t >> 6] = sm;
    __syncthreads();
    sm = reds[0] + reds[1] + reds[2] + reds[3] + (has_sink ? __expf(sinkv - mx) : 0.f);
    float e2 = 0.f, r2 = 0.f;
    if (t < 64) { float o = 0.f;
        for (int i = 0; i < nk; ++i) { const size_t kr = KROW(i); const bf16_t* v = kind == 0 ? PB + kr * EV_LD + 640 + 64 * (head >> 2) : kind == 1 ? KVB + kr * 1024 + 128 * head + 64 : PB + kr * OD_LD + 2048 + 64 * head; o += sc[i] * bfv(v + t); }
        o /= sm; const unsigned char* got = CWS(unsigned char, WS_AO) + qrow * 1024 + (kind == 1 ? 512 : 0) + 64 * head; const float g = f8v(got + t); e2 = (g - o) * (g - o); r2 = o * o; }
#undef KROW
    chk_acc(A, e2, r2);
}
__global__ void chk_outproj(CArgs A, const float* W) {
    const int row = A.layer == 3 ? (int)(hsh(blockIdx.x * 3 + 1) % TL) : srow(blockIdx.x), c = (int)((hsh(blockIdx.x * 977 + 5) + 7u * threadIdx.x) % 1024u);
    float a = 0.f; for (int k = 0; k < 1024; ++k) a += f8v(CWS(unsigned char, WS_AO) + (size_t)row * 1024 + k) * W[(size_t)k * 1024 + c];
    const float gate = naive_mod(A, A.layer, row < TL ? (row >> 13) : 4, 2 * 1024 + c);
    const float ref = CWS(float, WS_CHK)[(size_t)row * DM + c] + gate * a, got = CWS(float, WS_XLC)[(size_t)row * DM + c];
    chk_acc(A, (got - ref) * (got - ref), (gate * a) * (gate * a));
}
__global__ void chk_norm_router(CArgs A, int which, const bf16_t* hbuf, int hld) {
    __shared__ float hv[1024]; __shared__ float red[4]; __shared__ float lg[32]; __shared__ int ste[4]; __shared__ float stv[4];
    const int row = srow(blockIdx.x), t = threadIdx.x, bidx = row < TL ? (row >> 13) : 4;
    const float* x = CWS(float, WS_XLC) + (size_t)row * DM;
    float s = 0.f; for (int c = t; c < 1024; c += 256) s += x[c] * x[c];
    s = wave_sum(s); if ((t & 63) == 0) red[t >> 6] = s; __syncthreads();
    const float rstd = 1.0f / sqrtf((red[0] + red[1] + red[2] + red[3]) / 1024.0f + NORM_EPS);
    const float* g = (which == 0 ? A.in[I_N1G] : A.in[I_N2G]) + A.layer * DM;
    float e2 = 0.f, r2 = 0.f;
    for (int c = t; c < 1024; c += 256) { const float sh = naive_mod(A, A.layer, bidx, which * 1024 + c), scl = naive_mod(A, A.layer, bidx, (which + 1) * 1024 + c);
        const float h = x[c] * rstd * g[c] * (1.0f + scl) + sh; hv[c] = h; const float got = hld ? bfv(hbuf + (size_t)row * hld + c) : f8v((const unsigned char*)hbuf + (size_t)row * DM + c); e2 += (got - h) * (got - h); r2 += h * h; }
    __syncthreads();
    if (which == 3) {
        if (t < 32) { const float* rw = A.in[I_RW] + (size_t)A.layer * 1024 * 32; float a = 0.f; for (int k = 0; k < 1024; ++k) a += hv[k] * rw[k * 32 + t]; lg[t] = a + A.in[I_RB][A.layer * 32 + t]; }
        __syncthreads();
        if (t == 0) { unsigned used = 0u;
            for (int k = 0; k < 4; ++k) { float bv = -3e38f; int bi = 0; for (int e = 0; e < 32; ++e) if (!((used >> e) & 1u) && lg[e] > bv) { bv = lg[e]; bi = e; } used |= 1u << bi; ste[k] = bi; stv[k] = bv; }
            float den = 0.f; for (int k = 0; k < 4; ++k) den += __expf(stv[k] - stv[0]);
            for (int k = 0; k < 4; ++k) { const float gr = __expf(stv[k] - stv[0]) / den; const int ge = CWS(int, WS_TOPE)[(size_t)row * 4 + k]; const float gg = CWS(float, WS_TOPG)[(size_t)row * 4 + k];
                const float d = (ge == ste[k]) ? (gg - gr) : 1.0f; e2 += 1000.f * d * d; r2 += 1000.f * gr * gr; } }
    }
    chk_acc(A, e2, r2);
}
__global__ void chk_slots_count(CArgs A) {
    const int i = blockIdx.x * 256 + threadIdx.x; if (i < TT * 4) { const int sl = CWS(int, WS_SLOT)[i]; if (sl >= 0 && sl < MAXSLOT) atomicAdd(CWS(int, WS_CHK_CNT) + sl, 1); else atomicAdd((float*)(A.ws + WS_CTL) + CW_CHK + 2 * A.id, 1.0f); }
}
__global__ void chk_slots(CArgs A) {
    const int i = blockIdx.x * 256 + threadIdx.x; float e2 = 0.f, r2 = 0.f;
    if (i < MAXSLOT) { const int c = CWS(int, WS_CHK_CNT)[i]; if (c > 1) e2 += 1.f; }
    if (i < 8192) { const unsigned a = hsh(i * 5 + 3) % (unsigned)(TT * 4); const int row = a >> 2, sl = CWS(int, WS_SLOT)[a], e = CWS(int, WS_TOPE)[a];
        if (CWS(int, WS_TILEEXP)[sl >> 8] != e) e2 += 1.f;
        if (CWS(float, WS_GSLOT)[sl] != CWS(float, WS_TOPG)[a]) e2 += 1.f;
        if (CWS(int, WS_TOKSLOT)[sl] != row) e2 += 1.f; r2 += 1.f; }
    chk_acc(A, e2, r2);
}
__global__ void chk_moe(CArgs A, int which) {
    const unsigned a = hsh(blockIdx.x * 5 + 3) % (unsigned)(TT * 4); const int sl = CWS(int, WS_SLOT)[a], e = CWS(int, WS_TILEEXP)[sl >> 8];
    const int c = (int)((hsh(blockIdx.x * 977 + 5) + 7u * threadIdx.x) % 1024u);
    float ref, got;
    if (which == 0) { const float* W = A.in[I_W1] + ((size_t)A.layer * 32 + e) * 1024 * 2048; const unsigned char* x = CWS(unsigned char, WS_HB) + (size_t)(a >> 2) * DM; float g = 0.f, l = 0.f;
        for (int k = 0; k < 1024; ++k) { const float xv = f8v(x + k); g += xv * W[(size_t)k * 2048 + c]; l += xv * W[(size_t)k * 2048 + 1024 + c]; }
        g += A.in[I_B1][((size_t)A.layer * 32 + e) * 2048 + c]; l += A.in[I_B1][((size_t)A.layer * 32 + e) * 2048 + 1024 + c];
        g = fminf(g, 7.f); l = fminf(fmaxf(l, -7.f), 7.f); ref = g / (1.0f + __expf(-1.702f * g)) * (l + 1.0f); got = f8v(CWS(unsigned char, WS_HA) + (size_t)sl * DM + c); }
    else { const float* W = A.in[I_W2] + ((size_t)A.layer * 32 + e) * 1024 * 1024; const unsigned char* x = CWS(unsigned char, WS_HA) + (size_t)sl * DM; float y = 0.f;
        for (int k = 0; k < 1024; ++k) y += f8v(x + k) * W[(size_t)k * 1024 + c];
        ref = y + A.in[I_B2][((size_t)A.layer * 32 + e) * 1024 + c]; got = f8v(CWS(unsigned char, WS_XG) + (size_t)sl * DM + c) * (1.0f / YS_SCALE); }
    chk_acc(A, (got - ref) * (got - ref), ref * ref);
}
__global__ void chk_combine(CArgs A) {
    const int row = srow(blockIdx.x), c = (int)((hsh(blockIdx.x * 977 + 5) + 7u * threadIdx.x) % 1024u);
    float y = 0.f; for (int k = 0; k < 4; ++k) y += CWS(float, WS_TOPG)[(size_t)row * 4 + k] * (1.0f / YS_SCALE) * f8v(CWS(unsigned char, WS_XG) + (size_t)CWS(int, WS_SLOT)[(size_t)row * 4 + k] * DM + c);
    const float gate = naive_mod(A, A.layer, row < TL ? (row >> 13) : 4, 5 * 1024 + c);
    const float ref = CWS(float, WS_CHK)[(size_t)row * DM + c] + gate * y, got = CWS(float, WS_XLC)[(size_t)row * DM + c];
    chk_acc(A, (got - ref) * (got - ref), (gate * y) * (gate * y));
}
__global__ void chk_report(CArgs A) {
    if (threadIdx.x == 0 && blockIdx.x == 0) { const float* acc = (const float*)(A.ws + WS_CTL) + CW_CHK; int bad = 0, bad2 = 0;
        for (int id = NID - 1; id >= 1; --id) { const int q = (id - 1) % IDS_PER_PAIR + 1; const float tol = (id == ID_PROB || (q >= 6 && q <= 10) || q == 18 || q == 19 || q == 20 || q == 1 || q == 2 || q == 17 || q == 13 || q == 14 || q == 16 || q == 23 || q == 24 || q == 26) ? 0.1f : 0.03f;
            const float e2 = acc[2 * id], r2 = acc[2 * id + 1]; if (r2 <= 0.f || !(e2 <= tol * tol * r2)) { bad2 = bad; bad = id; } }
        if (bad) A.out[0] = 1000.0f * (float)bad;
        if (bad2) A.out[1] = 1000.0f * (float)bad2; }
}
static void chk_before(int p, const Args& a, hipStream_t st) {
    const int q = p < 2 ? -1 : (p - 2) % NPH_PAIR;
    if (q == 8 || q == 18) (void)hipMemsetAsync(a.ws + WS_CHK_CNT, 0, (size_t)MAXSLOT * 4, st);
    if (q == 4 || q == 11 || q == 14 || q == 21) (void)hipMemcpyAsync(a.ws + WS_CHK, a.ws + WS_XLC, (size_t)TT * DM * 4, hipMemcpyDeviceToDevice, st);
}
static void chk_after(int p, const Args& a, hipStream_t st) {
    CArgs A{}; for (int i = 0; i < 25; ++i) A.in[i] = a.in[i]; A.out = a.out; A.ws = a.ws;
    const int lp = p < 2 ? 0 : (p - 2) / NPH_PAIR, q = p < 2 ? -1 : (p - 2) % NPH_PAIR, base = IDS_PER_PAIR * lp;
    unsigned char* ws = a.ws; const int le = 2 * lp, lod = 2 * lp + 1;
#define CK(idv, layerv, kern, grid, ...) do { A.id = base + (idv); A.layer = (layerv); hipLaunchKernelGGL(kern, dim3(grid), dim3(256), 0, st, A, ##__VA_ARGS__); } while (0)
#define CK0(idv, layerv, kern, grid) do { A.id = base + (idv); A.layer = (layerv); hipLaunchKernelGGL(kern, dim3(grid), dim3(256), 0, st, A); } while (0)
    if (p == 1) { A.id = ID_PROB; A.layer = 0; hipLaunchKernelGGL(chk_norm_router, dim3(48), dim3(256), 0, st, A, 0, (const bf16_t*)(ws + WS_HB), 0); }
    if (q == 0) CK(1, le, chk_gemm, 64, (const bf16_t*)(ws + WS_HB), 0, a.in[I_EVWIN] + (size_t)lp * 1024 * EV_IN, (int)EV_IN, 1024, (int)EV_IN, (const bf16_t*)(ws + WS_PB), (int)EV_LD);
    if (q == 1) CK0(2, le, chk_e2, 48);
    if (q == 2) { CK(3, le, chk_gemm, 64, (const bf16_t*)(ws + WS_PB) + 768, (int)EV_LD, a.in[I_EVWUQ] + (size_t)lp * 768 * 768, 768, 768, 768, (const bf16_t*)(ws + WS_QB), 768);
                  CK(4, le, chk_gemm, 64, (const bf16_t*)(ws + WS_PB) + 1536, (int)EV_LD, a.in[I_EVWUKV] + (size_t)lp * 256 * 1024, 1024, 256, 1024, (const bf16_t*)(ws + WS_KVB), 1024);
                  CK0(5, le, chk_mark, 1); }
    if (q == 3) { CK(6, le, chk_attn, 96, 0, 0); CK(7, le, chk_attn, 48, 1, 0); CK(8, le, chk_attn, 32, 0, 1); CK(9, le, chk_attn, 32, 1, 1); }
    if (q == 4) CK(10, le, chk_outproj, 48, a.in[I_EVWOUT] + (size_t)lp * 1024 * 1024);
    if (q == 7) CK(11, le, chk_norm_router, 48, 3, (const bf16_t*)(ws + WS_PB), (int)H3_LD);
    if (q == 8) { CK0(12, le, chk_slots_count, (TT * 4 + 255) / 256); CK0(12, le, chk_slots, MAXSLOT / 256); }
    if (q == 9) CK(13, le, chk_moe, 64, 0);
    if (q == 10) CK(14, le, chk_moe, 64, 1);
    if (q == 11) { CK0(15, le, chk_combine, 64); CK(16, le + 1, chk_norm_router, 48, 0, (const bf16_t*)(ws + WS_HB), 0); }
    if (q == 12) CK(17, lod, chk_gemm, 64, (const bf16_t*)(ws + WS_HB), 0, a.in[I_ODWIN] + (size_t)lp * 1024 * 3072, 3072, 1024, 3072, (const bf16_t*)(ws + WS_PB), (int)OD_LD);
    if (q == 13) { CK(18, lod, chk_attn, 96, 2, 0); CK(19, lod, chk_attn, 32, 2, 1); }
    if (q == 14) CK(20, lod, chk_outproj, 48, a.in[I_ODWOUT] + (size_t)lp * 1024 * 1024);
    if (q == 17) CK(21, lod, chk_norm_router, 48, 3, (const bf16_t*)(ws + WS_PB), (int)H3_LD);
    if (q == 18) { CK0(22, lod, chk_slots_count, (TT * 4 + 255) / 256); CK0(22, lod, chk_slots, MAXSLOT / 256); }
    if (q == 19) CK(23, lod, chk_moe, 64, 0);
    if (q == 20) CK(24, lod, chk_moe, 64, 1);
    if (q == 21) { if (lod != 3) { CK0(25, lod, chk_combine, 64); CK(26, lod + 1, chk_norm_router, 48, 0, (const bf16_t*)(ws + WS_HB), 0); } else { CK0(25, lod, chk_mark, 1); CK0(26, lod, chk_mark, 1); } }
    if (p == NPH - 1) { A.id = 0; hipLaunchKernelGGL(chk_report, dim3(1), dim3(64), 0, st, A); }
#undef CK
#undef CK0
}
#endif

extern "C" void kernel_launch(void* const* d_in, const int* in_sizes, int n_in, void* d_out, int out_size, void* d_ws, size_t ws_size, hipStream_t stream) {
    static int grid = 0;
    if (grid == 0) {
        if (n_in != 25 || out_size != TL * DM || ws_size < WS_END) { fprintf(stderr, "kernel_launch: unexpected shapes (n_in %d, out %d, ws %zu < %zu); nothing launched\n", n_in, out_size, ws_size, (size_t)WS_END); grid = -1; return; }
        int dev = 0, cus = 0, per_cu = 0;
        if (hipGetDevice(&dev) != hipSuccess || hipDeviceGetAttribute(&cus, hipDeviceAttributeMultiprocessorCount, dev) != hipSuccess) { grid = -1; return; }
        if (hipFuncSetAttribute((const void*)fwd, hipFuncAttributeMaxDynamicSharedMemorySize, LDS_BYTES) != hipSuccess) { fprintf(stderr, "kernel_launch: hipFuncSetAttribute failed\n"); grid = -1; return; }
        if (hipOccupancyMaxActiveBlocksPerMultiprocessor(&per_cu, (const void*)fwd, 512, LDS_BYTES) != hipSuccess || per_cu < 1) { fprintf(stderr, "kernel_launch: occupancy query says %d blocks per CU\n", per_cu); }
        (void)hipGetLastError();
        grid = cus;
    }
    if (grid < 0) return;
    (void)hipMemsetAsync((char*)d_ws + WS_CTL, 0, CTL_ZERO_BYTES, stream);
    Args a{};
    for (int i = 0; i < 25; ++i) a.in[i] = (const float*)d_in[i];
    a.out = (float*)d_out; a.ws = (unsigned char*)d_ws;
#if MK_PER_PHASE
    for (int p = 0; p < NPH; ++p) {
#if MK_CHECK
        chk_before(p, a, stream);
#endif
        a.ph_lo = p; a.ph_hi = p + 1; hipLaunchKernelGGL(fwd, dim3(grid), dim3(512), LDS_BYTES, stream, a);
#if MK_CHECK
        chk_after(p, a, stream);
#endif
    }
#else
    a.ph_lo = 0; a.ph_hi = NPH;
    hipLaunchKernelGGL(fwd, dim3(grid), dim3(512), LDS_BYTES, stream, a);
#endif
    const hipError_t le = hipPeekAtLastError();
    if (le != hipSuccess) fprintf(stderr, "kernel_launch: launch failed: %s\n", hipGetErrorName(le));
}
```

```cpp
#include <hip/hip_runtime.h>
#include <cstdio>
#include <cstdint>

#ifndef MK_CHECK
#define MK_CHECK 0
#endif
#ifndef MK_PER_PHASE
#define MK_PER_PHASE MK_CHECK
#endif

#define LAS __attribute__((address_space(3)))
#define GAS __attribute__((address_space(1)))
typedef unsigned short bf16_t;
typedef short bf16x8 __attribute__((ext_vector_type(8)));
typedef short s16x4 __attribute__((ext_vector_type(4)));
typedef float f32x2 __attribute__((ext_vector_type(2)));
typedef float f32x4 __attribute__((ext_vector_type(4)));
typedef float f32x16 __attribute__((ext_vector_type(16)));
typedef unsigned u32x2 __attribute__((ext_vector_type(2)));
typedef unsigned u32x4 __attribute__((ext_vector_type(4)));

constexpr int DM = 1024, NB = 4, SEQ = 8192, TL = NB * SEQ, CTXL = 256, TC = NB * CTXL, TT = TL + TC;
constexpr int EV_LD = 2048, OD_LD = 3072;
constexpr int EV_IN = 1824;
constexpr int NEXP = 32, DEXP = 1024;
constexpr int MAXSLOT = 143360, MAXTILE = 560;
constexpr float NORM_EPS = 1e-6f;
constexpr float LOG2E = 1.4426950408889634f;

constexpr size_t MiB = 1u << 20;
constexpr size_t WS_CTL = 0, CTL_ZERO_BYTES = 1 * MiB;
constexpr size_t WS_MOD = 1 * MiB;
constexpr size_t WS_ROPE64 = 1 * MiB + 512 * 1024;
constexpr size_t WS_ROPE32 = WS_ROPE64 + 16384;
constexpr size_t WS_TOPE = 2 * MiB;
constexpr size_t WS_TOPG = WS_TOPE + 540672;
constexpr size_t WS_SLOT = WS_TOPG + 540672;
constexpr size_t WS_HIST = WS_SLOT + 540672;
constexpr size_t WS_TILEEXP = WS_HIST + 131072;
constexpr size_t WS_GSLOT = WS_TILEEXP + 4096;
constexpr size_t WS_TOKSLOT = WS_GSLOT + (size_t)MAXSLOT * 4;
static_assert(WS_TOKSLOT + (size_t)MAXSLOT * 4 <= 6 * MiB, "route map");
constexpr size_t WS_WINE = 6 * MiB, WS_WUQ = 14 * MiB, WS_WUKV = 17 * MiB, WS_WOUTE = 18 * MiB, WS_WINO = 22 * MiB, WS_WOUTO = 34 * MiB;
constexpr size_t WS_W1 = 38 * MiB, WS_W2 = 550 * MiB;
constexpr size_t WS_XLC = 806 * MiB, WS_HB = 938 * MiB, WS_PB = 1004 * MiB, WS_QB = 1202 * MiB, WS_KVB = 1252 * MiB, WS_AO = 1318 * MiB;
constexpr size_t WS_XG = 1384 * MiB, WS_HA = 1664 * MiB, WS_RWT = 1944 * MiB, WS_LOGIT = 1952 * MiB, WS_END = 1960 * MiB;
constexpr size_t WS_LOGIT12 = WS_XG + 160 * MiB;
constexpr int H3_LD = 3072;
constexpr int CW_BAR = 4096;

constexpr int ARENA_BYTES = 131072;
constexpr int LDSCTL_OFF = ARENA_BYTES;
constexpr int LDS_BYTES = 147456;

__device__ __forceinline__ unsigned f2bf(float f) { unsigned u = __builtin_bit_cast(unsigned, f); return (u + 0x7fffu + ((u >> 16) & 1u)) >> 16; }
__device__ __forceinline__ unsigned pk2(float lo, float hi) { return f2bf(lo) | (f2bf(hi) << 16); }
__device__ __forceinline__ f32x4 xun4(u32x2 w) { return (f32x4){__builtin_bit_cast(float, w.x << 16), __builtin_bit_cast(float, w.x & 0xffff0000u), __builtin_bit_cast(float, w.y << 16), __builtin_bit_cast(float, w.y & 0xffff0000u)}; }
__device__ __forceinline__ u32x2 xpk4(f32x4 v) { return (u32x2){pk2(v.x, v.y), pk2(v.z, v.w)}; }
__device__ __forceinline__ float bflo(unsigned w) { return __builtin_bit_cast(float, w << 16); }
__device__ __forceinline__ float bfhi(unsigned w) { return __builtin_bit_cast(float, w & 0xffff0000u); }
__device__ __forceinline__ float wave_sum(float v) {
#pragma unroll
    for (int o = 1; o < 64; o <<= 1) v += __shfl_xor(v, o);
    return v;
}
#define LDS_WAIT() asm volatile("s_waitcnt lgkmcnt(0)" ::: "memory")
__device__ __forceinline__ unsigned cvt4_fp8(float a, float b, float c, float d) { unsigned w = 0u; w = __builtin_amdgcn_cvt_pk_fp8_f32(a, b, w, false); w = __builtin_amdgcn_cvt_pk_fp8_f32(c, d, w, true); return w; }
__device__ __forceinline__ void swap16(unsigned& a, unsigned& b) { asm volatile("s_nop 1\n\tv_permlane16_swap_b32 %0, %1\n\ts_nop 1" : "+v"(a), "+v"(b)); }
constexpr float YS_SCALE = 16.0f;
constexpr float W8_SCALE = 32.0f;
__device__ __forceinline__ int opaque_tid() { int t = threadIdx.x; asm volatile("" : "+v"(t)); return t; }

#define XB_TMO      128
#define XB_XCNT(j)  (256  + 64 * (j))
#define XB_XSUB(j)  (1280 + 64 * (j))
#define XB_XGEN(j)  (2304 + 64 * (j))
#define XB_TOP      3328
#define XB_TOPGEN   3392
#define XCD_BAR_WORDS 3456
#define XB_SPIN_CAP (1u << 18)

__device__ __forceinline__ unsigned xb_ld(unsigned* p)              { return __hip_atomic_load(p, __ATOMIC_RELAXED, __HIP_MEMORY_SCOPE_AGENT); }
__device__ __forceinline__ unsigned xb_add(unsigned* p, unsigned v) { return __hip_atomic_fetch_add(p, v, __ATOMIC_RELAXED, __HIP_MEMORY_SCOPE_AGENT); }
__device__ __forceinline__ unsigned xb_xcc_id() { return (unsigned)__builtin_amdgcn_s_getreg((3 << 11) | 20) & 0xFu; }
#define XB_SPIN(cond, bar) do { unsigned _sp = 0; while (cond) { __builtin_amdgcn_s_sleep(1); \
    if ((++_sp & 255u) == 0u) { if (xb_ld(&(bar)[XB_TMO])) break; if (_sp > XB_SPIN_CAP) { atomicAdd(&(bar)[XB_TMO], 1u); break; } } } } while (0)

struct XcdBarrier { unsigned* bar; unsigned x; volatile LAS unsigned* st; };

__device__ __forceinline__ XcdBarrier xcd_barrier_post(unsigned* bar, volatile LAS unsigned* st) {
    XcdBarrier b; b.bar = bar; b.x = xb_xcc_id(); b.st = st;
    if (threadIdx.x == 0) (void)xb_add(&bar[XB_XCNT(b.x)], 1u);
    return b;
}
__device__ __forceinline__ void xcd_barrier_complete(unsigned* bar, unsigned x, unsigned& nloc, unsigned& nx) {
    const unsigned G = gridDim.x * gridDim.y * gridDim.z;
    unsigned sum, cnt, mine, sp = 0u;
    for (;;) {
        sum = 0u; cnt = 0u; mine = 0u;
#pragma unroll
        for (unsigned j = 0; j < 16; ++j) { const unsigned c = xb_ld(&bar[XB_XCNT(j)]); sum += c; cnt += (c > 0u) ? 1u : 0u; mine = (j == x) ? c : mine; }
        if (sum == G) break;
        __builtin_amdgcn_s_sleep(1);
        if ((++sp & 255u) == 0u) { if (xb_ld(&bar[XB_TMO])) break; if (sp > XB_SPIN_CAP) { atomicAdd(&bar[XB_TMO], 1u); break; } }
    }
    nloc = mine > 0u ? mine : 1u; nx = cnt > 0u ? cnt : 1u;
}
__device__ __forceinline__ void xcd_barrier(const XcdBarrier& b) {
    asm volatile("s_waitcnt vmcnt(0)" ::: "memory");
    __syncthreads();
    if (threadIdx.x == 0) {
        unsigned* bar = b.bar;
        __builtin_amdgcn_s_waitcnt(0);
        unsigned nloc = b.st[0], nx = b.st[1];
        if (nloc == 0u) { xcd_barrier_complete(bar, b.x, nloc, nx); b.st[0] = nloc; b.st[1] = nx; }
        const unsigned old = xb_add(&bar[XB_XSUB(b.x)], 1u);
        const unsigned gen = old / nloc;
        if (old + 1u == (gen + 1u) * nloc) {
            __builtin_amdgcn_fence(__ATOMIC_RELEASE, "agent");
            asm volatile("s_waitcnt vmcnt(0)" ::: "memory");
            const unsigned og = xb_add(&bar[XB_TOP], 1u);
            const unsigned tg = og / nx;
            if (og + 1u == (tg + 1u) * nx) xb_add(&bar[XB_TOPGEN], 1u);
            else XB_SPIN(xb_ld(&bar[XB_TOPGEN]) == tg, bar);
            __builtin_amdgcn_fence(__ATOMIC_ACQUIRE, "agent");
            xb_add(&bar[XB_XGEN(b.x)], 1u);
            asm volatile("s_waitcnt vmcnt(0)" ::: "memory");
        } else {
            XB_SPIN(xb_ld(&bar[XB_XGEN(b.x)]) == gen, bar);
            __builtin_amdgcn_fence(__ATOMIC_ACQUIRE, "agent");
            asm volatile("s_waitcnt vmcnt(0)" ::: "memory");
        }
    }
    __syncthreads();
}

namespace pg8 {
constexpr int BM = 256, BK = 64, HALF = 128, HTB = HALF * BK * 2, STAGE_BYTES = 8 * HTB, NXCD = 8, WGM = 8;
__host__ __device__ __forceinline__ int lds_byte(int r, int c) { const int st = (r >> 4) * 2 + (c >> 5), rr = r & 15, cc = c & 31, ob = rr * 64 + cc * 2; return st * 1024 + (ob ^ (((ob >> 9) & 1) << 5)); }
__host__ __device__ __forceinline__ void stage_rc(int b, int& R, int& C) { const int st = b / 1024, sb = b % 1024, swz = sb ^ (((sb >> 9) & 1) << 5); R = (st >> 1) * 16 + swz / 64; C = (st & 1) * 32 + (swz % 64) / 2; }
__host__ __device__ __forceinline__ int perm32(int rho) { const int n = rho >> 4, i = rho & 15; return 8 * (i >> 2) + 4 * n + (i & 3); }

typedef int v4i_t __attribute__((ext_vector_type(4)));
typedef int v8i_t __attribute__((ext_vector_type(8)));
struct Unit { unsigned a, b; int pm, pn, aux; };

struct DenseOrder {
    const char* A; const char* Bt; unsigned lda2, ldb2; int nM, nN, nwg, G, c;
    __device__ __forceinline__ const void* baseA() const { return A; }
    __device__ __forceinline__ const void* baseB() const { return Bt; }
    __device__ __forceinline__ const int* gather() const { return nullptr; }
    __device__ __forceinline__ void init(const void* A_, size_t lda_bytes, const void* Bt_, size_t ldb_bytes, int M, int N, int G_, int c_) { A = (const char*)A_; Bt = (const char*)Bt_; lda2 = (unsigned)lda_bytes; ldb2 = (unsigned)ldb_bytes; nM = M / BM; nN = N / BM; nwg = nM * nN; G = G_; c = c_; }
    __device__ __forceinline__ bool next(int i, Unit& u) const {
        const long L = (long)i * G + c; if (L >= nwg) return false;
        int wgid = (int)L; { const int q = nwg / NXCD, r = nwg % NXCD, xcd = wgid % NXCD, off = wgid / NXCD; wgid = (xcd < r ? xcd * (q + 1) : r * (q + 1) + (xcd - r) * q) + off; }
        const int nig = WGM * nN, gid = wgid / nig, fm = gid * WGM, gsz = (nM - fm) < WGM ? (nM - fm) : WGM;
        u.pm = fm + ((wgid % nig) % gsz); u.pn = (wgid % nig) / gsz; u.aux = 0;
        u.a = (unsigned)u.pm * BM * lda2; u.b = (unsigned)u.pn * BM * ldb2; return true;
    }
};
struct RouterOrder {
    const char* A; const char* Bt; unsigned lda2, ldb2; int nM, G, c;
    __device__ __forceinline__ const void* baseA() const { return A; }
    __device__ __forceinline__ const void* baseB() const { return Bt; }
    __device__ __forceinline__ const int* gather() const { return nullptr; }
    __device__ __forceinline__ bool next(int i, Unit& u) const {
        const int L = i * G + c; if (L >= nM * 3) return false;
        u.pm = L / 3; u.aux = L - 3 * u.pm; u.pn = 0;
        u.a = (unsigned)u.pm * BM * lda2 + (u.aux == 1 ? 2048u : 0u); u.b = (unsigned)u.aux * 2048u; return true;
    }
};
struct MoeOrder {
    const char* A; const char* W; const LAS int* tile_exp; const int* tokslot; unsigned lda2, ldb2, wstride; int ntiles, nN, G, c;
    __device__ __forceinline__ const void* baseA() const { return A; }
    __device__ __forceinline__ const void* baseB() const { return W; }
    __device__ __forceinline__ const int* gather() const { return tokslot; }
    __device__ __forceinline__ bool next(int i, Unit& u) const {
        const int tpr = G / nN, tpx = tpr >> 3, x = c & 7, j = c >> 3;
        int tile, pn;
        if ((G & 7) == 0 && tpx * 8 == tpr && tpx > 0) { tile = i * tpr + x * tpx + j / nN; pn = j % nN; }
        else { const long L = (long)i * G + c; tile = (int)(L / nN); pn = (int)(L % nN); }
        if (tile >= ntiles) return false;
        const int e = __builtin_amdgcn_readfirstlane(tile_exp[tile]);
        u.pm = tile; u.pn = pn; u.aux = e; u.a = (unsigned)tile * BM * lda2; u.b = (unsigned)e * wstride + (unsigned)pn * BM * ldb2; return true;
    }
};

__device__ __forceinline__ unsigned cvt_pk_bf16(float lo, float hi) { unsigned r; asm volatile("v_cvt_pk_bf16_f32 %0, %1, %2" : "=v"(r) : "v"(lo), "v"(hi)); return r; }

struct EpiBf16 {
    static constexpr bool PERM = true; static constexpr bool WIDE16 = false;
    bf16_t* O; int ldc; float sc;
    struct Pre {}; static constexpr bool HAS_BIAS = false;
    __device__ __forceinline__ void operator()(const f32x4 (&acc)[2][2][4][2], const Unit& u, int wr, int wc, int fr, int fq, const Pre& pre) const {
        const int row0 = u.pm * BM + wr * 64 + fr, col0 = u.pn * BM + wc * 32 + 8 * fq;
#pragma unroll
        for (int ai = 0; ai < 2; ++ai)
#pragma unroll
            for (int m = 0; m < 4; ++m) { bf16_t* rowp = O + (size_t)(row0 + ai * HALF + m * 16) * ldc + col0;
#pragma unroll
                for (int bj = 0; bj < 2; ++bj) { const f32x4 v0 = acc[ai][bj][m][0] * sc, v1 = acc[ai][bj][m][1] * sc;
                    u32x4 w; w.x = cvt_pk_bf16(v0[0], v0[1]); w.y = cvt_pk_bf16(v0[2], v0[3]); w.z = cvt_pk_bf16(v1[0], v1[1]); w.w = cvt_pk_bf16(v1[2], v1[3]);
                    *(u32x4*)(rowp + bj * HALF) = w; } }
    }
};
struct EpiResid {
    static constexpr bool PERM = true; static constexpr bool WIDE16 = false;
    bf16_t* X; const float* modl; float sc;
    struct Pre {}; static constexpr bool HAS_BIAS = false;
    __device__ __forceinline__ void operator()(const f32x4 (&acc)[2][2][4][2], const Unit& u, int wr, int wc, int fr, int fq, const Pre& pre) const {
        const int row0 = u.pm * BM + wr * 64 + fr, col0 = u.pn * BM + wc * 32 + 8 * fq;
        const int bidx = u.pm < 128 ? (u.pm >> 5) : 4;
        const float* gp = modl + (size_t)bidx * 6144 + col0;
        f32x4 gv[2][2];
#pragma unroll
        for (int bj = 0; bj < 2; ++bj)
#pragma unroll
            for (int n = 0; n < 2; ++n) gv[bj][n] = *(const f32x4*)(gp + bj * HALF + 4 * n) * sc;
        u32x4 xc[2], xn[2];
        { const bf16_t* rowp = X + (size_t)row0 * DM + col0; xc[0] = *(const u32x4*)rowp; xc[1] = *(const u32x4*)(rowp + HALF); xn[0] = xc[0]; xn[1] = xc[1]; }
#pragma unroll
        for (int g = 0; g < 8; ++g) { const int ai = g >> 2, m = g & 3;
            bf16_t* rowp = X + (size_t)(row0 + ai * HALF + m * 16) * DM + col0;
            if (g < 7) { const bf16_t* nrow = X + (size_t)(row0 + ((g + 1) >> 2) * HALF + ((g + 1) & 3) * 16) * DM + col0; xn[0] = *(const u32x4*)nrow; xn[1] = *(const u32x4*)(nrow + HALF); }
            asm volatile("" ::: "memory");
#pragma unroll
            for (int bj = 0; bj < 2; ++bj) { const u32x4 w = xc[bj];
                const f32x4 a = xun4((u32x2){w.x, w.y}) + gv[bj][0] * acc[ai][bj][m][0], b = xun4((u32x2){w.z, w.w}) + gv[bj][1] * acc[ai][bj][m][1];
                const u32x2 pa = xpk4(a), pb = xpk4(b);
                *(u32x4*)(rowp + bj * HALF) = (u32x4){pa.x, pa.y, pb.x, pb.y}; }
            asm volatile("" ::: "memory");
            xc[0] = xn[0]; xc[1] = xn[1]; }
    }
};
struct EpiLogits {
    static constexpr bool PERM = false; static constexpr bool WIDE16 = false;
    float* LG0; float* LG12; const float* rb;
    struct Pre {}; static constexpr bool HAS_BIAS = false;
    __device__ __forceinline__ void operator()(const f32x4 (&acc)[2][2][4][2], const Unit& u, int wr, int wc, int fr, int fq, const Pre& pre) const {
        if (wc != 0) return;
        const int row0 = u.pm * BM + wr * 64 + fr;
        float* LG = u.aux == 0 ? LG0 : LG12 + (size_t)(u.aux - 1) * TT * 32;
        const float bs = u.aux == 0 ? 1.0f : 0.0f;
        const f32x4 b0 = *(const f32x4*)(rb + 4 * fq) * bs, b1 = *(const f32x4*)(rb + 16 + 4 * fq) * bs;
#pragma unroll
        for (int ai = 0; ai < 2; ++ai)
#pragma unroll
            for (int m = 0; m < 4; ++m) { float* rowp = LG + (size_t)(row0 + ai * HALF + m * 16) * 32 + 4 * fq;
                *(f32x4*)rowp = acc[ai][0][m][0] + b0; *(f32x4*)(rowp + 16) = acc[ai][0][m][1] + b1; }
    }
};
struct EpiSwiglu {
    static constexpr bool PERM = true; static constexpr bool WIDE16 = false;
    unsigned char* O; const float* b1l;
    struct Pre { const LAS float* b; };
    static constexpr bool HAS_BIAS = true;
    __device__ __forceinline__ float bias_of(const Unit& u, int i) const { return b1l[(size_t)u.aux * 2048 + (i < 128 ? u.pn * HALF + i : 1024 + u.pn * HALF + (i - 128))]; }
    __device__ __forceinline__ void operator()(const f32x4 (&acc)[2][2][4][2], const Unit& u, int wr, int wc, int fr, int fq, const Pre& pre) const {
        const int row0 = u.pm * BM + wr * 64 + fr, cg = u.pn * HALF + wc * 32 + 8 * fq;
        f32x4 bg[2], bl[2];
#pragma unroll
        for (int n = 0; n < 2; ++n) { bg[n] = *(const LAS f32x4*)(pre.b + wc * 32 + 8 * fq + 4 * n); bl[n] = *(const LAS f32x4*)(pre.b + 128 + wc * 32 + 8 * fq + 4 * n) + 1.0f; }
#pragma unroll
        for (int ai = 0; ai < 2; ++ai)
#pragma unroll
            for (int mp = 0; mp < 2; ++mp) { unsigned wx[2], wy[2];
#pragma unroll
                for (int mm = 0; mm < 2; ++mm) { const int m = 2 * mp + mm; f32x4 r[2];
#pragma unroll
                    for (int n = 0; n < 2; ++n) { const f32x4 k4 = {1.0f / W8_SCALE, 1.0f / W8_SCALE, 1.0f / W8_SCALE, 1.0f / W8_SCALE};
                        f32x4 g = __builtin_elementwise_fma(acc[ai][0][m][n], k4, bg[n]), l = __builtin_elementwise_fma(acc[ai][1][m][n], k4, bl[n]);
#pragma unroll
                        for (int j = 0; j < 4; ++j) { g[j] = fminf(g[j], 7.0f); l[j] = fminf(fmaxf(l[j], -6.0f), 8.0f); }
                        f32x4 t = g * (-1.702f * LOG2E);
#pragma unroll
                        for (int j = 0; j < 4; ++j) t[j] = __builtin_amdgcn_exp2f(t[j]);
                        t = t + 1.0f;
#pragma unroll
                        for (int j = 0; j < 4; ++j) t[j] = __builtin_amdgcn_rcpf(t[j]);
                        r[n] = (g * t) * l; }
                    wx[mm] = cvt4_fp8(r[0][0], r[0][1], r[0][2], r[0][3]); wy[mm] = cvt4_fp8(r[1][0], r[1][1], r[1][2], r[1][3]); }
                swap16(wx[0], wx[1]); swap16(wy[0], wy[1]);
                unsigned char* rowp = O + (size_t)(row0 + ai * HALF + (2 * mp + (fq & 1)) * 16) * DEXP + (cg - 8 * (fq & 1));
                *(u32x4*)rowp = (u32x4){wx[0], wy[0], wx[1], wy[1]}; }
    }
};
struct EpiGate {
    static constexpr bool PERM = true; static constexpr bool WIDE16 = true;
    unsigned char* O; const float* b2l;
    struct Pre { const LAS float* b; };
    static constexpr bool HAS_BIAS = true;
    __device__ __forceinline__ float bias_of(const Unit& u, int i) const { return b2l[(size_t)u.aux * 1024 + u.pn * BM + i]; }
    __device__ __forceinline__ void operator()(const f32x4 (&acc)[2][2][4][2], const Unit& u, int wr, int wc, int fr, int fq, const Pre& pre) const {
        const int row0 = u.pm * BM + wr * 64 + fr, col0 = u.pn * BM + wc * 64 + 16 * fq;
        f32x4 bv[2][2];
#pragma unroll
        for (int bj = 0; bj < 2; ++bj)
#pragma unroll
            for (int n = 0; n < 2; ++n) bv[bj][n] = *(const LAS f32x4*)(pre.b + wc * 64 + 16 * fq + 8 * bj + 4 * n) * YS_SCALE;
#pragma unroll
        for (int ai = 0; ai < 2; ++ai)
#pragma unroll
            for (int m = 0; m < 4; ++m) { unsigned char* rowp = O + (size_t)(col0 >> 6) * ((size_t)MAXSLOT * 64) + (size_t)(row0 + ai * HALF + m * 16) * 64 + (col0 & 63);
                u32x4 w;
                { const f32x4 v = acc[ai][0][m][0] * (YS_SCALE / W8_SCALE) + bv[0][0]; w.x = cvt4_fp8(v[0], v[1], v[2], v[3]); }
                { const f32x4 v = acc[ai][0][m][1] * (YS_SCALE / W8_SCALE) + bv[0][1]; w.y = cvt4_fp8(v[0], v[1], v[2], v[3]); }
                { const f32x4 v = acc[ai][1][m][0] * (YS_SCALE / W8_SCALE) + bv[1][0]; w.z = cvt4_fp8(v[0], v[1], v[2], v[3]); }
                { const f32x4 v = acc[ai][1][m][1] * (YS_SCALE / W8_SCALE) + bv[1][1]; w.w = cvt4_fp8(v[0], v[1], v[2], v[3]); }
                *(u32x4*)rowp = w; }
    }
};

template <class Epi, class Sched, bool FP8 = false, bool GATHER = false>
__device__ __forceinline__ void gemm_phase(LAS unsigned char* lds, const int K, const size_t lda2, const size_t ldb2, const Sched& S, const Epi& E) {
    const int tid = opaque_tid(), wid = __builtin_amdgcn_readfirstlane(tid >> 6), lane = tid & 63, wr = wid >> 2, wc = wid & 3, fr = lane & 15, fq = lane >> 4;
    int nt = K / BK; asm volatile("" : "+s"(nt));
    unsigned voffA[2], voffB[2];
#pragma unroll
    for (int i = 0; i < 2; ++i) { int R, C; stage_rc(tid * 16 + i * 8192, R, C); int Rb = Epi::PERM ? ((R & ~31) + perm32(R & 31)) : R;
        if constexpr (Epi::WIDE16) Rb = (Rb >> 5) * 64 + ((Rb >> 3) & 3) * 16 + (Rb & 7);
        voffA[i] = (unsigned)(R * (unsigned)lda2 + C * 2u); voffB[i] = (unsigned)(Rb * (unsigned)ldb2 + C * 2u); }
    const unsigned kstep = (unsigned)(BK * 2);
    const unsigned hstepA = (unsigned)(HALF * lda2), hstepB = (unsigned)((Epi::WIDE16 ? 8 : HALF) * ldb2);
    const unsigned ldsw = (unsigned)wid * 1024u;
    const int aoff = lds_byte(wr * 64 + fr, fq * 8), boff = lds_byte(wc * 32 + fr, fq * 8);
    const __amdgpu_buffer_rsrc_t rsA = __builtin_amdgcn_make_buffer_rsrc((void*)S.baseA(), 0, 0x7fffffff, 0x00020000);
    const __amdgpu_buffer_rsrc_t rsB = __builtin_amdgcn_make_buffer_rsrc((void*)S.baseB(), 0, 0x7fffffff, 0x00020000);
#define PG8_SA(b, h) (((b) * 2 + (h)) * HTB)
#define PG8_SB(b, h) ((4 + (b) * 2 + (h)) * HTB)
#define PG8_STAGE(bufoff, rs, soff, voff) do { _Pragma("unroll") for (int _i = 0; _i < 2; ++_i) \
        __builtin_amdgcn_raw_ptr_buffer_load_lds(rs, (LAS unsigned*)(lds + (bufoff) + ldsw + _i * 8192), 16, (voff)[_i], (soff), 0, 0); } while (0)
#define PG8_STAGEA(b, h, aoffs, koff, nx) do { if constexpr (GATHER) { _Pragma("unroll") for (int _i = 0; _i < 2; ++_i) \
            __builtin_amdgcn_raw_ptr_buffer_load_lds(rsA, (LAS unsigned*)(lds + PG8_SA(b, h) + ldsw + _i * 8192), 16, (nx) ? ngvo[h][_i] : gvo[h][_i], (koff), 0, 0); } \
        else PG8_STAGE(PG8_SA(b, h), rsA, (aoffs) + (h) * hstepA, voffA); } while (0)
#define PG8_RD8(off) __builtin_shufflevector(*(const LAS v4i_t*)(lds + (off)), *(const LAS v4i_t*)(lds + (off) + 1024), 0, 1, 2, 3, 4, 5, 6, 7)
#define PG8_LDA(dst, b, h) do { if constexpr (FP8) { _Pragma("unroll") for (int m = 0; m < 4; ++m) dst##8[m] = PG8_RD8(PG8_SA(b, h) + aoff + m * 2048); } \
        else { _Pragma("unroll") for (int m = 0; m < 4; ++m) _Pragma("unroll") for (int k = 0; k < 2; ++k) dst[m][k] = *(const LAS bf16x8*)(lds + PG8_SA(b, h) + aoff + m * 2048 + k * 1024); } } while (0)
#define PG8_LDB(dst, b, h) do { if constexpr (FP8) { _Pragma("unroll") for (int n = 0; n < 2; ++n) dst##8[n] = PG8_RD8(PG8_SB(b, h) + boff + n * 2048); } \
        else { _Pragma("unroll") for (int n = 0; n < 2; ++n) _Pragma("unroll") for (int k = 0; k < 2; ++k) dst[n][k] = *(const LAS bf16x8*)(lds + PG8_SB(b, h) + boff + n * 2048 + k * 1024); } } while (0)
#define PG8_MMA(ai, bj, At, Bt, Z) do { __builtin_amdgcn_s_setprio(1); \
        if (Z) { _Pragma("unroll") for (int m = 0; m < 4; ++m) _Pragma("unroll") for (int n = 0; n < 2; ++n) { \
            if constexpr (FP8) asm volatile("s_nop 1\n\tv_mfma_scale_f32_16x16x128_f8f6f4 %0, %1, %2, 0, %3, %3 op_sel_hi:[0,0,0]" : "=&v"(acc[ai][bj][m][n]) : "v"(Bt##8[n]), "v"(At##8[m]), "v"(sc1)); \
            else { acc[ai][bj][m][n] = __builtin_amdgcn_mfma_f32_16x16x32_bf16(Bt[n][0], At[m][0], (f32x4){0.f, 0.f, 0.f, 0.f}, 0, 0, 0); \
                   acc[ai][bj][m][n] = __builtin_amdgcn_mfma_f32_16x16x32_bf16(Bt[n][1], At[m][1], acc[ai][bj][m][n], 0, 0, 0); } } } \
        else { _Pragma("unroll") for (int m = 0; m < 4; ++m) _Pragma("unroll") for (int n = 0; n < 2; ++n) { \
            if constexpr (FP8) asm volatile("s_nop 1\n\tv_mfma_scale_f32_16x16x128_f8f6f4 %0, %1, %2, %0, %3, %3 op_sel_hi:[0,0,0]" : "+v"(acc[ai][bj][m][n]) : "v"(Bt##8[n]), "v"(At##8[m]), "v"(sc1)); \
            else { _Pragma("unroll") for (int k = 0; k < 2; ++k) acc[ai][bj][m][n] = __builtin_amdgcn_mfma_f32_16x16x32_bf16(Bt[n][k], At[m][k], acc[ai][bj][m][n], 0, 0, 0); } } } \
        __builtin_amdgcn_s_setprio(0); } while (0)
#define PG8_WAIT_V(n) asm volatile("s_waitcnt vmcnt(" #n ")" ::: "memory")
#define PG8_WAIT_L(n) asm volatile("s_waitcnt lgkmcnt(" #n ")" ::: "memory")
#define PG8_BAR __builtin_amdgcn_s_barrier()
#define PG8_SCHED __builtin_amdgcn_sched_barrier(0)
    Unit cur, nxt; int ui = 0; typename Epi::Pre pre;
    if (!S.next(0, cur)) return;
    f32x4 acc[2][2][4][2];
#pragma unroll
    for (int a = 0; a < 2; ++a)
#pragma unroll
        for (int b = 0; b < 2; ++b)
#pragma unroll
            for (int m = 0; m < 4; ++m)
#pragma unroll
                for (int n = 0; n < 2; ++n) acc[a][b][m][n] = (f32x4){0.f, 0.f, 0.f, 0.f};
    bf16x8 At[4][2], B0[2][2], B1[2][2];
    v8i_t At8[4], B08[2], B18[2];
    int sc1 = 0x7f7f7f7f; asm volatile("" : "+v"(sc1));
    unsigned cA = cur.a, cB = cur.b;
    unsigned gvo[2][2] = {{0u, 0u}, {0u, 0u}}, ngvo[2][2] = {{0u, 0u}, {0u, 0u}};
    int gR[2], gC[2];
#pragma unroll
    for (int i = 0; i < 2; ++i) stage_rc(tid * 16 + i * 8192, gR[i], gC[i]);
#define PG8_GLOAD(dst, pm_) do { if constexpr (GATHER) { const int* tb_ = S.gather() + (pm_) * BM; \
        _Pragma("unroll") for (int h_ = 0; h_ < 2; ++h_) _Pragma("unroll") for (int i_ = 0; i_ < 2; ++i_) dst[h_][i_] = (unsigned)tb_[h_ * HALF + gR[i_]] * (unsigned)lda2 + (unsigned)gC[i_] * 2u; } } while (0)
    PG8_GLOAD(gvo, cur.pm);
    PG8_STAGE(PG8_SB(0, 0), rsB, cB, voffB); PG8_STAGE(PG8_SB(0, 1), rsB, cB + hstepB, voffB); PG8_STAGEA(0, 0, cA, 0u, false); PG8_STAGEA(0, 1, cA, 0u, false);
    if (wr == 1) PG8_BAR;
    PG8_WAIT_V(2); PG8_BAR;
    PG8_STAGE(PG8_SB(1, 0), rsB, cB + kstep, voffB); PG8_STAGEA(1, 0, cA + kstep, kstep, false); PG8_STAGE(PG8_SB(1, 1), rsB, cB + hstepB + kstep, voffB);
    PG8_WAIT_V(6); PG8_BAR;
    for (;;) {
        const bool has_next = S.next(ui + 1, nxt);
        const unsigned nA = has_next ? nxt.a : cA, nB = has_next ? nxt.b : cB;
        LAS int* gl = (LAS int*)(lds + LDSCTL_OFF + 8192) + (ui & 1) * 256;
        for (int t = 0; t < nt; t += 2) {
            const bool last = (t == nt - 2), z0 = (t == 0);
            int gstage = 0;
            if constexpr (GATHER) {
                if (t == 0 && has_next) { int tz = threadIdx.x; asm volatile("" : "+v"(tz)); gstage = S.gather()[nxt.pm * BM + (tz & 255)]; }
                if (last) { if (has_next) { _Pragma("unroll") for (int h_ = 0; h_ < 2; ++h_) _Pragma("unroll") for (int i_ = 0; i_ < 2; ++i_) ngvo[h_][i_] = (unsigned)gl[h_ * HALF + gR[i_]] * (unsigned)lda2 + (unsigned)gC[i_] * 2u; }
                            else { _Pragma("unroll") for (int h_ = 0; h_ < 2; ++h_) _Pragma("unroll") for (int i_ = 0; i_ < 2; ++i_) ngvo[h_][i_] = gvo[h_][i_]; } } }
            float bstage = 0.f;
            if constexpr (Epi::HAS_BIAS) { if (last) { int tz = threadIdx.x; asm volatile("" : "+v"(tz)); bstage = E.bias_of(cur, tz & 255); } }
            const unsigned a1 = cA + (unsigned)(t + 1) * kstep, k1 = (unsigned)(t + 1) * kstep;
            const unsigned a2 = last ? nA : cA + (unsigned)(t + 2) * kstep, b2 = last ? nB : cB + (unsigned)(t + 2) * kstep, k2 = last ? 0u : (unsigned)(t + 2) * kstep;
            const unsigned a3 = a2 + kstep, b3 = b2 + kstep, k3 = k2 + kstep;
            PG8_LDB(B0, 0, 0); PG8_LDB(B1, 0, 1); PG8_SCHED; PG8_LDA(At, 0, 0); PG8_STAGEA(1, 1, a1, k1, false);
            PG8_WAIT_V(8); PG8_WAIT_L(0); PG8_BAR; PG8_MMA(0, 0, At, B0, z0); PG8_MMA(0, 1, At, B1, z0); PG8_BAR; PG8_SCHED;
            PG8_LDA(At, 0, 1); PG8_STAGE(PG8_SB(0, 0), rsB, b2, voffB); PG8_STAGE(PG8_SB(0, 1), rsB, b2 + hstepB, voffB); PG8_STAGEA(0, 0, a2, k2, last);
            PG8_WAIT_V(8); PG8_WAIT_L(0); PG8_BAR; PG8_MMA(1, 0, At, B0, z0); PG8_MMA(1, 1, At, B1, z0); PG8_BAR; PG8_SCHED;
            if constexpr (Epi::HAS_BIAS) { if (last) { int tz = threadIdx.x; asm volatile("" : "+v"(tz)); if (tz < 256) ((LAS float*)(lds + LDSCTL_OFF + 2048 + (ui & 1) * 1024))[tz] = bstage; } }
            PG8_LDB(B0, 1, 0); PG8_LDB(B1, 1, 1); PG8_SCHED; PG8_LDA(At, 1, 0); PG8_STAGEA(0, 1, a2, k2, last);
            PG8_WAIT_V(8); PG8_WAIT_L(0); PG8_BAR; PG8_MMA(0, 0, At, B0, false); PG8_MMA(0, 1, At, B1, false); PG8_BAR; PG8_SCHED;
            PG8_LDA(At, 1, 1); PG8_STAGE(PG8_SB(1, 0), rsB, b3, voffB); PG8_STAGE(PG8_SB(1, 1), rsB, b3 + hstepB, voffB); PG8_STAGEA(1, 0, a3, k3, last);
            PG8_WAIT_V(8); PG8_WAIT_L(0); PG8_BAR; PG8_MMA(1, 0, At, B0, false); PG8_MMA(1, 1, At, B1, false); PG8_BAR; PG8_SCHED;
            if constexpr (GATHER) { if (t == 0 && has_next) { int tz = threadIdx.x; asm volatile("" : "+v"(tz)); if (tz < 256) gl[tz] = gstage; } }
        }
        if constexpr (FP8) asm volatile("s_nop 15\n\ts_nop 7" ::: "memory");
        if (wr == 0) PG8_BAR;
        { int tz = threadIdx.x; asm volatile("" : "+v"(tz)); const int ln = tz & 63;
          if constexpr (Epi::HAS_BIAS) pre.b = (const LAS float*)(lds + LDSCTL_OFF + 2048 + (ui & 1) * 1024);
          E(acc, cur, wr, wc, ln & 15, ln >> 4, pre); }
        if (!has_next) break;
        cur = nxt; cA = nA; cB = nB; ++ui;
        if constexpr (GATHER) { _Pragma("unroll") for (int h_ = 0; h_ < 2; ++h_) _Pragma("unroll") for (int i_ = 0; i_ < 2; ++i_) gvo[h_][i_] = ngvo[h_][i_]; }
        if (wr == 1) PG8_BAR;
    }
    PG8_WAIT_V(0);
    PG8_BAR;
#undef PG8_SA
#undef PG8_SB
#undef PG8_STAGE
#undef PG8_STAGEA
#undef PG8_GLOAD
#undef PG8_LDA
#undef PG8_LDB
#undef PG8_MMA
#undef PG8_RD8
#undef PG8_WAIT_V
#undef PG8_WAIT_L
#undef PG8_BAR
#undef PG8_SCHED
}
}

__device__ __forceinline__ u32x4 rope_chunk(u32x4 xw, u32x4 yw, const f32x2* tab, bool first) {
    u32x4 o;
#pragma unroll
    for (int i = 0; i < 4; ++i) {
        const f32x2 cs0 = tab[2 * i], cs1 = tab[2 * i + 1];
        const float x0 = bflo(xw[i]), x1 = bfhi(xw[i]), y0 = bflo(yw[i]), y1 = bfhi(yw[i]);
        const float r0 = first ? x0 * cs0.x - y0 * cs0.y : x0 * cs0.x + y0 * cs0.y;
        const float r1 = first ? x1 * cs1.x - y1 * cs1.y : x1 * cs1.x + y1 * cs1.y;
        o[i] = pk2(r0, r1);
    }
    return o;
}

namespace att {
constexpr int KCS = 1040;
constexpr int KSLOT = 12544, VSLOT = 8192;
constexpr int OFF_K = 0, OFF_V = 4 * KSLOT, OFF_WSF = OFF_V + 4 * VSLOT, OFF_OST = OFF_WSF + 2048, OFF_BIAS = OFF_OST + 32768, ATT_LDS = OFF_BIAS + 2048;
static_assert(ATT_LDS <= ARENA_BYTES, "attention LDS map");
__device__ __forceinline__ int crow(int r, int hi) { return (r & 3) + 8 * (r >> 2) + 4 * hi; }
__device__ __forceinline__ unsigned cvtpk(float lo, float hi) { typedef __bf16 bf16x2_t __attribute__((ext_vector_type(2))); f32x2 v = {lo, hi}; bf16x2_t b = __builtin_convertvector(v, bf16x2_t); return __builtin_bit_cast(unsigned, b); }
__device__ __forceinline__ s16x4 vtr(const LAS unsigned char* p) { return __builtin_bit_cast(s16x4, __builtin_amdgcn_ds_read_tr16_b64_v4i16((LAS s16x4*)p)); }
constexpr float NEGBIG = -1e30f;
__device__ __forceinline__ void pair32(float x, float& a, float& b) {
    unsigned u = __builtin_bit_cast(unsigned, x), v = u;
    asm volatile("s_nop 1\n\tv_permlane32_swap_b32 %0, %1\n\ts_nop 1" : "+v"(u), "+v"(v));
    a = __builtin_bit_cast(float, u); b = __builtin_bit_cast(float, v);
}

__device__ __forceinline__ unsigned xlane32(unsigned x, bool lo) {
    unsigned u = x, v = x;
    asm volatile("s_nop 1\n\tv_permlane32_swap_b32 %0, %1\n\ts_nop 1" : "+v"(u), "+v"(v));
    return lo ? v : u;
}
struct UMla {
    static constexpr int NKC = 12; static constexpr bool PLAIN = true; static constexpr bool SIDED = false;
    const bf16_t* QB; const bf16_t* KVB; const bf16_t* PB; bf16_t* AO; const f32x2* R32; int b, h, qblk; bool ctxq;
    template <int NKS> __device__ __forceinline__ void qfix(bf16x8 (&qr)[NKS], int wid, int r32, int hi) const {
        if (ctxq) return;
        const int t = 256 * qblk + 32 * wid + r32, prow = t >> 6, pcol = t & 63;
#pragma unroll
        for (int f = 0; f < 2; ++f) { const u32x4 own = __builtin_bit_cast(u32x4, qr[4 + f]); u32x4 oth;
            oth.x = xlane32(own.x, hi == 0); oth.y = xlane32(own.y, hi == 0); oth.z = xlane32(own.z, hi == 0); oth.w = xlane32(own.w, hi == 0);
            qr[4 + f] = __builtin_bit_cast(bf16x8, rope_chunk(own, oth, R32 + (f == 0 ? prow : pcol) * 8, hi == 0)); }
    }
    __device__ __forceinline__ float c2() const { return 0.10206207261596577f * LOG2E; }
    __device__ __forceinline__ int ntiles() const { return ctxq ? 4 : 132; }
    __device__ __forceinline__ bool active(int, int) const { return true; }
    __device__ __forceinline__ size_t krow(int t, int key) const { return ctxq ? (size_t)(TL + b * CTXL + 64 * t + key) : (t < 128 ? (size_t)(b * SEQ + 64 * t + key) : (size_t)(TL + b * CTXL + 64 * (t - 128) + key)); }
    __device__ __forceinline__ unsigned kofs() const { return (unsigned)WS_KVB + 256u * h; }  __device__ __forceinline__ unsigned kpitch() const { return 2048u; }
    __device__ __forceinline__ unsigned k2ofs() const { return (unsigned)WS_PB + 3584u; }     __device__ __forceinline__ unsigned k2pitch() const { return 2u * EV_LD; }
    __device__ __forceinline__ unsigned vofs() const { return (unsigned)WS_KVB + 256u * h + 128u; } __device__ __forceinline__ unsigned vpitch() const { return 2048u; }
    __device__ __forceinline__ unsigned trow(int t) const { return (unsigned)krow(t, 0); }
    __device__ __forceinline__ size_t qrow(int wid, int r) const { return ctxq ? (size_t)(TL + b * CTXL + 32 * wid + r) : (size_t)(b * SEQ + 256 * qblk + 32 * wid + r); }
    __device__ __forceinline__ const bf16_t* qptr(int wid, int r) const { return QB + qrow(wid, r) * 768 + 96 * h; }
    __device__ __forceinline__ unsigned char* optr(int wid, int r) const { return (unsigned char*)AO + qrow(wid, r) * 1024 + 512 + 64 * h; }
    __device__ __forceinline__ float m0(int) const { return NEGBIG; }
    __device__ __forceinline__ float l0() const { return 0.f; }
    __device__ __forceinline__ void prep(LAS unsigned char*) const {}
    __device__ __forceinline__ float adjust(int, int, int, int, float s, const LAS unsigned char*) const { return s; }
};
struct UWin {
    static constexpr int NKC = 8; static constexpr bool PLAIN = false; static constexpr bool SIDED = false;
    const bf16_t* PB; bf16_t* AO; const float* sink; int b, kvh, j; bool ctxq; int tlo, nlat;
    template <int NKS> __device__ __forceinline__ void qfix(bf16x8 (&)[NKS], int, int, int) const {}
    __device__ __forceinline__ void init() { tlo = j - 2 < 0 ? 0 : j - 2; const int thi = j + 2 > 127 ? 127 : j + 2; nlat = ctxq ? 0 : thi - tlo + 1; }
    __device__ __forceinline__ float c2() const { return 0.125f * LOG2E; }
    __device__ __forceinline__ int ntiles() const { return nlat + 4; }
    __device__ __forceinline__ bool active(int, int) const { return true; }
    __device__ __forceinline__ size_t krow(int t, int key) const { return t < nlat ? (size_t)(b * SEQ + 64 * (tlo + t) + key) : (size_t)(TL + b * CTXL + 64 * (t - nlat) + key); }
    __device__ __forceinline__ unsigned kofs() const { return (unsigned)WS_PB + 2u * (512 + 64 * kvh); }  __device__ __forceinline__ unsigned kpitch() const { return 2u * EV_LD; }
    __device__ __forceinline__ unsigned k2ofs() const { return 0u; }  __device__ __forceinline__ unsigned k2pitch() const { return 0u; }
    __device__ __forceinline__ unsigned vofs() const { return (unsigned)WS_PB + 2u * (640 + 64 * kvh); }  __device__ __forceinline__ unsigned vpitch() const { return 2u * EV_LD; }
    __device__ __forceinline__ unsigned trow(int t) const { return (unsigned)krow(t, 0); }
    __device__ __forceinline__ int qpos(int wid, int r) const { return 64 * j + 32 * (wid >> 2) + r; }
    __device__ __forceinline__ size_t qrow(int wid, int r) const { return ctxq ? (size_t)(TL + b * CTXL + qpos(wid, r)) : (size_t)(b * SEQ + qpos(wid, r)); }
    __device__ __forceinline__ const bf16_t* qptr(int wid, int r) const { return PB + qrow(wid, r) * EV_LD + 64 * (4 * kvh + (wid & 3)); }
    __device__ __forceinline__ unsigned char* optr(int wid, int r) const { return (unsigned char*)AO + qrow(wid, r) * 1024 + 64 * (4 * kvh + (wid & 3)); }
    __device__ __forceinline__ float m0(int wid) const { return sink[4 * kvh + (wid & 3)] * LOG2E; }
    __device__ __forceinline__ float l0() const { return 1.f; }
    __device__ __forceinline__ void prep(LAS unsigned char*) const {}
    __device__ __forceinline__ void adjust_tile(f32x16& P0, f32x16& P1, int t, int wid, int r32, int hi, float c2, const LAS unsigned char*, int) const {
        if (t >= nlat) {
#pragma unroll
            for (int r = 0; r < 16; ++r) { P0[r] *= c2; P1[r] *= c2; }
        } else { const int dq = qpos(wid, r32) - 64 * (tlo + t) - 4 * hi + 128;
#pragma unroll
            for (int r = 0; r < 16; ++r) { const int k0 = (r & 3) + 8 * (r >> 2);
                P0[r] = ((unsigned)(dq - k0) <= 256u) ? P0[r] * c2 : NEGBIG; P1[r] = ((unsigned)(dq - k0 - 32) <= 256u) ? P1[r] * c2 : NEGBIG; } }
    }
};
struct UNa {
    static constexpr int NKC = 8; static constexpr bool PLAIN = false; static constexpr bool SIDED = true;
    const bf16_t* PB; bf16_t* AO; const float* rpbh; int b, h, G; bool ctxq; int rlo, nlat;
    template <int NKS> __device__ __forceinline__ void qfix(bf16x8 (&)[NKS], int, int, int) const {}
    __device__ __forceinline__ void init() { int lo = 4 * G - 4; lo = lo < 0 ? 0 : (lo > 120 ? 120 : lo); int hi = 4 * G - 1; hi = hi < 0 ? 0 : (hi > 120 ? 120 : hi); rlo = lo; nlat = ctxq ? 0 : hi + 8 - lo; }
    __device__ __forceinline__ float c2() const { return 0.125f * LOG2E; }
    __device__ __forceinline__ int ntiles() const { return nlat + 4; }
    __device__ __forceinline__ int qgrow(int wid) const { return 4 * G + (wid >> 1); }
    __device__ __forceinline__ int r0w(int wid) const { int r0 = qgrow(wid) - 4; return r0 < 0 ? 0 : (r0 > 120 ? 120 : r0); }
    __device__ __forceinline__ bool active(int t, int wid) const { if (t >= nlat) return true; const int kr = rlo + t, r0 = r0w(wid); return kr >= r0 && kr < r0 + 8; }
    __device__ __forceinline__ size_t krow(int t, int key) const { return t < nlat ? (size_t)(b * SEQ + 64 * (rlo + t) + key) : (size_t)(TL + b * CTXL + 64 * (t - nlat) + key); }
    __device__ __forceinline__ unsigned kofs() const { return (unsigned)WS_PB + 2u * (1024 + 64 * h); }  __device__ __forceinline__ unsigned kpitch() const { return 2u * OD_LD; }
    __device__ __forceinline__ unsigned k2ofs() const { return 0u; }  __device__ __forceinline__ unsigned k2pitch() const { return 0u; }
    __device__ __forceinline__ unsigned vofs() const { return (unsigned)WS_PB + 2u * (2048 + 64 * h); }  __device__ __forceinline__ unsigned vpitch() const { return 2u * OD_LD; }
    __device__ __forceinline__ unsigned trow(int t) const { return (unsigned)krow(t, 0); }
    __device__ __forceinline__ size_t qrow(int wid, int r) const { return ctxq ? (size_t)(TL + b * CTXL + 32 * wid + r) : (size_t)(b * SEQ + 64 * qgrow(wid) + 32 * (wid & 1) + r); }
    __device__ __forceinline__ const bf16_t* qptr(int wid, int r) const { return PB + qrow(wid, r) * OD_LD + 64 * h; }
    __device__ __forceinline__ unsigned char* optr(int wid, int r) const { return (unsigned char*)AO + qrow(wid, r) * 1024 + 64 * h; }
    __device__ __forceinline__ float m0(int) const { return NEGBIG; }
    __device__ __forceinline__ float l0() const { return 0.f; }
    __device__ __forceinline__ void prep(LAS unsigned char* L) const {
        if (!ctxq) { LAS float* bt = (LAS float*)(L + OFF_BIAS); for (int i = opaque_tid(); i < 15 * 31; i += 512) bt[i] = rpbh[i] * LOG2E; }
    }
    __device__ __forceinline__ void adjust_tile(f32x16& P0, f32x16& P1, int t, int wid, int r32, int hi, float c2, const LAS unsigned char* L, int side) const {
        if (t >= nlat) {
#pragma unroll
            for (int r = 0; r < 16; ++r) { P0[r] *= c2; P1[r] *= c2; }
        } else { const int qc = 32 * (wid & 1) + r32; int c0 = qc - 8; c0 = c0 < 0 ? 0 : (c0 > 48 ? 48 : c0);
            const LAS float* bp = (const LAS float*)(L + OFF_BIAS) + (rlo + t - qgrow(wid) + 7) * 31 + (15 - qc + 4 * hi);
            const int kb = 4 * hi - c0;
#pragma unroll
            for (int r = 0; r < 16; ++r) { const int k0 = (r & 3) + 8 * (r >> 2);
                if (!(side == 2 && r < 12)) { const float b0 = bp[k0]; P0[r] = ((unsigned)(kb + k0) < 16u) ? P0[r] * c2 + b0 : NEGBIG; }
                if (!(side == 1 && r >= 4)) { const float b1 = bp[k0 + 32]; P1[r] = ((unsigned)(kb + k0 + 32) < 16u) ? P1[r] * c2 + b1 : NEGBIG; } } }
    }
};

__device__ __forceinline__ float fma_s(float a, float b, float c) { float r; asm("v_fma_f32 %0, %1, %2, %3" : "=v"(r) : "v"(a), "v"(b), "v"(c)); return r; }
__device__ __forceinline__ float max3f(float a, float b, float c) { float r; asm("v_max3_f32 %0, %1, %2, %3" : "=v"(r) : "v"(a), "v"(b), "v"(c)); return r; }
template <class U>
__device__ __forceinline__ void attn_unit(LAS unsigned char* L, unsigned char* wsbase, const U& u) {
    constexpr int NKC = U::NKC, NKS = NKC / 2;
    const int tid = opaque_tid(), lane = tid & 63, r32 = lane & 31, hi = lane >> 5; const int wid = __builtin_amdgcn_readfirstlane(tid >> 6);
    bf16x8 qr[NKS];
    float m = u.m0(wid), l = hi == 0 ? u.l0() : 0.f;
    f32x16 o[2];
#pragma unroll
    for (int r = 0; r < 16; ++r) { o[0][r] = 0.f; o[1][r] = 0.f; }
    const float c2 = u.c2();
    const int NT = u.ntiles();
    LAS float* wsf = (LAS float*)(L + OFF_WSF) + wid * 64;
    const LAS unsigned char* kbase = L + OFF_K + hi * KCS + r32 * 16;
    const LAS unsigned char* vbase = L + OFF_V + ((lane >> 4) & 1) * 32 + (lane & 3) * 8 + (4 * hi + ((lane & 15) >> 2)) * 64;
    const __amdgpu_buffer_rsrc_t rs = __builtin_amdgcn_make_buffer_rsrc((void*)wsbase, 0, 0x7fffffff, 0x00020000);
    const unsigned kvo = (unsigned)lane * u.kpitch(), kvo2 = (unsigned)lane * u.k2pitch(), vvo = (unsigned)(lane >> 2) * u.vpitch() + (unsigned)(lane & 3) * 16u;
    const unsigned kso = u.kofs() + 16u * wid, kso2 = u.k2ofs() + 16u * wid, vso = u.vofs() + 16u * (wid & 3) * u.vpitch() + 64u * (wid >> 2);
    const bool two = (NKC == 12) && (wid < 4);
#define ATT_DMAK(t) do { const int tc_ = (t) < NT ? (t) : NT - 1; const unsigned r0_ = u.trow(tc_); LAS unsigned char* kd_ = L + OFF_K + ((t) & 3) * KSLOT; \
        __builtin_amdgcn_raw_ptr_buffer_load_lds(rs, (LAS unsigned*)(kd_ + wid * KCS), 16, kvo, kso + r0_ * u.kpitch(), 0, 0); \
        if (two) __builtin_amdgcn_raw_ptr_buffer_load_lds(rs, (LAS unsigned*)(kd_ + (8 + wid) * KCS), 16, kvo2, kso2 + r0_ * u.k2pitch(), 0, 0); } while (0)
#define ATT_DMAV(t) do { const int tc_ = (t) < NT ? (t) : NT - 1; const unsigned r0_ = u.trow(tc_); \
        __builtin_amdgcn_raw_ptr_buffer_load_lds(rs, (LAS unsigned*)(L + OFF_V + ((t) & 3) * VSLOT + wid * 1024), 16, vvo, vso + r0_ * u.vpitch(), 0, 0); } while (0)
#define ATT_WAIT_BAR() do { if (two) asm volatile("s_waitcnt vmcnt(6)" ::: "memory"); else asm volatile("s_waitcnt vmcnt(4)" ::: "memory"); \
        __builtin_amdgcn_s_barrier(); asm volatile("" ::: "memory"); } while (0)
#define ATT_QKT(S0, S1, t) do { const LAS unsigned char* kb_ = kbase + ((t) & 3) * KSLOT; \
        _Pragma("unroll") for (int r = 0; r < 16; ++r) { S0[r] = 0.f; S1[r] = 0.f; } \
        _Pragma("unroll") for (int kh_ = 0; kh_ < 2; ++kh_) { bf16x8 kf0[NKS / 2], kf1[NKS / 2]; \
            _Pragma("unroll") for (int ks = 0; ks < NKS / 2; ++ks) { kf0[ks] = *(const LAS bf16x8*)(kb_ + (kh_ * (NKS / 2) + ks) * (2 * KCS)); kf1[ks] = *(const LAS bf16x8*)(kb_ + (kh_ * (NKS / 2) + ks) * (2 * KCS) + 512); } \
            _Pragma("unroll") for (int ks = 0; ks < NKS / 2; ++ks) { S0 = __builtin_amdgcn_mfma_f32_32x32x16_bf16(kf0[ks], qr[kh_ * (NKS / 2) + ks], S0, 0, 0, 0); S1 = __builtin_amdgcn_mfma_f32_32x32x16_bf16(kf1[ks], qr[kh_ * (NKS / 2) + ks], S1, 0, 0, 0); } } } while (0)
#define ATT_LIVE0(r, SIDE) (!((SIDE) == 2 && (r) < 12))
#define ATT_LIVE1(r, SIDE) (!((SIDE) == 1 && (r) >= 4))
#define ATT_SOFTMAX(P0, P1, T, SIDE) do { float rm; \
        if constexpr (U::PLAIN) { float a_ = max3f(P0[0], P1[0], P0[1]), b_ = max3f(P1[1], P0[2], P1[2]); \
            _Pragma("unroll") for (int r = 3; r < 15; r += 2) { a_ = max3f(a_, P0[r], P1[r]); b_ = max3f(b_, P0[r + 1], P1[r + 1]); } \
            rm = max3f(a_, b_, fmaxf(P0[15], P1[15])) * c2; } \
        else { u.adjust_tile(P0, P1, (T), wid, r32, hi, c2, L, (SIDE)); \
            if ((SIDE) == 0) { float a_ = max3f(P0[0], P1[0], P0[1]), b_ = max3f(P1[1], P0[2], P1[2]); \
                _Pragma("unroll") for (int r = 3; r < 15; r += 2) { a_ = max3f(a_, P0[r], P1[r]); b_ = max3f(b_, P0[r + 1], P1[r + 1]); } \
                rm = max3f(a_, b_, fmaxf(P0[15], P1[15])); } \
            else { float a_ = NEGBIG, b_ = NEGBIG; \
                _Pragma("unroll") for (int r = 0; r < 16; ++r) { if (ATT_LIVE0(r, SIDE)) a_ = fmaxf(a_, P0[r]); if (ATT_LIVE1(r, SIDE)) b_ = fmaxf(b_, P1[r]); } \
                rm = fmaxf(a_, b_); } } \
        { float ra, rb; pair32(rm, ra, rb); rm = fmaxf(ra, rb); } \
        const float mn = fmaxf(m, rm); alpha = __builtin_amdgcn_exp2f(m - mn); resc = __any(mn > m); m = mn; \
        float lsa = 0.f; const float nmn = -mn;       \
        if constexpr (U::PLAIN) { _Pragma("unroll") for (int r = 0; r < 16; ++r) { P0[r] = __builtin_amdgcn_exp2f(fma_s(P0[r], c2, nmn)); P1[r] = __builtin_amdgcn_exp2f(fma_s(P1[r], c2, nmn)); lsa += P0[r]; lsa += P1[r]; } } \
        else { _Pragma("unroll") for (int r = 0; r < 16; ++r) { \
                if (ATT_LIVE0(r, SIDE)) { P0[r] = __builtin_amdgcn_exp2f(P0[r] - mn); lsa += P0[r]; } else P0[r] = 0.f; \
                if (ATT_LIVE1(r, SIDE)) { P1[r] = __builtin_amdgcn_exp2f(P1[r] - mn); lsa += P1[r]; } else P1[r] = 0.f; } } \
        l = l * alpha + lsa; \
        _Pragma("unroll") for (int i = 0; i < 4; ++i) { if ((SIDE) != 2) pw[0][i] = cvtpk(P0[2 * i], P0[2 * i + 1]); pw[1][i] = cvtpk(P0[8 + 2 * i], P0[9 + 2 * i]); pw[2][i] = cvtpk(P1[2 * i], P1[2 * i + 1]); if ((SIDE) != 1) pw[3][i] = cvtpk(P1[8 + 2 * i], P1[9 + 2 * i]); } } while (0)
#define ATT_STEP(SC0, SC1, SN0, SN1, T, SIDE) do { const int t_ = (T); \
        ATT_DMAK(t_ + 3); ATT_DMAV(t_ + 2); \
        ATT_WAIT_BAR(); \
        const bool a_cur = u.active(t_, wid), a_nxt = (t_ + 1 < NT) && u.active(t_ + 1, wid); \
        float alpha = 1.f; bool resc = false; u32x4 pw[4]; \
        if (a_cur && a_nxt) { ATT_QKT(SN0, SN1, t_ + 1); ATT_SOFTMAX(SC0, SC1, t_, SIDE); } \
        else { if (a_nxt) ATT_QKT(SN0, SN1, t_ + 1); \
               if (a_cur) ATT_SOFTMAX(SC0, SC1, t_, SIDE); } \
        __builtin_amdgcn_sched_barrier(0); \
        if (a_cur) { \
            const LAS unsigned char* vb_ = vbase + (t_ & 3) * VSLOT; s16x4 vlo[2][4], vhi[2][4]; \
            _Pragma("unroll") for (int dh = 0; dh < 2; ++dh) _Pragma("unroll") for (int ks = 0; ks < 4; ++ks) { if (((SIDE) == 1 && ks == 3) || ((SIDE) == 2 && ks == 0)) continue; vlo[dh][ks] = vtr(vb_ + dh * 4096 + ks * 1024); vhi[dh][ks] = vtr(vb_ + dh * 4096 + ks * 1024 + 512); } \
            if (resc) { if (hi == 0) wsf[r32] = alpha; LDS_WAIT(); \
                _Pragma("unroll") for (int r = 0; r < 16; ++r) { const float f = wsf[crow(r, hi)]; o[0][r] *= f; o[1][r] *= f; } } \
            _Pragma("unroll") for (int dh = 0; dh < 2; ++dh) _Pragma("unroll") for (int ks = 0; ks < 4; ++ks) { if (((SIDE) == 1 && ks == 3) || ((SIDE) == 2 && ks == 0)) continue; \
                const s16x4 lo4 = vlo[dh][ks], hi4 = vhi[dh][ks]; const bf16x8 vf = {lo4[0], lo4[1], lo4[2], lo4[3], hi4[0], hi4[1], hi4[2], hi4[3]}; \
                o[dh] = __builtin_amdgcn_mfma_f32_32x32x16_bf16(__builtin_bit_cast(bf16x8, pw[ks]), vf, o[dh], 0, 0, 0); } } \
        LDS_WAIT(); __builtin_amdgcn_sched_barrier(0); } while (0)

    ATT_DMAK(0); ATT_DMAK(1); ATT_DMAV(0); ATT_DMAK(2); ATT_DMAV(1);
    { const bf16_t* qp = u.qptr(wid, r32);
#pragma unroll
      for (int ks = 0; ks < NKS; ++ks) qr[ks] = *(const bf16x8*)(qp + 16 * ks + 8 * hi); }
    u.prep(L);
    u.template qfix<NKS>(qr, wid, r32, hi);
    ATT_WAIT_BAR();
    f32x16 sA0, sA1, sB0, sB1;
#pragma unroll
    for (int r = 0; r < 16; ++r) { sA0[r] = 0.f; sA1[r] = 0.f; sB0[r] = 0.f; sB1[r] = 0.f; }
    if (u.active(0, wid)) ATT_QKT(sA0, sA1, 0);
    if constexpr (U::SIDED) { const int nl = u.nlat; int t = 0;
        if (wid & 1) { for (; t < nl; ++t) { ATT_STEP(sA0, sA1, sB0, sB1, t, 2); sA0 = sB0; sA1 = sB1; } }
        else { for (; t < nl; ++t) { ATT_STEP(sA0, sA1, sB0, sB1, t, 1); sA0 = sB0; sA1 = sB1; } }
        for (; t < NT; ++t) { ATT_STEP(sA0, sA1, sB0, sB1, t, 0); sA0 = sB0; sA1 = sB1; } }
    else { for (int t = 0; t < NT; ++t) { ATT_STEP(sA0, sA1, sB0, sB1, t, 0); sA0 = sB0; sA1 = sB1; } }
    asm volatile("s_waitcnt vmcnt(0)" ::: "memory");
#undef ATT_DMAK
#undef ATT_DMAV
#undef ATT_WAIT_BAR
#undef ATT_QKT
#undef ATT_SOFTMAX
#undef ATT_LIVE0
#undef ATT_LIVE1
#undef ATT_STEP
    { float la, lb; pair32(l, la, lb); l = la + lb; }
    if (hi == 0) wsf[32 + r32] = l;
    LDS_WAIT();
    LAS unsigned char* stg = L + OFF_OST + wid * 2048;
#pragma unroll
    for (int r = 0; r < 16; ++r) { const int orow = crow(r, hi); const float rl = __builtin_amdgcn_rcpf(wsf[32 + orow]);
        const unsigned w = __builtin_amdgcn_cvt_pk_fp8_f32(o[0][r] * rl, o[1][r] * rl, 0u, false);
        stg[orow * 64 + r32] = (unsigned char)(w & 0xffu); stg[orow * 64 + 32 + r32] = (unsigned char)((w >> 8) & 0xffu); }
    LDS_WAIT();
#pragma unroll
    for (int i = 0; i < 2; ++i) { const int row = i * 16 + (lane >> 2), ch = lane & 3; const u32x4 v = *(const LAS u32x4*)(stg + row * 64 + ch * 16); *(u32x4*)(u.optr(wid, row) + ch * 16) = v; }
    __syncthreads();
}
}

struct Args { const float* in[25]; float* out; unsigned char* ws; int ph_lo, ph_hi; };
enum InIdx { I_X = 0, I_C, I_CTX, I_CCTX, I_ADAW, I_ADAB, I_N1G, I_N2G, I_EVWIN, I_EVSINK, I_EVQNG, I_EVWUQ, I_EVKVNG, I_EVWUKV, I_EVWOUT, I_ODWIN, I_ODRPB, I_ODWOUT, I_RW, I_RB, I_W1, I_B1, I_W2, I_B2, I_FG };

struct Frame {
    LAS unsigned char* lds;
    int tid, lane, wave, vcu, G;
    float* out; unsigned char* ws;
};
__device__ __forceinline__ const float* inptr(const Frame& F, int i) {
    const volatile LAS unsigned* p = (const volatile LAS unsigned*)(F.lds + LDSCTL_OFF + 256) + 2 * i;
    const unsigned lo = __builtin_amdgcn_readfirstlane(p[0]), hi = __builtin_amdgcn_readfirstlane(p[1]);
    return (const float*)(const GAS float*)(((unsigned long long)hi << 32) | lo);
}
#define WSP(T, off) ((T*)(F.ws + (off)))
__device__ __forceinline__ void frame_tid(Frame& F) { F.tid = opaque_tid(); F.lane = F.tid & 63; F.wave = __builtin_amdgcn_readfirstlane(F.tid >> 6); }

__device__ __forceinline__ void tr_item(const float* W, int ldw, int K, int k0, int n0, bf16_t* WT, int dst_row0, LAS float* scr, int lane) {
    float wv[32];
#pragma unroll
    for (int i = 0; i < 32; ++i) wv[i] = W[(size_t)(k0 + 2 * i + (lane >> 5)) * ldw + n0 + (lane & 31)];
#pragma unroll
    for (int i = 0; i < 32; ++i) scr[(2 * i + (lane >> 5)) * 33 + (lane & 31)] = wv[i];
    LDS_WAIT(); asm volatile("" ::: "memory");
    const int c = lane & 7;
#pragma unroll
    for (int j = 0; j < 4; ++j) { const int n = (lane >> 3) + 8 * j; const LAS float* s = scr + (8 * c) * 33 + n;
        u32x4 o; o.x = pk2(s[0 * 33], s[1 * 33]); o.y = pk2(s[2 * 33], s[3 * 33]); o.z = pk2(s[4 * 33], s[5 * 33]); o.w = pk2(s[6 * 33], s[7 * 33]);
        *(u32x4*)(WT + (size_t)(dst_row0 + n) * K + k0 + 8 * c) = o; }
    LDS_WAIT(); asm volatile("" ::: "memory");
}

__device__ __forceinline__ void tr_item8(const float* W, int ldw, int K, int k0, int n0, unsigned char* WT8, int dst_row0, LAS float* scr, int lane, float scale) {
    float wv[32];
#pragma unroll
    for (int i = 0; i < 32; ++i) wv[i] = W[(size_t)(k0 + 2 * i + (lane >> 5)) * ldw + n0 + (lane & 31)];
#pragma unroll
    for (int i = 0; i < 32; ++i) scr[(2 * i + (lane >> 5)) * 33 + (lane & 31)] = wv[i] * scale;
    LDS_WAIT(); asm volatile("" ::: "memory");
    const int c = lane & 3;
#pragma unroll
    for (int j = 0; j < 2; ++j) { const int n = (lane >> 2) + 16 * j; const LAS float* s = scr + (16 * c) * 33 + n;
        u32x4 o; o.x = cvt4_fp8(s[0 * 33], s[1 * 33], s[2 * 33], s[3 * 33]); o.y = cvt4_fp8(s[4 * 33], s[5 * 33], s[6 * 33], s[7 * 33]);
        o.z = cvt4_fp8(s[8 * 33], s[9 * 33], s[10 * 33], s[11 * 33]); o.w = cvt4_fp8(s[12 * 33], s[13 * 33], s[14 * 33], s[15 * 33]);
        *(u32x4*)(WT8 + (size_t)(dst_row0 + n) * K + k0 + 16 * c) = o; }
    LDS_WAIT(); asm volatile("" ::: "memory");
}
__device__ __forceinline__ float silu_f(float c) { return c / (1.0f + __expf(-c)); }

__device__ __forceinline__ void pro_a(Frame& F) {
    frame_tid(F);
    const int gwm = F.wave * F.G + F.vcu, NGW = F.G * 8;
    for (int it = gwm; it < 4 * 96; it += NGW) {
        const int l = it / 96, col = (it % 96) * 64 + F.lane;
        float sv[5][16];
#pragma unroll
        for (int j = 0; j < 16; ++j) {
#pragma unroll
            for (int v = 0; v < 4; ++v) sv[v][j] = silu_f(inptr(F, I_C)[v * 1024 + 64 * j + F.lane]);
            sv[4][j] = silu_f(inptr(F, I_CCTX)[64 * j + F.lane]);
        }
        const float* W = inptr(F, I_ADAW) + (size_t)l * 1024 * 6144 + col;
        float acc[5] = {0.f, 0.f, 0.f, 0.f, 0.f};
#pragma unroll
        for (int j = 0; j < 16; ++j) {
            float wl[64];
#pragma unroll
            for (int ln = 0; ln < 64; ++ln) wl[ln] = W[(size_t)(64 * j + ln) * 6144];
#pragma unroll
            for (int ln = 0; ln < 64; ++ln) {
#pragma unroll
                for (int v = 0; v < 5; ++v) acc[v] += __builtin_bit_cast(float, __builtin_amdgcn_readlane(__builtin_bit_cast(int, sv[v][j]), ln)) * wl[ln];
            }
        }
        const float bb = inptr(F, I_ADAB)[l * 6144 + col];
        float* MOD = WSP(float, WS_MOD);
#pragma unroll
        for (int v = 0; v < 5; ++v) MOD[(size_t)(l * 5 + v) * 6144 + col] = acc[v] + bb;
    }
    { const int gt = blockIdx.x * 512 + F.tid;
      if (gt < 128 * 16) { const int pos = gt >> 4, i = gt & 15; const float inv = __builtin_amdgcn_exp2f(-((float)i / 16.0f) * 13.287712379549449f); const float a = (float)pos * inv; WSP(f32x2, WS_ROPE64)[gt] = (f32x2){__cosf(a), __sinf(a)}; }
      else if (gt < 128 * 16 + 128 * 8) { const int g2 = gt - 128 * 16, pos = g2 >> 3, i = g2 & 7; const float inv = __builtin_amdgcn_exp2f(-((float)i / 8.0f) * 13.287712379549449f); const float a = (float)pos * inv; WSP(f32x2, WS_ROPE32)[g2] = (f32x2){__cosf(a), __sinf(a)}; } }
    { const int nchunk = 2 * 224 * 64;
      for (int i = blockIdx.x * 512 + F.tid; i < nchunk; i += F.G * 512) { const int mi = i / (224 * 64), r = (i / 64) % 224, c = i % 64;
          *(u32x4*)(WSP(unsigned char, WS_WINE) + ((size_t)mi * 2048 + 1824 + r) * 1024 + 16 * c) = (u32x4){0u, 0u, 0u, 0u}; } }
    { bf16_t* RWT = WSP(bf16_t, WS_RWT);
      for (int i = blockIdx.x * 512 + F.tid; i < 4 * 32 * 1024; i += F.G * 512) { const int l = i >> 15, e = (i >> 10) & 31, k = i & 1023;
          const float v = inptr(F, I_RW)[((size_t)l * 1024 + k) * 32 + e]; const unsigned hi = f2bf(v); const unsigned lo = f2bf(v - __builtin_bit_cast(float, hi << 16));
          bf16_t* r = RWT + ((size_t)l * 256 + e) * H3_LD; r[k] = (bf16_t)hi; r[1024 + k] = (bf16_t)hi; r[2048 + k] = (bf16_t)lo; }
      const int nz = 4 * 224 * (H3_LD / 8);
      for (int i = blockIdx.x * 512 + F.tid; i < nz; i += F.G * 512) { const int l = i / (224 * (H3_LD / 8)), r = (i / (H3_LD / 8)) % 224, c = i % (H3_LD / 8);
          *(u32x4*)(RWT + ((size_t)l * 256 + 32 + r) * H3_LD + 8 * c) = (u32x4){0u, 0u, 0u, 0u}; } }
    LAS float* scr = (LAS float*)(F.lds + F.wave * 16384);
    constexpr int S0 = 2 * 16 * 57, S1 = S0 + 2 * 12 * 24, S2 = S1 + 2 * 4 * 32, S3 = S2 + 2 * 16 * 32, S4 = S3 + 2 * 16 * 96, S5 = S4 + 2 * 16 * 32, S6 = S5 + 128 * 16 * 64, S7 = S6 + 128 * 16 * 32;
    const int gw = F.vcu * 8 + F.wave;
    for (int it = gw; it < S7; it += NGW) {
        if (it < S0) { const int r = it, mi = r / (16 * 57), q = r % (16 * 57), kb = q / 57, nb = q % 57;
            tr_item8(inptr(F, I_EVWIN) + (size_t)mi * 1024 * EV_IN, EV_IN, 1024, 64 * kb, 32 * nb, WSP(unsigned char, WS_WINE) + (size_t)mi * 2048 * 1024, 32 * nb, scr, F.lane, W8_SCALE); }
        else if (it < S1) { const int r = it - S0, mi = r / (12 * 24), q = r % (12 * 24), kb = q / 24, nb = q % 24;
            tr_item(inptr(F, I_EVWUQ) + (size_t)mi * 768 * 768, 768, 768, 64 * kb, 32 * nb, WSP(bf16_t, WS_WUQ) + (size_t)mi * 768 * 768, 32 * nb, scr, F.lane); }
        else if (it < S2) { const int r = it - S1, mi = r / (4 * 32), q = r % (4 * 32), kb = q / 32, nb = q % 32;
            tr_item(inptr(F, I_EVWUKV) + (size_t)mi * 256 * 1024, 1024, 256, 64 * kb, 32 * nb, WSP(bf16_t, WS_WUKV) + (size_t)mi * 1024 * 256, 32 * nb, scr, F.lane); }
        else if (it < S3) { const int r = it - S2, mi = r / (16 * 32), q = r % (16 * 32), kb = q / 32, nb = q % 32;
            tr_item8(inptr(F, I_EVWOUT) + (size_t)mi * 1024 * 1024, 1024, 1024, 64 * kb, 32 * nb, WSP(unsigned char, WS_WOUTE) + (size_t)mi * 1024 * 1024, 32 * nb, scr, F.lane, W8_SCALE); }
        else if (it < S4) { const int r = it - S3, mi = r / (16 * 96), q = r % (16 * 96), kb = q / 96, nb = q % 96;
            tr_item8(inptr(F, I_ODWIN) + (size_t)mi * 1024 * 3072, 3072, 1024, 64 * kb, 32 * nb, WSP(unsigned char, WS_WINO) + (size_t)mi * 3072 * 1024, 32 * nb, scr, F.lane, W8_SCALE); }
        else if (it < S5) { const int r = it - S4, mi = r / (16 * 32), q = r % (16 * 32), kb = q / 32, nb = q % 32;
            tr_item8(inptr(F, I_ODWOUT) + (size_t)mi * 1024 * 1024, 1024, 1024, 64 * kb, 32 * nb, WSP(unsigned char, WS_WOUTO) + (size_t)mi * 1024 * 1024, 32 * nb, scr, F.lane, W8_SCALE); }
        else if (it < S6) { const int r = it - S5, mi = r / (16 * 64), q = r % (16 * 64), kb = q / 64, nb = q % 64;
            const int c0 = 32 * (nb & 31), drow = (c0 >> 7) * 256 + (nb >= 32 ? 128 : 0) + (c0 & 127);
            tr_item8(inptr(F, I_W1) + (size_t)mi * 1024 * 2048, 2048, 1024, 64 * kb, 32 * nb, WSP(unsigned char, WS_W1) + (size_t)mi * 2048 * 1024, drow, scr, F.lane, W8_SCALE); }
        else { const int r = it - S6, mi = r / (16 * 32), q = r % (16 * 32), kb = q / 32, nb = q % 32;
            tr_item8(inptr(F, I_W2) + (size_t)mi * 1024 * 1024, 1024, 1024, 64 * kb, 32 * nb, WSP(unsigned char, WS_W2) + (size_t)mi * 1024 * 1024, 32 * nb, scr, F.lane, W8_SCALE); }
    }
}

__device__ __forceinline__ int mod_bidx(int row) { return row < TL ? (row >> 13) : 4; }
__device__ __forceinline__ void norm_mod_store(const f32x4 (&v)[4], int lane, const float* g, const float* shift, const float* scale, unsigned char* hrow, f32x4 (*hf)[4] = nullptr) {
    float s = 0.f;
#pragma unroll
    for (int j = 0; j < 4; ++j) s += (v[j].x * v[j].x + v[j].y * v[j].y) + (v[j].z * v[j].z + v[j].w * v[j].w);
    const float rstd = 1.0f / sqrtf(wave_sum(s) * (1.0f / DM) + NORM_EPS);
#pragma unroll
    for (int j = 0; j < 4; ++j) { const int col = 4 * lane + 256 * j;
        const f32x4 gg = *(const f32x4*)(g + col), sh = *(const f32x4*)(shift + col), sc = *(const f32x4*)(scale + col);
        const f32x4 h = (v[j] * rstd) * gg * (sc + 1.0f) + sh;
        if (hf) (*hf)[j] = h;
        *(unsigned*)(hrow + col) = cvt4_fp8(h.x, h.y, h.z, h.w); }
}

__device__ __forceinline__ void norm_mod_store_r(const f32x4 (&v)[4], int lane, const f32x4 (&gg)[4], const f32x4 (&sh)[4], const f32x4 (&sc1)[4], unsigned char* hrow) {
    float s = 0.f;
#pragma unroll
    for (int j = 0; j < 4; ++j) s += (v[j].x * v[j].x + v[j].y * v[j].y) + (v[j].z * v[j].z + v[j].w * v[j].w);
    const float rstd = 1.0f / sqrtf(wave_sum(s) * (1.0f / DM) + NORM_EPS);
#pragma unroll
    for (int j = 0; j < 4; ++j) { const int col = 4 * lane + 256 * j;
        const f32x4 h = (v[j] * rstd) * gg[j] * sc1[j] + sh[j];
        *(unsigned*)(hrow + col) = cvt4_fp8(h.x, h.y, h.z, h.w); }
}

__device__ __forceinline__ void pro_b(Frame& F) {
    frame_tid(F);
    const int gw = F.vcu * 8 + F.wave, NGW = F.G * 8, lane = F.lane;
    const float* MOD = WSP(float, WS_MOD);
    f32x4 gg[4], sh[4], sc1[4], vn[4]; int cb = -1;
#pragma unroll
    for (int j = 0; j < 4; ++j) { gg[j] = *(const f32x4*)(inptr(F, I_N1G) + 4 * lane + 256 * j); sh[j] = gg[j]; sc1[j] = gg[j]; vn[j] = gg[j]; }
#define PB_SRC(r_) ((r_) < TL ? inptr(F, I_X) + (size_t)(r_) * DM : inptr(F, I_CTX) + (size_t)((r_) - TL) * DM)
    if (gw < TT) { const float* src = PB_SRC(gw);
#pragma unroll
        for (int j = 0; j < 4; ++j) vn[j] = *(const f32x4*)(src + 4 * lane + 256 * j); }
    for (int row = gw; row < TT; row += NGW) {
        f32x4 v[4];
#pragma unroll
        for (int j = 0; j < 4; ++j) v[j] = vn[j];
        if (row + NGW < TT) { const float* src = PB_SRC(row + NGW);
#pragma unroll
            for (int j = 0; j < 4; ++j) vn[j] = *(const f32x4*)(src + 4 * lane + 256 * j); }
        const int bi = mod_bidx(row);
        if (bi != cb) { cb = bi; const float* mb = MOD + (size_t)(0 * 5 + bi) * 6144;
#pragma unroll
            for (int j = 0; j < 4; ++j) { sh[j] = *(const f32x4*)(mb + 4 * lane + 256 * j); sc1[j] = *(const f32x4*)(mb + 1024 + 4 * lane + 256 * j) + 1.0f; } }
        bf16_t* xr = WSP(bf16_t, WS_XLC) + (size_t)row * DM;
#pragma unroll
        for (int j = 0; j < 4; ++j) *(u32x2*)(xr + 4 * lane + 256 * j) = xpk4(v[j]);
        norm_mod_store_r(v, lane, gg, sh, sc1, WSP(unsigned char, WS_HB) + (size_t)row * DM);
    }
#undef PB_SRC
}

__device__ __forceinline__ u32x4 shfl_xor4(u32x4 v, int m) { u32x4 r; r.x = __shfl_xor(v.x, m); r.y = __shfl_xor(v.y, m); r.z = __shfl_xor(v.z, m); r.w = __shfl_xor(v.w, m); return r; }
__device__ __forceinline__ float ssq8(u32x4 w) { float s = 0.f;
#pragma unroll
    for (int i = 0; i < 4; ++i) { const float a = bflo(w[i]), b = bfhi(w[i]); s += a * a + b * b; } return s; }
__device__ __forceinline__ u32x4 scale8(u32x4 w, float r, const float* g) { u32x4 o; const f32x4 g0 = *(const f32x4*)g, g1 = *(const f32x4*)(g + 4);
    o.x = pk2(bflo(w.x) * r * g0.x, bfhi(w.x) * r * g0.y); o.y = pk2(bflo(w.y) * r * g0.z, bfhi(w.y) * r * g0.w);
    o.z = pk2(bflo(w.z) * r * g1.x, bfhi(w.z) * r * g1.y); o.w = pk2(bflo(w.w) * r * g1.z, bfhi(w.w) * r * g1.w); return o; }

__device__ __forceinline__ u32x4 rope_chunk_r(u32x4 xw, u32x4 yw, const f32x2 (&tab)[8], bool first) {
    u32x4 o;
#pragma unroll
    for (int i = 0; i < 4; ++i) {
        const f32x2 cs0 = tab[2 * i], cs1 = tab[2 * i + 1];
        const float x0 = bflo(xw[i]), x1 = bfhi(xw[i]), y0 = bflo(yw[i]), y1 = bfhi(yw[i]);
        const float r0 = first ? x0 * cs0.x - y0 * cs0.y : x0 * cs0.x + y0 * cs0.y;
        const float r1 = first ? x1 * cs1.x - y1 * cs1.y : x1 * cs1.x + y1 * cs1.y;
        o[i] = pk2(r0, r1);
    }
    return o;
}
__device__ __forceinline__ u32x4 scale8_r(u32x4 w, float r, f32x4 g0, f32x4 g1) { u32x4 o;
    o.x = pk2(bflo(w.x) * r * g0.x, bfhi(w.x) * r * g0.y); o.y = pk2(bflo(w.y) * r * g0.z, bfhi(w.y) * r * g0.w);
    o.z = pk2(bflo(w.z) * r * g1.x, bfhi(w.z) * r * g1.y); o.w = pk2(bflo(w.w) * r * g1.z, bfhi(w.w) * r * g1.w); return o; }

__device__ __forceinline__ void e2_pass(Frame& F, int li) {
    frame_tid(F);
    const int gw = F.vcu * 8 + F.wave, NGW = F.G * 8, lane = F.lane;
    const float* gq = inptr(F, I_EVQNG) + li * 768; const float* gkv = inptr(F, I_EVKVNG) + li * 256;
    const f32x2* R64 = WSP(f32x2, WS_ROPE64); const f32x2* R32 = WSP(f32x2, WS_ROPE32);
    const int cw = lane & 7, seg = cw >> 1, c4 = (lane >= 32 && lane < 36) ? lane - 32 : 0;
    const float* gq1p = gq + (lane >= 32 ? 8 * (lane + 64) - 768 : 0); const float* gq2p = gq + 8 * (lane + 128) - 768; const float* gkvp = gkv + (lane < 32 ? 8 * lane : 0);
    const f32x4 gq1a = *(const f32x4*)gq1p, gq1b = *(const f32x4*)(gq1p + 4), gq2a = *(const f32x4*)gq2p, gq2b = *(const f32x4*)(gq2p + 4), gkva = *(const f32x4*)gkvp, gkvb = *(const f32x4*)(gkvp + 4);
    u32x4 wn[4]; f32x2 t64n[8], t32n[8];
#define E2_LOAD(r_) do { const bf16_t* pr_ = WSP(bf16_t, WS_PB) + (size_t)(r_) * EV_LD; \
        _Pragma("unroll") for (int j = 0; j < 4; ++j) wn[j] = *(const u32x4*)(pr_ + 8 * (lane + 64 * j)); \
        const int t_ = (r_) & (SEQ - 1), prow_ = t_ >> 6, pcol_ = t_ & 63; \
        const f32x2* a_ = R64 + ((seg < 2) ? prow_ : pcol_) * 16 + (cw & 1) * 8; const f32x2* b_ = R32 + ((c4 < 2) ? prow_ : pcol_) * 8; \
        _Pragma("unroll") for (int i = 0; i < 8; ++i) { t64n[i] = a_[i]; t32n[i] = b_[i]; } } while (0)
#pragma unroll
    for (int j = 0; j < 4; ++j) wn[j] = (u32x4){0u, 0u, 0u, 0u};
#pragma unroll
    for (int i = 0; i < 8; ++i) { t64n[i] = (f32x2){0.f, 0.f}; t32n[i] = (f32x2){0.f, 0.f}; }
    if (gw < TT) E2_LOAD(gw);
    for (int row = gw; row < TT; row += NGW) {
        bf16_t* pr = WSP(bf16_t, WS_PB) + (size_t)row * EV_LD;
        u32x4 w[4]; f32x2 t64[8], t32[8];
#pragma unroll
        for (int j = 0; j < 4; ++j) w[j] = wn[j];
#pragma unroll
        for (int i = 0; i < 8; ++i) { t64[i] = t64n[i]; t32[i] = t32n[i]; }
        if (row + NGW < TT) E2_LOAD(row + NGW);
        float sq = ssq8(w[2]) + (lane >= 32 ? ssq8(w[1]) : 0.f), skv = lane < 32 ? ssq8(w[3]) : 0.f;
        const float rq = 1.0f / sqrtf(wave_sum(sq) * (1.0f / 768.0f) + NORM_EPS), rkv = 1.0f / sqrtf(wave_sum(skv) * (1.0f / 256.0f) + NORM_EPS);
        const bool lat = row < TL;
        const u32x4 y0 = shfl_xor4(w[0], 2), y1 = shfl_xor4(w[1], 2), y3 = shfl_xor4(w[3], 1);
        if (lat) { w[0] = rope_chunk_r(w[0], y0, t64, (seg & 1) == 0); if (lane < 16) w[1] = rope_chunk_r(w[1], y1, t64, (seg & 1) == 0); }
        if (lane >= 32) w[1] = scale8_r(w[1], rq, gq1a, gq1b);
        w[2] = scale8_r(w[2], rq, gq2a, gq2b);
        if (lane < 32) w[3] = scale8_r(w[3], rkv, gkva, gkvb);
        else if (lane < 36 && lat) w[3] = rope_chunk_r(w[3], y3, t32, ((lane - 32) & 1) == 0);
#pragma unroll
        for (int j = 0; j < 4; ++j) *(u32x4*)(pr + 8 * (lane + 64 * j)) = w[j];
    }
#undef E2_LOAD
}
__device__ __forceinline__ void m1a_pass(Frame& F, int layer) {
    frame_tid(F);
    const int gw = F.vcu * 8 + F.wave, NGW = F.G * 8, lane = F.lane;
    const float* MOD = WSP(float, WS_MOD); const float* g2 = inptr(F, I_N2G) + layer * DM;
    f32x4 gg[4], sh[4], sc1[4], vn[4]; int cb = -1;
#pragma unroll
    for (int j = 0; j < 4; ++j) { gg[j] = *(const f32x4*)(g2 + 4 * lane + 256 * j); sh[j] = gg[j]; sc1[j] = gg[j]; vn[j] = gg[j]; }
    if (gw < TT) {
#pragma unroll
        for (int j = 0; j < 4; ++j) vn[j] = xun4(*(const u32x2*)(WSP(bf16_t, WS_XLC) + (size_t)gw * DM + 4 * lane + 256 * j)); }
    for (int row = gw; row < TT; row += NGW) {
        f32x4 v[4];
#pragma unroll
        for (int j = 0; j < 4; ++j) v[j] = vn[j];
        if (row + NGW < TT) {
#pragma unroll
            for (int j = 0; j < 4; ++j) vn[j] = xun4(*(const u32x2*)(WSP(bf16_t, WS_XLC) + (size_t)(row + NGW) * DM + 4 * lane + 256 * j)); }
        const int bi = mod_bidx(row);
        if (bi != cb) { cb = bi; const float* mb = MOD + (size_t)(layer * 5 + bi) * 6144;
#pragma unroll
            for (int j = 0; j < 4; ++j) { sh[j] = *(const f32x4*)(mb + 3 * 1024 + 4 * lane + 256 * j); sc1[j] = *(const f32x4*)(mb + 4 * 1024 + 4 * lane + 256 * j) + 1.0f; } }
        float s = 0.f;
#pragma unroll
        for (int j = 0; j < 4; ++j) s += (v[j].x * v[j].x + v[j].y * v[j].y) + (v[j].z * v[j].z + v[j].w * v[j].w);
        const float rstd = 1.0f / sqrtf(wave_sum(s) * (1.0f / DM) + NORM_EPS);
        bf16_t* hr = WSP(bf16_t, WS_PB) + (size_t)row * H3_LD;
#pragma unroll
        for (int j = 0; j < 4; ++j) { const int col = 4 * lane + 256 * j;
            const f32x4 h = (v[j] * rstd) * gg[j] * sc1[j] + sh[j];
            unsigned hi[4], lo[4];
#pragma unroll
            for (int i = 0; i < 4; ++i) { hi[i] = f2bf(h[i]); lo[i] = f2bf(h[i] - __builtin_bit_cast(float, hi[i] << 16)); }
            const u32x2 wh = {hi[0] | (hi[1] << 16), hi[2] | (hi[3] << 16)}, wl = {lo[0] | (lo[1] << 16), lo[2] | (lo[3] << 16)};
            *(u32x2*)(hr + col) = wh; *(u32x2*)(hr + 1024 + col) = wl;
            *(unsigned*)(WSP(unsigned char, WS_HB) + (size_t)row * DM + col) = cvt4_fp8(h[0], h[1], h[2], h[3]); }
    }
}
__device__ __forceinline__ void m1b_gemm(Frame& F, int layer) {
    pg8::RouterOrder S; S.A = (const char*)WSP(bf16_t, WS_PB); S.Bt = (const char*)(WSP(bf16_t, WS_RWT) + (size_t)layer * 256 * H3_LD); S.lda2 = H3_LD * 2; S.ldb2 = H3_LD * 2; S.nM = TT / 256; S.G = F.G; S.c = blockIdx.x;
    pg8::EpiLogits E{WSP(float, WS_LOGIT), WSP(float, WS_LOGIT12), inptr(F, I_RB) + layer * 32};
    pg8::gemm_phase<pg8::EpiLogits, pg8::RouterOrder>(F.lds, 1024, (size_t)H3_LD * 2, (size_t)H3_LD * 2, S, E);
}
__device__ __forceinline__ void m1c_pass(Frame& F) {
    frame_tid(F);
    const int lane = F.lane, blk = blockIdx.x, CH = (TT + F.G - 1) / F.G;
    const int r0 = blk * CH, r1 = (r0 + CH < TT) ? r0 + CH : TT;
    LAS int* hist = (LAS int*)(F.lds + LDSCTL_OFF + 512);
    if (F.tid < 32) hist[F.tid] = 0;
    __syncthreads();
    const int e = lane & 31, sub = lane >> 5;
    float n0 = 0.f, n1 = 0.f, n2 = 0.f;
    { const int row = r0 + 2 * F.wave + sub; const size_t li_ = (size_t)(row < r1 ? row : r1 - 1) * 32 + e;
      n0 = WSP(float, WS_LOGIT)[li_]; n1 = WSP(float, WS_LOGIT12)[li_]; n2 = WSP(float, WS_LOGIT12)[(size_t)TT * 32 + li_]; }
    for (int rbase = r0 + 2 * F.wave; rbase < r1; rbase += 16) {
        const int row = rbase + sub; const bool ok = row < r1;
        float logit = (n0 + n1) + n2;
        { const int rn = rbase + 16 + sub; const size_t li_ = (size_t)(rn < r1 ? rn : r1 - 1) * 32 + e;
          n0 = WSP(float, WS_LOGIT)[li_]; n1 = WSP(float, WS_LOGIT12)[li_]; n2 = WSP(float, WS_LOGIT12)[(size_t)TT * 32 + li_]; }
        float tv[4]; int ti[4];
#pragma unroll
        for (int k = 0; k < 4; ++k) {
            float bv = logit; int bi = e;
#pragma unroll
            for (int o = 16; o >= 1; o >>= 1) { const float ov = __shfl_xor(bv, o); const int oi = __shfl_xor(bi, o); if (ov > bv || (ov == bv && oi < bi)) { bv = ov; bi = oi; } }
            tv[k] = bv; ti[k] = bi; if (e == bi) logit = -3.0e38f;
        }
        const float w1 = __expf(tv[1] - tv[0]), w2 = __expf(tv[2] - tv[0]), w3 = __expf(tv[3] - tv[0]); const float inv = 1.0f / (1.0f + w1 + w2 + w3);
        if (e == 0 && ok) {
            *(int4*)(WSP(int, WS_TOPE) + (size_t)row * 4) = make_int4(ti[0], ti[1], ti[2], ti[3]);
            *(f32x4*)(WSP(float, WS_TOPG) + (size_t)row * 4) = (f32x4){inv, w1 * inv, w2 * inv, w3 * inv};
            atomicAdd((int*)(hist + ti[0]), 1); atomicAdd((int*)(hist + ti[1]), 1); atomicAdd((int*)(hist + ti[2]), 1); atomicAdd((int*)(hist + ti[3]), 1);
        }
    }
    __syncthreads();
    if (F.tid < 32) WSP(int, WS_HIST)[blk * 32 + F.tid] = hist[F.tid];
    __syncthreads();
}

__device__ __forceinline__ void m2_pass(Frame& F) {
    frame_tid(F);
    const int blk = blockIdx.x, CH = (TT + F.G - 1) / F.G;
    const int r0 = blk * CH, r1 = (r0 + CH < TT) ? r0 + CH : TT, nr = r1 > r0 ? r1 - r0 : 0;
    LAS int* tot = (LAS int*)(F.lds), *bef = tot + 32, *pst = tot + 64, *ntl = tot + 96;
    LAS int* te = (LAS int*)(F.lds + 1024);
    LAS float* tg = (LAS float*)(F.lds + 1024 + 32768);
    const int* HIST = WSP(int, WS_HIST);
    if (F.tid < 64) tot[F.tid] = 0;
    __syncthreads();
    for (int i = F.tid; i < F.G * 32; i += 512) { const int h = HIST[i]; atomicAdd((int*)(tot + (i & 31)), h); if ((i >> 5) < blk) atomicAdd((int*)(bef + (i & 31)), h); }
    for (int i = F.tid; i < nr * 4; i += 512) { te[i] = WSP(int, WS_TOPE)[(size_t)r0 * 4 + i]; tg[i] = WSP(float, WS_TOPG)[(size_t)r0 * 4 + i]; }
    __syncthreads();
    if (F.tid == 0) { int ps = 0; for (int e = 0; e < 32; ++e) { pst[e] = ps; ps += (tot[e] + 255) & ~255; } ntl[0] = ps >> 8; }
    __syncthreads();
    LAS int* cnt = (LAS int*)(F.lds + 1024 + 65536);
    const int nent = nr * 4, nch = (nent + 63) >> 6;
    int myrank[4] = {0, 0, 0, 0}, myex[4] = {-1, -1, -1, -1};
#pragma unroll
    for (int q = 0; q < 4; ++q) { const int c = F.wave + 8 * q;
        if (c < nch) { const int i = 64 * c + F.lane; const int ex = i < nent ? te[i] : -1; myex[q] = ex; int rk = 0, mine = 0;
            for (int e = 0; e < 32; ++e) { const unsigned long long m = __ballot(ex == e); if (ex == e) rk = __popcll(m & ((1ull << F.lane) - 1ull)); if (F.lane == e) mine = __popcll(m); }
            myrank[q] = rk; if (F.lane < 32) cnt[c * 32 + F.lane] = mine; } }
    __syncthreads();
#pragma unroll
    for (int q = 0; q < 4; ++q) { const int c = F.wave + 8 * q; const int i = 64 * c + F.lane;
        if (c < nch && i < nent) { const int ex = myex[q]; int before = 0; for (int c2 = 0; c2 < c; ++c2) before += cnt[c2 * 32 + ex];
            const int sl = pst[ex] + bef[ex] + before + myrank[q];
            WSP(int, WS_SLOT)[(size_t)r0 * 4 + i] = sl; WSP(float, WS_GSLOT)[sl] = tg[i]; WSP(int, WS_TOKSLOT)[sl] = r0 + (i >> 2); } }
    if (blk == 0) { const int nt = ntl[0]; int* TE = WSP(int, WS_TILEEXP);
        for (int tl = F.tid; tl < nt; tl += 512) { int e = 0; for (int q = 1; q < 32; ++q) if (pst[q] <= tl * 256) e = q; TE[tl] = e; }
        if (F.tid == 0) TE[1023] = nt;
        for (int e = 0; e < 32; ++e) { const int p0 = pst[e] + tot[e], p1 = pst[e] + ((tot[e] + 255) & ~255); for (int sidx = p0 + F.tid; sidx < p1; sidx += 512) WSP(int, WS_TOKSLOT)[sidx] = 0; } }
    __syncthreads();
}

__device__ __forceinline__ void m5_pass(Frame& F, int layer) {
    frame_tid(F);
    const int gw = F.vcu * 8 + F.wave, NGW = F.G * 8, lane = F.lane;
    const float* MOD = WSP(float, WS_MOD);
    const bool last = layer == 3; const int RL = last ? TL : TT;
    f32x4 gg[4], g2v[4], sh[4], sc1[4]; int cb = -1;
    { const float* gp = last ? inptr(F, I_FG) : inptr(F, I_N1G) + (layer + 1) * DM;
#pragma unroll
      for (int j = 0; j < 4; ++j) { gg[j] = *(const f32x4*)(gp + 4 * lane + 256 * j); g2v[j] = gg[j]; sh[j] = gg[j]; sc1[j] = gg[j]; } }
    int4 sC = make_int4(0, 0, 0, 0), sN = sC; f32x4 gC = {0.f, 0.f, 0.f, 0.f}, gN = gC;
    unsigned yw[4][4], ywn[4][4]; f32x4 xv[4], xvn[4];
#pragma unroll
    for (int j = 0; j < 4; ++j) { xv[j] = gg[j]; xvn[j] = gg[j];
#pragma unroll
        for (int k = 0; k < 4; ++k) { yw[j][k] = 0u; ywn[j][k] = 0u; } }
#define M5_SLOTS(S_, G_, r_) do { S_ = *(const int4*)(WSP(int, WS_SLOT) + (size_t)(r_) * 4); G_ = *(const f32x4*)(WSP(float, WS_TOPG) + (size_t)(r_) * 4); } while (0)
#define M5_DATA(Y_, X_, S_, r_) do { const int sl_[4] = {S_.x, S_.y, S_.z, S_.w}; \
        _Pragma("unroll") for (int j = 0; j < 4; ++j) { const int col = 4 * lane + 256 * j; \
            _Pragma("unroll") for (int k = 0; k < 4; ++k) Y_[j][k] = *(const unsigned*)(WSP(unsigned char, WS_XG) + (size_t)(col >> 6) * ((size_t)MAXSLOT * 64) + (size_t)sl_[k] * 64 + (col & 63)); \
            X_[j] = xun4(*(const u32x2*)(WSP(bf16_t, WS_XLC) + (size_t)(r_) * DM + col)); } } while (0)
    if (gw < RL) { M5_SLOTS(sC, gC, gw); M5_DATA(yw, xv, sC, gw); }
    if (gw + NGW < RL) M5_SLOTS(sN, gN, gw + NGW);
    for (int row = gw; row < RL; row += NGW) {
        const f32x4 gcur = gC;
        if (row + NGW < RL) { M5_DATA(ywn, xvn, sN, row + NGW); gC = gN; }
        if (row + 2 * NGW < RL) M5_SLOTS(sN, gN, row + 2 * NGW);
        const int bi = mod_bidx(row);
        if (bi != cb) { cb = bi; const float* mb = MOD + (size_t)(layer * 5 + bi) * 6144; const float* mn = MOD + (size_t)((last ? layer : layer + 1) * 5 + bi) * 6144;
#pragma unroll
            for (int j = 0; j < 4; ++j) { const int col = 4 * lane + 256 * j; g2v[j] = *(const f32x4*)(mb + 5 * 1024 + col); sh[j] = *(const f32x4*)(mn + col); sc1[j] = *(const f32x4*)(mn + 1024 + col) + 1.0f; } }
        const float gk[4] = {gcur.x * (1.0f / YS_SCALE), gcur.y * (1.0f / YS_SCALE), gcur.z * (1.0f / YS_SCALE), gcur.w * (1.0f / YS_SCALE)};
        bf16_t* xr = WSP(bf16_t, WS_XLC) + (size_t)row * DM;
        f32x4 v[4];
#pragma unroll
        for (int j = 0; j < 4; ++j) { f32x4 y = {0.f, 0.f, 0.f, 0.f};
#pragma unroll
            for (int k = 0; k < 4; ++k) { const unsigned w = yw[j][k];
                y += (f32x4){__builtin_amdgcn_cvt_f32_fp8(w, 0), __builtin_amdgcn_cvt_f32_fp8(w, 1), __builtin_amdgcn_cvt_f32_fp8(w, 2), __builtin_amdgcn_cvt_f32_fp8(w, 3)} * gk[k]; }
            v[j] = xv[j] + g2v[j] * y; }
        if (!last) {
#pragma unroll
            for (int j = 0; j < 4; ++j) *(u32x2*)(xr + 4 * lane + 256 * j) = xpk4(v[j]);
            norm_mod_store_r(v, lane, gg, sh, sc1, WSP(unsigned char, WS_HB) + (size_t)row * DM);
        } else {
            float s = 0.f;
#pragma unroll
            for (int j = 0; j < 4; ++j) s += (v[j].x * v[j].x + v[j].y * v[j].y) + (v[j].z * v[j].z + v[j].w * v[j].w);
            const float rstd = 1.0f / sqrtf(wave_sum(s) * (1.0f / DM) + NORM_EPS);
#pragma unroll
            for (int j = 0; j < 4; ++j) { const int col = 4 * lane + 256 * j; *(f32x4*)(F.out + (size_t)row * DM + col) = (v[j] * rstd) * gg[j]; }
        }
#pragma unroll
        for (int j = 0; j < 4; ++j) { xv[j] = xvn[j];
#pragma unroll
            for (int k = 0; k < 4; ++k) yw[j][k] = ywn[j][k]; }
    }
#undef M5_SLOTS
#undef M5_DATA
}

constexpr int NPH_PAIR = 22, NPH = 2 + 2 * NPH_PAIR;

__device__ __forceinline__ void moe_gemm1(Frame& F, int layer) {
    const int* TE = WSP(int, WS_TILEEXP);
    LAS int* tel = (LAS int*)(F.lds + LDSCTL_OFF + 4096);
    { const int tz = opaque_tid(); tel[tz] = TE[tz]; tel[512 + tz] = TE[512 + tz]; __syncthreads(); }
    pg8::MoeOrder S; S.A = (const char*)WSP(unsigned char, WS_HB); S.W = (const char*)(WSP(unsigned char, WS_W1) + (size_t)layer * 32 * 2048 * 1024); S.tile_exp = tel; S.tokslot = WSP(int, WS_TOKSLOT);
    S.lda2 = 1024; S.ldb2 = 1024; S.wstride = 2048u * 1024u; S.ntiles = __builtin_amdgcn_readfirstlane(TE[1023]); S.nN = 8; S.G = F.G; S.c = blockIdx.x;
    pg8::EpiSwiglu E{WSP(unsigned char, WS_HA), inptr(F, I_B1) + (size_t)layer * 32 * 2048};
    pg8::gemm_phase<pg8::EpiSwiglu, pg8::MoeOrder, true, true>(F.lds, 512, 1024, 1024, S, E);
}
__device__ __forceinline__ void moe_gemm2(Frame& F, int layer) {
    const int* TE = WSP(int, WS_TILEEXP);
    LAS int* tel = (LAS int*)(F.lds + LDSCTL_OFF + 4096);
    { const int tz = opaque_tid(); tel[tz] = TE[tz]; tel[512 + tz] = TE[512 + tz]; __syncthreads(); }
    pg8::MoeOrder S; S.A = (const char*)WSP(unsigned char, WS_HA); S.W = (const char*)(WSP(unsigned char, WS_W2) + (size_t)layer * 32 * 1024 * 1024); S.tile_exp = tel; S.tokslot = nullptr;
    S.lda2 = 1024; S.ldb2 = 1024; S.wstride = 1024u * 1024u; S.ntiles = __builtin_amdgcn_readfirstlane(TE[1023]); S.nN = 4; S.G = F.G; S.c = blockIdx.x;
    pg8::EpiGate E{WSP(unsigned char, WS_XG), inptr(F, I_B2) + (size_t)layer * 32 * 1024};
    pg8::gemm_phase<pg8::EpiGate, pg8::MoeOrder, true>(F.lds, 512, 1024, 1024, S, E);
}
__device__ __forceinline__ void dense_gemm_bf16(Frame& F, const bf16_t* A, size_t lda2, const bf16_t* Bt, int N, int K, bf16_t* O, int ldc) {
    pg8::DenseOrder S; S.init(A, lda2, Bt, (size_t)K * 2, TT, N, F.G, blockIdx.x);
    pg8::EpiBf16 E{O, ldc, 1.0f};
    pg8::gemm_phase<pg8::EpiBf16, pg8::DenseOrder>(F.lds, K, lda2, (size_t)K * 2, S, E);
}
__device__ __forceinline__ void dense_gemm_f8(Frame& F, const unsigned char* A8, const unsigned char* Bt8, int N, int K8, bf16_t* O, int ldc) {
    pg8::DenseOrder S; S.init(A8, (size_t)K8, Bt8, (size_t)K8, TT, N, F.G, blockIdx.x);
    pg8::EpiBf16 E{O, ldc, 1.0f / W8_SCALE};
    pg8::gemm_phase<pg8::EpiBf16, pg8::DenseOrder, true>(F.lds, K8 / 2, (size_t)K8, (size_t)K8, S, E);
}
__device__ __forceinline__ void outproj_gemm(Frame& F, const unsigned char* Bt8, int layer, int nrows) {
    pg8::DenseOrder S; S.init(WSP(unsigned char, WS_AO), 1024, Bt8, 1024, nrows, 1024, F.G, blockIdx.x);
    pg8::EpiResid E{WSP(bf16_t, WS_XLC), WSP(float, WS_MOD) + (size_t)layer * 5 * 6144 + 2 * 1024, 1.0f / W8_SCALE};
    pg8::gemm_phase<pg8::EpiResid, pg8::DenseOrder, true>(F.lds, 512, 1024, 1024, S, E);
}

__global__ void __launch_bounds__(512, 2) fwd(Args args) {
    extern __shared__ __attribute__((aligned(16))) unsigned char lds_raw[];
    Frame F;
    F.lds = (LAS unsigned char*)lds_raw;
    F.tid = threadIdx.x; F.lane = F.tid & 63; F.wave = __builtin_amdgcn_readfirstlane(F.tid >> 6);
    F.G = gridDim.x; { const int bx = blockIdx.x; F.vcu = (F.G % 8 == 0) ? (bx % 8) * (F.G / 8) + bx / 8 : bx; }
    F.out = args.out; F.ws = args.ws;
    volatile LAS unsigned* MISC = (volatile LAS unsigned*)(F.lds + LDSCTL_OFF);
    if (F.tid < 64) MISC[F.tid] = 0u;
    if (F.tid < 25) { const unsigned long long pv = ((const unsigned long long*)__builtin_amdgcn_kernarg_segment_ptr())[F.tid]; MISC[64 + 2 * F.tid] = (unsigned)pv; MISC[65 + 2 * F.tid] = (unsigned)(pv >> 32); }
    __syncthreads();
    unsigned* ctl = (unsigned*)(F.ws + WS_CTL);
#if !MK_PER_PHASE
    XcdBarrier bar = xcd_barrier_post(ctl + CW_BAR, MISC + 8);
#define GRID_BAR() xcd_barrier(bar)
#else
#define GRID_BAR() do { } while (0)
#endif
    const int lo = args.ph_lo, hi = args.ph_hi;
    int pid = 0;
    enum { CNT0 = __COUNTER__ + 1 };
#ifndef PHMASK
#define PHMASK 0xFFFFFFFFull
#endif
#ifndef REPMASK
#define REPMASK 0ull
#endif
#define PHASE_BEGIN { const int site_ = __COUNTER__ - CNT0; const int nrep_ = 1 + (int)(((unsigned long long)REPMASK >> site_) & 1ull); \
    if ((((unsigned long long)PHMASK >> site_) & 1ull) && lo <= pid && pid < hi) { for (int rep_ = 0; rep_ < nrep_; ++rep_) {
#define PHASE_END if (rep_ + 1 < nrep_ || pid + 1 < hi) GRID_BAR(); } } ++pid; }

    PHASE_BEGIN pro_a(F); PHASE_END
    PHASE_BEGIN pro_b(F); PHASE_END

    for (int lp = 0; lp < 2; ++lp) {
        { const int layer = 2 * lp, li = lp;
        PHASE_BEGIN dense_gemm_f8(F, WSP(unsigned char, WS_HB), WSP(unsigned char, WS_WINE) + (size_t)li * 2048 * 1024, 2048, 1024, WSP(bf16_t, WS_PB), EV_LD); PHASE_END
        PHASE_BEGIN e2_pass(F, li); PHASE_END
        PHASE_BEGIN
            dense_gemm_bf16(F, WSP(bf16_t, WS_PB) + 768, (size_t)EV_LD * 2, WSP(bf16_t, WS_WUQ) + (size_t)li * 768 * 768, 768, 768, WSP(bf16_t, WS_QB), 768);
            dense_gemm_bf16(F, WSP(bf16_t, WS_PB) + 1536, (size_t)EV_LD * 2, WSP(bf16_t, WS_WUKV) + (size_t)li * 1024 * 256, 1024, 256, WSP(bf16_t, WS_KVB), 1024);
        PHASE_END
        PHASE_BEGIN
            for (int rr_ = 0; rr_ < 1 + (int)(((unsigned long long)REPMASK >> 40) & 1ull); ++rr_)
            for (int u = F.vcu; u < 1024 + 32; u += F.G) {
                att::UMla U; U.QB = WSP(bf16_t, WS_QB); U.KVB = WSP(bf16_t, WS_KVB); U.PB = WSP(bf16_t, WS_PB); U.AO = WSP(bf16_t, WS_AO); U.R32 = WSP(f32x2, WS_ROPE32);
                if (u < 1024) { const int bh = u >> 5; U.b = bh >> 3; U.h = bh & 7; U.qblk = u & 31; U.ctxq = false; }
                else { const int v = u - 1024; U.b = v >> 3; U.h = v & 7; U.qblk = 0; U.ctxq = true; }
                att::attn_unit<att::UMla>(F.lds, F.ws, U);
            }
            for (int rr_ = 0; rr_ < 1 + (int)(((unsigned long long)REPMASK >> 41) & 1ull); ++rr_)
            for (int u = F.vcu; u < 1024 + 32; u += F.G) {
                att::UWin U; U.PB = WSP(bf16_t, WS_PB); U.AO = WSP(bf16_t, WS_AO); U.sink = inptr(F, I_EVSINK) + li * 8;
                if (u < 1024) { U.b = u >> 8; U.kvh = (u >> 7) & 1; U.j = u & 127; U.ctxq = false; }
                else { const int v = u - 1024; U.b = v >> 3; U.kvh = (v >> 2) & 1; U.j = v & 3; U.ctxq = true; }
                U.init();
                att::attn_unit<att::UWin>(F.lds, F.ws, U);
            }
        PHASE_END
        PHASE_BEGIN outproj_gemm(F, WSP(unsigned char, WS_WOUTE) + (size_t)li * 1024 * 1024, layer, TT); PHASE_END
        PHASE_BEGIN m1a_pass(F, layer); PHASE_END
        PHASE_BEGIN m1b_gemm(F, layer); PHASE_END
        PHASE_BEGIN m1c_pass(F); PHASE_END
        PHASE_BEGIN m2_pass(F); PHASE_END
        PHASE_BEGIN moe_gemm1(F, layer); PHASE_END
        PHASE_BEGIN moe_gemm2(F, layer); PHASE_END
        PHASE_BEGIN m5_pass(F, layer); PHASE_END
        }
        { const int layer = 2 * lp + 1, li = lp;
        PHASE_BEGIN dense_gemm_f8(F, WSP(unsigned char, WS_HB), WSP(unsigned char, WS_WINO) + (size_t)li * 3072 * 1024, 3072, 1024, WSP(bf16_t, WS_PB), OD_LD); PHASE_END
        PHASE_BEGIN
            for (int u = F.vcu; u < 2048 + (layer == 3 ? 0 : 64); u += F.G) {
                att::UNa U; U.PB = WSP(bf16_t, WS_PB); U.AO = WSP(bf16_t, WS_AO);
                if (u < 2048) { U.b = u >> 9; U.h = (u >> 5) & 15; U.G = u & 31; U.ctxq = false; }
                else { const int v = u - 2048; U.b = v >> 4; U.h = v & 15; U.G = 0; U.ctxq = true; }
                U.rpbh = inptr(F, I_ODRPB) + (size_t)(li * 16 + U.h) * 15 * 31;
                U.init();
                att::attn_unit<att::UNa>(F.lds, F.ws, U);
            }
        PHASE_END
        PHASE_BEGIN outproj_gemm(F, WSP(unsigned char, WS_WOUTO) + (size_t)li * 1024 * 1024, layer, layer == 3 ? TL : TT); PHASE_END
        PHASE_BEGIN m1a_pass(F, layer); PHASE_END
        PHASE_BEGIN m1b_gemm(F, layer); PHASE_END
        PHASE_BEGIN m1c_pass(F); PHASE_END
        PHASE_BEGIN m2_pass(F); PHASE_END
        PHASE_BEGIN moe_gemm1(F, layer); PHASE_END
        PHASE_BEGIN moe_gemm2(F, layer); PHASE_END
        PHASE_BEGIN m5_pass(F, layer); PHASE_END
        }
    }
}


#if MK_CHECK
constexpr int CW_CHK = 8192;
constexpr size_t WS_CHK = 1968 * MiB;
constexpr size_t WS_CHK_CNT = WS_CHK + 136 * MiB;
constexpr int IDS_PER_PAIR = 26, ID_PROB = 53, NID = 54;
struct CArgs { const float* in[25]; float* out; unsigned char* ws; int layer, id; };
#define CWS(T, off) ((T*)(A.ws + (off)))
__device__ __forceinline__ unsigned hsh(unsigned x) { x ^= x >> 16; x *= 0x7feb352du; x ^= x >> 15; x *= 0x846ca68bu; x ^= x >> 16; return x; }
__device__ __forceinline__ float bfv(const bf16_t* p) { return __builtin_bit_cast(float, (unsigned)(*p) << 16); }
__device__ __forceinline__ float f8v(const unsigned char* p) { const unsigned b = *p; const unsigned e = (b >> 3) & 15u, m = b & 7u; const float v = e ? __builtin_bit_cast(float, ((e + 120u) << 23) | (m << 20)) : (float)m * 0.001953125f; return (b & 128u) ? -v : v; }
__device__ __forceinline__ float rbf(float a) { return __builtin_bit_cast(float, f2bf(a) << 16); }
__device__ __forceinline__ void chk_acc(const CArgs& A, float e2, float r2) {
    __shared__ float sh[2][8];
    e2 = wave_sum(e2); r2 = wave_sum(r2);
    const int w = threadIdx.x >> 6;
    if ((threadIdx.x & 63) == 0) { sh[0][w] = e2; sh[1][w] = r2; }
    __syncthreads();
    if (threadIdx.x == 0) { float a = 0.f, b = 0.f; for (int i = 0; i < (int)(blockDim.x >> 6); ++i) { a += sh[0][i]; b += sh[1][i]; }
        float* acc = (float*)(A.ws + WS_CTL) + CW_CHK + 2 * A.id; atomicAdd(acc, a); atomicAdd(acc + 1, b); }
    __syncthreads();
}
__device__ __forceinline__ void sincos_d(float a, float& s, float& c) {
    double x = (double)a; const double tp = 6.283185307179586476925; double k = __builtin_rint(x / tp); double r = x - k * tp; double r2 = r * r;
    double sp = r, cp = 1.0, ts = r, tc = 1.0;
#pragma unroll
    for (int i = 1; i < 14; ++i) { tc *= -r2 / (double)((2 * i - 1) * (2 * i)); cp += tc; ts *= -r2 / (double)((2 * i) * (2 * i + 1)); sp += ts; }
    s = (float)sp; c = (float)cp;
}
__device__ __forceinline__ float invfreq(int i, int half) { return __builtin_amdgcn_exp2f(-((float)i / (float)half) * 13.287712379549449f); }
__device__ __forceinline__ float nsilu(float c) { return c / (1.0f + __expf(-c)); }
__device__ float naive_mod(const CArgs& A, int layer, int bidx, int n) {
    const float* cv = bidx < 4 ? A.in[I_C] + bidx * 1024 : A.in[I_CCTX]; const float* W = A.in[I_ADAW] + (size_t)layer * 1024 * 6144 + n;
    float acc = 0.f; for (int k = 0; k < 1024; ++k) acc += nsilu(cv[k]) * W[(size_t)k * 6144];
    return acc + A.in[I_ADAB][layer * 6144 + n];
}
__device__ __forceinline__ int srow(unsigned s) { return (s & 3) == 0 ? TL + (int)(hsh(s * 3 + 1) % TC) : (int)(hsh(s * 3 + 1) % TL); }
__global__ void chk_mark(CArgs A) { if (threadIdx.x == 0) ((float*)(A.ws + WS_CTL))[CW_CHK + 2 * A.id + 1] = 1.0f; }

__global__ void chk_gemm(CArgs A, const bf16_t* X, int ldx, const float* W, int ldw, int K, int ncol, const bf16_t* O, int ldo) {
    const int row = srow(blockIdx.x); const int col = (int)((hsh(blockIdx.x * 977 + 5) + 7u * threadIdx.x) % (unsigned)ncol);
    float ref = 0.f; for (int k = 0; k < K; ++k) ref += (ldx ? bfv(X + (size_t)row * ldx + k) : f8v((const unsigned char*)X + (size_t)row * 1024 + k)) * W[(size_t)k * ldw + col];
    const float got = bfv(O + (size_t)row * ldo + col);
    chk_acc(A, (got - ref) * (got - ref), ref * ref);
}
__global__ void chk_e2(CArgs A) {
    __shared__ float P[EV_IN]; __shared__ float red[2];
    const int li = A.layer >> 1, row = srow(blockIdx.x), t = threadIdx.x;
    const float* W = A.in[I_EVWIN] + (size_t)li * 1024 * EV_IN; const unsigned char* h = CWS(unsigned char, WS_HB) + (size_t)row * DM;
    for (int c = t; c < EV_IN; c += 256) { float a = 0.f; for (int k = 0; k < 1024; ++k) a += f8v(h + k) * W[(size_t)k * EV_IN + c]; P[c] = rbf(a); }
    __syncthreads();
    if (t == 0) { float a = 0.f; for (int c = 768; c < 1536; ++c) a += P[c] * P[c]; red[0] = 1.0f / sqrtf(a / 768.0f + NORM_EPS); float b = 0.f; for (int c = 1536; c < 1792; ++c) b += P[c] * P[c]; red[1] = 1.0f / sqrtf(b / 256.0f + NORM_EPS); }
    __syncthreads();
    const bool lat = row < TL; const int tt = row & (SEQ - 1), prow = tt >> 6, pcol = tt & 63;
    float e2 = 0.f, r2 = 0.f;
    for (int c = t; c < EV_IN; c += 256) {
        float ref = P[c];
        if (c < 640 && lat) { const int d = c & 63, dd = d & 31, i = dd & 15; const bool first = dd < 16; const float y = P[first ? c + 16 : c - 16];
            float sn, cs; sincos_d((float)((d < 32) ? prow : pcol) * invfreq(i, 16), sn, cs); ref = first ? P[c] * cs - y * sn : P[c] * cs + y * sn; }
        else if (c >= 768 && c < 1536) ref = P[c] * red[0] * A.in[I_EVQNG][li * 768 + c - 768];
        else if (c >= 1536 && c < 1792) ref = P[c] * red[1] * A.in[I_EVKVNG][li * 256 + c - 1536];
        else if (c >= 1792 && lat) { const int d = c - 1792, dd = d & 15, i = dd & 7; const bool first = dd < 8; const float y = P[first ? c + 8 : c - 8];
            float sn, cs; sincos_d((float)((d < 16) ? prow : pcol) * invfreq(i, 8), sn, cs); ref = first ? P[c] * cs - y * sn : P[c] * cs + y * sn; }
        const float got = bfv(CWS(bf16_t, WS_PB) + (size_t)row * EV_LD + c);
        e2 += (got - ref) * (got - ref); r2 += ref * ref;
    }
    chk_acc(A, e2, r2);
}
__global__ void chk_e4(CArgs A) {
    __shared__ float Q[768];
    const int li = A.layer >> 1, row = (int)(hsh(blockIdx.x * 3 + 1) % TL), t = threadIdx.x;
    const float* W = A.in[I_EVWUQ] + (size_t)li * 768 * 768; const bf16_t* x = CWS(bf16_t, WS_PB) + (size_t)row * EV_LD + 768;
    for (int c = t; c < 768; c += 256) { float a = 0.f; for (int k = 0; k < 768; ++k) a += bfv(x + k) * W[(size_t)k * 768 + c]; Q[c] = rbf(a); }
    __syncthreads();
    const int tt = row & (SEQ - 1), prow = tt >> 6, pcol = tt & 63;
    float e2 = 0.f, r2 = 0.f;
    for (int c = t; c < 768; c += 256) { const int d = c % 96; float ref = Q[c];
        if (d >= 64) { const int dr = d - 64, dd = dr & 15, i = dd & 7; const bool first = dd < 8; const float y = Q[first ? c + 8 : c - 8];
            float sn, cs; sincos_d((float)((dr < 16) ? prow : pcol) * invfreq(i, 8), sn, cs); ref = first ? Q[c] * cs - y * sn : Q[c] * cs + y * sn; }
        const float got = bfv(CWS(bf16_t, WS_QB) + (size_t)row * 768 + c); e2 += (got - ref) * (got - ref); r2 += ref * ref; }
    chk_acc(A, e2, r2);
}
__global__ void chk_attn(CArgs A, int kind, int ctxq) {
    __shared__ float sc[8448]; __shared__ float redm[4], reds[4], qs[96];
    const int li = A.layer >> 1, t = threadIdx.x; const unsigned s = blockIdx.x;
    const int b = hsh(s * 7 + 1) % NB, head = hsh(s * 7 + 2) % (kind == 2 ? 16 : 8);
    const int pos = ctxq ? hsh(s * 7 + 3) % CTXL : ((s & 7) == 0 ? (hsh(s) % 200) : (s & 7) == 1 ? SEQ - 1 - (hsh(s) % 200) : hsh(s * 7 + 3) % SEQ);
    const size_t qrow = ctxq ? (size_t)(TL + b * CTXL + pos) : (size_t)(b * SEQ + pos);
    int nlat = 0, wlo = 0, r = pos >> 6, c = pos & 63, r0 = 0, c0 = 0;
    if (!ctxq) {
        if (kind == 0) { wlo = pos - 128 < 0 ? 0 : pos - 128; const int whi = pos + 128 > SEQ - 1 ? SEQ - 1 : pos + 128; nlat = whi - wlo + 1; }
        else if (kind == 1) nlat = SEQ;
        else { r0 = r - 4; r0 = r0 < 0 ? 0 : (r0 > 120 ? 120 : r0); c0 = c - 8; c0 = c0 < 0 ? 0 : (c0 > 48 ? 48 : c0); nlat = 128; }
    }
    const int nk = nlat + CTXL;
    const bf16_t* PB = CWS(bf16_t, WS_PB); const bf16_t* KVB = CWS(bf16_t, WS_KVB);
    const int pld = kind == 2 ? OD_LD : EV_LD, dqk = kind == 1 ? 96 : 64;
    const bf16_t* q = kind == 1 ? CWS(bf16_t, WS_QB) + qrow * 768 + 96 * head : PB + qrow * pld + 64 * head;
    const float scale = kind == 1 ? 0.10206207261596577f : 0.125f;
    const bool has_sink = kind == 0; const float sinkv = has_sink ? A.in[I_EVSINK][li * 8 + head] : 0.f;
    const float* rp = A.in[I_ODRPB] + (size_t)(li * 16 + head) * 15 * 31;
    if (t < dqk) qs[t] = bfv(q + t);
    __syncthreads();
    if (kind == 1 && !ctxq) { float rv = 0.f;
        if (t >= 64 && t < 96) { const int dr = t - 64, dd = dr & 15, i = dd & 7; const bool first = dd < 8; const float y = qs[first ? t + 8 : t - 8];
            float sn, cs; sincos_d((float)((dr < 16) ? r : c) * invfreq(i, 8), sn, cs); rv = rbf(first ? qs[t] * cs - y * sn : qs[t] * cs + y * sn); }
        __syncthreads();
        if (t >= 64 && t < 96) qs[t] = rv;
        __syncthreads(); }
#define KROW(i) ((i) >= nlat ? (size_t)(TL + b * CTXL + ((i) - nlat)) : kind == 0 ? (size_t)(b * SEQ + wlo + (i)) : kind == 1 ? (size_t)(b * SEQ + (i)) : (size_t)(b * SEQ + (r0 + ((i) >> 4)) * 64 + c0 + ((i) & 15)))
    float mx = has_sink ? sinkv : -3e38f;
    for (int i = t; i < nk; i += 256) { const size_t kr = KROW(i); float a = 0.f;
        if (kind == 0) { const bf16_t* k = PB + kr * EV_LD + 512 + 64 * (head >> 2); for (int d = 0; d < 64; ++d) a += qs[d] * bfv(k + d); }
        else if (kind == 1) { const bf16_t* k = KVB + kr * 1024 + 128 * head; for (int d = 0; d < 64; ++d) a += qs[d] * bfv(k + d); const bf16_t* k2 = PB + kr * EV_LD + 1792; for (int d = 0; d < 32; ++d) a += qs[64 + d] * bfv(k2 + d); }
        else { const bf16_t* k = PB + kr * OD_LD + 1024 + 64 * head; for (int d = 0; d < 64; ++d) a += qs[d] * bfv(k + d); }
        a *= scale;
        if (kind == 2 && i < nlat) { const int kr_ = r0 + (i >> 4), kc_ = c0 + (i & 15); a += rp[(kr_ - r + 7) * 31 + (kc_ - c + 15)]; }
        sc[i] = a; mx = fmaxf(mx, a); }
    for (int o = 1; o < 64; o <<= 1) mx = fmaxf(mx, __shfl_xor(mx, o));
    if ((t & 63) == 0) redm[t >> 6] = mx;
    __syncthreads();
    mx = fmaxf(fmaxf(redm[0], redm[1]), fmaxf(redm[2], redm[3]));
    float sm = 0.f;
    for (int i = t; i < nk; i += 256) { const float p = __expf(sc[i] - mx); sc[i] = p; sm += p; }
    sm = wave_sum(sm);
    if ((t & 63) == 0) reds[t >> 6] = sm;
    __syncthreads();
    sm = reds[0] + reds[1] + reds[2] + reds[3] + (has_sink ? __expf(sinkv - mx) : 0.f);
    float e2 = 0.f, r2 = 0.f;
    if (t < 64) { float o = 0.f;
        for (int i = 0; i < nk; ++i) { const size_t kr = KROW(i); const bf16_t* v = kind == 0 ? PB + kr * EV_LD + 640 + 64 * (head >> 2) : kind == 1 ? KVB + kr * 1024 + 128 * head + 64 : PB + kr * OD_LD + 2048 + 64 * head; o += sc[i] * bfv(v + t); }
        o /= sm; const unsigned char* got = CWS(unsigned char, WS_AO) + qrow * 1024 + (kind == 1 ? 512 : 0) + 64 * head; const float g = f8v(got + t); e2 = (g - o) * (g - o); r2 = o * o; }
#undef KROW
    chk_acc(A, e2, r2);
}
__global__ void chk_outproj(CArgs A, const float* W) {
    const int row = A.layer == 3 ? (int)(hsh(blockIdx.x * 3 + 1) % TL) : srow(blockIdx.x), c = (int)((hsh(blockIdx.x * 977 + 5) + 7u * threadIdx.x) % 1024u);
    float a = 0.f; for (int k = 0; k < 1024; ++k) a += f8v(CWS(unsigned char, WS_AO) + (size_t)row * 1024 + k) * W[(size_t)k * 1024 + c];
    const float gate = naive_mod(A, A.layer, row < TL ? (row >> 13) : 4, 2 * 1024 + c);
    const float ref = CWS(float, WS_CHK)[(size_t)row * DM + c] + gate * a, got = CWS(float, WS_XLC)[(size_t)row * DM + c];
    chk_acc(A, (got - ref) * (got - ref), (gate * a) * (gate * a));
}
__global__ void chk_norm_router(CArgs A, int which, const bf16_t* hbuf, int hld) {
    __shared__ float hv[1024]; __shared__ float red[4]; __shared__ float lg[32]; __shared__ int ste[4]; __shared__ float stv[4];
    const int row = srow(blockIdx.x), t = threadIdx.x, bidx = row < TL ? (row >> 13) : 4;
    const float* x = CWS(float, WS_XLC) + (size_t)row * DM;
    float s = 0.f; for (int c = t; c < 1024; c += 256) s += x[c] * x[c];
    s = wave_sum(s); if ((t & 63) == 0) red[t >> 6] = s; __syncthreads();
    const float rstd = 1.0f / sqrtf((red[0] + red[1] + red[2] + red[3]) / 1024.0f + NORM_EPS);
    const float* g = (which == 0 ? A.in[I_N1G] : A.in[I_N2G]) + A.layer * DM;
    float e2 = 0.f, r2 = 0.f;
    for (int c = t; c < 1024; c += 256) { const float sh = naive_mod(A, A.layer, bidx, which * 1024 + c), scl = naive_mod(A, A.layer, bidx, (which + 1) * 1024 + c);
        const float h = x[c] * rstd * g[c] * (1.0f + scl) + sh; hv[c] = h; const float got = hld ? bfv(hbuf + (size_t)row * hld + c) : f8v((const unsigned char*)hbuf + (size_t)row * DM + c); e2 += (got - h) * (got - h); r2 += h * h; }
    __syncthreads();
    if (which == 3) {
        if (t < 32) { const float* rw = A.in[I_RW] + (size_t)A.layer * 1024 * 32; float a = 0.f; for (int k = 0; k < 1024; ++k) a += hv[k] * rw[k * 32 + t]; lg[t] = a + A.in[I_RB][A.layer * 32 + t]; }
        __syncthreads();
        if (t == 0) { unsigned used = 0u;
            for (int k = 0; k < 4; ++k) { float bv = -3e38f; int bi = 0; for (int e = 0; e < 32; ++e) if (!((used >> e) & 1u) && lg[e] > bv) { bv = lg[e]; bi = e; } used |= 1u << bi; ste[k] = bi; stv[k] = bv; }
            float den = 0.f; for (int k = 0; k < 4; ++k) den += __expf(stv[k] - stv[0]);
            for (int k = 0; k < 4; ++k) { const float gr = __expf(stv[k] - stv[0]) / den; const int ge = CWS(int, WS_TOPE)[(size_t)row * 4 + k]; const float gg = CWS(float, WS_TOPG)[(size_t)row * 4 + k];
                const float d = (ge == ste[k]) ? (gg - gr) : 1.0f; e2 += 1000.f * d * d; r2 += 1000.f * gr * gr; } }
    }
    chk_acc(A, e2, r2);
}
__global__ void chk_slots_count(CArgs A) {
    const int i = blockIdx.x * 256 + threadIdx.x; if (i < TT * 4) { const int sl = CWS(int, WS_SLOT)[i]; if (sl >= 0 && sl < MAXSLOT) atomicAdd(CWS(int, WS_CHK_CNT) + sl, 1); else atomicAdd((float*)(A.ws + WS_CTL) + CW_CHK + 2 * A.id, 1.0f); }
}
__global__ void chk_slots(CArgs A) {
    const int i = blockIdx.x * 256 + threadIdx.x; float e2 = 0.f, r2 = 0.f;
    if (i < MAXSLOT) { const int c = CWS(int, WS_CHK_CNT)[i]; if (c > 1) e2 += 1.f; }
    if (i < 8192) { const unsigned a = hsh(i * 5 + 3) % (unsigned)(TT * 4); const int row = a >> 2, sl = CWS(int, WS_SLOT)[a], e = CWS(int, WS_TOPE)[a];
        if (CWS(int, WS_TILEEXP)[sl >> 8] != e) e2 += 1.f;
        if (CWS(float, WS_GSLOT)[sl] != CWS(float, WS_TOPG)[a]) e2 += 1.f;
        if (CWS(int, WS_TOKSLOT)[sl] != row) e2 += 1.f; r2 += 1.f; }
    chk_acc(A, e2, r2);
}
__global__ void chk_moe(CArgs A, int which) {
    const unsigned a = hsh(blockIdx.x * 5 + 3) % (unsigned)(TT * 4); const int sl = CWS(int, WS_SLOT)[a], e = CWS(int, WS_TILEEXP)[sl >> 8];
    const int c = (int)((hsh(blockIdx.x * 977 + 5) + 7u * threadIdx.x) % 1024u);
    float ref, got;
    if (which == 0) { const float* W = A.in[I_W1] + ((size_t)A.layer * 32 + e) * 1024 * 2048; const unsigned char* x = CWS(unsigned char, WS_HB) + (size_t)(a >> 2) * DM; float g = 0.f, l = 0.f;
        for (int k = 0; k < 1024; ++k) { const float xv = f8v(x + k); g += xv * W[(size_t)k * 2048 + c]; l += xv * W[(size_t)k * 2048 + 1024 + c]; }
        g += A.in[I_B1][((size_t)A.layer * 32 + e) * 2048 + c]; l += A.in[I_B1][((size_t)A.layer * 32 + e) * 2048 + 1024 + c];
        g = fminf(g, 7.f); l = fminf(fmaxf(l, -7.f), 7.f); ref = g / (1.0f + __expf(-1.702f * g)) * (l + 1.0f); got = f8v(CWS(unsigned char, WS_HA) + (size_t)sl * DM + c); }
    else { const float* W = A.in[I_W2] + ((size_t)A.layer * 32 + e) * 1024 * 1024; const unsigned char* x = CWS(unsigned char, WS_HA) + (size_t)sl * DM; float y = 0.f;
        for (int k = 0; k < 1024; ++k) y += f8v(x + k) * W[(size_t)k * 1024 + c];
        ref = y + A.in[I_B2][((size_t)A.layer * 32 + e) * 1024 + c]; got = f8v(CWS(unsigned char, WS_XG) + (size_t)sl * DM + c) * (1.0f / YS_SCALE); }
    chk_acc(A, (got - ref) * (got - ref), ref * ref);
}
__global__ void chk_combine(CArgs A) {
    const int row = srow(blockIdx.x), c = (int)((hsh(blockIdx.x * 977 + 5) + 7u * threadIdx.x) % 1024u);
    float y = 0.f; for (int k = 0; k < 4; ++k) y += CWS(float, WS_TOPG)[(size_t)row * 4 + k] * (1.0f / YS_SCALE) * f8v(CWS(unsigned char, WS_XG) + (size_t)CWS(int, WS_SLOT)[(size_t)row * 4 + k] * DM + c);
    const float gate = naive_mod(A, A.layer, row < TL ? (row >> 13) : 4, 5 * 1024 + c);
    const float ref = CWS(float, WS_CHK)[(size_t)row * DM + c] + gate * y, got = CWS(float, WS_XLC)[(size_t)row * DM + c];
    chk_acc(A, (got - ref) * (got - ref), (gate * y) * (gate * y));
}
__global__ void chk_report(CArgs A) {
    if (threadIdx.x == 0 && blockIdx.x == 0) { const float* acc = (const float*)(A.ws + WS_CTL) + CW_CHK; int bad = 0, bad2 = 0;
        for (int id = NID - 1; id >= 1; --id) { const int q = (id - 1) % IDS_PER_PAIR + 1; const float tol = (id == ID_PROB || (q >= 6 && q <= 10) || q == 18 || q == 19 || q == 20 || q == 1 || q == 2 || q == 17 || q == 13 || q == 14 || q == 16 || q == 23 || q == 24 || q == 26) ? 0.1f : 0.03f;
            const float e2 = acc[2 * id], r2 = acc[2 * id + 1]; if (r2 <= 0.f || !(e2 <= tol * tol * r2)) { bad2 = bad; bad = id; } }
        if (bad) A.out[0] = 1000.0f * (float)bad;
        if (bad2) A.out[1] = 1000.0f * (float)bad2; }
}
static void chk_before(int p, const Args& a, hipStream_t st) {
    const int q = p < 2 ? -1 : (p - 2) % NPH_PAIR;
    if (q == 8 || q == 18) (void)hipMemsetAsync(a.ws + WS_CHK_CNT, 0, (size_t)MAXSLOT * 4, st);
    if (q == 4 || q == 11 || q == 14 || q == 21) (void)hipMemcpyAsync(a.ws + WS_CHK, a.ws + WS_XLC, (size_t)TT * DM * 4, hipMemcpyDeviceToDevice, st);
}
static void chk_after(int p, const Args& a, hipStream_t st) {
    CArgs A{}; for (int i = 0; i < 25; ++i) A.in[i] = a.in[i]; A.out = a.out; A.ws = a.ws;
    const int lp = p < 2 ? 0 : (p - 2) / NPH_PAIR, q = p < 2 ? -1 : (p - 2) % NPH_PAIR, base = IDS_PER_PAIR * lp;
    unsigned char* ws = a.ws; const int le = 2 * lp, lod = 2 * lp + 1;
#define CK(idv, layerv, kern, grid, ...) do { A.id = base + (idv); A.layer = (layerv); hipLaunchKernelGGL(kern, dim3(grid), dim3(256), 0, st, A, ##__VA_ARGS__); } while (0)
#define CK0(idv, layerv, kern, grid) do { A.id = base + (idv); A.layer = (layerv); hipLaunchKernelGGL(kern, dim3(grid), dim3(256), 0, st, A); } while (0)
    if (p == 1) { A.id = ID_PROB; A.layer = 0; hipLaunchKernelGGL(chk_norm_router, dim3(48), dim3(256), 0, st, A, 0, (const bf16_t*)(ws + WS_HB), 0); }
    if (q == 0) CK(1, le, chk_gemm, 64, (const bf16_t*)(ws + WS_HB), 0, a.in[I_EVWIN] + (size_t)lp * 1024 * EV_IN, (int)EV_IN, 1024, (int)EV_IN, (const bf16_t*)(ws + WS_PB), (int)EV_LD);
    if (q == 1) CK0(2, le, chk_e2, 48);
    if (q == 2) { CK(3, le, chk_gemm, 64, (const bf16_t*)(ws + WS_PB) + 768, (int)EV_LD, a.in[I_EVWUQ] + (size_t)lp * 768 * 768, 768, 768, 768, (const bf16_t*)(ws + WS_QB), 768);
                  CK(4, le, chk_gemm, 64, (const bf16_t*)(ws + WS_PB) + 1536, (int)EV_LD, a.in[I_EVWUKV] + (size_t)lp * 256 * 1024, 1024, 256, 1024, (const bf16_t*)(ws + WS_KVB), 1024);
                  CK0(5, le, chk_mark, 1); }
    if (q == 3) { CK(6, le, chk_attn, 96, 0, 0); CK(7, le, chk_attn, 48, 1, 0); CK(8, le, chk_attn, 32, 0, 1); CK(9, le, chk_attn, 32, 1, 1); }
    if (q == 4) CK(10, le, chk_outproj, 48, a.in[I_EVWOUT] + (size_t)lp * 1024 * 1024);
    if (q == 7) CK(11, le, chk_norm_router, 48, 3, (const bf16_t*)(ws + WS_PB), (int)H3_LD);
    if (q == 8) { CK0(12, le, chk_slots_count, (TT * 4 + 255) / 256); CK0(12, le, chk_slots, MAXSLOT / 256); }
    if (q == 9) CK(13, le, chk_moe, 64, 0);
    if (q == 10) CK(14, le, chk_moe, 64, 1);
    if (q == 11) { CK0(15, le, chk_combine, 64); CK(16, le + 1, chk_norm_router, 48, 0, (const bf16_t*)(ws + WS_HB), 0); }
    if (q == 12) CK(17, lod, chk_gemm, 64, (const bf16_t*)(ws + WS_HB), 0, a.in[I_ODWIN] + (size_t)lp * 1024 * 3072, 3072, 1024, 3072, (const bf16_t*)(ws + WS_PB), (int)OD_LD);
    if (q == 13) { CK(18, lod, chk_attn, 96, 2, 0); CK(19, lod, chk_attn, 32, 2, 1); }
    if (q == 14) CK(20, lod, chk_outproj, 48, a.in[I_ODWOUT] + (size_t)lp * 1024 * 1024);
    if (q == 17) CK(21, lod, chk_norm_router, 48, 3, (const bf16_t*)(ws + WS_PB), (int)H3_LD);
    if (q == 18) { CK0(22, lod, chk_slots_count, (TT * 4 + 255) / 256); CK0(22, lod, chk_slots, MAXSLOT / 256); }
    if (q == 19) CK(23, lod, chk_moe, 64, 0);
    if (q == 20) CK(24, lod, chk_moe, 64, 1);
    if (q == 21) { if (lod != 3) { CK0(25, lod, chk_combine, 64); CK(26, lod + 1, chk_norm_router, 48, 0, (const bf16_t*)(ws + WS_HB), 0); } else { CK0(25, lod, chk_mark, 1); CK0(26, lod, chk_mark, 1); } }
    if (p == NPH - 1) { A.id = 0; hipLaunchKernelGGL(chk_report, dim3(1), dim3(64), 0, st, A); }
#undef CK
#undef CK0
}
#endif

extern "C" void kernel_launch(void* const* d_in, const int* in_sizes, int n_in, void* d_out, int out_size, void* d_ws, size_t ws_size, hipStream_t stream) {
    static int grid = 0;
    if (grid == 0) {
        if (n_in != 25 || out_size != TL * DM || ws_size < WS_END) { fprintf(stderr, "kernel_launch: unexpected shapes (n_in %d, out %d, ws %zu < %zu); nothing launched\n", n_in, out_size, ws_size, (size_t)WS_END); grid = -1; return; }
        int dev = 0, cus = 0, per_cu = 0;
        if (hipGetDevice(&dev) != hipSuccess || hipDeviceGetAttribute(&cus, hipDeviceAttributeMultiprocessorCount, dev) != hipSuccess) { grid = -1; return; }
        if (hipFuncSetAttribute((const void*)fwd, hipFuncAttributeMaxDynamicSharedMemorySize, LDS_BYTES) != hipSuccess) { fprintf(stderr, "kernel_launch: hipFuncSetAttribute failed\n"); grid = -1; return; }
        if (hipOccupancyMaxActiveBlocksPerMultiprocessor(&per_cu, (const void*)fwd, 512, LDS_BYTES) != hipSuccess || per_cu < 1) { fprintf(stderr, "kernel_launch: occupancy query says %d blocks per CU\n", per_cu); }
        (void)hipGetLastError();
        grid = cus;
    }
    if (grid < 0) return;
    (void)hipMemsetAsync((char*)d_ws + WS_CTL, 0, CTL_ZERO_BYTES, stream);
    Args a{};
    for (int i = 0; i < 25; ++i) a.in[i] = (const float*)d_in[i];
    a.out = (float*)d_out; a.ws = (unsigned char*)d_ws;
#if MK_PER_PHASE
    for (int p = 0; p < NPH; ++p) {
#if MK_CHECK
        chk_before(p, a, stream);
#endif
        a.ph_lo = p; a.ph_hi = p + 1; hipLaunchKernelGGL(fwd, dim3(grid), dim3(512), LDS_BYTES, stream, a);
#if MK_CHECK
        chk_after(p, a, stream);
#endif
    }
#else
    a.ph_lo = 0; a.ph_hi = NPH;
    hipLaunchKernelGGL(fwd, dim3(grid), dim3(512), LDS_BYTES, stream, a);
#endif
    const hipError_t le = hipPeekAtLastError();
    if (le != hipSuccess) fprintf(stderr, "kernel_launch: launch failed: %s\n", hipGetErrorName(le));
}
```

```cpp
#include <hip/hip_runtime.h>
#include <cstdio>
#include <cstdint>

#ifndef MK_CHECK
#define MK_CHECK 0
#endif
#ifndef MK_PER_PHASE
#define MK_PER_PHASE MK_CHECK
#endif

#define LAS __attribute__((address_space(3)))
#define GAS __attribute__((address_space(1)))
typedef unsigned short bf16_t;
typedef short bf16x8 __attribute__((ext_vector_type(8)));
typedef short s16x4 __attribute__((ext_vector_type(4)));
typedef float f32x2 __attribute__((ext_vector_type(2)));
typedef float f32x4 __attribute__((ext_vector_type(4)));
typedef float f32x16 __attribute__((ext_vector_type(16)));
typedef unsigned u32x2 __attribute__((ext_vector_type(2)));
typedef unsigned u32x4 __attribute__((ext_vector_type(4)));

constexpr int DM = 1024, NB = 4, SEQ = 8192, TL = NB * SEQ, CTXL = 256, TC = NB * CTXL, TT = TL + TC;
constexpr int EV_LD = 2048, OD_LD = 3072;
constexpr int EV_IN = 1824;
constexpr int NEXP = 32, DEXP = 1024;
constexpr int MAXSLOT = 143360, MAXTILE = 560;
constexpr float NORM_EPS = 1e-6f;
constexpr float LOG2E = 1.4426950408889634f;

constexpr size_t MiB = 1u << 20;
constexpr size_t WS_CTL = 0, CTL_ZERO_BYTES = 1 * MiB;
constexpr size_t WS_MOD = 1 * MiB;
constexpr size_t WS_ROPE64 = 1 * MiB + 512 * 1024;
constexpr size_t WS_ROPE32 = WS_ROPE64 + 16384;
constexpr size_t WS_TOPE = 2 * MiB;
constexpr size_t WS_TOPG = WS_TOPE + 540672;
constexpr size_t WS_SLOT = WS_TOPG + 540672;
constexpr size_t WS_HIST = WS_SLOT + 540672;
constexpr size_t WS_TILEEXP = WS_HIST + 131072;
constexpr size_t WS_GSLOT = WS_TILEEXP + 4096;
constexpr size_t WS_TOKSLOT = WS_GSLOT + (size_t)MAXSLOT * 4;
static_assert(WS_TOKSLOT + (size_t)MAXSLOT * 4 <= 6 * MiB, "route map");
constexpr size_t WS_WINE = 6 * MiB, WS_WUQ = 14 * MiB, WS_WUKV = 17 * MiB, WS_WOUTE = 18 * MiB, WS_WINO = 22 * MiB, WS_WOUTO = 34 * MiB;
constexpr size_t WS_W1 = 38 * MiB, WS_W2 = 550 * MiB;
constexpr size_t WS_XLC = 806 * MiB, WS_HB = 938 * MiB, WS_PB = 1004 * MiB, WS_QB = 1202 * MiB, WS_KVB = 1252 * MiB, WS_AO = 1318 * MiB;
constexpr size_t WS_XG = 1384 * MiB, WS_HA = 1664 * MiB, WS_RWT = 1944 * MiB, WS_LOGIT = 1952 * MiB, WS_END = 1960 * MiB;
constexpr size_t WS_LOGIT12 = WS_XG + 160 * MiB;
constexpr int H3_LD = 3072;
constexpr int CW_BAR = 4096;

constexpr int ARENA_BYTES = 131072;
constexpr int LDSCTL_OFF = ARENA_BYTES;
constexpr int LDS_BYTES = 147456;

__device__ __forceinline__ unsigned f2bf(float f) { unsigned u = __builtin_bit_cast(unsigned, f); return (u + 0x7fffu + ((u >> 16) & 1u)) >> 16; }
__device__ __forceinline__ unsigned pk2(float lo, float hi) { return f2bf(lo) | (f2bf(hi) << 16); }
__device__ __forceinline__ f32x4 xun4(u32x2 w) { return (f32x4){__builtin_bit_cast(float, w.x << 16), __builtin_bit_cast(float, w.x & 0xffff0000u), __builtin_bit_cast(float, w.y << 16), __builtin_bit_cast(float, w.y & 0xffff0000u)}; }
__device__ __forceinline__ u32x2 xpk4(f32x4 v) { return (u32x2){pk2(v.x, v.y), pk2(v.z, v.w)}; }
__device__ __forceinline__ float bflo(unsigned w) { return __builtin_bit_cast(float, w << 16); }
__device__ __forceinline__ float bfhi(unsigned w) { return __builtin_bit_cast(float, w & 0xffff0000u); }
__device__ __forceinline__ float wave_sum(float v) {
#pragma unroll
    for (int o = 1; o < 64; o <<= 1) v += __shfl_xor(v, o);
    return v;
}
#define LDS_WAIT() asm volatile("s_waitcnt lgkmcnt(0)" ::: "memory")
__device__ __forceinline__ unsigned cvt4_fp8(float a, float b, float c, float d) { unsigned w = 0u; w = __builtin_amdgcn_cvt_pk_fp8_f32(a, b, w, false); w = __builtin_amdgcn_cvt_pk_fp8_f32(c, d, w, true); return w; }
__device__ __forceinline__ void swap16(unsigned& a, unsigned& b) { asm volatile("s_nop 1\n\tv_permlane16_swap_b32 %0, %1\n\ts_nop 1" : "+v"(a), "+v"(b)); }
constexpr float YS_SCALE = 16.0f;
constexpr float W8_SCALE = 32.0f;
__device__ __forceinline__ int opaque_tid() { int t = threadIdx.x; asm volatile("" : "+v"(t)); return t; }

#define XB_TMO      128
#define XB_XCNT(j)  (256  + 64 * (j))
#define XB_XSUB(j)  (1280 + 64 * (j))
#define XB_XGEN(j)  (2304 + 64 * (j))
#define XB_TOP      3328
#define XB_TOPGEN   3392
#define XCD_BAR_WORDS 3456
#define XB_SPIN_CAP (1u << 18)

__device__ __forceinline__ unsigned xb_ld(unsigned* p)              { return __hip_atomic_load(p, __ATOMIC_RELAXED, __HIP_MEMORY_SCOPE_AGENT); }
__device__ __forceinline__ unsigned xb_add(unsigned* p, unsigned v) { return __hip_atomic_fetch_add(p, v, __ATOMIC_RELAXED, __HIP_MEMORY_SCOPE_AGENT); }
__device__ __forceinline__ unsigned xb_xcc_id() { return (unsigned)__builtin_amdgcn_s_getreg((3 << 11) | 20) & 0xFu; }
#define XB_SPIN(cond, bar) do { unsigned _sp = 0; while (cond) { __builtin_amdgcn_s_sleep(1); \
    if ((++_sp & 255u) == 0u) { if (xb_ld(&(bar)[XB_TMO])) break; if (_sp > XB_SPIN_CAP) { atomicAdd(&(bar)[XB_TMO], 1u); break; } } } } while (0)

struct XcdBarrier { unsigned* bar; unsigned x; volatile LAS unsigned* st; };

__device__ __forceinline__ XcdBarrier xcd_barrier_post(unsigned* bar, volatile LAS unsigned* st) {
    XcdBarrier b; b.bar = bar; b.x = xb_xcc_id(); b.st = st;
    if (threadIdx.x == 0) (void)xb_add(&bar[XB_XCNT(b.x)], 1u);
    return b;
}
__device__ __forceinline__ void xcd_barrier_complete(unsigned* bar, unsigned x, unsigned& nloc, unsigned& nx) {
    const unsigned G = gridDim.x * gridDim.y * gridDim.z;
    unsigned sum, cnt, mine, sp = 0u;
    for (;;) {
        sum = 0u; cnt = 0u; mine = 0u;
#pragma unroll
        for (unsigned j = 0; j < 16; ++j) { const unsigned c = xb_ld(&bar[XB_XCNT(j)]); sum += c; cnt += (c > 0u) ? 1u : 0u; mine = (j == x) ? c : mine; }
        if (sum == G) break;
        __builtin_amdgcn_s_sleep(1);
        if ((++sp & 255u) == 0u) { if (xb_ld(&bar[XB_TMO])) break; if (sp > XB_SPIN_CAP) { atomicAdd(&bar[XB_TMO], 1u); break; } }
    }
    nloc = mine > 0u ? mine : 1u; nx = cnt > 0u ? cnt : 1u;
}
__device__ __forceinline__ void xcd_barrier(const XcdBarrier& b) {
    asm volatile("s_waitcnt vmcnt(0)" ::: "memory");
    __syncthreads();
    if (threadIdx.x == 0) {
        unsigned* bar = b.bar;
        __builtin_amdgcn_s_waitcnt(0);
        unsigned nloc = b.st[0], nx = b.st[1];
        if (nloc == 0u) { xcd_barrier_complete(bar, b.x, nloc, nx); b.st[0] = nloc; b.st[1] = nx; }
        const unsigned old = xb_add(&bar[XB_XSUB(b.x)], 1u);
        const unsigned gen = old / nloc;
        if (old + 1u == (gen + 1u) * nloc) {
            __builtin_amdgcn_fence(__ATOMIC_RELEASE, "agent");
            asm volatile("s_waitcnt vmcnt(0)" ::: "memory");
            const unsigned og = xb_add(&bar[XB_TOP], 1u);
            const unsigned tg = og / nx;
            if (og + 1u == (tg + 1u) * nx) xb_add(&bar[XB_TOPGEN], 1u);
            else XB_SPIN(xb_ld(&bar[XB_TOPGEN]) == tg, bar);
            __builtin_amdgcn_fence(__ATOMIC_ACQUIRE, "agent");
            xb_add(&bar[XB_XGEN(b.x)], 1u);
            asm volatile("s_waitcnt vmcnt(0)" ::: "memory");
        } else {
            XB_SPIN(xb_ld(&bar[XB_XGEN(b.x)]) == gen, bar);
            __builtin_amdgcn_fence(__ATOMIC_ACQUIRE, "agent");
            asm volatile("s_waitcnt vmcnt(0)" ::: "memory");
        }
    }
    __syncthreads();
}

namespace pg8 {
constexpr int BM = 256, BK = 64, HALF = 128, HTB = HALF * BK * 2, STAGE_BYTES = 8 * HTB, NXCD = 8, WGM = 8;
__host__ __device__ __forceinline__ int lds_byte(int r, int c) { const int st = (r >> 4) * 2 + (c >> 5), rr = r & 15, cc = c & 31, ob = rr * 64 + cc * 2; return st * 1024 + (ob ^ (((ob >> 9) & 1) << 5)); }
__host__ __device__ __forceinline__ void stage_rc(int b, int& R, int& C) { const int st = b / 1024, sb = b % 1024, swz = sb ^ (((sb >> 9) & 1) << 5); R = (st >> 1) * 16 + swz / 64; C = (st & 1) * 32 + (swz % 64) / 2; }
__host__ __device__ __forceinline__ int perm32(int rho) { const int n = rho >> 4, i = rho & 15; return 8 * (i >> 2) + 4 * n + (i & 3); }

typedef int v4i_t __attribute__((ext_vector_type(4)));
typedef int v8i_t __attribute__((ext_vector_type(8)));
struct Unit { unsigned a, b; int pm, pn, aux; };

struct DenseOrder {
    const char* A; const char* Bt; unsigned lda2, ldb2; int nM, nN, nwg, G, c;
    __device__ __forceinline__ const void* baseA() const { return A; }
    __device__ __forceinline__ const void* baseB() const { return Bt; }
    __device__ __forceinline__ const int* gather() const { return nullptr; }
    __device__ __forceinline__ void init(const void* A_, size_t lda_bytes, const void* Bt_, size_t ldb_bytes, int M, int N, int G_, int c_) { A = (const char*)A_; Bt = (const char*)Bt_; lda2 = (unsigned)lda_bytes; ldb2 = (unsigned)ldb_bytes; nM = M / BM; nN = N / BM; nwg = nM * nN; G = G_; c = c_; }
    __device__ __forceinline__ bool next(int i, Unit& u) const {
        const long L = (long)i * G + c; if (L >= nwg) return false;
        int wgid = (int)L; { const int q = nwg / NXCD, r = nwg % NXCD, xcd = wgid % NXCD, off = wgid / NXCD; wgid = (xcd < r ? xcd * (q + 1) : r * (q + 1) + (xcd - r) * q) + off; }
        const int nig = WGM * nN, gid = wgid / nig, fm = gid * WGM, gsz = (nM - fm) < WGM ? (nM - fm) : WGM;
        u.pm = fm + ((wgid % nig) % gsz); u.pn = (wgid % nig) / gsz; u.aux = 0;
        u.a = (unsigned)u.pm * BM * lda2; u.b = (unsigned)u.pn * BM * ldb2; return true;
    }
};
struct RouterOrder {
    const char* A; const char* Bt; unsigned lda2, ldb2; int nM, G, c;
    __device__ __forceinline__ const void* baseA() const { return A; }
    __device__ __forceinline__ const void* baseB() const { return Bt; }
    __device__ __forceinline__ const int* gather() const { return nullptr; }
    __device__ __forceinline__ bool next(int i, Unit& u) const {
        const int L = i * G + c; if (L >= nM * 3) return false;
        u.pm = L / 3; u.aux = L - 3 * u.pm; u.pn = 0;
        u.a = (unsigned)u.pm * BM * lda2 + (u.aux == 1 ? 2048u : 0u); u.b = (unsigned)u.aux * 2048u; return true;
    }
};
struct MoeOrder {
    const char* A; const char* W; const LAS int* tile_exp; const int* tokslot; unsigned lda2, ldb2, wstride; int ntiles, nN, G, c;
    __device__ __forceinline__ const void* baseA() const { return A; }
    __device__ __forceinline__ const void* baseB() const { return W; }
    __device__ __forceinline__ const int* gather() const { return tokslot; }
    __device__ __forceinline__ bool next(int i, Unit& u) const {
        const int tpr = G / nN, tpx = tpr >> 3, x = c & 7, j = c >> 3;
        int tile, pn;
        if ((G & 7) == 0 && tpx * 8 == tpr && tpx > 0) { tile = i * tpr + x * tpx + j / nN; pn = j % nN; }
        else { const long L = (long)i * G + c; tile = (int)(L / nN); pn = (int)(L % nN); }
        if (tile >= ntiles) return false;
        const int e = __builtin_amdgcn_readfirstlane(tile_exp[tile]);
        u.pm = tile; u.pn = pn; u.aux = e; u.a = (unsigned)tile * BM * lda2; u.b = (unsigned)e * wstride + (unsigned)pn * BM * ldb2; return true;
    }
};

__device__ __forceinline__ unsigned cvt_pk_bf16(float lo, float hi) { unsigned r; asm volatile("v_cvt_pk_bf16_f32 %0, %1, %2" : "=v"(r) : "v"(lo), "v"(hi)); return r; }

struct EpiBf16 {
    static constexpr bool PERM = true; static constexpr bool WIDE16 = false;
    bf16_t* O; int ldc; float sc;
    struct Pre {}; static constexpr bool HAS_BIAS = false;
    __device__ __forceinline__ void operator()(const f32x4 (&acc)[2][2][4][2], const Unit& u, int wr, int wc, int fr, int fq, const Pre& pre) const {
        const int row0 = u.pm * BM + wr * 64 + fr, col0 = u.pn * BM + wc * 32 + 8 * fq;
#pragma unroll
        for (int ai = 0; ai < 2; ++ai)
#pragma unroll
            for (int m = 0; m < 4; ++m) { bf16_t* rowp = O + (size_t)(row0 + ai * HALF + m * 16) * ldc + col0;
#pragma unroll
                for (int bj = 0; bj < 2; ++bj) { const f32x4 v0 = acc[ai][bj][m][0] * sc, v1 = acc[ai][bj][m][1] * sc;
                    u32x4 w; w.x = cvt_pk_bf16(v0[0], v0[1]); w.y = cvt_pk_bf16(v0[2], v0[3]); w.z = cvt_pk_bf16(v1[0], v1[1]); w.w = cvt_pk_bf16(v1[2], v1[3]);
                    *(u32x4*)(rowp + bj * HALF) = w; } }
    }
};
struct EpiResid {
    static constexpr bool PERM = true; static constexpr bool WIDE16 = false;
    bf16_t* X; const float* modl; float sc;
    struct Pre {}; static constexpr bool HAS_BIAS = false;
    __device__ __forceinline__ void operator()(const f32x4 (&acc)[2][2][4][2], const Unit& u, int wr, int wc, int fr, int fq, const Pre& pre) const {
        const int row0 = u.pm * BM + wr * 64 + fr, col0 = u.pn * BM + wc * 32 + 8 * fq;
        const int bidx = u.pm < 128 ? (u.pm >> 5) : 4;
        const float* gp = modl + (size_t)bidx * 6144 + col0;
        f32x4 gv[2][2];
#pragma unroll
        for (int bj = 0; bj < 2; ++bj)
#pragma unroll
            for (int n = 0; n < 2; ++n) gv[bj][n] = *(const f32x4*)(gp + bj * HALF + 4 * n) * sc;
        u32x4 xc[2], xn[2];
        { const bf16_t* rowp = X + (size_t)row0 * DM + col0; xc[0] = *(const u32x4*)rowp; xc[1] = *(const u32x4*)(rowp + HALF); xn[0] = xc[0]; xn[1] = xc[1]; }
#pragma unroll
        for (int g = 0; g < 8; ++g) { const int ai = g >> 2, m = g & 3;
            bf16_t* rowp = X + (size_t)(row0 + ai * HALF + m * 16) * DM + col0;
            if (g < 7) { const bf16_t* nrow = X + (size_t)(row0 + ((g + 1) >> 2) * HALF + ((g + 1) & 3) * 16) * DM + col0; xn[0] = *(const u32x4*)nrow; xn[1] = *(const u32x4*)(nrow + HALF); }
            asm volatile("" ::: "memory");
#pragma unroll
            for (int bj = 0; bj < 2; ++bj) { const u32x4 w = xc[bj];
                const f32x4 a = xun4((u32x2){w.x, w.y}) + gv[bj][0] * acc[ai][bj][m][0], b = xun4((u32x2){w.z, w.w}) + gv[bj][1] * acc[ai][bj][m][1];
                const u32x2 pa = xpk4(a), pb = xpk4(b);
                *(u32x4*)(rowp + bj * HALF) = (u32x4){pa.x, pa.y, pb.x, pb.y}; }
            asm volatile("" ::: "memory");
            xc[0] = xn[0]; xc[1] = xn[1]; }
    }
};
struct EpiLogits {
    static constexpr bool PERM = false; static constexpr bool WIDE16 = false;
    float* LG0; float* LG12; const float* rb;
    struct Pre {}; static constexpr bool HAS_BIAS = false;
    __device__ __forceinline__ void operator()(const f32x4 (&acc)[2][2][4][2], const Unit& u, int wr, int wc, int fr, int fq, const Pre& pre) const {
        if (wc != 0) return;
        const int row0 = u.pm * BM + wr * 64 + fr;
        float* LG = u.aux == 0 ? LG0 : LG12 + (size_t)(u.aux - 1) * TT * 32;
        const float bs = u.aux == 0 ? 1.0f : 0.0f;
        const f32x4 b0 = *(const f32x4*)(rb + 4 * fq) * bs, b1 = *(const f32x4*)(rb + 16 + 4 * fq) * bs;
#pragma unroll
        for (int ai = 0; ai < 2; ++ai)
#pragma unroll
            for (int m = 0; m < 4; ++m) { float* rowp = LG + (size_t)(row0 + ai * HALF + m * 16) * 32 + 4 * fq;
                *(f32x4*)rowp = acc[ai][0][m][0] + b0; *(f32x4*)(rowp + 16) = acc[ai][0][m][1] + b1; }
    }
};
struct EpiSwiglu {
    static constexpr bool PERM = true; static constexpr bool WIDE16 = false;
    unsigned char* O; const float* b1l;
    struct Pre { const LAS float* b; };
    static constexpr bool HAS_BIAS = true;
    __device__ __forceinline__ float bias_of(const Unit& u, int i) const { return b1l[(size_t)u.aux * 2048 + (i < 128 ? u.pn * HALF + i : 1024 + u.pn * HALF + (i - 128))]; }
    __device__ __forceinline__ void operator()(const f32x4 (&acc)[2][2][4][2], const Unit& u, int wr, int wc, int fr, int fq, const Pre& pre) const {
        const int row0 = u.pm * BM + wr * 64 + fr, cg = u.pn * HALF + wc * 32 + 8 * fq;
        f32x4 bg[2], bl[2];
#pragma unroll
        for (int n = 0; n < 2; ++n) { bg[n] = *(const LAS f32x4*)(pre.b + wc * 32 + 8 * fq + 4 * n); bl[n] = *(const LAS f32x4*)(pre.b + 128 + wc * 32 + 8 * fq + 4 * n) + 1.0f; }
#pragma unroll
        for (int ai = 0; ai < 2; ++ai)
#pragma unroll
            for (int mp = 0; mp < 2; ++mp) { unsigned wx[2], wy[2];
#pragma unroll
                for (int mm = 0; mm < 2; ++mm) { const int m = 2 * mp + mm; f32x4 r[2];
#pragma unroll
                    for (int n = 0; n < 2; ++n) { const f32x4 k4 = {1.0f / W8_SCALE, 1.0f / W8_SCALE, 1.0f / W8_SCALE, 1.0f / W8_SCALE};
                        f32x4 g = __builtin_elementwise_fma(acc[ai][0][m][n], k4, bg[n]), l = __builtin_elementwise_fma(acc[ai][1][m][n], k4, bl[n]);
#pragma unroll
                        for (int j = 0; j < 4; ++j) { g[j] = fminf(g[j], 7.0f); l[j] = fminf(fmaxf(l[j], -6.0f), 8.0f); }
                        f32x4 t = g * (-1.702f * LOG2E);
#pragma unroll
                        for (int j = 0; j < 4; ++j) t[j] = __builtin_amdgcn_exp2f(t[j]);
                        t = t + 1.0f;
#pragma unroll
                        for (int j = 0; j < 4; ++j) t[j] = __builtin_amdgcn_rcpf(t[j]);
                        r[n] = (g * t) * l; }
                    wx[mm] = cvt4_fp8(r[0][0], r[0][1], r[0][2], r[0][3]); wy[mm] = cvt4_fp8(r[1][0], r[1][1], r[1][2], r[1][3]); }
                swap16(wx[0], wx[1]); swap16(wy[0], wy[1]);
                unsigned char* rowp = O + (size_t)(row0 + ai * HALF + (2 * mp + (fq & 1)) * 16) * DEXP + (cg - 8 * (fq & 1));
                *(u32x4*)rowp = (u32x4){wx[0], wy[0], wx[1], wy[1]}; }
    }
};
struct EpiGate {
    static constexpr bool PERM = true; static constexpr bool WIDE16 = true;
    unsigned char* O; const float* b2l;
    struct Pre { const LAS float* b; };
    static constexpr bool HAS_BIAS = true;
    __device__ __forceinline__ float bias_of(const Unit& u, int i) const { return b2l[(size_t)u.aux * 1024 + u.pn * BM + i]; }
    __device__ __forceinline__ void operator()(const f32x4 (&acc)[2][2][4][2], const Unit& u, int wr, int wc, int fr, int fq, const Pre& pre) const {
        const int row0 = u.pm * BM + wr * 64 + fr, col0 = u.pn * BM + wc * 64 + 16 * fq;
        f32x4 bv[2][2];
#pragma unroll
        for (int bj = 0; bj < 2; ++bj)
#pragma unroll
            for (int n = 0; n < 2; ++n) bv[bj][n] = *(const LAS f32x4*)(pre.b + wc * 64 + 16 * fq + 8 * bj + 4 * n) * YS_SCALE;
#pragma unroll
        for (int ai = 0; ai < 2; ++ai)
#pragma unroll
            for (int m = 0; m < 4; ++m) { unsigned char* rowp = O + (size_t)(col0 >> 6) * ((size_t)MAXSLOT * 64) + (size_t)(row0 + ai * HALF + m * 16) * 64 + (col0 & 63);
                u32x4 w;
                { const f32x4 v = acc[ai][0][m][0] * (YS_SCALE / W8_SCALE) + bv[0][0]; w.x = cvt4_fp8(v[0], v[1], v[2], v[3]); }
                { const f32x4 v = acc[ai][0][m][1] * (YS_SCALE / W8_SCALE) + bv[0][1]; w.y = cvt4_fp8(v[0], v[1], v[2], v[3]); }
                { const f32x4 v = acc[ai][1][m][0] * (YS_SCALE / W8_SCALE) + bv[1][0]; w.z = cvt4_fp8(v[0], v[1], v[2], v[3]); }
                { const f32x4 v = acc[ai][1][m][1] * (YS_SCALE / W8_SCALE) + bv[1][1]; w.w = cvt4_fp8(v[0], v[1], v[2], v[3]); }
                *(u32x4*)rowp = w; }
    }
};

template <class Epi, class Sched, bool FP8 = false, bool GATHER = false>
__device__ __forceinline__ void gemm_phase(LAS unsigned char* lds, const int K, const size_t lda2, const size_t ldb2, const Sched& S, const Epi& E) {
    const int tid = opaque_tid(), wid = __builtin_amdgcn_readfirstlane(tid >> 6), lane = tid & 63, wr = wid >> 2, wc = wid & 3, fr = lane & 15, fq = lane >> 4;
    int nt = K / BK; asm volatile("" : "+s"(nt));
    unsigned voffA[2], voffB[2];
#pragma unroll
    for (int i = 0; i < 2; ++i) { int R, C; stage_rc(tid * 16 + i * 8192, R, C); int Rb = Epi::PERM ? ((R & ~31) + perm32(R & 31)) : R;
        if constexpr (Epi::WIDE16) Rb = (Rb >> 5) * 64 + ((Rb >> 3) & 3) * 16 + (Rb & 7);
        voffA[i] = (unsigned)(R * (unsigned)lda2 + C * 2u); voffB[i] = (unsigned)(Rb * (unsigned)ldb2 + C * 2u); }
    const unsigned kstep = (unsigned)(BK * 2);
    const unsigned hstepA = (unsigned)(HALF * lda2), hstepB = (unsigned)((Epi::WIDE16 ? 8 : HALF) * ldb2);
    const unsigned ldsw = (unsigned)wid * 1024u;
    const int aoff = lds_byte(wr * 64 + fr, fq * 8), boff = lds_byte(wc * 32 + fr, fq * 8);
    const __amdgpu_buffer_rsrc_t rsA = __builtin_amdgcn_make_buffer_rsrc((void*)S.baseA(), 0, 0x7fffffff, 0x00020000);
    const __amdgpu_buffer_rsrc_t rsB = __builtin_amdgcn_make_buffer_rsrc((void*)S.baseB(), 0, 0x7fffffff, 0x00020000);
#define PG8_SA(b, h) (((b) * 2 + (h)) * HTB)
#define PG8_SB(b, h) ((4 + (b) * 2 + (h)) * HTB)
#define PG8_STAGE(bufoff, rs, soff, voff) do { _Pragma("unroll") for (int _i = 0; _i < 2; ++_i) \
        __builtin_amdgcn_raw_ptr_buffer_load_lds(rs, (LAS unsigned*)(lds + (bufoff) + ldsw + _i * 8192), 16, (voff)[_i], (soff), 0, 0); } while (0)
#define PG8_STAGEA(b, h, aoffs, koff, nx) do { if constexpr (GATHER) { _Pragma("unroll") for (int _i = 0; _i < 2; ++_i) \
            __builtin_amdgcn_raw_ptr_buffer_load_lds(rsA, (LAS unsigned*)(lds + PG8_SA(b, h) + ldsw + _i * 8192), 16, (nx) ? ngvo[h][_i] : gvo[h][_i], (koff), 0, 0); } \
        else PG8_STAGE(PG8_SA(b, h), rsA, (aoffs) + (h) * hstepA, voffA); } while (0)
#define PG8_RD8(off) __builtin_shufflevector(*(const LAS v4i_t*)(lds + (off)), *(const LAS v4i_t*)(lds + (off) + 1024), 0, 1, 2, 3, 4, 5, 6, 7)
#define PG8_LDA(dst, b, h) do { if constexpr (FP8) { _Pragma("unroll") for (int m = 0; m < 4; ++m) dst##8[m] = PG8_RD8(PG8_SA(b, h) + aoff + m * 2048); } \
        else { _Pragma("unroll") for (int m = 0; m < 4; ++m) _Pragma("unroll") for (int k = 0; k < 2; ++k) dst[m][k] = *(const LAS bf16x8*)(lds + PG8_SA(b, h) + aoff + m * 2048 + k * 1024); } } while (0)
#define PG8_LDB(dst, b, h) do { if constexpr (FP8) { _Pragma("unroll") for (int n = 0; n < 2; ++n) dst##8[n] = PG8_RD8(PG8_SB(b, h) + boff + n * 2048); } \
        else { _Pragma("unroll") for (int n = 0; n < 2; ++n) _Pragma("unroll") for (int k = 0; k < 2; ++k) dst[n][k] = *(const LAS bf16x8*)(lds + PG8_SB(b, h) + boff + n * 2048 + k * 1024); } } while (0)
#define PG8_MMA(ai, bj, At, Bt, Z) do { __builtin_amdgcn_s_setprio(1); \
        if (Z) { _Pragma("unroll") for (int m = 0; m < 4; ++m) _Pragma("unroll") for (int n = 0; n < 2; ++n) { \
            if constexpr (FP8) asm volatile("s_nop 1\n\tv_mfma_scale_f32_16x16x128_f8f6f4 %0, %1, %2, 0, %3, %3 op_sel_hi:[0,0,0]" : "=&v"(acc[ai][bj][m][n]) : "v"(Bt##8[n]), "v"(At##8[m]), "v"(sc1)); \
            else { acc[ai][bj][m][n] = __builtin_amdgcn_mfma_f32_16x16x32_bf16(Bt[n][0], At[m][0], (f32x4){0.f, 0.f, 0.f, 0.f}, 0, 0, 0); \
                   acc[ai][bj][m][n] = __builtin_amdgcn_mfma_f32_16x16x32_bf16(Bt[n][1], At[m][1], acc[ai][bj][m][n], 0, 0, 0); } } } \
        else { _Pragma("unroll") for (int m = 0; m < 4; ++m) _Pragma("unroll") for (int n = 0; n < 2; ++n) { \
            if constexpr (FP8) asm volatile("s_nop 1\n\tv_mfma_scale_f32_16x16x128_f8f6f4 %0, %1, %2, %0, %3, %3 op_sel_hi:[0,0,0]" : "+v"(acc[ai][bj][m][n]) : "v"(Bt##8[n]), "v"(At##8[m]), "v"(sc1)); \
            else { _Pragma("unroll") for (int k = 0; k < 2; ++k) acc[ai][bj][m][n] = __builtin_amdgcn_mfma_f32_16x16x32_bf16(Bt[n][k], At[m][k], acc[ai][bj][m][n], 0, 0, 0); } } } \
        __builtin_amdgcn_s_setprio(0); } while (0)
#define PG8_WAIT_V(n) asm volatile("s_waitcnt vmcnt(" #n ")" ::: "memory")
#define PG8_WAIT_L(n) asm volatile("s_waitcnt lgkmcnt(" #n ")" ::: "memory")
#define PG8_BAR __builtin_amdgcn_s_barrier()
#define PG8_SCHED __builtin_amdgcn_sched_barrier(0)
    Unit cur, nxt; int ui = 0; typename Epi::Pre pre;
    if (!S.next(0, cur)) return;
    f32x4 acc[2][2][4][2];
#pragma unroll
    for (int a = 0; a < 2; ++a)
#pragma unroll
        for (int b = 0; b < 2; ++b)
#pragma unroll
            for (int m = 0; m < 4; ++m)
#pragma unroll
                for (int n = 0; n < 2; ++n) acc[a][b][m][n] = (f32x4){0.f, 0.f, 0.f, 0.f};
    bf16x8 At[4][2], B0[2][2], B1[2][2];
    v8i_t At8[4], B08[2], B18[2];
    int sc1 = 0x7f7f7f7f; asm volatile("" : "+v"(sc1));
    unsigned cA = cur.a, cB = cur.b;
    unsigned gvo[2][2] = {{0u, 0u}, {0u, 0u}}, ngvo[2][2] = {{0u, 0u}, {0u, 0u}};
    int gR[2], gC[2];
#pragma unroll
    for (int i = 0; i < 2; ++i) stage_rc(tid * 16 + i * 8192, gR[i], gC[i]);
#define PG8_GLOAD(dst, pm_) do { if constexpr (GATHER) { const int* tb_ = S.gather() + (pm_) * BM; \
        _Pragma("unroll") for (int h_ = 0; h_ < 2; ++h_) _Pragma("unroll") for (int i_ = 0; i_ < 2; ++i_) dst[h_][i_] = (unsigned)tb_[h_ * HALF + gR[i_]] * (unsigned)lda2 + (unsigned)gC[i_] * 2u; } } while (0)
    PG8_GLOAD(gvo, cur.pm);
    PG8_STAGE(PG8_SB(0, 0), rsB, cB, voffB); PG8_STAGE(PG8_SB(0, 1), rsB, cB + hstepB, voffB); PG8_STAGEA(0, 0, cA, 0u, false); PG8_STAGEA(0, 1, cA, 0u, false);
    if (wr == 1) PG8_BAR;
    PG8_WAIT_V(2); PG8_BAR;
    PG8_STAGE(PG8_SB(1, 0), rsB, cB + kstep, voffB); PG8_STAGEA(1, 0, cA + kstep, kstep, false); PG8_STAGE(PG8_SB(1, 1), rsB, cB + hstepB + kstep, voffB);
    PG8_WAIT_V(6); PG8_BAR;
    for (;;) {
        const bool has_next = S.next(ui + 1, nxt);
        const unsigned nA = has_next ? nxt.a : cA, nB = has_next ? nxt.b : cB;
        LAS int* gl = (LAS int*)(lds + LDSCTL_OFF + 8192) + (ui & 1) * 256;
        for (int t = 0; t < nt; t += 2) {
            const bool last = (t == nt - 2), z0 = (t == 0);
            int gstage = 0;
            if constexpr (GATHER) {
                if (t == 0 && has_next) { int tz = threadIdx.x; asm volatile("" : "+v"(tz)); gstage = S.gather()[nxt.pm * BM + (tz & 255)]; }
                if (last) { if (has_next) { _Pragma("unroll") for (int h_ = 0; h_ < 2; ++h_) _Pragma("unroll") for (int i_ = 0; i_ < 2; ++i_) ngvo[h_][i_] = (unsigned)gl[h_ * HALF + gR[i_]] * (unsigned)lda2 + (unsigned)gC[i_] * 2u; }
                            else { _Pragma("unroll") for (int h_ = 0; h_ < 2; ++h_) _Pragma("unroll") for (int i_ = 0; i_ < 2; ++i_) ngvo[h_][i_] = gvo[h_][i_]; } } }
            float bstage = 0.f;
            if constexpr (Epi::HAS_BIAS) { if (last) { int tz = threadIdx.x; asm volatile("" : "+v"(tz)); bstage = E.bias_of(cur, tz & 255); } }
            const unsigned a1 = cA + (unsigned)(t + 1) * kstep, k1 = (unsigned)(t + 1) * kstep;
            const unsigned a2 = last ? nA : cA + (unsigned)(t + 2) * kstep, b2 = last ? nB : cB + (unsigned)(t + 2) * kstep, k2 = last ? 0u : (unsigned)(t + 2) * kstep;
            const unsigned a3 = a2 + kstep, b3 = b2 + kstep, k3 = k2 + kstep;
            PG8_LDB(B0, 0, 0); PG8_LDB(B1, 0, 1); PG8_SCHED; PG8_LDA(At, 0, 0); PG8_STAGEA(1, 1, a1, k1, false);
            PG8_WAIT_V(8); PG8_WAIT_L(0); PG8_BAR; PG8_MMA(0, 0, At, B0, z0); PG8_MMA(0, 1, At, B1, z0); PG8_BAR; PG8_SCHED;
            PG8_LDA(At, 0, 1); PG8_STAGE(PG8_SB(0, 0), rsB, b2, voffB); PG8_STAGE(PG8_SB(0, 1), rsB, b2 + hstepB, voffB); PG8_STAGEA(0, 0, a2, k2, last);
            PG8_WAIT_V(8); PG8_WAIT_L(0); PG8_BAR; PG8_MMA(1, 0, At, B0, z0); PG8_MMA(1, 1, At, B1, z0); PG8_BAR; PG8_SCHED;
            if constexpr (Epi::HAS_BIAS) { if (last) { int tz = threadIdx.x; asm volatile("" : "+v"(tz)); if (tz < 256) ((LAS float*)(lds + LDSCTL_OFF + 2048 + (ui & 1) * 1024))[tz] = bstage; } }
            PG8_LDB(B0, 1, 0); PG8_LDB(B1, 1, 1); PG8_SCHED; PG8_LDA(At, 1, 0); PG8_STAGEA(0, 1, a2, k2, last);
            PG8_WAIT_V(8); PG8_WAIT_L(0); PG8_BAR; PG8_MMA(0, 0, At, B0, false); PG8_MMA(0, 1, At, B1, false); PG8_BAR; PG8_SCHED;
            PG8_LDA(At, 1, 1); PG8_STAGE(PG8_SB(1, 0), rsB, b3, voffB); PG8_STAGE(PG8_SB(1, 1), rsB, b3 + hstepB, voffB); PG8_STAGEA(1, 0, a3, k3, last);
            PG8_WAIT_V(8); PG8_WAIT_L(0); PG8_BAR; PG8_MMA(1, 0, At, B0, false); PG8_MMA(1, 1, At, B1, false); PG8_BAR; PG8_SCHED;
            if constexpr (GATHER) { if (t == 0 && has_next) { int tz = threadIdx.x; asm volatile("" : "+v"(tz)); if (tz < 256) gl[tz] = gstage; } }
        }
        if constexpr (FP8) asm volatile("s_nop 15\n\ts_nop 7" ::: "memory");
        if (wr == 0) PG8_BAR;
        { int tz = threadIdx.x; asm volatile("" : "+v"(tz)); const int ln = tz & 63;
          if constexpr (Epi::HAS_BIAS) pre.b = (const LAS float*)(lds + LDSCTL_OFF + 2048 + (ui & 1) * 1024);
          E(acc, cur, wr, wc, ln & 15, ln >> 4, pre); }
        if (!has_next) break;
        cur = nxt; cA = nA; cB = nB; ++ui;
        if constexpr (GATHER) { _Pragma("unroll") for (int h_ = 0; h_ < 2; ++h_) _Pragma("unroll") for (int i_ = 0; i_ < 2; ++i_) gvo[h_][i_] = ngvo[h_][i_]; }
        if (wr == 1) PG8_BAR;
    }
    PG8_WAIT_V(0);
    PG8_BAR;
#undef PG8_SA
#undef PG8_SB
#undef PG8_STAGE
#undef PG8_STAGEA
#undef PG8_GLOAD
#undef PG8_LDA
#undef PG8_LDB
#undef PG8_MMA
#undef PG8_RD8
#undef PG8_WAIT_V
#undef PG8_WAIT_L
#undef PG8_BAR
#undef PG8_SCHED
}
}

__device__ __forceinline__ u32x4 rope_chunk(u32x4 xw, u32x4 yw, const f32x2* tab, bool first) {
    u32x4 o;
#pragma unroll
    for (int i = 0; i < 4; ++i) {
        const f32x2 cs0 = tab[2 * i], cs1 = tab[2 * i + 1];
        const float x0 = bflo(xw[i]), x1 = bfhi(xw[i]), y0 = bflo(yw[i]), y1 = bfhi(yw[i]);
        const float r0 = first ? x0 * cs0.x - y0 * cs0.y : x0 * cs0.x + y0 * cs0.y;
        const float r1 = first ? x1 * cs1.x - y1 * cs1.y : x1 * cs1.x + y1 * cs1.y;
        o[i] = pk2(r0, r1);
    }
    return o;
}

namespace att {
constexpr int KCS = 1040;
constexpr int KSLOT = 12544, VSLOT = 8192;
constexpr int OFF_K = 0, OFF_V = 4 * KSLOT, OFF_WSF = OFF_V + 4 * VSLOT, OFF_OST = OFF_WSF + 2048, OFF_BIAS = OFF_OST + 32768, ATT_LDS = OFF_BIAS + 2048;
static_assert(ATT_LDS <= ARENA_BYTES, "attention LDS map");
__device__ __forceinline__ int crow(int r, int hi) { return (r & 3) + 8 * (r >> 2) + 4 * hi; }
__device__ __forceinline__ unsigned cvtpk(float lo, float hi) { typedef __bf16 bf16x2_t __attribute__((ext_vector_type(2))); f32x2 v = {lo, hi}; bf16x2_t b = __builtin_convertvector(v, bf16x2_t); return __builtin_bit_cast(unsigned, b); }
__device__ __forceinline__ s16x4 vtr(const LAS unsigned char* p) { return __builtin_bit_cast(s16x4, __builtin_amdgcn_ds_read_tr16_b64_v4i16((LAS s16x4*)p)); }
constexpr float NEGBIG = -1e30f;
__device__ __forceinline__ void pair32(float x, float& a, float& b) {
    unsigned u = __builtin_bit_cast(unsigned, x), v = u;
    asm volatile("s_nop 1\n\tv_permlane32_swap_b32 %0, %1\n\ts_nop 1" : "+v"(u), "+v"(v));
    a = __builtin_bit_cast(float, u); b = __builtin_bit_cast(float, v);
}

__device__ __forceinline__ unsigned xlane32(unsigned x, bool lo) {
    unsigned u = x, v = x;
    asm volatile("s_nop 1\n\tv_permlane32_swap_b32 %0, %1\n\ts_nop 1" : "+v"(u), "+v"(v));
    return lo ? v : u;
}
struct UMla {
    static constexpr int NKC = 12; static constexpr bool PLAIN = true; static constexpr bool SIDED = false;
    const bf16_t* QB; const bf16_t* KVB; const bf16_t* PB; bf16_t* AO; const f32x2* R32; int b, h, qblk; bool ctxq;
    template <int NKS> __device__ __forceinline__ void qfix(bf16x8 (&qr)[NKS], int wid, int r32, int hi) const {
        if (ctxq) return;
        const int t = 256 * qblk + 32 * wid + r32, prow = t >> 6, pcol = t & 63;
#pragma unroll
        for (int f = 0; f < 2; ++f) { const u32x4 own = __builtin_bit_cast(u32x4, qr[4 + f]); u32x4 oth;
            oth.x = xlane32(own.x, hi == 0); oth.y = xlane32(own.y, hi == 0); oth.z = xlane32(own.z, hi == 0); oth.w = xlane32(own.w, hi == 0);
            qr[4 + f] = __builtin_bit_cast(bf16x8, rope_chunk(own, oth, R32 + (f == 0 ? prow : pcol) * 8, hi == 0)); }
    }
    __device__ __forceinline__ float c2() const { return 0.10206207261596577f * LOG2E; }
    __device__ __forceinline__ int ntiles() const { return ctxq ? 4 : 132; }
    __device__ __forceinline__ bool active(int, int) const { return true; }
    __device__ __forceinline__ size_t krow(int t, int key) const { return ctxq ? (size_t)(TL + b * CTXL + 64 * t + key) : (t < 128 ? (size_t)(b * SEQ + 64 * t + key) : (size_t)(TL + b * CTXL + 64 * (t - 128) + key)); }
    __device__ __forceinline__ unsigned kofs() const { return (unsigned)WS_KVB + 256u * h; }  __device__ __forceinline__ unsigned kpitch() const { return 2048u; }
    __device__ __forceinline__ unsigned k2ofs() const { return (unsigned)WS_PB + 3584u; }     __device__ __forceinline__ unsigned k2pitch() const { return 2u * EV_LD; }
    __device__ __forceinline__ unsigned vofs() const { return (unsigned)WS_KVB + 256u * h + 128u; } __device__ __forceinline__ unsigned vpitch() const { return 2048u; }
    __device__ __forceinline__ unsigned trow(int t) const { return (unsigned)krow(t, 0); }
    __device__ __forceinline__ size_t qrow(int wid, int r) const { return ctxq ? (size_t)(TL + b * CTXL + 32 * wid + r) : (size_t)(b * SEQ + 256 * qblk + 32 * wid + r); }
    __device__ __forceinline__ const bf16_t* qptr(int wid, int r) const { return QB + qrow(wid, r) * 768 + 96 * h; }
    __device__ __forceinline__ unsigned char* optr(int wid, int r) const { return (unsigned char*)AO + qrow(wid, r) * 1024 + 512 + 64 * h; }
    __device__ __forceinline__ float m0(int) const { return NEGBIG; }
    __device__ __forceinline__ float l0() const { return 0.f; }
    __device__ __forceinline__ void prep(LAS unsigned char*) const {}
    __device__ __forceinline__ float adjust(int, int, int, int, float s, const LAS unsigned char*) const { return s; }
};
struct UWin {
    static constexpr int NKC = 8; static constexpr bool PLAIN = false; static constexpr bool SIDED = false;
    const bf16_t* PB; bf16_t* AO; const float* sink; int b, kvh, j; bool ctxq; int tlo, nlat;
    template <int NKS> __device__ __forceinline__ void qfix(bf16x8 (&)[NKS], int, int, int) const {}
    __device__ __forceinline__ void init() { tlo = j - 2 < 0 ? 0 : j - 2; const int thi = j + 2 > 127 ? 127 : j + 2; nlat = ctxq ? 0 : thi - tlo + 1; }
    __device__ __forceinline__ float c2() const { return 0.125f * LOG2E; }
    __device__ __forceinline__ int ntiles() const { return nlat + 4; }
    __device__ __forceinline__ bool active(int, int) const { return true; }
    __device__ __forceinline__ size_t krow(int t, int key) const { return t < nlat ? (size_t)(b * SEQ + 64 * (tlo + t) + key) : (size_t)(TL + b * CTXL + 64 * (t - nlat) + key); }
    __device__ __forceinline__ unsigned kofs() const { return (unsigned)WS_PB + 2u * (512 + 64 * kvh); }  __device__ __forceinline__ unsigned kpitch() const { return 2u * EV_LD; }
    __device__ __forceinline__ unsigned k2ofs() const { return 0u; }  __device__ __forceinline__ unsigned k2pitch() const { return 0u; }
    __device__ __forceinline__ unsigned vofs() const { return (unsigned)WS_PB + 2u * (640 + 64 * kvh); }  __device__ __forceinline__ unsigned vpitch() const { return 2u * EV_LD; }
    __device__ __forceinline__ unsigned trow(int t) const { return (unsigned)krow(t, 0); }
    __device__ __forceinline__ int qpos(int wid, int r) const { return 64 * j + 32 * (wid >> 2) + r; }
    __device__ __forceinline__ size_t qrow(int wid, int r) const { return ctxq ? (size_t)(TL + b * CTXL + qpos(wid, r)) : (size_t)(b * SEQ + qpos(wid, r)); }
    __device__ __forceinline__ const bf16_t* qptr(int wid, int r) const { return PB + qrow(wid, r) * EV_LD + 64 * (4 * kvh + (wid & 3)); }
    __device__ __forceinline__ unsigned char* optr(int wid, int r) const { return (unsigned char*)AO + qrow(wid, r) * 1024 + 64 * (4 * kvh + (wid & 3)); }
    __device__ __forceinline__ float m0(int wid) const { return sink[4 * kvh + (wid & 3)] * LOG2E; }
    __device__ __forceinline__ float l0() const { return 1.f; }
    __device__ __forceinline__ void prep(LAS unsigned char*) const {}
    __device__ __forceinline__ void adjust_tile(f32x16& P0, f32x16& P1, int t, int wid, int r32, int hi, float c2, const LAS unsigned char*, int) const {
        const int tt = tlo + t;
        if (t >= nlat || (tt > j - 2 && tt < j + 2)) {
#pragma unroll
            for (int r = 0; r < 16; ++r) { P0[r] *= c2; P1[r] *= c2; }
        } else { const int dq = qpos(wid, r32) - 64 * (tlo + t) - 4 * hi + 128;
#pragma unroll
            for (int r = 0; r < 16; ++r) { const int k0 = (r & 3) + 8 * (r >> 2);
                P0[r] = ((unsigned)(dq - k0) <= 256u) ? P0[r] * c2 : NEGBIG; P1[r] = ((unsigned)(dq - k0 - 32) <= 256u) ? P1[r] * c2 : NEGBIG; } }
    }
};
struct UNa {
    static constexpr int NKC = 8; static constexpr bool PLAIN = false; static constexpr bool SIDED = true;
    const bf16_t* PB; bf16_t* AO; const float* rpbh; int b, h, G; bool ctxq; int rlo, nlat;
    template <int NKS> __device__ __forceinline__ void qfix(bf16x8 (&)[NKS], int, int, int) const {}
    __device__ __forceinline__ void init() { int lo = 4 * G - 4; lo = lo < 0 ? 0 : (lo > 120 ? 120 : lo); int hi = 4 * G - 1; hi = hi < 0 ? 0 : (hi > 120 ? 120 : hi); rlo = lo; nlat = ctxq ? 0 : hi + 8 - lo; }
    __device__ __forceinline__ float c2() const { return 0.125f * LOG2E; }
    __device__ __forceinline__ int ntiles() const { return nlat + 4; }
    __device__ __forceinline__ int qgrow(int wid) const { return 4 * G + (wid >> 1); }
    __device__ __forceinline__ int r0w(int wid) const { int r0 = qgrow(wid) - 4; return r0 < 0 ? 0 : (r0 > 120 ? 120 : r0); }
    __device__ __forceinline__ bool active(int t, int wid) const { if (t >= nlat) return true; const int kr = rlo + t, r0 = r0w(wid); return kr >= r0 && kr < r0 + 8; }
    __device__ __forceinline__ size_t krow(int t, int key) const { return t < nlat ? (size_t)(b * SEQ + 64 * (rlo + t) + key) : (size_t)(TL + b * CTXL + 64 * (t - nlat) + key); }
    __device__ __forceinline__ unsigned kofs() const { return (unsigned)WS_PB + 2u * (1024 + 64 * h); }  __device__ __forceinline__ unsigned kpitch() const { return 2u * OD_LD; }
    __device__ __forceinline__ unsigned k2ofs() const { return 0u; }  __device__ __forceinline__ unsigned k2pitch() const { return 0u; }
    __device__ __forceinline__ unsigned vofs() const { return (unsigned)WS_PB + 2u * (2048 + 64 * h); }  __device__ __forceinline__ unsigned vpitch() const { return 2u * OD_LD; }
    __device__ __forceinline__ unsigned trow(int t) const { return (unsigned)krow(t, 0); }
    __device__ __forceinline__ size_t qrow(int wid, int r) const { return ctxq ? (size_t)(TL + b * CTXL + 32 * wid + r) : (size_t)(b * SEQ + 64 * qgrow(wid) + 32 * (wid & 1) + r); }
    __device__ __forceinline__ const bf16_t* qptr(int wid, int r) const { return PB + qrow(wid, r) * OD_LD + 64 * h; }
    __device__ __forceinline__ unsigned char* optr(int wid, int r) const { return (unsigned char*)AO + qrow(wid, r) * 1024 + 64 * h; }
    __device__ __forceinline__ float m0(int) const { return NEGBIG; }
    __device__ __forceinline__ float l0() const { return 0.f; }
    __device__ __forceinline__ void prep(LAS unsigned char* L) const {
        if (!ctxq) { LAS float* bt = (LAS float*)(L + OFF_BIAS); for (int i = opaque_tid(); i < 15 * 31; i += 512) bt[i] = rpbh[i] * LOG2E; }
    }
    __device__ __forceinline__ void adjust_tile(f32x16& P0, f32x16& P1, int t, int wid, int r32, int hi, float c2, const LAS unsigned char* L, int side) const {
        if (t >= nlat) {
#pragma unroll
            for (int r = 0; r < 16; ++r) { P0[r] *= c2; P1[r] *= c2; }
        } else { const int qc = 32 * (wid & 1) + r32; int c0 = qc - 8; c0 = c0 < 0 ? 0 : (c0 > 48 ? 48 : c0);
            const LAS float* bp = (const LAS float*)(L + OFF_BIAS) + (rlo + t - qgrow(wid) + 7) * 31 + (15 - qc + 4 * hi);
            const int kb = 4 * hi - c0;
#pragma unroll
            for (int r = 0; r < 16; ++r) { const int k0 = (r & 3) + 8 * (r >> 2);
                if (!(side == 2 && r < 12)) { const float b0 = bp[k0]; P0[r] = ((unsigned)(kb + k0) < 16u) ? P0[r] * c2 + b0 : NEGBIG; }
                if (!(side == 1 && r >= 4)) { const float b1 = bp[k0 + 32]; P1[r] = ((unsigned)(kb + k0 + 32) < 16u) ? P1[r] * c2 + b1 : NEGBIG; } } }
    }
};

__device__ __forceinline__ float fma_s(float a, float b, float c) { float r; asm("v_fma_f32 %0, %1, %2, %3" : "=v"(r) : "v"(a), "v"(b), "v"(c)); return r; }
__device__ __forceinline__ float max3f(float a, float b, float c) { float r; asm("v_max3_f32 %0, %1, %2, %3" : "=v"(r) : "v"(a), "v"(b), "v"(c)); return r; }
template <class U>
__device__ __forceinline__ void attn_unit(LAS unsigned char* L, unsigned char* wsbase, const U& u) {
    constexpr int NKC = U::NKC, NKS = NKC / 2;
    const int tid = opaque_tid(), lane = tid & 63, r32 = lane & 31, hi = lane >> 5; const int wid = __builtin_amdgcn_readfirstlane(tid >> 6);
    bf16x8 qr[NKS];
    float m = u.m0(wid), l = hi == 0 ? u.l0() : 0.f;
    f32x16 o[2];
#pragma unroll
    for (int r = 0; r < 16; ++r) { o[0][r] = 0.f; o[1][r] = 0.f; }
    const float c2 = u.c2();
    const int NT = u.ntiles();
    LAS float* wsf = (LAS float*)(L + OFF_WSF) + wid * 64;
    const LAS unsigned char* kbase = L + OFF_K + hi * KCS + r32 * 16;
    const LAS unsigned char* vbase = L + OFF_V + ((lane >> 4) & 1) * 32 + (lane & 3) * 8 + (4 * hi + ((lane & 15) >> 2)) * 64;
    const __amdgpu_buffer_rsrc_t rs = __builtin_amdgcn_make_buffer_rsrc((void*)wsbase, 0, 0x7fffffff, 0x00020000);
    const unsigned kvo = (unsigned)lane * u.kpitch(), kvo2 = (unsigned)lane * u.k2pitch(), vvo = (unsigned)(lane >> 2) * u.vpitch() + (unsigned)(lane & 3) * 16u;
    const unsigned kso = u.kofs() + 16u * wid, kso2 = u.k2ofs() + 16u * wid, vso = u.vofs() + 16u * (wid & 3) * u.vpitch() + 64u * (wid >> 2);
    const bool two = (NKC == 12) && (wid < 4);
#define ATT_DMAK(t) do { const int tc_ = (t) < NT ? (t) : NT - 1; const unsigned r0_ = u.trow(tc_); LAS unsigned char* kd_ = L + OFF_K + ((t) & 3) * KSLOT; \
        __builtin_amdgcn_raw_ptr_buffer_load_lds(rs, (LAS unsigned*)(kd_ + wid * KCS), 16, kvo, kso + r0_ * u.kpitch(), 0, 0); \
        if (two) __builtin_amdgcn_raw_ptr_buffer_load_lds(rs, (LAS unsigned*)(kd_ + (8 + wid) * KCS), 16, kvo2, kso2 + r0_ * u.k2pitch(), 0, 0); } while (0)
#define ATT_DMAV(t) do { const int tc_ = (t) < NT ? (t) : NT - 1; const unsigned r0_ = u.trow(tc_); \
        __builtin_amdgcn_raw_ptr_buffer_load_lds(rs, (LAS unsigned*)(L + OFF_V + ((t) & 3) * VSLOT + wid * 1024), 16, vvo, vso + r0_ * u.vpitch(), 0, 0); } while (0)
#define ATT_WAIT_BAR() do { if (two) asm volatile("s_waitcnt vmcnt(6)" ::: "memory"); else asm volatile("s_waitcnt vmcnt(4)" ::: "memory"); \
        __builtin_amdgcn_s_barrier(); asm volatile("" ::: "memory"); } while (0)
#define ATT_QKT(S0, S1, t) do { const LAS unsigned char* kb_ = kbase + ((t) & 3) * KSLOT; \
        _Pragma("unroll") for (int r = 0; r < 16; ++r) { S0[r] = 0.f; S1[r] = 0.f; } \
        _Pragma("unroll") for (int kh_ = 0; kh_ < 2; ++kh_) { bf16x8 kf0[NKS / 2], kf1[NKS / 2]; \
            _Pragma("unroll") for (int ks = 0; ks < NKS / 2; ++ks) { kf0[ks] = *(const LAS bf16x8*)(kb_ + (kh_ * (NKS / 2) + ks) * (2 * KCS)); kf1[ks] = *(const LAS bf16x8*)(kb_ + (kh_ * (NKS / 2) + ks) * (2 * KCS) + 512); } \
            _Pragma("unroll") for (int ks = 0; ks < NKS / 2; ++ks) { S0 = __builtin_amdgcn_mfma_f32_32x32x16_bf16(kf0[ks], qr[kh_ * (NKS / 2) + ks], S0, 0, 0, 0); S1 = __builtin_amdgcn_mfma_f32_32x32x16_bf16(kf1[ks], qr[kh_ * (NKS / 2) + ks], S1, 0, 0, 0); } } } while (0)
#define ATT_LIVE0(r, SIDE) (!((SIDE) == 2 && (r) < 12))
#define ATT_LIVE1(r, SIDE) (!((SIDE) == 1 && (r) >= 4))
#define ATT_SOFTMAX(P0, P1, T, SIDE) do { float rm; \
        if constexpr (U::PLAIN) { float a_ = max3f(P0[0], P1[0], P0[1]), b_ = max3f(P1[1], P0[2], P1[2]); \
            _Pragma("unroll") for (int r = 3; r < 15; r += 2) { a_ = max3f(a_, P0[r], P1[r]); b_ = max3f(b_, P0[r + 1], P1[r + 1]); } \
            rm = max3f(a_, b_, fmaxf(P0[15], P1[15])) * c2; } \
        else { u.adjust_tile(P0, P1, (T), wid, r32, hi, c2, L, (SIDE)); \
            if ((SIDE) == 0) { float a_ = max3f(P0[0], P1[0], P0[1]), b_ = max3f(P1[1], P0[2], P1[2]); \
                _Pragma("unroll") for (int r = 3; r < 15; r += 2) { a_ = max3f(a_, P0[r], P1[r]); b_ = max3f(b_, P0[r + 1], P1[r + 1]); } \
                rm = max3f(a_, b_, fmaxf(P0[15], P1[15])); } \
            else { float a_ = NEGBIG, b_ = NEGBIG; \
                _Pragma("unroll") for (int r = 0; r < 16; ++r) { if (ATT_LIVE0(r, SIDE)) a_ = fmaxf(a_, P0[r]); if (ATT_LIVE1(r, SIDE)) b_ = fmaxf(b_, P1[r]); } \
                rm = fmaxf(a_, b_); } } \
        { float ra, rb; pair32(rm, ra, rb); rm = fmaxf(ra, rb); } \
        const float mn = fmaxf(m, rm); alpha = __builtin_amdgcn_exp2f(m - mn); resc = __any(mn > m); m = mn; \
        float lsa = 0.f; const float nmn = -mn;       \
        if constexpr (U::PLAIN) { _Pragma("unroll") for (int r = 0; r < 16; ++r) { P0[r] = __builtin_amdgcn_exp2f(fma_s(P0[r], c2, nmn)); P1[r] = __builtin_amdgcn_exp2f(fma_s(P1[r], c2, nmn)); lsa += P0[r]; lsa += P1[r]; } } \
        else { _Pragma("unroll") for (int r = 0; r < 16; ++r) { \
                if (ATT_LIVE0(r, SIDE)) { P0[r] = __builtin_amdgcn_exp2f(P0[r] - mn); lsa += P0[r]; } else P0[r] = 0.f; \
                if (ATT_LIVE1(r, SIDE)) { P1[r] = __builtin_amdgcn_exp2f(P1[r] - mn); lsa += P1[r]; } else P1[r] = 0.f; } } \
        l = l * alpha + lsa; \
        _Pragma("unroll") for (int i = 0; i < 4; ++i) { if ((SIDE) != 2) pw[0][i] = cvtpk(P0[2 * i], P0[2 * i + 1]); pw[1][i] = cvtpk(P0[8 + 2 * i], P0[9 + 2 * i]); pw[2][i] = cvtpk(P1[2 * i], P1[2 * i + 1]); if ((SIDE) != 1) pw[3][i] = cvtpk(P1[8 + 2 * i], P1[9 + 2 * i]); } } while (0)
#define ATT_STEP(SC0, SC1, SN0, SN1, T, SIDE) do { const int t_ = (T); \
        ATT_DMAK(t_ + 3); ATT_DMAV(t_ + 2); \
        ATT_WAIT_BAR(); \
        const bool a_cur = u.active(t_, wid), a_nxt = (t_ + 1 < NT) && u.active(t_ + 1, wid); \
        float alpha = 1.f; bool resc = false; u32x4 pw[4]; \
        if (a_cur && a_nxt) { ATT_QKT(SN0, SN1, t_ + 1); ATT_SOFTMAX(SC0, SC1, t_, SIDE); } \
        else { if (a_nxt) ATT_QKT(SN0, SN1, t_ + 1); \
               if (a_cur) ATT_SOFTMAX(SC0, SC1, t_, SIDE); } \
        __builtin_amdgcn_sched_barrier(0); \
        if (a_cur) { \
            const LAS unsigned char* vb_ = vbase + (t_ & 3) * VSLOT; s16x4 vlo[2][4], vhi[2][4]; \
            _Pragma("unroll") for (int dh = 0; dh < 2; ++dh) _Pragma("unroll") for (int ks = 0; ks < 4; ++ks) { if (((SIDE) == 1 && ks == 3) || ((SIDE) == 2 && ks == 0)) continue; vlo[dh][ks] = vtr(vb_ + dh * 4096 + ks * 1024); vhi[dh][ks] = vtr(vb_ + dh * 4096 + ks * 1024 + 512); } \
            if (resc) { if (hi == 0) wsf[r32] = alpha; LDS_WAIT(); \
                _Pragma("unroll") for (int r = 0; r < 16; ++r) { const float f = wsf[crow(r, hi)]; o[0][r] *= f; o[1][r] *= f; } } \
            _Pragma("unroll") for (int dh = 0; dh < 2; ++dh) _Pragma("unroll") for (int ks = 0; ks < 4; ++ks) { if (((SIDE) == 1 && ks == 3) || ((SIDE) == 2 && ks == 0)) continue; \
                const s16x4 lo4 = vlo[dh][ks], hi4 = vhi[dh][ks]; const bf16x8 vf = {lo4[0], lo4[1], lo4[2], lo4[3], hi4[0], hi4[1], hi4[2], hi4[3]}; \
                o[dh] = __builtin_amdgcn_mfma_f32_32x32x16_bf16(__builtin_bit_cast(bf16x8, pw[ks]), vf, o[dh], 0, 0, 0); } } \
        LDS_WAIT(); __builtin_amdgcn_sched_barrier(0); } while (0)

    ATT_DMAK(0); ATT_DMAK(1); ATT_DMAV(0); ATT_DMAK(2); ATT_DMAV(1);
    { const bf16_t* qp = u.qptr(wid, r32);
#pragma unroll
      for (int ks = 0; ks < NKS; ++ks) qr[ks] = *(const bf16x8*)(qp + 16 * ks + 8 * hi); }
    u.prep(L);
    u.template qfix<NKS>(qr, wid, r32, hi);
    ATT_WAIT_BAR();
    f32x16 sA0, sA1, sB0, sB1;
#pragma unroll
    for (int r = 0; r < 16; ++r) { sA0[r] = 0.f; sA1[r] = 0.f; sB0[r] = 0.f; sB1[r] = 0.f; }
    if (u.active(0, wid)) ATT_QKT(sA0, sA1, 0);
    if constexpr (U::SIDED) { const int nl = u.nlat; int t = 0;
        if (wid & 1) { for (; t < nl; ++t) { ATT_STEP(sA0, sA1, sB0, sB1, t, 2); sA0 = sB0; sA1 = sB1; } }
        else { for (; t < nl; ++t) { ATT_STEP(sA0, sA1, sB0, sB1, t, 1); sA0 = sB0; sA1 = sB1; } }
        for (; t < NT; ++t) { ATT_STEP(sA0, sA1, sB0, sB1, t, 0); sA0 = sB0; sA1 = sB1; } }
    else { for (int t = 0; t < NT; ++t) { ATT_STEP(sA0, sA1, sB0, sB1, t, 0); sA0 = sB0; sA1 = sB1; } }
    asm volatile("s_waitcnt vmcnt(0)" ::: "memory");
#undef ATT_DMAK
#undef ATT_DMAV
#undef ATT_WAIT_BAR
#undef ATT_QKT
#undef ATT_SOFTMAX
#undef ATT_LIVE0
#undef ATT_LIVE1
#undef ATT_STEP
    { float la, lb; pair32(l, la, lb); l = la + lb; }
    if (hi == 0) wsf[32 + r32] = l;
    LDS_WAIT();
    LAS unsigned char* stg = L + OFF_OST + wid * 2048;
#pragma unroll
    for (int r = 0; r < 16; ++r) { const int orow = crow(r, hi); const float rl = __builtin_amdgcn_rcpf(wsf[32 + orow]);
        const unsigned w = __builtin_amdgcn_cvt_pk_fp8_f32(o[0][r] * rl, o[1][r] * rl, 0u, false);
        stg[orow * 64 + r32] = (unsigned char)(w & 0xffu); stg[orow * 64 + 32 + r32] = (unsigned char)((w >> 8) & 0xffu); }
    LDS_WAIT();
#pragma unroll
    for (int i = 0; i < 2; ++i) { const int row = i * 16 + (lane >> 2), ch = lane & 3; const u32x4 v = *(const LAS u32x4*)(stg + row * 64 + ch * 16); *(u32x4*)(u.optr(wid, row) + ch * 16) = v; }
    __syncthreads();
}
}

struct Args { const float* in[25]; float* out; unsigned char* ws; int ph_lo, ph_hi; };
enum InIdx { I_X = 0, I_C, I_CTX, I_CCTX, I_ADAW, I_ADAB, I_N1G, I_N2G, I_EVWIN, I_EVSINK, I_EVQNG, I_EVWUQ, I_EVKVNG, I_EVWUKV, I_EVWOUT, I_ODWIN, I_ODRPB, I_ODWOUT, I_RW, I_RB, I_W1, I_B1, I_W2, I_B2, I_FG };

struct Frame {
    LAS unsigned char* lds;
    int tid, lane, wave, vcu, G;
    float* out; unsigned char* ws;
};
__device__ __forceinline__ const float* inptr(const Frame& F, int i) {
    const volatile LAS unsigned* p = (const volatile LAS unsigned*)(F.lds + LDSCTL_OFF + 256) + 2 * i;
    const unsigned lo = __builtin_amdgcn_readfirstlane(p[0]), hi = __builtin_amdgcn_readfirstlane(p[1]);
    return (const float*)(const GAS float*)(((unsigned long long)hi << 32) | lo);
}
#define WSP(T, off) ((T*)(F.ws + (off)))
__device__ __forceinline__ void frame_tid(Frame& F) { F.tid = opaque_tid(); F.lane = F.tid & 63; F.wave = __builtin_amdgcn_readfirstlane(F.tid >> 6); }

__device__ __forceinline__ void tr_item(const float* W, int ldw, int K, int k0, int n0, bf16_t* WT, int dst_row0, LAS float* scr, int lane) {
    float wv[32];
#pragma unroll
    for (int i = 0; i < 32; ++i) wv[i] = W[(size_t)(k0 + 2 * i + (lane >> 5)) * ldw + n0 + (lane & 31)];
#pragma unroll
    for (int i = 0; i < 32; ++i) scr[(2 * i + (lane >> 5)) * 33 + (lane & 31)] = wv[i];
    LDS_WAIT(); asm volatile("" ::: "memory");
    const int c = lane & 7;
#pragma unroll
    for (int j = 0; j < 4; ++j) { const int n = (lane >> 3) + 8 * j; const LAS float* s = scr + (8 * c) * 33 + n;
        u32x4 o; o.x = pk2(s[0 * 33], s[1 * 33]); o.y = pk2(s[2 * 33], s[3 * 33]); o.z = pk2(s[4 * 33], s[5 * 33]); o.w = pk2(s[6 * 33], s[7 * 33]);
        *(u32x4*)(WT + (size_t)(dst_row0 + n) * K + k0 + 8 * c) = o; }
    LDS_WAIT(); asm volatile("" ::: "memory");
}

__device__ __forceinline__ void tr_item8(const float* W, int ldw, int K, int k0, int n0, unsigned char* WT8, int dst_row0, LAS float* scr, int lane, float scale) {
    float wv[32];
#pragma unroll
    for (int i = 0; i < 32; ++i) wv[i] = W[(size_t)(k0 + 2 * i + (lane >> 5)) * ldw + n0 + (lane & 31)];
#pragma unroll
    for (int i = 0; i < 32; ++i) scr[(2 * i + (lane >> 5)) * 33 + (lane & 31)] = wv[i] * scale;
    LDS_WAIT(); asm volatile("" ::: "memory");
    const int c = lane & 3;
#pragma unroll
    for (int j = 0; j < 2; ++j) { const int n = (lane >> 2) + 16 * j; const LAS float* s = scr + (16 * c) * 33 + n;
        u32x4 o; o.x = cvt4_fp8(s[0 * 33], s[1 * 33], s[2 * 33], s[3 * 33]); o.y = cvt4_fp8(s[4 * 33], s[5 * 33], s[6 * 33], s[7 * 33]);
        o.z = cvt4_fp8(s[8 * 33], s[9 * 33], s[10 * 33], s[11 * 33]); o.w = cvt4_fp8(s[12 * 33], s[13 * 33], s[14 * 33], s[15 * 33]);
        *(u32x4*)(WT8 + (size_t)(dst_row0 + n) * K + k0 + 16 * c) = o; }
    LDS_WAIT(); asm volatile("" ::: "memory");
}
__device__ __forceinline__ float silu_f(float c) { return c / (1.0f + __expf(-c)); }

__device__ __forceinline__ void pro_a(Frame& F) {
    frame_tid(F);
    const int gwm = F.wave * F.G + F.vcu, NGW = F.G * 8;
    for (int it = gwm; it < 4 * 96; it += NGW) {
        const int l = it / 96, col = (it % 96) * 64 + F.lane;
        float sv[5][16];
#pragma unroll
        for (int j = 0; j < 16; ++j) {
#pragma unroll
            for (int v = 0; v < 4; ++v) sv[v][j] = silu_f(inptr(F, I_C)[v * 1024 + 64 * j + F.lane]);
            sv[4][j] = silu_f(inptr(F, I_CCTX)[64 * j + F.lane]);
        }
        const float* W = inptr(F, I_ADAW) + (size_t)l * 1024 * 6144 + col;
        float acc[5] = {0.f, 0.f, 0.f, 0.f, 0.f};
#pragma unroll
        for (int j = 0; j < 16; ++j) {
            float wl[64];
#pragma unroll
            for (int ln = 0; ln < 64; ++ln) wl[ln] = W[(size_t)(64 * j + ln) * 6144];
#pragma unroll
            for (int ln = 0; ln < 64; ++ln) {
#pragma unroll
                for (int v = 0; v < 5; ++v) acc[v] += __builtin_bit_cast(float, __builtin_amdgcn_readlane(__builtin_bit_cast(int, sv[v][j]), ln)) * wl[ln];
            }
        }
        const float bb = inptr(F, I_ADAB)[l * 6144 + col];
        float* MOD = WSP(float, WS_MOD);
#pragma unroll
        for (int v = 0; v < 5; ++v) MOD[(size_t)(l * 5 + v) * 6144 + col] = acc[v] + bb;
    }
    { const int gt = blockIdx.x * 512 + F.tid;
      if (gt < 128 * 16) { const int pos = gt >> 4, i = gt & 15; const float inv = __builtin_amdgcn_exp2f(-((float)i / 16.0f) * 13.287712379549449f); const float a = (float)pos * inv; WSP(f32x2, WS_ROPE64)[gt] = (f32x2){__cosf(a), __sinf(a)}; }
      else if (gt < 128 * 16 + 128 * 8) { const int g2 = gt - 128 * 16, pos = g2 >> 3, i = g2 & 7; const float inv = __builtin_amdgcn_exp2f(-((float)i / 8.0f) * 13.287712379549449f); const float a = (float)pos * inv; WSP(f32x2, WS_ROPE32)[g2] = (f32x2){__cosf(a), __sinf(a)}; } }
    { const int nchunk = 2 * 224 * 64;
      for (int i = blockIdx.x * 512 + F.tid; i < nchunk; i += F.G * 512) { const int mi = i / (224 * 64), r = (i / 64) % 224, c = i % 64;
          *(u32x4*)(WSP(unsigned char, WS_WINE) + ((size_t)mi * 2048 + 1824 + r) * 1024 + 16 * c) = (u32x4){0u, 0u, 0u, 0u}; } }
    { bf16_t* RWT = WSP(bf16_t, WS_RWT);
      for (int i = blockIdx.x * 512 + F.tid; i < 4 * 32 * 1024; i += F.G * 512) { const int l = i >> 15, e = (i >> 10) & 31, k = i & 1023;
          const float v = inptr(F, I_RW)[((size_t)l * 1024 + k) * 32 + e]; const unsigned hi = f2bf(v); const unsigned lo = f2bf(v - __builtin_bit_cast(float, hi << 16));
          bf16_t* r = RWT + ((size_t)l * 256 + e) * H3_LD; r[k] = (bf16_t)hi; r[1024 + k] = (bf16_t)hi; r[2048 + k] = (bf16_t)lo; }
      const int nz = 4 * 224 * (H3_LD / 8);
      for (int i = blockIdx.x * 512 + F.tid; i < nz; i += F.G * 512) { const int l = i / (224 * (H3_LD / 8)), r = (i / (H3_LD / 8)) % 224, c = i % (H3_LD / 8);
          *(u32x4*)(RWT + ((size_t)l * 256 + 32 + r) * H3_LD + 8 * c) = (u32x4){0u, 0u, 0u, 0u}; } }
    LAS float* scr = (LAS float*)(F.lds + F.wave * 16384);
    constexpr int S0 = 2 * 16 * 57, S1 = S0 + 2 * 12 * 24, S2 = S1 + 2 * 4 * 32, S3 = S2 + 2 * 16 * 32, S4 = S3 + 2 * 16 * 96, S5 = S4 + 2 * 16 * 32, S6 = S5 + 128 * 16 * 64, S7 = S6 + 128 * 16 * 32;
    const int gw = F.vcu * 8 + F.wave;
    for (int it = gw; it < S7; it += NGW) {
        if (it < S0) { const int r = it, mi = r / (16 * 57), q = r % (16 * 57), kb = q / 57, nb = q % 57;
            tr_item8(inptr(F, I_EVWIN) + (size_t)mi * 1024 * EV_IN, EV_IN, 1024, 64 * kb, 32 * nb, WSP(unsigned char, WS_WINE) + (size_t)mi * 2048 * 1024, 32 * nb, scr, F.lane, W8_SCALE); }
        else if (it < S1) { const int r = it - S0, mi = r / (12 * 24), q = r % (12 * 24), kb = q / 24, nb = q % 24;
            tr_item(inptr(F, I_EVWUQ) + (size_t)mi * 768 * 768, 768, 768, 64 * kb, 32 * nb, WSP(bf16_t, WS_WUQ) + (size_t)mi * 768 * 768, 32 * nb, scr, F.lane); }
        else if (it < S2) { const int r = it - S1, mi = r / (4 * 32), q = r % (4 * 32), kb = q / 32, nb = q % 32;
            tr_item(inptr(F, I_EVWUKV) + (size_t)mi * 256 * 1024, 1024, 256, 64 * kb, 32 * nb, WSP(bf16_t, WS_WUKV) + (size_t)mi * 1024 * 256, 32 * nb, scr, F.lane); }
        else if (it < S3) { const int r = it - S2, mi = r / (16 * 32), q = r % (16 * 32), kb = q / 32, nb = q % 32;
            tr_item8(inptr(F, I_EVWOUT) + (size_t)mi * 1024 * 1024, 1024, 1024, 64 * kb, 32 * nb, WSP(unsigned char, WS_WOUTE) + (size_t)mi * 1024 * 1024, 32 * nb, scr, F.lane, W8_SCALE); }
        else if (it < S4) { const int r = it - S3, mi = r / (16 * 96), q = r % (16 * 96), kb = q / 96, nb = q % 96;
            tr_item8(inptr(F, I_ODWIN) + (size_t)mi * 1024 * 3072, 3072, 1024, 64 * kb, 32 * nb, WSP(unsigned char, WS_WINO) + (size_t)mi * 3072 * 1024, 32 * nb, scr, F.lane, W8_SCALE); }
        else if (it < S5) { const int r = it - S4, mi = r / (16 * 32), q = r % (16 * 32), kb = q / 32, nb = q % 32;
            tr_item8(inptr(F, I_ODWOUT) + (size_t)mi * 1024 * 1024, 1024, 1024, 64 * kb, 32 * nb, WSP(unsigned char, WS_WOUTO) + (size_t)mi * 1024 * 1024, 32 * nb, scr, F.lane, W8_SCALE); }
        else if (it < S6) { const int r = it - S5, mi = r / (16 * 64), q = r % (16 * 64), kb = q / 64, nb = q % 64;
            const int c0 = 32 * (nb & 31), drow = (c0 >> 7) * 256 + (nb >= 32 ? 128 : 0) + (c0 & 127);
            tr_item8(inptr(F, I_W1) + (size_t)mi * 1024 * 2048, 2048, 1024, 64 * kb, 32 * nb, WSP(unsigned char, WS_W1) + (size_t)mi * 2048 * 1024, drow, scr, F.lane, W8_SCALE); }
        else { const int r = it - S6, mi = r / (16 * 32), q = r % (16 * 32), kb = q / 32, nb = q % 32;
            tr_item8(inptr(F, I_W2) + (size_t)mi * 1024 * 1024, 1024, 1024, 64 * kb, 32 * nb, WSP(unsigned char, WS_W2) + (size_t)mi * 1024 * 1024, 32 * nb, scr, F.lane, W8_SCALE); }
    }
}

__device__ __forceinline__ int mod_bidx(int row) { return row < TL ? (row >> 13) : 4; }
__device__ __forceinline__ void norm_mod_store(const f32x4 (&v)[4], int lane, const float* g, const float* shift, const float* scale, unsigned char* hrow, f32x4 (*hf)[4] = nullptr) {
    float s = 0.f;
#pragma unroll
    for (int j = 0; j < 4; ++j) s += (v[j].x * v[j].x + v[j].y * v[j].y) + (v[j].z * v[j].z + v[j].w * v[j].w);
    const float rstd = 1.0f / sqrtf(wave_sum(s) * (1.0f / DM) + NORM_EPS);
#pragma unroll
    for (int j = 0; j < 4; ++j) { const int col = 4 * lane + 256 * j;
        const f32x4 gg = *(const f32x4*)(g + col), sh = *(const f32x4*)(shift + col), sc = *(const f32x4*)(scale + col);
        const f32x4 h = (v[j] * rstd) * gg * (sc + 1.0f) + sh;
        if (hf) (*hf)[j] = h;
        *(unsigned*)(hrow + col) = cvt4_fp8(h.x, h.y, h.z, h.w); }
}

__device__ __forceinline__ void norm_mod_store_r(const f32x4 (&v)[4], int lane, const f32x4 (&gg)[4], const f32x4 (&sh)[4], const f32x4 (&sc1)[4], unsigned char* hrow) {
    float s = 0.f;
#pragma unroll
    for (int j = 0; j < 4; ++j) s += (v[j].x * v[j].x + v[j].y * v[j].y) + (v[j].z * v[j].z + v[j].w * v[j].w);
    const float rstd = 1.0f / sqrtf(wave_sum(s) * (1.0f / DM) + NORM_EPS);
#pragma unroll
    for (int j = 0; j < 4; ++j) { const int col = 4 * lane + 256 * j;
        const f32x4 h = (v[j] * rstd) * gg[j] * sc1[j] + sh[j];
        *(unsigned*)(hrow + col) = cvt4_fp8(h.x, h.y, h.z, h.w); }
}

__device__ __forceinline__ void pro_b(Frame& F) {
    frame_tid(F);
    const int gw = F.vcu * 8 + F.wave, NGW = F.G * 8, lane = F.lane;
    const float* MOD = WSP(float, WS_MOD);
    f32x4 gg[4], sh[4], sc1[4], vn[4]; int cb = -1;
#pragma unroll
    for (int j = 0; j < 4; ++j) { gg[j] = *(const f32x4*)(inptr(F, I_N1G) + 4 * lane + 256 * j); sh[j] = gg[j]; sc1[j] = gg[j]; vn[j] = gg[j]; }
#define PB_SRC(r_) ((r_) < TL ? inptr(F, I_X) + (size_t)(r_) * DM : inptr(F, I_CTX) + (size_t)((r_) - TL) * DM)
    if (gw < TT) { const float* src = PB_SRC(gw);
#pragma unroll
        for (int j = 0; j < 4; ++j) vn[j] = *(const f32x4*)(src + 4 * lane + 256 * j); }
    for (int row = gw; row < TT; row += NGW) {
        f32x4 v[4];
#pragma unroll
        for (int j = 0; j < 4; ++j) v[j] = vn[j];
        if (row + NGW < TT) { const float* src = PB_SRC(row + NGW);
#pragma unroll
            for (int j = 0; j < 4; ++j) vn[j] = *(const f32x4*)(src + 4 * lane + 256 * j); }
        const int bi = mod_bidx(row);
        if (bi != cb) { cb = bi; const float* mb = MOD + (size_t)(0 * 5 + bi) * 6144;
#pragma unroll
            for (int j = 0; j < 4; ++j) { sh[j] = *(const f32x4*)(mb + 4 * lane + 256 * j); sc1[j] = *(const f32x4*)(mb + 1024 + 4 * lane + 256 * j) + 1.0f; } }
        bf16_t* xr = WSP(bf16_t, WS_XLC) + (size_t)row * DM;
#pragma unroll
        for (int j = 0; j < 4; ++j) *(u32x2*)(xr + 4 * lane + 256 * j) = xpk4(v[j]);
        norm_mod_store_r(v, lane, gg, sh, sc1, WSP(unsigned char, WS_HB) + (size_t)row * DM);
    }
#undef PB_SRC
}

__device__ __forceinline__ u32x4 shfl_xor4(u32x4 v, int m) { u32x4 r; r.x = __shfl_xor(v.x, m); r.y = __shfl_xor(v.y, m); r.z = __shfl_xor(v.z, m); r.w = __shfl_xor(v.w, m); return r; }
__device__ __forceinline__ float ssq8(u32x4 w) { float s = 0.f;
#pragma unroll
    for (int i = 0; i < 4; ++i) { const float a = bflo(w[i]), b = bfhi(w[i]); s += a * a + b * b; } return s; }
__device__ __forceinline__ u32x4 scale8(u32x4 w, float r, const float* g) { u32x4 o; const f32x4 g0 = *(const f32x4*)g, g1 = *(const f32x4*)(g + 4);
    o.x = pk2(bflo(w.x) * r * g0.x, bfhi(w.x) * r * g0.y); o.y = pk2(bflo(w.y) * r * g0.z, bfhi(w.y) * r * g0.w);
    o.z = pk2(bflo(w.z) * r * g1.x, bfhi(w.z) * r * g1.y); o.w = pk2(bflo(w.w) * r * g1.z, bfhi(w.w) * r * g1.w); return o; }

__device__ __forceinline__ u32x4 rope_chunk_r(u32x4 xw, u32x4 yw, const f32x2 (&tab)[8], bool first) {
    u32x4 o;
#pragma unroll
    for (int i = 0; i < 4; ++i) {
        const f32x2 cs0 = tab[2 * i], cs1 = tab[2 * i + 1];
        const float x0 = bflo(xw[i]), x1 = bfhi(xw[i]), y0 = bflo(yw[i]), y1 = bfhi(yw[i]);
        const float r0 = first ? x0 * cs0.x - y0 * cs0.y : x0 * cs0.x + y0 * cs0.y;
        const float r1 = first ? x1 * cs1.x - y1 * cs1.y : x1 * cs1.x + y1 * cs1.y;
        o[i] = pk2(r0, r1);
    }
    return o;
}
__device__ __forceinline__ u32x4 scale8_r(u32x4 w, float r, f32x4 g0, f32x4 g1) { u32x4 o;
    o.x = pk2(bflo(w.x) * r * g0.x, bfhi(w.x) * r * g0.y); o.y = pk2(bflo(w.y) * r * g0.z, bfhi(w.y) * r * g0.w);
    o.z = pk2(bflo(w.z) * r * g1.x, bfhi(w.z) * r * g1.y); o.w = pk2(bflo(w.w) * r * g1.z, bfhi(w.w) * r * g1.w); return o; }

__device__ __forceinline__ void e2_pass(Frame& F, int li) {
    frame_tid(F);
    const int gw = F.vcu * 8 + F.wave, NGW = F.G * 8, lane = F.lane;
    const float* gq = inptr(F, I_EVQNG) + li * 768; const float* gkv = inptr(F, I_EVKVNG) + li * 256;
    const f32x2* R64 = WSP(f32x2, WS_ROPE64); const f32x2* R32 = WSP(f32x2, WS_ROPE32);
    const int cw = lane & 7, seg = cw >> 1, c4 = (lane >= 32 && lane < 36) ? lane - 32 : 0;
    const float* gq1p = gq + (lane >= 32 ? 8 * (lane + 64) - 768 : 0); const float* gq2p = gq + 8 * (lane + 128) - 768; const float* gkvp = gkv + (lane < 32 ? 8 * lane : 0);
    const f32x4 gq1a = *(const f32x4*)gq1p, gq1b = *(const f32x4*)(gq1p + 4), gq2a = *(const f32x4*)gq2p, gq2b = *(const f32x4*)(gq2p + 4), gkva = *(const f32x4*)gkvp, gkvb = *(const f32x4*)(gkvp + 4);
    u32x4 wn[4]; f32x2 t64n[8], t32n[8];
#define E2_LOAD(r_) do { const bf16_t* pr_ = WSP(bf16_t, WS_PB) + (size_t)(r_) * EV_LD; \
        _Pragma("unroll") for (int j = 0; j < 4; ++j) wn[j] = *(const u32x4*)(pr_ + 8 * (lane + 64 * j)); \
        const int t_ = (r_) & (SEQ - 1), prow_ = t_ >> 6, pcol_ = t_ & 63; \
        const f32x2* a_ = R64 + ((seg < 2) ? prow_ : pcol_) * 16 + (cw & 1) * 8; const f32x2* b_ = R32 + ((c4 < 2) ? prow_ : pcol_) * 8; \
        _Pragma("unroll") for (int i = 0; i < 8; ++i) { t64n[i] = a_[i]; t32n[i] = b_[i]; } } while (0)
#pragma unroll
    for (int j = 0; j < 4; ++j) wn[j] = (u32x4){0u, 0u, 0u, 0u};
#pragma unroll
    for (int i = 0; i < 8; ++i) { t64n[i] = (f32x2){0.f, 0.f}; t32n[i] = (f32x2){0.f, 0.f}; }
    if (gw < TT) E2_LOAD(gw);
    for (int row = gw; row < TT; row += NGW) {
        bf16_t* pr = WSP(bf16_t, WS_PB) + (size_t)row * EV_LD;
        u32x4 w[4]; f32x2 t64[8], t32[8];
#pragma unroll
        for (int j = 0; j < 4; ++j) w[j] = wn[j];
#pragma unroll
        for (int i = 0; i < 8; ++i) { t64[i] = t64n[i]; t32[i] = t32n[i]; }
        if (row + NGW < TT) E2_LOAD(row + NGW);
        float sq = ssq8(w[2]) + (lane >= 32 ? ssq8(w[1]) : 0.f), skv = lane < 32 ? ssq8(w[3]) : 0.f;
        const float rq = 1.0f / sqrtf(wave_sum(sq) * (1.0f / 768.0f) + NORM_EPS), rkv = 1.0f / sqrtf(wave_sum(skv) * (1.0f / 256.0f) + NORM_EPS);
        const bool lat = row < TL;
        const u32x4 y0 = shfl_xor4(w[0], 2), y1 = shfl_xor4(w[1], 2), y3 = shfl_xor4(w[3], 1);
        if (lat) { w[0] = rope_chunk_r(w[0], y0, t64, (seg & 1) == 0); if (lane < 16) w[1] = rope_chunk_r(w[1], y1, t64, (seg & 1) == 0); }
        if (lane >= 32) w[1] = scale8_r(w[1], rq, gq1a, gq1b);
        w[2] = scale8_r(w[2], rq, gq2a, gq2b);
        if (lane < 32) w[3] = scale8_r(w[3], rkv, gkva, gkvb);
        else if (lane < 36 && lat) w[3] = rope_chunk_r(w[3], y3, t32, ((lane - 32) & 1) == 0);
        if (lat) *(u32x4*)(pr + 8 * lane) = w[0];
        if (lane >= 32 || (lat && lane < 16)) *(u32x4*)(pr + 8 * (lane + 64)) = w[1];
        *(u32x4*)(pr + 8 * (lane + 128)) = w[2];
        if (lane < 32 || (lat && lane < 36)) *(u32x4*)(pr + 8 * (lane + 192)) = w[3];
    }
#undef E2_LOAD
}
__device__ __forceinline__ void m1a_pass(Frame& F, int layer) {
    frame_tid(F);
    const int gw = F.vcu * 8 + F.wave, NGW = F.G * 8, lane = F.lane;
    const float* MOD = WSP(float, WS_MOD); const float* g2 = inptr(F, I_N2G) + layer * DM;
    f32x4 gg[4], sh[4], sc1[4], vn[4]; int cb = -1;
#pragma unroll
    for (int j = 0; j < 4; ++j) { gg[j] = *(const f32x4*)(g2 + 4 * lane + 256 * j); sh[j] = gg[j]; sc1[j] = gg[j]; vn[j] = gg[j]; }
    if (gw < TT) {
#pragma unroll
        for (int j = 0; j < 4; ++j) vn[j] = xun4(*(const u32x2*)(WSP(bf16_t, WS_XLC) + (size_t)gw * DM + 4 * lane + 256 * j)); }
    for (int row = gw; row < TT; row += NGW) {
        f32x4 v[4];
#pragma unroll
        for (int j = 0; j < 4; ++j) v[j] = vn[j];
        if (row + NGW < TT) {
#pragma unroll
            for (int j = 0; j < 4; ++j) vn[j] = xun4(*(const u32x2*)(WSP(bf16_t, WS_XLC) + (size_t)(row + NGW) * DM + 4 * lane + 256 * j)); }
        const int bi = mod_bidx(row);
        if (bi != cb) { cb = bi; const float* mb = MOD + (size_t)(layer * 5 + bi) * 6144;
#pragma unroll
            for (int j = 0; j < 4; ++j) { sh[j] = *(const f32x4*)(mb + 3 * 1024 + 4 * lane + 256 * j); sc1[j] = *(const f32x4*)(mb + 4 * 1024 + 4 * lane + 256 * j) + 1.0f; } }
        float s = 0.f;
#pragma unroll
        for (int j = 0; j < 4; ++j) s += (v[j].x * v[j].x + v[j].y * v[j].y) + (v[j].z * v[j].z + v[j].w * v[j].w);
        const float rstd = 1.0f / sqrtf(wave_sum(s) * (1.0f / DM) + NORM_EPS);
        bf16_t* hr = WSP(bf16_t, WS_PB) + (size_t)row * H3_LD;
#pragma unroll
        for (int j = 0; j < 4; ++j) { const int col = 4 * lane + 256 * j;
            const f32x4 h = (v[j] * rstd) * gg[j] * sc1[j] + sh[j];
            unsigned hi[4], lo[4];
#pragma unroll
            for (int i = 0; i < 4; ++i) { hi[i] = f2bf(h[i]); lo[i] = f2bf(h[i] - __builtin_bit_cast(float, hi[i] << 16)); }
            const u32x2 wh = {hi[0] | (hi[1] << 16), hi[2] | (hi[3] << 16)}, wl = {lo[0] | (lo[1] << 16), lo[2] | (lo[3] << 16)};
            *(u32x2*)(hr + col) = wh; *(u32x2*)(hr + 1024 + col) = wl;
            *(unsigned*)(WSP(unsigned char, WS_HB) + (size_t)row * DM + col) = cvt4_fp8(h[0], h[1], h[2], h[3]); }
    }
}
__device__ __forceinline__ void m1b_gemm(Frame& F, int layer) {
    pg8::RouterOrder S; S.A = (const char*)WSP(bf16_t, WS_PB); S.Bt = (const char*)(WSP(bf16_t, WS_RWT) + (size_t)layer * 256 * H3_LD); S.lda2 = H3_LD * 2; S.ldb2 = H3_LD * 2; S.nM = TT / 256; S.G = F.G; S.c = blockIdx.x;
    pg8::EpiLogits E{WSP(float, WS_LOGIT), WSP(float, WS_LOGIT12), inptr(F, I_RB) + layer * 32};
    pg8::gemm_phase<pg8::EpiLogits, pg8::RouterOrder>(F.lds, 1024, (size_t)H3_LD * 2, (size_t)H3_LD * 2, S, E);
}
__device__ __forceinline__ void m1c_pass(Frame& F) {
    frame_tid(F);
    const int lane = F.lane, blk = blockIdx.x, CH = (TT + F.G - 1) / F.G;
    const int r0 = blk * CH, r1 = (r0 + CH < TT) ? r0 + CH : TT;
    LAS int* hist = (LAS int*)(F.lds + LDSCTL_OFF + 512);
    if (F.tid < 32) hist[F.tid] = 0;
    __syncthreads();
    const int e = lane & 31, sub = lane >> 5;
    float n0 = 0.f, n1 = 0.f, n2 = 0.f;
    { const int row = r0 + 2 * F.wave + sub; const size_t li_ = (size_t)(row < r1 ? row : r1 - 1) * 32 + e;
      n0 = WSP(float, WS_LOGIT)[li_]; n1 = WSP(float, WS_LOGIT12)[li_]; n2 = WSP(float, WS_LOGIT12)[(size_t)TT * 32 + li_]; }
    for (int rbase = r0 + 2 * F.wave; rbase < r1; rbase += 16) {
        const int row = rbase + sub; const bool ok = row < r1;
        float logit = (n0 + n1) + n2;
        { const int rn = rbase + 16 + sub; const size_t li_ = (size_t)(rn < r1 ? rn : r1 - 1) * 32 + e;
          n0 = WSP(float, WS_LOGIT)[li_]; n1 = WSP(float, WS_LOGIT12)[li_]; n2 = WSP(float, WS_LOGIT12)[(size_t)TT * 32 + li_]; }
        float tv[4]; int ti[4];
#pragma unroll
        for (int k = 0; k < 4; ++k) {
            float bv = logit; int bi = e;
#pragma unroll
            for (int o = 16; o >= 1; o >>= 1) { const float ov = __shfl_xor(bv, o); const int oi = __shfl_xor(bi, o); if (ov > bv || (ov == bv && oi < bi)) { bv = ov; bi = oi; } }
            tv[k] = bv; ti[k] = bi; if (e == bi) logit = -3.0e38f;
        }
        const float w1 = __expf(tv[1] - tv[0]), w2 = __expf(tv[2] - tv[0]), w3 = __expf(tv[3] - tv[0]); const float inv = 1.0f / (1.0f + w1 + w2 + w3);
        if (e == 0 && ok) {
            *(int4*)(WSP(int, WS_TOPE) + (size_t)row * 4) = make_int4(ti[0], ti[1], ti[2], ti[3]);
            *(f32x4*)(WSP(float, WS_TOPG) + (size_t)row * 4) = (f32x4){inv, w1 * inv, w2 * inv, w3 * inv};
            atomicAdd((int*)(hist + ti[0]), 1); atomicAdd((int*)(hist + ti[1]), 1); atomicAdd((int*)(hist + ti[2]), 1); atomicAdd((int*)(hist + ti[3]), 1);
        }
    }
    __syncthreads();
    if (F.tid < 32) WSP(int, WS_HIST)[blk * 32 + F.tid] = hist[F.tid];
    __syncthreads();
}

__device__ __forceinline__ void m2_pass(Frame& F) {
    frame_tid(F);
    const int blk = blockIdx.x, CH = (TT + F.G - 1) / F.G;
    const int r0 = blk * CH, r1 = (r0 + CH < TT) ? r0 + CH : TT, nr = r1 > r0 ? r1 - r0 : 0;
    LAS int* tot = (LAS int*)(F.lds), *bef = tot + 32, *pst = tot + 64, *ntl = tot + 96;
    LAS int* te = (LAS int*)(F.lds + 1024);
    LAS float* tg = (LAS float*)(F.lds + 1024 + 32768);
    const int* HIST = WSP(int, WS_HIST);
    if (F.tid < 64) tot[F.tid] = 0;
    __syncthreads();
    for (int i = F.tid; i < F.G * 32; i += 512) { const int h = HIST[i]; atomicAdd((int*)(tot + (i & 31)), h); if ((i >> 5) < blk) atomicAdd((int*)(bef + (i & 31)), h); }
    for (int i = F.tid; i < nr * 4; i += 512) { te[i] = WSP(int, WS_TOPE)[(size_t)r0 * 4 + i]; tg[i] = WSP(float, WS_TOPG)[(size_t)r0 * 4 + i]; }
    __syncthreads();
    if (F.tid == 0) { int ps = 0; for (int e = 0; e < 32; ++e) { pst[e] = ps; ps += (tot[e] + 255) & ~255; } ntl[0] = ps >> 8; }
    __syncthreads();
    LAS int* cnt = (LAS int*)(F.lds + 1024 + 65536);
    const int nent = nr * 4, nch = (nent + 63) >> 6;
    int myrank[4] = {0, 0, 0, 0}, myex[4] = {-1, -1, -1, -1};
#pragma unroll
    for (int q = 0; q < 4; ++q) { const int c = F.wave + 8 * q;
        if (c < nch) { const int i = 64 * c + F.lane; const int ex = i < nent ? te[i] : -1; myex[q] = ex; int rk = 0, mine = 0;
            for (int e = 0; e < 32; ++e) { const unsigned long long m = __ballot(ex == e); if (ex == e) rk = __popcll(m & ((1ull << F.lane) - 1ull)); if (F.lane == e) mine = __popcll(m); }
            myrank[q] = rk; if (F.lane < 32) cnt[c * 32 + F.lane] = mine; } }
    __syncthreads();
#pragma unroll
    for (int q = 0; q < 4; ++q) { const int c = F.wave + 8 * q; const int i = 64 * c + F.lane;
        if (c < nch && i < nent) { const int ex = myex[q]; int before = 0; for (int c2 = 0; c2 < c; ++c2) before += cnt[c2 * 32 + ex];
            const int sl = pst[ex] + bef[ex] + before + myrank[q];
            WSP(int, WS_SLOT)[(size_t)r0 * 4 + i] = sl; WSP(float, WS_GSLOT)[sl] = tg[i]; WSP(int, WS_TOKSLOT)[sl] = r0 + (i >> 2); } }
    if (blk == 0) { const int nt = ntl[0]; int* TE = WSP(int, WS_TILEEXP);
        for (int tl = F.tid; tl < nt; tl += 512) { int e = 0; for (int q = 1; q < 32; ++q) if (pst[q] <= tl * 256) e = q; TE[tl] = e; }
        if (F.tid == 0) TE[1023] = nt;
        for (int e = 0; e < 32; ++e) { const int p0 = pst[e] + tot[e], p1 = pst[e] + ((tot[e] + 255) & ~255); for (int sidx = p0 + F.tid; sidx < p1; sidx += 512) WSP(int, WS_TOKSLOT)[sidx] = 0; } }
    __syncthreads();
}

__device__ __forceinline__ void m5_pass(Frame& F, int layer) {
    frame_tid(F);
    const int gw = F.vcu * 8 + F.wave, NGW = F.G * 8, lane = F.lane;
    const float* MOD = WSP(float, WS_MOD);
    const bool last = layer == 3; const int RL = last ? TL : TT;
    f32x4 gg[4], g2v[4], sh[4], sc1[4]; int cb = -1;
    { const float* gp = last ? inptr(F, I_FG) : inptr(F, I_N1G) + (layer + 1) * DM;
#pragma unroll
      for (int j = 0; j < 4; ++j) { gg[j] = *(const f32x4*)(gp + 4 * lane + 256 * j); g2v[j] = gg[j]; sh[j] = gg[j]; sc1[j] = gg[j]; } }
    int4 sC = make_int4(0, 0, 0, 0), sN = sC; f32x4 gC = {0.f, 0.f, 0.f, 0.f}, gN = gC;
    unsigned yw[4][4], ywn[4][4]; f32x4 xv[4], xvn[4];
#pragma unroll
    for (int j = 0; j < 4; ++j) { xv[j] = gg[j]; xvn[j] = gg[j];
#pragma unroll
        for (int k = 0; k < 4; ++k) { yw[j][k] = 0u; ywn[j][k] = 0u; } }
#define M5_SLOTS(S_, G_, r_) do { S_ = *(const int4*)(WSP(int, WS_SLOT) + (size_t)(r_) * 4); G_ = *(const f32x4*)(WSP(float, WS_TOPG) + (size_t)(r_) * 4); } while (0)
#define M5_DATA(Y_, X_, S_, r_) do { const int sl_[4] = {S_.x, S_.y, S_.z, S_.w}; \
        _Pragma("unroll") for (int j = 0; j < 4; ++j) { const int col = 4 * lane + 256 * j; \
            _Pragma("unroll") for (int k = 0; k < 4; ++k) Y_[j][k] = *(const unsigned*)(WSP(unsigned char, WS_XG) + (size_t)(col >> 6) * ((size_t)MAXSLOT * 64) + (size_t)sl_[k] * 64 + (col & 63)); \
            X_[j] = xun4(*(const u32x2*)(WSP(bf16_t, WS_XLC) + (size_t)(r_) * DM + col)); } } while (0)
    if (gw < RL) { M5_SLOTS(sC, gC, gw); M5_DATA(yw, xv, sC, gw); }
    if (gw + NGW < RL) M5_SLOTS(sN, gN, gw + NGW);
    for (int row = gw; row < RL; row += NGW) {
        const f32x4 gcur = gC;
        if (row + NGW < RL) { M5_DATA(ywn, xvn, sN, row + NGW); gC = gN; }
        if (row + 2 * NGW < RL) M5_SLOTS(sN, gN, row + 2 * NGW);
        const int bi = mod_bidx(row);
        if (bi != cb) { cb = bi; const float* mb = MOD + (size_t)(layer * 5 + bi) * 6144; const float* mn = MOD + (size_t)((last ? layer : layer + 1) * 5 + bi) * 6144;
#pragma unroll
            for (int j = 0; j < 4; ++j) { const int col = 4 * lane + 256 * j; g2v[j] = *(const f32x4*)(mb + 5 * 1024 + col); sh[j] = *(const f32x4*)(mn + col); sc1[j] = *(const f32x4*)(mn + 1024 + col) + 1.0f; } }
        const float gk[4] = {gcur.x * (1.0f / YS_SCALE), gcur.y * (1.0f / YS_SCALE), gcur.z * (1.0f / YS_SCALE), gcur.w * (1.0f / YS_SCALE)};
        bf16_t* xr = WSP(bf16_t, WS_XLC) + (size_t)row * DM;
        f32x4 v[4];
#pragma unroll
        for (int j = 0; j < 4; ++j) { f32x4 y = {0.f, 0.f, 0.f, 0.f};
#pragma unroll
            for (int k = 0; k < 4; ++k) { const unsigned w = yw[j][k];
                y += (f32x4){__builtin_amdgcn_cvt_f32_fp8(w, 0), __builtin_amdgcn_cvt_f32_fp8(w, 1), __builtin_amdgcn_cvt_f32_fp8(w, 2), __builtin_amdgcn_cvt_f32_fp8(w, 3)} * gk[k]; }
            v[j] = xv[j] + g2v[j] * y; }
        if (!last) {
#pragma unroll
            for (int j = 0; j < 4; ++j) *(u32x2*)(xr + 4 * lane + 256 * j) = xpk4(v[j]);
            norm_mod_store_r(v, lane, gg, sh, sc1, WSP(unsigned char, WS_HB) + (size_t)row * DM);
        } else {
            float s = 0.f;
#pragma unroll
            for (int j = 0; j < 4; ++j) s += (v[j].x * v[j].x + v[j].y * v[j].y) + (v[j].z * v[j].z + v[j].w * v[j].w);
            const float rstd = 1.0f / sqrtf(wave_sum(s) * (1.0f / DM) + NORM_EPS);
#pragma unroll
            for (int j = 0; j < 4; ++j) { const int col = 4 * lane + 256 * j; *(f32x4*)(F.out + (size_t)row * DM + col) = (v[j] * rstd) * gg[j]; }
        }
#pragma unroll
        for (int j = 0; j < 4; ++j) { xv[j] = xvn[j];
#pragma unroll
            for (int k = 0; k < 4; ++k) yw[j][k] = ywn[j][k]; }
    }
#undef M5_SLOTS
#undef M5_DATA
}

constexpr int NPH_PAIR = 22, NPH = 2 + 2 * NPH_PAIR;

__device__ __forceinline__ void moe_gemm1(Frame& F, int layer) {
    const int* TE = WSP(int, WS_TILEEXP);
    LAS int* tel = (LAS int*)(F.lds + LDSCTL_OFF + 4096);
    { const int tz = opaque_tid(); tel[tz] = TE[tz]; tel[512 + tz] = TE[512 + tz]; __syncthreads(); }
    pg8::MoeOrder S; S.A = (const char*)WSP(unsigned char, WS_HB); S.W = (const char*)(WSP(unsigned char, WS_W1) + (size_t)layer * 32 * 2048 * 1024); S.tile_exp = tel; S.tokslot = WSP(int, WS_TOKSLOT);
    S.lda2 = 1024; S.ldb2 = 1024; S.wstride = 2048u * 1024u; S.ntiles = __builtin_amdgcn_readfirstlane(TE[1023]); S.nN = 8; S.G = F.G; S.c = blockIdx.x;
    pg8::EpiSwiglu E{WSP(unsigned char, WS_HA), inptr(F, I_B1) + (size_t)layer * 32 * 2048};
    pg8::gemm_phase<pg8::EpiSwiglu, pg8::MoeOrder, true, true>(F.lds, 512, 1024, 1024, S, E);
}
__device__ __forceinline__ void moe_gemm2(Frame& F, int layer) {
    const int* TE = WSP(int, WS_TILEEXP);
    LAS int* tel = (LAS int*)(F.lds + LDSCTL_OFF + 4096);
    { const int tz = opaque_tid(); tel[tz] = TE[tz]; tel[512 + tz] = TE[512 + tz]; __syncthreads(); }
    pg8::MoeOrder S; S.A = (const char*)WSP(unsigned char, WS_HA); S.W = (const char*)(WSP(unsigned char, WS_W2) + (size_t)layer * 32 * 1024 * 1024); S.tile_exp = tel; S.tokslot = nullptr;
    S.lda2 = 1024; S.ldb2 = 1024; S.wstride = 1024u * 1024u; S.ntiles = __builtin_amdgcn_readfirstlane(TE[1023]); S.nN = 4; S.G = F.G; S.c = blockIdx.x;
    pg8::EpiGate E{WSP(unsigned char, WS_XG), inptr(F, I_B2) + (size_t)layer * 32 * 1024};
    pg8::gemm_phase<pg8::EpiGate, pg8::MoeOrder, true>(F.lds, 512, 1024, 1024, S, E);
}
__device__ __forceinline__ void dense_gemm_bf16(Frame& F, const bf16_t* A, size_t lda2, const bf16_t* Bt, int N, int K, bf16_t* O, int ldc) {
    pg8::DenseOrder S; S.init(A, lda2, Bt, (size_t)K * 2, TT, N, F.G, blockIdx.x);
    pg8::EpiBf16 E{O, ldc, 1.0f};
    pg8::gemm_phase<pg8::EpiBf16, pg8::DenseOrder>(F.lds, K, lda2, (size_t)K * 2, S, E);
}
__device__ __forceinline__ void dense_gemm_f8(Frame& F, const unsigned char* A8, const unsigned char* Bt8, int N, int K8, bf16_t* O, int ldc) {
    pg8::DenseOrder S; S.init(A8, (size_t)K8, Bt8, (size_t)K8, TT, N, F.G, blockIdx.x);
    pg8::EpiBf16 E{O, ldc, 1.0f / W8_SCALE};
    pg8::gemm_phase<pg8::EpiBf16, pg8::DenseOrder, true>(F.lds, K8 / 2, (size_t)K8, (size_t)K8, S, E);
}
__device__ __forceinline__ void outproj_gemm(Frame& F, const unsigned char* Bt8, int layer, int nrows) {
    pg8::DenseOrder S; S.init(WSP(unsigned char, WS_AO), 1024, Bt8, 1024, nrows, 1024, F.G, blockIdx.x);
    pg8::EpiResid E{WSP(bf16_t, WS_XLC), WSP(float, WS_MOD) + (size_t)layer * 5 * 6144 + 2 * 1024, 1.0f / W8_SCALE};
    pg8::gemm_phase<pg8::EpiResid, pg8::DenseOrder, true>(F.lds, 512, 1024, 1024, S, E);
}

__global__ void __launch_bounds__(512, 2) fwd(Args args) {
    extern __shared__ __attribute__((aligned(16))) unsigned char lds_raw[];
    Frame F;
    F.lds = (LAS unsigned char*)lds_raw;
    F.tid = threadIdx.x; F.lane = F.tid & 63; F.wave = __builtin_amdgcn_readfirstlane(F.tid >> 6);
    F.G = gridDim.x; { const int bx = blockIdx.x; F.vcu = (F.G % 8 == 0) ? (bx % 8) * (F.G / 8) + bx / 8 : bx; }
    F.out = args.out; F.ws = args.ws;
    volatile LAS unsigned* MISC = (volatile LAS unsigned*)(F.lds + LDSCTL_OFF);
    if (F.tid < 64) MISC[F.tid] = 0u;
    if (F.tid < 25) { const unsigned long long pv = ((const unsigned long long*)__builtin_amdgcn_kernarg_segment_ptr())[F.tid]; MISC[64 + 2 * F.tid] = (unsigned)pv; MISC[65 + 2 * F.tid] = (unsigned)(pv >> 32); }
    __syncthreads();
    unsigned* ctl = (unsigned*)(F.ws + WS_CTL);
#if !MK_PER_PHASE
    XcdBarrier bar = xcd_barrier_post(ctl + CW_BAR, MISC + 8);
#define GRID_BAR() xcd_barrier(bar)
#else
#define GRID_BAR() do { } while (0)
#endif
    const int lo = args.ph_lo, hi = args.ph_hi;
    int pid = 0;
    enum { CNT0 = __COUNTER__ + 1 };
#ifndef PHMASK
#define PHMASK 0xFFFFFFFFull
#endif
#ifndef REPMASK
#define REPMASK 0ull
#endif
#define PHASE_BEGIN { const int site_ = __COUNTER__ - CNT0; const int nrep_ = 1 + (int)(((unsigned long long)REPMASK >> site_) & 1ull); \
    if ((((unsigned long long)PHMASK >> site_) & 1ull) && lo <= pid && pid < hi) { for (int rep_ = 0; rep_ < nrep_; ++rep_) {
#define PHASE_END if (rep_ + 1 < nrep_ || pid + 1 < hi) GRID_BAR(); } } ++pid; }

    PHASE_BEGIN pro_a(F); PHASE_END
    PHASE_BEGIN pro_b(F); PHASE_END

    for (int lp = 0; lp < 2; ++lp) {
        { const int layer = 2 * lp, li = lp;
        PHASE_BEGIN dense_gemm_f8(F, WSP(unsigned char, WS_HB), WSP(unsigned char, WS_WINE) + (size_t)li * 2048 * 1024, 2048, 1024, WSP(bf16_t, WS_PB), EV_LD); PHASE_END
        PHASE_BEGIN e2_pass(F, li); PHASE_END
        PHASE_BEGIN
            dense_gemm_bf16(F, WSP(bf16_t, WS_PB) + 768, (size_t)EV_LD * 2, WSP(bf16_t, WS_WUQ) + (size_t)li * 768 * 768, 768, 768, WSP(bf16_t, WS_QB), 768);
            dense_gemm_bf16(F, WSP(bf16_t, WS_PB) + 1536, (size_t)EV_LD * 2, WSP(bf16_t, WS_WUKV) + (size_t)li * 1024 * 256, 1024, 256, WSP(bf16_t, WS_KVB), 1024);
        PHASE_END
        PHASE_BEGIN
            for (int rr_ = 0; rr_ < 1 + (int)(((unsigned long long)REPMASK >> 40) & 1ull); ++rr_)
            for (int u = F.vcu; u < 1024 + 32; u += F.G) {
                att::UMla U; U.QB = WSP(bf16_t, WS_QB); U.KVB = WSP(bf16_t, WS_KVB); U.PB = WSP(bf16_t, WS_PB); U.AO = WSP(bf16_t, WS_AO); U.R32 = WSP(f32x2, WS_ROPE32);
                if (u < 1024) { const int bh = u >> 5; U.b = bh >> 3; U.h = bh & 7; U.qblk = u & 31; U.ctxq = false; }
                else { const int v = u - 1024; U.b = v >> 3; U.h = v & 7; U.qblk = 0; U.ctxq = true; }
                att::attn_unit<att::UMla>(F.lds, F.ws, U);
            }
            for (int rr_ = 0; rr_ < 1 + (int)(((unsigned long long)REPMASK >> 41) & 1ull); ++rr_)
            for (int u = (F.vcu + F.G / 2) % F.G; u < 1024 + 32; u += F.G) {
                att::UWin U; U.PB = WSP(bf16_t, WS_PB); U.AO = WSP(bf16_t, WS_AO); U.sink = inptr(F, I_EVSINK) + li * 8;
                if (u < 1024) { U.b = u >> 8; U.kvh = (u >> 7) & 1; U.j = u & 127; U.ctxq = false; }
                else { const int v = u - 1024; U.b = v >> 3; U.kvh = (v >> 2) & 1; U.j = v & 3; U.ctxq = true; }
                U.init();
                att::attn_unit<att::UWin>(F.lds, F.ws, U);
            }
        PHASE_END
        PHASE_BEGIN outproj_gemm(F, WSP(unsigned char, WS_WOUTE) + (size_t)li * 1024 * 1024, layer, TT); PHASE_END
        PHASE_BEGIN m1a_pass(F, layer); PHASE_END
        PHASE_BEGIN m1b_gemm(F, layer); PHASE_END
        PHASE_BEGIN m1c_pass(F); PHASE_END
        PHASE_BEGIN m2_pass(F); PHASE_END
        PHASE_BEGIN moe_gemm1(F, layer); PHASE_END
        PHASE_BEGIN moe_gemm2(F, layer); PHASE_END
        PHASE_BEGIN m5_pass(F, layer); PHASE_END
        }
        { const int layer = 2 * lp + 1, li = lp;
        PHASE_BEGIN dense_gemm_f8(F, WSP(unsigned char, WS_HB), WSP(unsigned char, WS_WINO) + (size_t)li * 3072 * 1024, 3072, 1024, WSP(bf16_t, WS_PB), OD_LD); PHASE_END
        PHASE_BEGIN
            for (int u = F.vcu; u < 2048 + (layer == 3 ? 0 : 64); u += F.G) {
                att::UNa U; U.PB = WSP(bf16_t, WS_PB); U.AO = WSP(bf16_t, WS_AO);
                if (u < 2048) { U.b = u >> 9; U.h = (u >> 5) & 15; U.G = u & 31; U.ctxq = false; }
                else { const int v = u - 2048; U.b = v >> 4; U.h = v & 15; U.G = 0; U.ctxq = true; }
                U.rpbh = inptr(F, I_ODRPB) + (size_t)(li * 16 + U.h) * 15 * 31;
                U.init();
                att::attn_unit<att::UNa>(F.lds, F.ws, U);
            }
        PHASE_END
        PHASE_BEGIN outproj_gemm(F, WSP(unsigned char, WS_WOUTO) + (size_t)li * 1024 * 1024, layer, layer == 3 ? TL : TT); PHASE_END
        PHASE_BEGIN m1a_pass(F, layer); PHASE_END
        PHASE_BEGIN m1b_gemm(F, layer); PHASE_END
        PHASE_BEGIN m1c_pass(F); PHASE_END
        PHASE_BEGIN m2_pass(F); PHASE_END
        PHASE_BEGIN moe_gemm1(F, layer); PHASE_END
        PHASE_BEGIN moe_gemm2(F, layer); PHASE_END
        PHASE_BEGIN m5_pass(F, layer); PHASE_END
        }
    }
}


#if MK_CHECK
constexpr int CW_CHK = 8192;
constexpr size_t WS_CHK = 1968 * MiB;
constexpr size_t WS_CHK_CNT = WS_CHK + 136 * MiB;
constexpr int IDS_PER_PAIR = 26, ID_PROB = 53, NID = 54;
struct CArgs { const float* in[25]; float* out; unsigned char* ws; int layer, id; };
#define CWS(T, off) ((T*)(A.ws + (off)))
__device__ __forceinline__ unsigned hsh(unsigned x) { x ^= x >> 16; x *= 0x7feb352du; x ^= x >> 15; x *= 0x846ca68bu; x ^= x >> 16; return x; }
__device__ __forceinline__ float bfv(const bf16_t* p) { return __builtin_bit_cast(float, (unsigned)(*p) << 16); }
__device__ __forceinline__ float f8v(const unsigned char* p) { const unsigned b = *p; const unsigned e = (b >> 3) & 15u, m = b & 7u; const float v = e ? __builtin_bit_cast(float, ((e + 120u) << 23) | (m << 20)) : (float)m * 0.001953125f; return (b & 128u) ? -v : v; }
__device__ __forceinline__ float rbf(float a) { return __builtin_bit_cast(float, f2bf(a) << 16); }
__device__ __forceinline__ void chk_acc(const CArgs& A, float e2, float r2) {
    __shared__ float sh[2][8];
    e2 = wave_sum(e2); r2 = wave_sum(r2);
    const int w = threadIdx.x >> 6;
    if ((threadIdx.x & 63) == 0) { sh[0][w] = e2; sh[1][w] = r2; }
    __syncthreads();
    if (threadIdx.x == 0) { float a = 0.f, b = 0.f; for (int i = 0; i < (int)(blockDim.x >> 6); ++i) { a += sh[0][i]; b += sh[1][i]; }
        float* acc = (float*)(A.ws + WS_CTL) + CW_CHK + 2 * A.id; atomicAdd(acc, a); atomicAdd(acc + 1, b); }
    __syncthreads();
}
__device__ __forceinline__ void sincos_d(float a, float& s, float& c) {
    double x = (double)a; const double tp = 6.283185307179586476925; double k = __builtin_rint(x / tp); double r = x - k * tp; double r2 = r * r;
    double sp = r, cp = 1.0, ts = r, tc = 1.0;
#pragma unroll
    for (int i = 1; i < 14; ++i) { tc *= -r2 / (double)((2 * i - 1) * (2 * i)); cp += tc; ts *= -r2 / (double)((2 * i) * (2 * i + 1)); sp += ts; }
    s = (float)sp; c = (float)cp;
}
__device__ __forceinline__ float invfreq(int i, int half) { return __builtin_amdgcn_exp2f(-((float)i / (float)half) * 13.287712379549449f); }
__device__ __forceinline__ float nsilu(float c) { return c / (1.0f + __expf(-c)); }
__device__ float naive_mod(const CArgs& A, int layer, int bidx, int n) {
    const float* cv = bidx < 4 ? A.in[I_C] + bidx * 1024 : A.in[I_CCTX]; const float* W = A.in[I_ADAW] + (size_t)layer * 1024 * 6144 + n;
    float acc = 0.f; for (int k = 0; k < 1024; ++k) acc += nsilu(cv[k]) * W[(size_t)k * 6144];
    return acc + A.in[I_ADAB][layer * 6144 + n];
}
__device__ __forceinline__ int srow(unsigned s) { return (s & 3) == 0 ? TL + (int)(hsh(s * 3 + 1) % TC) : (int)(hsh(s * 3 + 1) % TL); }
__global__ void chk_mark(CArgs A) { if (threadIdx.x == 0) ((float*)(A.ws + WS_CTL))[CW_CHK + 2 * A.id + 1] = 1.0f; }

__global__ void chk_gemm(CArgs A, const bf16_t* X, int ldx, const float* W, int ldw, int K, int ncol, const bf16_t* O, int ldo) {
    const int row = srow(blockIdx.x); const int col = (int)((hsh(blockIdx.x * 977 + 5) + 7u * threadIdx.x) % (unsigned)ncol);
    float ref = 0.f; for (int k = 0; k < K; ++k) ref += (ldx ? bfv(X + (size_t)row * ldx + k) : f8v((const unsigned char*)X + (size_t)row * 1024 + k)) * W[(size_t)k * ldw + col];
    const float got = bfv(O + (size_t)row * ldo + col);
    chk_acc(A, (got - ref) * (got - ref), ref * ref);
}
__global__ void chk_e2(CArgs A) {
    __shared__ float P[EV_IN]; __shared__ float red[2];
    const int li = A.layer >> 1, row = srow(blockIdx.x), t = threadIdx.x;
    const float* W = A.in[I_EVWIN] + (size_t)li * 1024 * EV_IN; const unsigned char* h = CWS(unsigned char, WS_HB) + (size_t)row * DM;
    for (int c = t; c < EV_IN; c += 256) { float a = 0.f; for (int k = 0; k < 1024; ++k) a += f8v(h + k) * W[(size_t)k * EV_IN + c]; P[c] = rbf(a); }
    __syncthreads();
    if (t == 0) { float a = 0.f; for (int c = 768; c < 1536; ++c) a += P[c] * P[c]; red[0] = 1.0f / sqrtf(a / 768.0f + NORM_EPS); float b = 0.f; for (int c = 1536; c < 1792; ++c) b += P[c] * P[c]; red[1] = 1.0f / sqrtf(b / 256.0f + NORM_EPS); }
    __syncthreads();
    const bool lat = row < TL; const int tt = row & (SEQ - 1), prow = tt >> 6, pcol = tt & 63;
    float e2 = 0.f, r2 = 0.f;
    for (int c = t; c < EV_IN; c += 256) {
        float ref = P[c];
        if (c < 640 && lat) { const int d = c & 63, dd = d & 31, i = dd & 15; const bool first = dd < 16; const float y = P[first ? c + 16 : c - 16];
            float sn, cs; sincos_d((float)((d < 32) ? prow : pcol) * invfreq(i, 16), sn, cs); ref = first ? P[c] * cs - y * sn : P[c] * cs + y * sn; }
        else if (c >= 768 && c < 1536) ref = P[c] * red[0] * A.in[I_EVQNG][li * 768 + c - 768];
        else if (c >= 1536 && c < 1792) ref = P[c] * red[1] * A.in[I_EVKVNG][li * 256 + c - 1536];
        else if (c >= 1792 && lat) { const int d = c - 1792, dd = d & 15, i = dd & 7; const bool first = dd < 8; const float y = P[first ? c + 8 : c - 8];
            float sn, cs; sincos_d((float)((d < 16) ? prow : pcol) * invfreq(i, 8), sn, cs); ref = first ? P[c] * cs - y * sn : P[c] * cs + y * sn; }
        const float got = bfv(CWS(bf16_t, WS_PB) + (size_t)row * EV_LD + c);
        e2 += (got - ref) * (got - ref); r2 += ref * ref;
    }
    chk_acc(A, e2, r2);
}
__global__ void chk_e4(CArgs A) {
    __shared__ float Q[768];
    const int li = A.layer >> 1, row = (int)(hsh(blockIdx.x * 3 + 1) % TL), t = threadIdx.x;
    const float* W = A.in[I_EVWUQ] + (size_t)li * 768 * 768; const bf16_t* x = CWS(bf16_t, WS_PB) + (size_t)row * EV_LD + 768;
    for (int c = t; c < 768; c += 256) { float a = 0.f; for (int k = 0; k < 768; ++k) a += bfv(x + k) * W[(size_t)k * 768 + c]; Q[c] = rbf(a); }
    __syncthreads();
    const int tt = row & (SEQ - 1), prow = tt >> 6, pcol = tt & 63;
    float e2 = 0.f, r2 = 0.f;
    for (int c = t; c < 768; c += 256) { const int d = c % 96; float ref = Q[c];
        if (d >= 64) { const int dr = d - 64, dd = dr & 15, i = dd & 7; const bool first = dd < 8; const float y = Q[first ? c + 8 : c - 8];
            float sn, cs; sincos_d((float)((dr < 16) ? prow : pcol) * invfreq(i, 8), sn, cs); ref = first ? Q[c] * cs - y * sn : Q[c] * cs + y * sn; }
        const float got = bfv(CWS(bf16_t, WS_QB) + (size_t)row * 768 + c); e2 += (got - ref) * (got - ref); r2 += ref * ref; }
    chk_acc(A, e2, r2);
}
__global__ void chk_attn(CArgs A, int kind, int ctxq) {
    __shared__ float sc[8448]; __shared__ float redm[4], reds[4], qs[96];
    const int li = A.layer >> 1, t = threadIdx.x; const unsigned s = blockIdx.x;
    const int b = hsh(s * 7 + 1) % NB, head = hsh(s * 7 + 2) % (kind == 2 ? 16 : 8);
    const int pos = ctxq ? hsh(s * 7 + 3) % CTXL : ((s & 7) == 0 ? (hsh(s) % 200) : (s & 7) == 1 ? SEQ - 1 - (hsh(s) % 200) : hsh(s * 7 + 3) % SEQ);
    const size_t qrow = ctxq ? (size_t)(TL + b * CTXL + pos) : (size_t)(b * SEQ + pos);
    int nlat = 0, wlo = 0, r = pos >> 6, c = pos & 63, r0 = 0, c0 = 0;
    if (!ctxq) {
        if (kind == 0) { wlo = pos - 128 < 0 ? 0 : pos - 128; const int whi = pos + 128 > SEQ - 1 ? SEQ - 1 : pos + 128; nlat = whi - wlo + 1; }
        else if (kind == 1) nlat = SEQ;
        else { r0 = r - 4; r0 = r0 < 0 ? 0 : (r0 > 120 ? 120 : r0); c0 = c - 8; c0 = c0 < 0 ? 0 : (c0 > 48 ? 48 : c0); nlat = 128; }
    }
    const int nk = nlat + CTXL;
    const bf16_t* PB = CWS(bf16_t, WS_PB); const bf16_t* KVB = CWS(bf16_t, WS_KVB);
    const int pld = kind == 2 ? OD_LD : EV_LD, dqk = kind == 1 ? 96 : 64;
    const bf16_t* q = kind == 1 ? CWS(bf16_t, WS_QB) + qrow * 768 + 96 * head : PB + qrow * pld + 64 * head;
    const float scale = kind == 1 ? 0.10206207261596577f : 0.125f;
    const bool has_sink = kind == 0; const float sinkv = has_sink ? A.in[I_EVSINK][li * 8 + head] : 0.f;
    const float* rp = A.in[I_ODRPB] + (size_t)(li * 16 + head) * 15 * 31;
    if (t < dqk) qs[t] = bfv(q + t);
    __syncthreads();
    if (kind == 1 && !ctxq) { float rv = 0.f;
        if (t >= 64 && t < 96) { const int dr = t - 64, dd = dr & 15, i = dd & 7; const bool first = dd < 8; const float y = qs[first ? t + 8 : t - 8];
            float sn, cs; sincos_d((float)((dr < 16) ? r : c) * invfreq(i, 8), sn, cs); rv = rbf(first ? qs[t] * cs - y * sn : qs[t] * cs + y * sn); }
        __syncthreads();
        if (t >= 64 && t < 96) qs[t] = rv;
        __syncthreads(); }
#define KROW(i) ((i) >= nlat ? (size_t)(TL + b * CTXL + ((i) - nlat)) : kind == 0 ? (size_t)(b * SEQ + wlo + (i)) : kind == 1 ? (size_t)(b * SEQ + (i)) : (size_t)(b * SEQ + (r0 + ((i) >> 4)) * 64 + c0 + ((i) & 15)))
    float mx = has_sink ? sinkv : -3e38f;
    for (int i = t; i < nk; i += 256) { const size_t kr = KROW(i); float a = 0.f;
        if (kind == 0) { const bf16_t* k = PB + kr * EV_LD + 512 + 64 * (head >> 2); for (int d = 0; d < 64; ++d) a += qs[d] * bfv(k + d); }
        else if (kind == 1) { const bf16_t* k = KVB + kr * 1024 + 128 * head; for (int d = 0; d < 64; ++d) a += qs[d] * bfv(k + d); const bf16_t* k2 = PB + kr * EV_LD + 1792; for (int d = 0; d < 32; ++d) a += qs[64 + d] * bfv(k2 + d); }
        else { const bf16_t* k = PB + kr * OD_LD + 1024 + 64 * head; for (int d = 0; d < 64; ++d) a += qs[d] * bfv(k + d); }
        a *= scale;
        if (kind == 2 && i < nlat) { const int kr_ = r0 + (i >> 4), kc_ = c0 + (i & 15); a += rp[(kr_ - r + 7) * 31 + (kc_ - c + 15)]; }
        sc[i] = a; mx = fmaxf(mx, a); }
    for (int o = 1; o < 64; o <<= 1) mx = fmaxf(mx, __shfl_xor(mx, o));
    if ((t & 63) == 0) redm[t >> 6] = mx;
    __syncthreads();
    mx = fmaxf(fmaxf(redm[0], redm[1]), fmaxf(redm[2], redm[3]));
    float sm = 0.f;
    for (int i = t; i < nk; i += 256) { const float p = __expf(sc[i] - mx); sc[i] = p; sm += p; }
    sm = wave_sum(sm);
    if ((t & 63) == 0) reds[t >> 6] = sm;
    __syncthreads();
    sm = reds[0] + reds[1] + reds[2] + reds[3] + (has_sink ? __expf(sinkv - mx) : 0.f);
    float e2 = 0.f, r2 = 0.f;
    if (t < 64) { float o = 0.f;
        for (int i = 0; i < nk; ++i) { const size_t kr = KROW(i); const bf16_t* v = kind == 0 ? PB + kr * EV_LD + 640 + 64 * (head >> 2) : kind == 1 ? KVB + kr * 1024 + 128 * head + 64 : PB + kr * OD_LD + 2048 + 64 * head; o += sc[i] * bfv(v + t); }
        o /= sm; const unsigned char* got = CWS(unsigned char, WS_AO) + qrow * 1024 + (kind == 1 ? 512 : 0) + 64 * head; const float g = f8v(got + t); e2 = (g - o) * (g - o); r2 = o * o; }
#undef KROW
    chk_acc(A, e2, r2);
}
__global__ void chk_outproj(CArgs A, const float* W) {
    const int row = A.layer == 3 ? (int)(hsh(blockIdx.x * 3 + 1) % TL) : srow(blockIdx.x), c = (int)((hsh(blockIdx.x * 977 + 5) + 7u * threadIdx.x) % 1024u);
    float a = 0.f; for (int k = 0; k < 1024; ++k) a += f8v(CWS(unsigned char, WS_AO) + (size_t)row * 1024 + k) * W[(size_t)k * 1024 + c];
    const float gate = naive_mod(A, A.layer, row < TL ? (row >> 13) : 4, 2 * 1024 + c);
    const float ref = CWS(float, WS_CHK)[(size_t)row * DM + c] + gate * a, got = CWS(float, WS_XLC)[(size_t)row * DM + c];
    chk_acc(A, (got - ref) * (got - ref), (gate * a) * (gate * a));
}
__global__ void chk_norm_router(CArgs A, int which, const bf16_t* hbuf, int hld) {
    __shared__ float hv[1024]; __shared__ float red[4]; __shared__ float lg[32]; __shared__ int ste[4]; __shared__ float stv[4];
    const int row = srow(blockIdx.x), t = threadIdx.x, bidx = row < TL ? (row >> 13) : 4;
    const float* x = CWS(float, WS_XLC) + (size_t)row * DM;
    float s = 0.f; for (int c = t; c < 1024; c += 256) s += x[c] * x[c];
    s = wave_sum(s); if ((t & 63) == 0) red[t >> 6] = s; __syncthreads();
    const float rstd = 1.0f / sqrtf((red[0] + red[1] + red[2] + red[3]) / 1024.0f + NORM_EPS);
    const float* g = (which == 0 ? A.in[I_N1G] : A.in[I_N2G]) + A.layer * DM;
    float e2 = 0.f, r2 = 0.f;
    for (int c = t; c < 1024; c += 256) { const float sh = naive_mod(A, A.layer, bidx, which * 1024 + c), scl = naive_mod(A, A.layer, bidx, (which + 1) * 1024 + c);
        const float h = x[c] * rstd * g[c] * (1.0f + scl) + sh; hv[c] = h; const float got = hld ? bfv(hbuf + (size_t)row * hld + c) : f8v((const unsigned char*)hbuf + (size_t)row * DM + c); e2 += (got - h) * (got - h); r2 += h * h; }
    __syncthreads();
    if (which == 3) {
        if (t < 32) { const float* rw = A.in[I_RW] + (size_t)A.layer * 1024 * 32; float a = 0.f; for (int k = 0; k < 1024; ++k) a += hv[k] * rw[k * 32 + t]; lg[t] = a + A.in[I_RB][A.layer * 32 + t]; }
        __syncthreads();
        if (t == 0) { unsigned used = 0u;
            for (int k = 0; k < 4; ++k) { float bv = -3e38f; int bi = 0; for (int e = 0; e < 32; ++e) if (!((used >> e) & 1u) && lg[e] > bv) { bv = lg[e]; bi = e; } used |= 1u << bi; ste[k] = bi; stv[k] = bv; }
            float den = 0.f; for (int k = 0; k < 4; ++k) den += __expf(stv[k] - stv[0]);
            for (int k = 0; k < 4; ++k) { const float gr = __expf(stv[k] - stv[0]) / den; const int ge = CWS(int, WS_TOPE)[(size_t)row * 4 + k]; const float gg = CWS(float, WS_TOPG)[(size_t)row * 4 + k];
                const float d = (ge == ste[k]) ? (gg - gr) : 1.0f; e2 += 1000.f * d * d; r2 += 1000.f * gr * gr; } }
    }
    chk_acc(A, e2, r2);
}
__global__ void chk_slots_count(CArgs A) {
    const int i = blockIdx.x * 256 + threadIdx.x; if (i < TT * 4) { const int sl = CWS(int, WS_SLOT)[i]; if (sl >= 0 && sl < MAXSLOT) atomicAdd(CWS(int, WS_CHK_CNT) + sl, 1); else atomicAdd((float*)(A.ws + WS_CTL) + CW_CHK + 2 * A.id, 1.0f); }
}
__global__ void chk_slots(CArgs A) {
    const int i = blockIdx.x * 256 + threadIdx.x; float e2 = 0.f, r2 = 0.f;
    if (i < MAXSLOT) { const int c = CWS(int, WS_CHK_CNT)[i]; if (c > 1) e2 += 1.f; }
    if (i < 8192) { const unsigned a = hsh(i * 5 + 3) % (unsigned)(TT * 4); const int row = a >> 2, sl = CWS(int, WS_SLOT)[a], e = CWS(int, WS_TOPE)[a];
        if (CWS(int, WS_TILEEXP)[sl >> 8] != e) e2 += 1.f;
        if (CWS(float, WS_GSLOT)[sl] != CWS(float, WS_TOPG)[a]) e2 += 1.f;
        if (CWS(int, WS_TOKSLOT)[sl] != row) e2 += 1.f; r2 += 1.f; }
    chk_acc(A, e2, r2);
}
__global__ void chk_moe(CArgs A, int which) {
    const unsigned a = hsh(blockIdx.x * 5 + 3) % (unsigned)(TT * 4); const int sl = CWS(int, WS_SLOT)[a], e = CWS(int, WS_TILEEXP)[sl >> 8];
    const int c = (int)((hsh(blockIdx.x * 977 + 5) + 7u * threadIdx.x) % 1024u);
    float ref, got;
    if (which == 0) { const float* W = A.in[I_W1] + ((size_t)A.layer * 32 + e) * 1024 * 2048; const unsigned char* x = CWS(unsigned char, WS_HB) + (size_t)(a >> 2) * DM; float g = 0.f, l = 0.f;
        for (int k = 0; k < 1024; ++k) { const float xv = f8v(x + k); g += xv * W[(size_t)k * 2048 + c]; l += xv * W[(size_t)k * 2048 + 1024 + c]; }
        g += A.in[I_B1][((size_t)A.layer * 32 + e) * 2048 + c]; l += A.in[I_B1][((size_t)A.layer * 32 + e) * 2048 + 1024 + c];
        g = fminf(g, 7.f); l = fminf(fmaxf(l, -7.f), 7.f); ref = g / (1.0f + __expf(-1.702f * g)) * (l + 1.0f); got = f8v(CWS(unsigned char, WS_HA) + (size_t)sl * DM + c); }
    else { const float* W = A.in[I_W2] + ((size_t)A.layer * 32 + e) * 1024 * 1024; const unsigned char* x = CWS(unsigned char, WS_HA) + (size_t)sl * DM; float y = 0.f;
        for (int k = 0; k < 1024; ++k) y += f8v(x + k) * W[(size_t)k * 1024 + c];
        ref = y + A.in[I_B2][((size_t)A.layer * 32 + e) * 1024 + c]; got = f8v(CWS(unsigned char, WS_XG) + (size_t)sl * DM + c) * (1.0f / YS_SCALE); }
    chk_acc(A, (got - ref) * (got - ref), ref * ref);
}
__global__ void chk_combine(CArgs A) {
    const int row = srow(blockIdx.x), c = (int)((hsh(blockIdx.x * 977 + 5) + 7u * threadIdx.x) % 1024u);
    float y = 0.f; for (int k = 0; k < 4; ++k) y += CWS(float, WS_TOPG)[(size_t)row * 4 + k] * (1.0f / YS_SCALE) * f8v(CWS(unsigned char, WS_XG) + (size_t)CWS(int, WS_SLOT)[(size_t)row * 4 + k] * DM + c);
    const float gate = naive_mod(A, A.layer, row < TL ? (row >> 13) : 4, 5 * 1024 + c);
    const float ref = CWS(float, WS_CHK)[(size_t)row * DM + c] + gate * y, got = CWS(float, WS_XLC)[(size_t)row * DM + c];
    chk_acc(A, (got - ref) * (got - ref), (gate * y) * (gate * y));
}
__global__ void chk_report(CArgs A) {
    if (threadIdx.x == 0 && blockIdx.x == 0) { const float* acc = (const float*)(A.ws + WS_CTL) + CW_CHK; int bad = 0, bad2 = 0;
        for (int id = NID - 1; id >= 1; --id) { const int q = (id - 1) % IDS_PER_PAIR + 1; const float tol = (id == ID_PROB || (q >= 6 && q <= 10) || q == 18 || q == 19 || q == 20 || q == 1 || q == 2 || q == 17 || q == 13 || q == 14 || q == 16 || q == 23 || q == 24 || q == 26) ? 0.1f : 0.03f;
            const float e2 = acc[2 * id], r2 = acc[2 * id + 1]; if (r2 <= 0.f || !(e2 <= tol * tol * r2)) { bad2 = bad; bad = id; } }
        if (bad) A.out[0] = 1000.0f * (float)bad;
        if (bad2) A.out[1] = 1000.0f * (float)bad2; }
}
static void chk_before(int p, const Args& a, hipStream_t st) {
    const int q = p < 2 ? -1 : (p - 2) % NPH_PAIR;
    if (q == 8 || q == 18) (void)hipMemsetAsync(a.ws + WS_CHK_CNT, 0, (size_t)MAXSLOT * 4, st);
    if (q == 4 || q == 11 || q == 14 || q == 21) (void)hipMemcpyAsync(a.ws + WS_CHK, a.ws + WS_XLC, (size_t)TT * DM * 4, hipMemcpyDeviceToDevice, st);
}
static void chk_after(int p, const Args& a, hipStream_t st) {
    CArgs A{}; for (int i = 0; i < 25; ++i) A.in[i] = a.in[i]; A.out = a.out; A.ws = a.ws;
    const int lp = p < 2 ? 0 : (p - 2) / NPH_PAIR, q = p < 2 ? -1 : (p - 2) % NPH_PAIR, base = IDS_PER_PAIR * lp;
    unsigned char* ws = a.ws; const int le = 2 * lp, lod = 2 * lp + 1;
#define CK(idv, layerv, kern, grid, ...) do { A.id = base + (idv); A.layer = (layerv); hipLaunchKernelGGL(kern, dim3(grid), dim3(256), 0, st, A, ##__VA_ARGS__); } while (0)
#define CK0(idv, layerv, kern, grid) do { A.id = base + (idv); A.layer = (layerv); hipLaunchKernelGGL(kern, dim3(grid), dim3(256), 0, st, A); } while (0)
    if (p == 1) { A.id = ID_PROB; A.layer = 0; hipLaunchKernelGGL(chk_norm_router, dim3(48), dim3(256), 0, st, A, 0, (const bf16_t*)(ws + WS_HB), 0); }
    if (q == 0) CK(1, le, chk_gemm, 64, (const bf16_t*)(ws + WS_HB), 0, a.in[I_EVWIN] + (size_t)lp * 1024 * EV_IN, (int)EV_IN, 1024, (int)EV_IN, (const bf16_t*)(ws + WS_PB), (int)EV_LD);
    if (q == 1) CK0(2, le, chk_e2, 48);
    if (q == 2) { CK(3, le, chk_gemm, 64, (const bf16_t*)(ws + WS_PB) + 768, (int)EV_LD, a.in[I_EVWUQ] + (size_t)lp * 768 * 768, 768, 768, 768, (const bf16_t*)(ws + WS_QB), 768);
                  CK(4, le, chk_gemm, 64, (const bf16_t*)(ws + WS_PB) + 1536, (int)EV_LD, a.in[I_EVWUKV] + (size_t)lp * 256 * 1024, 1024, 256, 1024, (const bf16_t*)(ws + WS_KVB), 1024);
                  CK0(5, le, chk_mark, 1); }
    if (q == 3) { CK(6, le, chk_attn, 96, 0, 0); CK(7, le, chk_attn, 48, 1, 0); CK(8, le, chk_attn, 32, 0, 1); CK(9, le, chk_attn, 32, 1, 1); }
    if (q == 4) CK(10, le, chk_outproj, 48, a.in[I_EVWOUT] + (size_t)lp * 1024 * 1024);
    if (q == 7) CK(11, le, chk_norm_router, 48, 3, (const bf16_t*)(ws + WS_PB), (int)H3_LD);
    if (q == 8) { CK0(12, le, chk_slots_count, (TT * 4 + 255) / 256); CK0(12, le, chk_slots, MAXSLOT / 256); }
    if (q == 9) CK(13, le, chk_moe, 64, 0);
    if (q == 10) CK(14, le, chk_moe, 64, 1);
    if (q == 11) { CK0(15, le, chk_combine, 64); CK(16, le + 1, chk_norm_router, 48, 0, (const bf16_t*)(ws + WS_HB), 0); }
    if (q == 12) CK(17, lod, chk_gemm, 64, (const bf16_t*)(ws + WS_HB), 0, a.in[I_ODWIN] + (size_t)lp * 1024 * 3072, 3072, 1024, 3072, (const bf16_t*)(ws + WS_PB), (int)OD_LD);
    if (q == 13) { CK(18, lod, chk_attn, 96, 2, 0); CK(19, lod, chk_attn, 32, 2, 1); }
    if (q == 14) CK(20, lod, chk_outproj, 48, a.in[I_ODWOUT] + (size_t)lp * 1024 * 1024);
    if (q == 17) CK(21, lod, chk_norm_router, 48, 3, (const bf16_t*)(ws + WS_PB), (int)H3_LD);
    if (q == 18) { CK0(22, lod, chk_slots_count, (TT * 4 + 255) / 256); CK0(22, lod, chk_slots, MAXSLOT / 256); }
    if (q == 19) CK(23, lod, chk_moe, 64, 0);
    if (q == 20) CK(24, lod, chk_moe, 64, 1);
    if (q == 21) { if (lod != 3) { CK0(25, lod, chk_combine, 64); CK(26, lod + 1, chk_norm_router, 48, 0, (const bf16_t*)(ws + WS_HB), 0); } else { CK0(25, lod, chk_mark, 1); CK0(26, lod, chk_mark, 1); } }
    if (p == NPH - 1) { A.id = 0; hipLaunchKernelGGL(chk_report, dim3(1), dim3(64), 0, st, A); }
#undef CK
#undef CK0
}
#endif

extern "C" void kernel_launch(void* const* d_in, const int* in_sizes, int n_in, void* d_out, int out_size, void* d_ws, size_t ws_size, hipStream_t stream) {
    static int grid = 0;
    if (grid == 0) {
        if (n_in != 25 || out_size != TL * DM || ws_size < WS_END) { fprintf(stderr, "kernel_launch: unexpected shapes (n_in %d, out %d, ws %zu < %zu); nothing launched\n", n_in, out_size, ws_size, (size_t)WS_END); grid = -1; return; }
        int dev = 0, cus = 0, per_cu = 0;
        if (hipGetDevice(&dev) != hipSuccess || hipDeviceGetAttribute(&cus, hipDeviceAttributeMultiprocessorCount, dev) != hipSuccess) { grid = -1; return; }
        if (hipFuncSetAttribute((const void*)fwd, hipFuncAttributeMaxDynamicSharedMemorySize, LDS_BYTES) != hipSuccess) { fprintf(stderr, "kernel_launch: hipFuncSetAttribute failed\n"); grid = -1; return; }
        if (hipOccupancyMaxActiveBlocksPerMultiprocessor(&per_cu, (const void*)fwd, 512, LDS_BYTES) != hipSuccess || per_cu < 1) { fprintf(stderr, "kernel_launch: occupancy query says %d blocks per CU\n", per_cu); }
        (void)hipGetLastError();
        grid = cus;
    }
    if (grid < 0) return;
    (void)hipMemsetAsync((char*)d_ws + WS_CTL, 0, CTL_ZERO_BYTES, stream);
    Args a{};
    for (int i = 0; i < 25; ++i) a.in[i] = (const float*)d_in[i];
    a.out = (float*)d_out; a.ws = (unsigned char*)d_ws;
#if MK_PER_PHASE
    for (int p = 0; p < NPH; ++p) {
#if MK_CHECK
        chk_before(p, a, stream);
#endif
        a.ph_lo = p; a.ph_hi = p + 1; hipLaunchKernelGGL(fwd, dim3(grid), dim3(512), LDS_BYTES, stream, a);
#if MK_CHECK
        chk_after(p, a, stream);
#endif
    }
#else
    a.ph_lo = 0; a.ph_hi = NPH;
    hipLaunchKernelGGL(fwd, dim3(grid), dim3(512), LDS_BYTES, stream, a);
#endif
    const hipError_t le = hipPeekAtLastError();
    if (le != hipSuccess) fprintf(stderr, "kernel_launch: launch failed: %s\n", hipGetErrorName(le));
}
```

```cpp
#include <hip/hip_runtime.h>
#include <cstdio>
#include <cstdint>

#ifndef MK_CHECK
#define MK_CHECK 0
#endif
#ifndef MK_PER_PHASE
#define MK_PER_PHASE MK_CHECK
#endif

#define LAS __attribute__((address_space(3)))
#define GAS __attribute__((address_space(1)))
typedef unsigned short bf16_t;
typedef short bf16x8 __attribute__((ext_vector_type(8)));
typedef short s16x4 __attribute__((ext_vector_type(4)));
typedef float f32x2 __attribute__((ext_vector_type(2)));
typedef float f32x4 __attribute__((ext_vector_type(4)));
typedef float f32x16 __attribute__((ext_vector_type(16)));
typedef unsigned u32x2 __attribute__((ext_vector_type(2)));
typedef unsigned u32x4 __attribute__((ext_vector_type(4)));

constexpr int DM = 1024, NB = 4, SEQ = 8192, TL = NB * SEQ, CTXL = 256, TC = NB * CTXL, TT = TL + TC;
constexpr int EV_LD = 2048, OD_LD = 3072;
constexpr int EV_IN = 1824;
constexpr int NEXP = 32, DEXP = 1024;
constexpr int MAXSLOT = 143360, MAXTILE = 560;
constexpr float NORM_EPS = 1e-6f;
constexpr float LOG2E = 1.4426950408889634f;

constexpr size_t MiB = 1u << 20;
constexpr size_t WS_CTL = 0, CTL_ZERO_BYTES = 1 * MiB;
constexpr size_t WS_MOD = 1 * MiB;
constexpr size_t WS_ROPE64 = 1 * MiB + 512 * 1024;
constexpr size_t WS_ROPE32 = WS_ROPE64 + 16384;
constexpr size_t WS_TOPE = 2 * MiB;
constexpr size_t WS_TOPG = WS_TOPE + 540672;
constexpr size_t WS_SLOT = WS_TOPG + 540672;
constexpr size_t WS_HIST = WS_SLOT + 540672;
constexpr size_t WS_TILEEXP = WS_HIST + 131072;
constexpr size_t WS_GSLOT = WS_TILEEXP + 4096;
constexpr size_t WS_TOKSLOT = WS_GSLOT + (size_t)MAXSLOT * 4;
static_assert(WS_TOKSLOT + (size_t)MAXSLOT * 4 <= 6 * MiB, "route map");
constexpr size_t WS_WINE = 6 * MiB, WS_WUQ = 14 * MiB, WS_WUKV = 17 * MiB, WS_WOUTE = 18 * MiB, WS_WINO = 22 * MiB, WS_WOUTO = 34 * MiB;
constexpr size_t WS_W1 = 38 * MiB, WS_W2 = 550 * MiB;
constexpr size_t WS_XLC = 806 * MiB, WS_HB = 938 * MiB, WS_PB = 1004 * MiB, WS_QB = 1202 * MiB, WS_KVB = 1252 * MiB, WS_AO = 1318 * MiB;
constexpr size_t WS_XG = 1384 * MiB, WS_HA = 1664 * MiB, WS_RWT = 1944 * MiB, WS_LOGIT = 1952 * MiB, WS_END = 1960 * MiB;
constexpr size_t WS_LOGIT12 = WS_XG + 160 * MiB;
constexpr int H3_LD = 3072;
constexpr int CW_BAR = 4096;

constexpr int ARENA_BYTES = 131072;
constexpr int LDSCTL_OFF = ARENA_BYTES;
constexpr int LDS_BYTES = 147456;

__device__ __forceinline__ unsigned f2bf(float f) { unsigned u = __builtin_bit_cast(unsigned, f); return (u + 0x7fffu + ((u >> 16) & 1u)) >> 16; }
__device__ __forceinline__ unsigned pk2(float lo, float hi) { return f2bf(lo) | (f2bf(hi) << 16); }
__device__ __forceinline__ f32x4 xun4(u32x2 w) { return (f32x4){__builtin_bit_cast(float, w.x << 16), __builtin_bit_cast(float, w.x & 0xffff0000u), __builtin_bit_cast(float, w.y << 16), __builtin_bit_cast(float, w.y & 0xffff0000u)}; }
__device__ __forceinline__ u32x2 xpk4(f32x4 v) { return (u32x2){pk2(v.x, v.y), pk2(v.z, v.w)}; }
__device__ __forceinline__ float bflo(unsigned w) { return __builtin_bit_cast(float, w << 16); }
__device__ __forceinline__ float bfhi(unsigned w) { return __builtin_bit_cast(float, w & 0xffff0000u); }
__device__ __forceinline__ float wave_sum(float v) {
#pragma unroll
    for (int o = 1; o < 64; o <<= 1) v += __shfl_xor(v, o);
    return v;
}
#define LDS_WAIT() asm volatile("s_waitcnt lgkmcnt(0)" ::: "memory")
__device__ __forceinline__ unsigned cvt4_fp8(float a, float b, float c, float d) { unsigned w = 0u; w = __builtin_amdgcn_cvt_pk_fp8_f32(a, b, w, false); w = __builtin_amdgcn_cvt_pk_fp8_f32(c, d, w, true); return w; }
__device__ __forceinline__ void swap16(unsigned& a, unsigned& b) { asm volatile("s_nop 1\n\tv_permlane16_swap_b32 %0, %1\n\ts_nop 1" : "+v"(a), "+v"(b)); }
constexpr float YS_SCALE = 16.0f;
constexpr float W8_SCALE = 32.0f;
__device__ __forceinline__ int opaque_tid() { int t = threadIdx.x; asm volatile("" : "+v"(t)); return t; }

#define XB_TMO      128
#define XB_XCNT(j)  (256  + 64 * (j))
#define XB_XSUB(j)  (1280 + 64 * (j))
#define XB_XGEN(j)  (2304 + 64 * (j))
#define XB_TOP      3328
#define XB_TOPGEN   3392
#define XCD_BAR_WORDS 3456
#define XB_SPIN_CAP (1u << 18)

__device__ __forceinline__ unsigned xb_ld(unsigned* p)              { return __hip_atomic_load(p, __ATOMIC_RELAXED, __HIP_MEMORY_SCOPE_AGENT); }
__device__ __forceinline__ unsigned xb_add(unsigned* p, unsigned v) { return __hip_atomic_fetch_add(p, v, __ATOMIC_RELAXED, __HIP_MEMORY_SCOPE_AGENT); }
__device__ __forceinline__ unsigned xb_xcc_id() { return (unsigned)__builtin_amdgcn_s_getreg((3 << 11) | 20) & 0xFu; }
#define XB_SPIN(cond, bar) do { unsigned _sp = 0; while (cond) { __builtin_amdgcn_s_sleep(1); \
    if ((++_sp & 255u) == 0u) { if (xb_ld(&(bar)[XB_TMO])) break; if (_sp > XB_SPIN_CAP) { atomicAdd(&(bar)[XB_TMO], 1u); break; } } } } while (0)

struct XcdBarrier { unsigned* bar; unsigned x; volatile LAS unsigned* st; };

__device__ __forceinline__ XcdBarrier xcd_barrier_post(unsigned* bar, volatile LAS unsigned* st) {
    XcdBarrier b; b.bar = bar; b.x = xb_xcc_id(); b.st = st;
    if (threadIdx.x == 0) (void)xb_add(&bar[XB_XCNT(b.x)], 1u);
    return b;
}
__device__ __forceinline__ void xcd_barrier_complete(unsigned* bar, unsigned x, unsigned& nloc, unsigned& nx) {
    const unsigned G = gridDim.x * gridDim.y * gridDim.z;
    unsigned sum, cnt, mine, sp = 0u;
    for (;;) {
        sum = 0u; cnt = 0u; mine = 0u;
#pragma unroll
        for (unsigned j = 0; j < 16; ++j) { const unsigned c = xb_ld(&bar[XB_XCNT(j)]); sum += c; cnt += (c > 0u) ? 1u : 0u; mine = (j == x) ? c : mine; }
        if (sum == G) break;
        __builtin_amdgcn_s_sleep(1);
        if ((++sp & 255u) == 0u) { if (xb_ld(&bar[XB_TMO])) break; if (sp > XB_SPIN_CAP) { atomicAdd(&bar[XB_TMO], 1u); break; } }
    }
    nloc = mine > 0u ? mine : 1u; nx = cnt > 0u ? cnt : 1u;
}
__device__ __forceinline__ void xcd_barrier(const XcdBarrier& b) {
    asm volatile("s_waitcnt vmcnt(0)" ::: "memory");
    __syncthreads();
    if (threadIdx.x == 0) {
        unsigned* bar = b.bar;
        __builtin_amdgcn_s_waitcnt(0);
        unsigned nloc = b.st[0], nx = b.st[1];
        if (nloc == 0u) { xcd_barrier_complete(bar, b.x, nloc, nx); b.st[0] = nloc; b.st[1] = nx; }
        const unsigned old = xb_add(&bar[XB_XSUB(b.x)], 1u);
        const unsigned gen = old / nloc;
        if (old + 1u == (gen + 1u) * nloc) {
            __builtin_amdgcn_fence(__ATOMIC_RELEASE, "agent");
            asm volatile("s_waitcnt vmcnt(0)" ::: "memory");
            const unsigned og = xb_add(&bar[XB_TOP], 1u);
            const unsigned tg = og / nx;
            if (og + 1u == (tg + 1u) * nx) xb_add(&bar[XB_TOPGEN], 1u);
            else XB_SPIN(xb_ld(&bar[XB_TOPGEN]) == tg, bar);
            __builtin_amdgcn_fence(__ATOMIC_ACQUIRE, "agent");
            xb_add(&bar[XB_XGEN(b.x)], 1u);
            asm volatile("s_waitcnt vmcnt(0)" ::: "memory");
        } else {
            XB_SPIN(xb_ld(&bar[XB_XGEN(b.x)]) == gen, bar);
            __builtin_amdgcn_fence(__ATOMIC_ACQUIRE, "agent");
            asm volatile("s_waitcnt vmcnt(0)" ::: "memory");
        }
    }
    __syncthreads();
}

namespace pg8 {
constexpr int BM = 256, BK = 64, HALF = 128, HTB = HALF * BK * 2, STAGE_BYTES = 8 * HTB, NXCD = 8, WGM = 8;
__host__ __device__ __forceinline__ int lds_byte(int r, int c) { const int st = (r >> 4) * 2 + (c >> 5), rr = r & 15, cc = c & 31, ob = rr * 64 + cc * 2; return st * 1024 + (ob ^ (((ob >> 9) & 1) << 5)); }
__host__ __device__ __forceinline__ void stage_rc(int b, int& R, int& C) { const int st = b / 1024, sb = b % 1024, swz = sb ^ (((sb >> 9) & 1) << 5); R = (st >> 1) * 16 + swz / 64; C = (st & 1) * 32 + (swz % 64) / 2; }
__host__ __device__ __forceinline__ int perm32(int rho) { const int n = rho >> 4, i = rho & 15; return 8 * (i >> 2) + 4 * n + (i & 3); }

typedef int v4i_t __attribute__((ext_vector_type(4)));
typedef int v8i_t __attribute__((ext_vector_type(8)));
struct Unit { unsigned a, b; int pm, pn, aux; };

struct DenseOrder {
    const char* A; const char* Bt; unsigned lda2, ldb2; int nM, nN, nwg, G, c;
    __device__ __forceinline__ const void* baseA() const { return A; }
    __device__ __forceinline__ const void* baseB() const { return Bt; }
    __device__ __forceinline__ const int* gather() const { return nullptr; }
    __device__ __forceinline__ void init(const void* A_, size_t lda_bytes, const void* Bt_, size_t ldb_bytes, int M, int N, int G_, int c_) { A = (const char*)A_; Bt = (const char*)Bt_; lda2 = (unsigned)lda_bytes; ldb2 = (unsigned)ldb_bytes; nM = M / BM; nN = N / BM; nwg = nM * nN; G = G_; c = c_; }
    __device__ __forceinline__ bool next(int i, Unit& u) const {
        const long L = (long)i * G + c; if (L >= nwg) return false;
        int wgid = (int)L; { const int q = nwg / NXCD, r = nwg % NXCD, xcd = wgid % NXCD, off = wgid / NXCD; wgid = (xcd < r ? xcd * (q + 1) : r * (q + 1) + (xcd - r) * q) + off; }
        const int nig = WGM * nN, gid = wgid / nig, fm = gid * WGM, gsz = (nM - fm) < WGM ? (nM - fm) : WGM;
        u.pm = fm + ((wgid % nig) % gsz); u.pn = (wgid % nig) / gsz; u.aux = 0;
        u.a = (unsigned)u.pm * BM * lda2; u.b = (unsigned)u.pn * BM * ldb2; return true;
    }
};
struct RouterOrder {
    const char* A; const char* Bt; unsigned lda2, ldb2; int nM, G, c;
    __device__ __forceinline__ const void* baseA() const { return A; }
    __device__ __forceinline__ const void* baseB() const { return Bt; }
    __device__ __forceinline__ const int* gather() const { return nullptr; }
    __device__ __forceinline__ bool next(int i, Unit& u) const {
        const int L = i * G + c; if (L >= nM * 3) return false;
        u.pm = L / 3; u.aux = L - 3 * u.pm; u.pn = 0;
        u.a = (unsigned)u.pm * BM * lda2 + (u.aux == 1 ? 2048u : 0u); u.b = (unsigned)u.aux * 2048u; return true;
    }
};
struct MoeOrder {
    const char* A; const char* W; const LAS int* tile_exp; const int* tokslot; unsigned lda2, ldb2, wstride; int ntiles, nN, G, c;
    __device__ __forceinline__ const void* baseA() const { return A; }
    __device__ __forceinline__ const void* baseB() const { return W; }
    __device__ __forceinline__ const int* gather() const { return tokslot; }
    __device__ __forceinline__ bool next(int i, Unit& u) const {
        const int tpr = G / nN, tpx = tpr >> 3, x = c & 7, j = c >> 3;
        int tile, pn;
        if ((G & 7) == 0 && tpx * 8 == tpr && tpx > 0) { tile = i * tpr + x * tpx + j / nN; pn = j % nN; }
        else { const long L = (long)i * G + c; tile = (int)(L / nN); pn = (int)(L % nN); }
        if (tile >= ntiles) return false;
        const int e = __builtin_amdgcn_readfirstlane(tile_exp[tile]);
        u.pm = tile; u.pn = pn; u.aux = e; u.a = (unsigned)tile * BM * lda2; u.b = (unsigned)e * wstride + (unsigned)pn * BM * ldb2; return true;
    }
};

__device__ __forceinline__ unsigned cvt_pk_bf16(float lo, float hi) { unsigned r; asm volatile("v_cvt_pk_bf16_f32 %0, %1, %2" : "=v"(r) : "v"(lo), "v"(hi)); return r; }

struct EpiBf16 {
    static constexpr bool PERM = true; static constexpr bool WIDE16 = false;
    bf16_t* O; int ldc; float sc;
    struct Pre {}; static constexpr bool HAS_BIAS = false; static constexpr bool HALFN = false;
    __device__ __forceinline__ void operator()(const f32x4 (&acc)[2][2][4][2], const Unit& u, int wr, int wc, int fr, int fq, const Pre& pre) const {
        const int row0 = u.pm * BM + wr * 64 + fr, col0 = u.pn * BM + wc * 32 + 8 * fq;
#pragma unroll
        for (int ai = 0; ai < 2; ++ai)
#pragma unroll
            for (int m = 0; m < 4; ++m) { bf16_t* rowp = O + (size_t)(row0 + ai * HALF + m * 16) * ldc + col0;
#pragma unroll
                for (int bj = 0; bj < 2; ++bj) { const f32x4 v0 = acc[ai][bj][m][0] * sc, v1 = acc[ai][bj][m][1] * sc;
                    u32x4 w; w.x = cvt_pk_bf16(v0[0], v0[1]); w.y = cvt_pk_bf16(v0[2], v0[3]); w.z = cvt_pk_bf16(v1[0], v1[1]); w.w = cvt_pk_bf16(v1[2], v1[3]);
                    *(u32x4*)(rowp + bj * HALF) = w; } }
    }
};
struct EpiResid {
    static constexpr bool PERM = true; static constexpr bool WIDE16 = false;
    bf16_t* X; const float* modl; float sc;
    struct Pre {}; static constexpr bool HAS_BIAS = false; static constexpr bool HALFN = false;
    __device__ __forceinline__ void operator()(const f32x4 (&acc)[2][2][4][2], const Unit& u, int wr, int wc, int fr, int fq, const Pre& pre) const {
        const int row0 = u.pm * BM + wr * 64 + fr, col0 = u.pn * BM + wc * 32 + 8 * fq;
        const int bidx = u.pm < 128 ? (u.pm >> 5) : 4;
        const float* gp = modl + (size_t)bidx * 6144 + col0;
        f32x4 gv[2][2];
#pragma unroll
        for (int bj = 0; bj < 2; ++bj)
#pragma unroll
            for (int n = 0; n < 2; ++n) gv[bj][n] = *(const f32x4*)(gp + bj * HALF + 4 * n) * sc;
        u32x4 xc[2], xn[2];
        { const bf16_t* rowp = X + (size_t)row0 * DM + col0; xc[0] = *(const u32x4*)rowp; xc[1] = *(const u32x4*)(rowp + HALF); xn[0] = xc[0]; xn[1] = xc[1]; }
#pragma unroll
        for (int g = 0; g < 8; ++g) { const int ai = g >> 2, m = g & 3;
            bf16_t* rowp = X + (size_t)(row0 + ai * HALF + m * 16) * DM + col0;
            if (g < 7) { const bf16_t* nrow = X + (size_t)(row0 + ((g + 1) >> 2) * HALF + ((g + 1) & 3) * 16) * DM + col0; xn[0] = *(const u32x4*)nrow; xn[1] = *(const u32x4*)(nrow + HALF); }
            asm volatile("" ::: "memory");
#pragma unroll
            for (int bj = 0; bj < 2; ++bj) { const u32x4 w = xc[bj];
                const f32x4 a = xun4((u32x2){w.x, w.y}) + gv[bj][0] * acc[ai][bj][m][0], b = xun4((u32x2){w.z, w.w}) + gv[bj][1] * acc[ai][bj][m][1];
                const u32x2 pa = xpk4(a), pb = xpk4(b);
                *(u32x4*)(rowp + bj * HALF) = (u32x4){pa.x, pa.y, pb.x, pb.y}; }
            asm volatile("" ::: "memory");
            xc[0] = xn[0]; xc[1] = xn[1]; }
    }
};
struct EpiLogits {
    static constexpr bool PERM = false; static constexpr bool WIDE16 = false;
    float* LG0; float* LG12; const float* rb;
    struct Pre {}; static constexpr bool HAS_BIAS = false; static constexpr bool HALFN = true;
    __device__ __forceinline__ void operator()(const f32x4 (&acc)[2][2][4][2], const Unit& u, int wr, int wc, int fr, int fq, const Pre& pre) const {
        if (wc != 0) return;
        const int row0 = u.pm * BM + wr * 64 + fr;
        float* LG = u.aux == 0 ? LG0 : LG12 + (size_t)(u.aux - 1) * TT * 32;
        const float bs = u.aux == 0 ? 1.0f : 0.0f;
        const f32x4 b0 = *(const f32x4*)(rb + 4 * fq) * bs, b1 = *(const f32x4*)(rb + 16 + 4 * fq) * bs;
#pragma unroll
        for (int ai = 0; ai < 2; ++ai)
#pragma unroll
            for (int m = 0; m < 4; ++m) { float* rowp = LG + (size_t)(row0 + ai * HALF + m * 16) * 32 + 4 * fq;
                *(f32x4*)rowp = acc[ai][0][m][0] + b0; *(f32x4*)(rowp + 16) = acc[ai][0][m][1] + b1; }
    }
};
struct EpiSwiglu {
    static constexpr bool PERM = true; static constexpr bool WIDE16 = false;
    unsigned char* O; const float* b1l;
    struct Pre { const LAS float* b; };
    static constexpr bool HAS_BIAS = true; static constexpr bool HALFN = false;
    __device__ __forceinline__ float bias_of(const Unit& u, int i) const { return b1l[(size_t)u.aux * 2048 + (i < 128 ? u.pn * HALF + i : 1024 + u.pn * HALF + (i - 128))]; }
    __device__ __forceinline__ void operator()(const f32x4 (&acc)[2][2][4][2], const Unit& u, int wr, int wc, int fr, int fq, const Pre& pre) const {
        const int row0 = u.pm * BM + wr * 64 + fr, cg = u.pn * HALF + wc * 32 + 8 * fq;
        f32x4 bg[2], bl[2];
#pragma unroll
        for (int n = 0; n < 2; ++n) { bg[n] = *(const LAS f32x4*)(pre.b + wc * 32 + 8 * fq + 4 * n); bl[n] = *(const LAS f32x4*)(pre.b + 128 + wc * 32 + 8 * fq + 4 * n) + 1.0f; }
#pragma unroll
        for (int ai = 0; ai < 2; ++ai)
#pragma unroll
            for (int mp = 0; mp < 2; ++mp) { unsigned wx[2], wy[2];
#pragma unroll
                for (int mm = 0; mm < 2; ++mm) { const int m = 2 * mp + mm; f32x4 r[2];
#pragma unroll
                    for (int n = 0; n < 2; ++n) { const f32x4 k4 = {1.0f / W8_SCALE, 1.0f / W8_SCALE, 1.0f / W8_SCALE, 1.0f / W8_SCALE};
                        f32x4 g = __builtin_elementwise_fma(acc[ai][0][m][n], k4, bg[n]), l = __builtin_elementwise_fma(acc[ai][1][m][n], k4, bl[n]);
#pragma unroll
                        for (int j = 0; j < 4; ++j) { g[j] = fminf(g[j], 7.0f); l[j] = fminf(fmaxf(l[j], -6.0f), 8.0f); }
                        f32x4 t = g * (-1.702f * LOG2E);
#pragma unroll
                        for (int j = 0; j < 4; ++j) t[j] = __builtin_amdgcn_exp2f(t[j]);
                        t = t + 1.0f;
#pragma unroll
                        for (int j = 0; j < 4; ++j) t[j] = __builtin_amdgcn_rcpf(t[j]);
                        r[n] = (g * t) * l; }
                    wx[mm] = cvt4_fp8(r[0][0], r[0][1], r[0][2], r[0][3]); wy[mm] = cvt4_fp8(r[1][0], r[1][1], r[1][2], r[1][3]); }
                swap16(wx[0], wx[1]); swap16(wy[0], wy[1]);
                unsigned char* rowp = O + (size_t)(row0 + ai * HALF + (2 * mp + (fq & 1)) * 16) * DEXP + (cg - 8 * (fq & 1));
                *(u32x4*)rowp = (u32x4){wx[0], wy[0], wx[1], wy[1]}; }
    }
};
struct EpiGate {
    static constexpr bool PERM = true; static constexpr bool WIDE16 = true;
    unsigned char* O; const float* b2l;
    struct Pre { const LAS float* b; };
    static constexpr bool HAS_BIAS = true; static constexpr bool HALFN = false;
    __device__ __forceinline__ float bias_of(const Unit& u, int i) const { return b2l[(size_t)u.aux * 1024 + u.pn * BM + i]; }
    __device__ __forceinline__ void operator()(const f32x4 (&acc)[2][2][4][2], const Unit& u, int wr, int wc, int fr, int fq, const Pre& pre) const {
        const int row0 = u.pm * BM + wr * 64 + fr, col0 = u.pn * BM + wc * 64 + 16 * fq;
        f32x4 bv[2][2];
#pragma unroll
        for (int bj = 0; bj < 2; ++bj)
#pragma unroll
            for (int n = 0; n < 2; ++n) bv[bj][n] = *(const LAS f32x4*)(pre.b + wc * 64 + 16 * fq + 8 * bj + 4 * n) * YS_SCALE;
#pragma unroll
        for (int ai = 0; ai < 2; ++ai)
#pragma unroll
            for (int m = 0; m < 4; ++m) { unsigned char* rowp = O + (size_t)(col0 >> 6) * ((size_t)MAXSLOT * 64) + (size_t)(row0 + ai * HALF + m * 16) * 64 + (col0 & 63);
                u32x4 w;
                { const f32x4 v = acc[ai][0][m][0] * (YS_SCALE / W8_SCALE) + bv[0][0]; w.x = cvt4_fp8(v[0], v[1], v[2], v[3]); }
                { const f32x4 v = acc[ai][0][m][1] * (YS_SCALE / W8_SCALE) + bv[0][1]; w.y = cvt4_fp8(v[0], v[1], v[2], v[3]); }
                { const f32x4 v = acc[ai][1][m][0] * (YS_SCALE / W8_SCALE) + bv[1][0]; w.z = cvt4_fp8(v[0], v[1], v[2], v[3]); }
                { const f32x4 v = acc[ai][1][m][1] * (YS_SCALE / W8_SCALE) + bv[1][1]; w.w = cvt4_fp8(v[0], v[1], v[2], v[3]); }
                *(u32x4*)rowp = w; }
    }
};

template <class Epi, class Sched, bool FP8 = false, bool GATHER = false>
__device__ __forceinline__ void gemm_phase(LAS unsigned char* lds, const int K, const size_t lda2, const size_t ldb2, const Sched& S, const Epi& E) {
    const int tid = opaque_tid(), wid = __builtin_amdgcn_readfirstlane(tid >> 6), lane = tid & 63, wr = wid >> 2, wc = wid & 3, fr = lane & 15, fq = lane >> 4;
    int nt = K / BK; asm volatile("" : "+s"(nt));
    unsigned voffA[2], voffB[2];
#pragma unroll
    for (int i = 0; i < 2; ++i) { int R, C; stage_rc(tid * 16 + i * 8192, R, C); int Rb = Epi::PERM ? ((R & ~31) + perm32(R & 31)) : R;
        if constexpr (Epi::WIDE16) Rb = (Rb >> 5) * 64 + ((Rb >> 3) & 3) * 16 + (Rb & 7);
        voffA[i] = (unsigned)(R * (unsigned)lda2 + C * 2u); voffB[i] = (unsigned)(Rb * (unsigned)ldb2 + C * 2u); }
    const unsigned kstep = (unsigned)(BK * 2);
    const unsigned hstepA = (unsigned)(HALF * lda2), hstepB = (unsigned)((Epi::WIDE16 ? 8 : HALF) * ldb2);
    const unsigned ldsw = (unsigned)wid * 1024u;
    const int aoff = lds_byte(wr * 64 + fr, fq * 8), boff = lds_byte(wc * 32 + fr, fq * 8);
    const __amdgpu_buffer_rsrc_t rsA = __builtin_amdgcn_make_buffer_rsrc((void*)S.baseA(), 0, 0x7fffffff, 0x00020000);
    const __amdgpu_buffer_rsrc_t rsB = __builtin_amdgcn_make_buffer_rsrc((void*)S.baseB(), 0, 0x7fffffff, 0x00020000);
#define PG8_SA(b, h) (((b) * 2 + (h)) * HTB)
#define PG8_SB(b, h) ((4 + (b) * 2 + (h)) * HTB)
#define PG8_STAGE(bufoff, rs, soff, voff) do { _Pragma("unroll") for (int _i = 0; _i < 2; ++_i) \
        __builtin_amdgcn_raw_ptr_buffer_load_lds(rs, (LAS unsigned*)(lds + (bufoff) + ldsw + _i * 8192), 16, (voff)[_i], (soff), 0, 0); } while (0)
#define PG8_STAGEA(b, h, aoffs, koff, nx) do { if constexpr (GATHER) { _Pragma("unroll") for (int _i = 0; _i < 2; ++_i) \
            __builtin_amdgcn_raw_ptr_buffer_load_lds(rsA, (LAS unsigned*)(lds + PG8_SA(b, h) + ldsw + _i * 8192), 16, (nx) ? ngvo[h][_i] : gvo[h][_i], (koff), 0, 0); } \
        else PG8_STAGE(PG8_SA(b, h), rsA, (aoffs) + (h) * hstepA, voffA); } while (0)
#define PG8_RD8(off) __builtin_shufflevector(*(const LAS v4i_t*)(lds + (off)), *(const LAS v4i_t*)(lds + (off) + 1024), 0, 1, 2, 3, 4, 5, 6, 7)
#define PG8_LDA(dst, b, h) do { if constexpr (FP8) { _Pragma("unroll") for (int m = 0; m < 4; ++m) dst##8[m] = PG8_RD8(PG8_SA(b, h) + aoff + m * 2048); } \
        else { _Pragma("unroll") for (int m = 0; m < 4; ++m) _Pragma("unroll") for (int k = 0; k < 2; ++k) dst[m][k] = *(const LAS bf16x8*)(lds + PG8_SA(b, h) + aoff + m * 2048 + k * 1024); } } while (0)
#define PG8_LDB(dst, b, h) do { if constexpr (FP8) { _Pragma("unroll") for (int n = 0; n < 2; ++n) dst##8[n] = PG8_RD8(PG8_SB(b, h) + boff + n * 2048); } \
        else { _Pragma("unroll") for (int n = 0; n < 2; ++n) _Pragma("unroll") for (int k = 0; k < 2; ++k) dst[n][k] = *(const LAS bf16x8*)(lds + PG8_SB(b, h) + boff + n * 2048 + k * 1024); } } while (0)
#define PG8_MMA(ai, bj, At, Bt, Z) do { __builtin_amdgcn_s_setprio(1); \
        if (Z) { _Pragma("unroll") for (int m = 0; m < 4; ++m) _Pragma("unroll") for (int n = 0; n < 2; ++n) { \
            if constexpr (FP8) asm volatile("s_nop 1\n\tv_mfma_scale_f32_16x16x128_f8f6f4 %0, %1, %2, 0, %3, %3 op_sel_hi:[0,0,0]" : "=&v"(acc[ai][bj][m][n]) : "v"(Bt##8[n]), "v"(At##8[m]), "v"(sc1)); \
            else { acc[ai][bj][m][n] = __builtin_amdgcn_mfma_f32_16x16x32_bf16(Bt[n][0], At[m][0], (f32x4){0.f, 0.f, 0.f, 0.f}, 0, 0, 0); \
                   acc[ai][bj][m][n] = __builtin_amdgcn_mfma_f32_16x16x32_bf16(Bt[n][1], At[m][1], acc[ai][bj][m][n], 0, 0, 0); } } } \
        else { _Pragma("unroll") for (int m = 0; m < 4; ++m) _Pragma("unroll") for (int n = 0; n < 2; ++n) { \
            if constexpr (FP8) asm volatile("s_nop 1\n\tv_mfma_scale_f32_16x16x128_f8f6f4 %0, %1, %2, %0, %3, %3 op_sel_hi:[0,0,0]" : "+v"(acc[ai][bj][m][n]) : "v"(Bt##8[n]), "v"(At##8[m]), "v"(sc1)); \
            else { _Pragma("unroll") for (int k = 0; k < 2; ++k) acc[ai][bj][m][n] = __builtin_amdgcn_mfma_f32_16x16x32_bf16(Bt[n][k], At[m][k], acc[ai][bj][m][n], 0, 0, 0); } } } \
        __builtin_amdgcn_s_setprio(0); } while (0)
#define PG8_WAIT_V(n) asm volatile("s_waitcnt vmcnt(" #n ")" ::: "memory")
#define PG8_WAIT_L(n) asm volatile("s_waitcnt lgkmcnt(" #n ")" ::: "memory")
#define PG8_BAR __builtin_amdgcn_s_barrier()
#define PG8_SCHED __builtin_amdgcn_sched_barrier(0)
    Unit cur, nxt; int ui = 0; typename Epi::Pre pre;
    if (!S.next(0, cur)) return;
    f32x4 acc[2][2][4][2];
#pragma unroll
    for (int a = 0; a < 2; ++a)
#pragma unroll
        for (int b = 0; b < 2; ++b)
#pragma unroll
            for (int m = 0; m < 4; ++m)
#pragma unroll
                for (int n = 0; n < 2; ++n) acc[a][b][m][n] = (f32x4){0.f, 0.f, 0.f, 0.f};
    bf16x8 At[4][2], B0[2][2], B1[2][2];
    v8i_t At8[4], B08[2], B18[2];
    int sc1 = 0x7f7f7f7f; asm volatile("" : "+v"(sc1));
    unsigned cA = cur.a, cB = cur.b;
    unsigned gvo[2][2] = {{0u, 0u}, {0u, 0u}}, ngvo[2][2] = {{0u, 0u}, {0u, 0u}};
    int gR[2], gC[2];
#pragma unroll
    for (int i = 0; i < 2; ++i) stage_rc(tid * 16 + i * 8192, gR[i], gC[i]);
#define PG8_GLOAD(dst, pm_) do { if constexpr (GATHER) { const int* tb_ = S.gather() + (pm_) * BM; \
        _Pragma("unroll") for (int h_ = 0; h_ < 2; ++h_) _Pragma("unroll") for (int i_ = 0; i_ < 2; ++i_) dst[h_][i_] = (unsigned)tb_[h_ * HALF + gR[i_]] * (unsigned)lda2 + (unsigned)gC[i_] * 2u; } } while (0)
    PG8_GLOAD(gvo, cur.pm);
#define PG8_STAGEB1(b, boffs) do { if constexpr (!Epi::HALFN) PG8_STAGE(PG8_SB(b, 1), rsB, (boffs) + hstepB, voffB); } while (0)
#define PG8_WAIT_VS() do { if constexpr (Epi::HALFN) PG8_WAIT_V(6); else PG8_WAIT_V(8); } while (0)
    PG8_STAGE(PG8_SB(0, 0), rsB, cB, voffB); PG8_STAGEB1(0, cB); PG8_STAGEA(0, 0, cA, 0u, false); PG8_STAGEA(0, 1, cA, 0u, false);
    if (wr == 1) PG8_BAR;
    PG8_WAIT_V(2); PG8_BAR;
    PG8_STAGE(PG8_SB(1, 0), rsB, cB + kstep, voffB); PG8_STAGEA(1, 0, cA + kstep, kstep, false); PG8_STAGEB1(1, cB + kstep);
    if constexpr (Epi::HALFN) PG8_WAIT_V(4); else PG8_WAIT_V(6);
    PG8_BAR;
    for (;;) {
        const bool has_next = S.next(ui + 1, nxt);
        const unsigned nA = has_next ? nxt.a : cA, nB = has_next ? nxt.b : cB;
        LAS int* gl = (LAS int*)(lds + LDSCTL_OFF + 8192) + (ui & 1) * 256;
        for (int t = 0; t < nt; t += 2) {
            const bool last = (t == nt - 2), z0 = (t == 0);
            int gstage = 0;
            if constexpr (GATHER) {
                if (t == 0 && has_next) { int tz = threadIdx.x; asm volatile("" : "+v"(tz)); gstage = S.gather()[nxt.pm * BM + (tz & 255)]; }
                if (last) { if (has_next) { _Pragma("unroll") for (int h_ = 0; h_ < 2; ++h_) _Pragma("unroll") for (int i_ = 0; i_ < 2; ++i_) ngvo[h_][i_] = (unsigned)gl[h_ * HALF + gR[i_]] * (unsigned)lda2 + (unsigned)gC[i_] * 2u; }
                            else { _Pragma("unroll") for (int h_ = 0; h_ < 2; ++h_) _Pragma("unroll") for (int i_ = 0; i_ < 2; ++i_) ngvo[h_][i_] = gvo[h_][i_]; } } }
            float bstage = 0.f;
            if constexpr (Epi::HAS_BIAS) { if (last) { int tz = threadIdx.x; asm volatile("" : "+v"(tz)); bstage = E.bias_of(cur, tz & 255); } }
            const unsigned a1 = cA + (unsigned)(t + 1) * kstep, k1 = (unsigned)(t + 1) * kstep;
            const unsigned a2 = last ? nA : cA + (unsigned)(t + 2) * kstep, b2 = last ? nB : cB + (unsigned)(t + 2) * kstep, k2 = last ? 0u : (unsigned)(t + 2) * kstep;
            const unsigned a3 = a2 + kstep, b3 = b2 + kstep, k3 = k2 + kstep;
            PG8_LDB(B0, 0, 0); if constexpr (!Epi::HALFN) PG8_LDB(B1, 0, 1); PG8_SCHED; PG8_LDA(At, 0, 0); PG8_STAGEA(1, 1, a1, k1, false);
            PG8_WAIT_VS(); PG8_WAIT_L(0); PG8_BAR; PG8_MMA(0, 0, At, B0, z0); if constexpr (!Epi::HALFN) PG8_MMA(0, 1, At, B1, z0); PG8_BAR; PG8_SCHED;
            PG8_LDA(At, 0, 1); PG8_STAGE(PG8_SB(0, 0), rsB, b2, voffB); PG8_STAGEB1(0, b2); PG8_STAGEA(0, 0, a2, k2, last);
            PG8_WAIT_VS(); PG8_WAIT_L(0); PG8_BAR; PG8_MMA(1, 0, At, B0, z0); if constexpr (!Epi::HALFN) PG8_MMA(1, 1, At, B1, z0); PG8_BAR; PG8_SCHED;
            if constexpr (Epi::HAS_BIAS) { if (last) { int tz = threadIdx.x; asm volatile("" : "+v"(tz)); if (tz < 256) ((LAS float*)(lds + LDSCTL_OFF + 2048 + (ui & 1) * 1024))[tz] = bstage; } }
            PG8_LDB(B0, 1, 0); if constexpr (!Epi::HALFN) PG8_LDB(B1, 1, 1); PG8_SCHED; PG8_LDA(At, 1, 0); PG8_STAGEA(0, 1, a2, k2, last);
            PG8_WAIT_VS(); PG8_WAIT_L(0); PG8_BAR; PG8_MMA(0, 0, At, B0, false); if constexpr (!Epi::HALFN) PG8_MMA(0, 1, At, B1, false); PG8_BAR; PG8_SCHED;
            PG8_LDA(At, 1, 1); PG8_STAGE(PG8_SB(1, 0), rsB, b3, voffB); PG8_STAGEB1(1, b3); PG8_STAGEA(1, 0, a3, k3, last);
            PG8_WAIT_VS(); PG8_WAIT_L(0); PG8_BAR; PG8_MMA(1, 0, At, B0, false); if constexpr (!Epi::HALFN) PG8_MMA(1, 1, At, B1, false); PG8_BAR; PG8_SCHED;
            if constexpr (GATHER) { if (t == 0 && has_next) { int tz = threadIdx.x; asm volatile("" : "+v"(tz)); if (tz < 256) gl[tz] = gstage; } }
        }
        if constexpr (FP8) asm volatile("s_nop 15\n\ts_nop 7" ::: "memory");
        if (wr == 0) PG8_BAR;
        { int tz = threadIdx.x; asm volatile("" : "+v"(tz)); const int ln = tz & 63;
          if constexpr (Epi::HAS_BIAS) pre.b = (const LAS float*)(lds + LDSCTL_OFF + 2048 + (ui & 1) * 1024);
          E(acc, cur, wr, wc, ln & 15, ln >> 4, pre); }
        if (!has_next) break;
        cur = nxt; cA = nA; cB = nB; ++ui;
        if constexpr (GATHER) { _Pragma("unroll") for (int h_ = 0; h_ < 2; ++h_) _Pragma("unroll") for (int i_ = 0; i_ < 2; ++i_) gvo[h_][i_] = ngvo[h_][i_]; }
        if (wr == 1) PG8_BAR;
    }
    PG8_WAIT_V(0);
    PG8_BAR;
#undef PG8_SA
#undef PG8_SB
#undef PG8_STAGE
#undef PG8_STAGEA
#undef PG8_GLOAD
#undef PG8_LDA
#undef PG8_LDB
#undef PG8_MMA
#undef PG8_RD8
#undef PG8_WAIT_V
#undef PG8_WAIT_L
#undef PG8_BAR
#undef PG8_SCHED
}
}

__device__ __forceinline__ u32x4 rope_chunk(u32x4 xw, u32x4 yw, const f32x2* tab, bool first) {
    u32x4 o;
#pragma unroll
    for (int i = 0; i < 4; ++i) {
        const f32x2 cs0 = tab[2 * i], cs1 = tab[2 * i + 1];
        const float x0 = bflo(xw[i]), x1 = bfhi(xw[i]), y0 = bflo(yw[i]), y1 = bfhi(yw[i]);
        const float r0 = first ? x0 * cs0.x - y0 * cs0.y : x0 * cs0.x + y0 * cs0.y;
        const float r1 = first ? x1 * cs1.x - y1 * cs1.y : x1 * cs1.x + y1 * cs1.y;
        o[i] = pk2(r0, r1);
    }
    return o;
}

namespace att {
constexpr int KCS = 1040;
constexpr int KSLOT = 12544, VSLOT = 8192;
constexpr int OFF_K = 0, OFF_V = 4 * KSLOT, OFF_WSF = OFF_V + 4 * VSLOT, OFF_OST = OFF_WSF + 2048, OFF_BIAS = OFF_OST + 32768, ATT_LDS = OFF_BIAS + 2048;
static_assert(ATT_LDS <= ARENA_BYTES, "attention LDS map");
__device__ __forceinline__ int crow(int r, int hi) { return (r & 3) + 8 * (r >> 2) + 4 * hi; }
__device__ __forceinline__ unsigned cvtpk(float lo, float hi) { typedef __bf16 bf16x2_t __attribute__((ext_vector_type(2))); f32x2 v = {lo, hi}; bf16x2_t b = __builtin_convertvector(v, bf16x2_t); return __builtin_bit_cast(unsigned, b); }
__device__ __forceinline__ s16x4 vtr(const LAS unsigned char* p) { return __builtin_bit_cast(s16x4, __builtin_amdgcn_ds_read_tr16_b64_v4i16((LAS s16x4*)p)); }
constexpr float NEGBIG = -1e30f;
__device__ __forceinline__ void pair32(float x, float& a, float& b) {
    unsigned u = __builtin_bit_cast(unsigned, x), v = u;
    asm volatile("s_nop 1\n\tv_permlane32_swap_b32 %0, %1\n\ts_nop 1" : "+v"(u), "+v"(v));
    a = __builtin_bit_cast(float, u); b = __builtin_bit_cast(float, v);
}

__device__ __forceinline__ unsigned xlane32(unsigned x, bool lo) {
    unsigned u = x, v = x;
    asm volatile("s_nop 1\n\tv_permlane32_swap_b32 %0, %1\n\ts_nop 1" : "+v"(u), "+v"(v));
    return lo ? v : u;
}
struct UMla {
    static constexpr int NKC = 12; static constexpr bool PLAIN = true; static constexpr bool SIDED = false;
    const bf16_t* QB; const bf16_t* KVB; const bf16_t* PB; bf16_t* AO; const f32x2* R32; int b, h, qblk; bool ctxq;
    template <int NKS> __device__ __forceinline__ void qfix(bf16x8 (&qr)[NKS], int wid, int r32, int hi) const {
        if (ctxq) return;
        const int t = 256 * qblk + 32 * wid + r32, prow = t >> 6, pcol = t & 63;
#pragma unroll
        for (int f = 0; f < 2; ++f) { const u32x4 own = __builtin_bit_cast(u32x4, qr[4 + f]); u32x4 oth;
            oth.x = xlane32(own.x, hi == 0); oth.y = xlane32(own.y, hi == 0); oth.z = xlane32(own.z, hi == 0); oth.w = xlane32(own.w, hi == 0);
            qr[4 + f] = __builtin_bit_cast(bf16x8, rope_chunk(own, oth, R32 + (f == 0 ? prow : pcol) * 8, hi == 0)); }
    }
    __device__ __forceinline__ float c2() const { return 0.10206207261596577f * LOG2E; }
    __device__ __forceinline__ int ntiles() const { return ctxq ? 4 : 132; }
    __device__ __forceinline__ bool active(int, int) const { return true; }
    __device__ __forceinline__ size_t krow(int t, int key) const { return ctxq ? (size_t)(TL + b * CTXL + 64 * t + key) : (t < 128 ? (size_t)(b * SEQ + 64 * t + key) : (size_t)(TL + b * CTXL + 64 * (t - 128) + key)); }
    __device__ __forceinline__ unsigned kofs() const { return (unsigned)WS_KVB + 256u * h; }  __device__ __forceinline__ unsigned kpitch() const { return 2048u; }
    __device__ __forceinline__ unsigned k2ofs() const { return (unsigned)WS_PB + 3584u; }     __device__ __forceinline__ unsigned k2pitch() const { return 2u * EV_LD; }
    __device__ __forceinline__ unsigned vofs() const { return (unsigned)WS_KVB + 256u * h + 128u; } __device__ __forceinline__ unsigned vpitch() const { return 2048u; }
    __device__ __forceinline__ unsigned trow(int t) const { return (unsigned)krow(t, 0); }
    __device__ __forceinline__ size_t qrow(int wid, int r) const { return ctxq ? (size_t)(TL + b * CTXL + 32 * wid + r) : (size_t)(b * SEQ + 256 * qblk + 32 * wid + r); }
    __device__ __forceinline__ const bf16_t* qptr(int wid, int r) const { return QB + qrow(wid, r) * 768 + 96 * h; }
    __device__ __forceinline__ unsigned char* optr(int wid, int r) const { return (unsigned char*)AO + qrow(wid, r) * 1024 + 512 + 64 * h; }
    __device__ __forceinline__ float m0(int) const { return NEGBIG; }
    __device__ __forceinline__ float l0() const { return 0.f; }
    __device__ __forceinline__ void prep(LAS unsigned char*) const {}
    __device__ __forceinline__ float adjust(int, int, int, int, float s, const LAS unsigned char*) const { return s; }
};
struct UWin {
    static constexpr int NKC = 8; static constexpr bool PLAIN = false; static constexpr bool SIDED = false;
    const bf16_t* PB; bf16_t* AO; const float* sink; int b, kvh, j; bool ctxq; int tlo, nlat;
    template <int NKS> __device__ __forceinline__ void qfix(bf16x8 (&)[NKS], int, int, int) const {}
    __device__ __forceinline__ void init() { tlo = j - 2 < 0 ? 0 : j - 2; const int thi = j + 2 > 127 ? 127 : j + 2; nlat = ctxq ? 0 : thi - tlo + 1; }
    __device__ __forceinline__ float c2() const { return 0.125f * LOG2E; }
    __device__ __forceinline__ int ntiles() const { return nlat + 4; }
    __device__ __forceinline__ bool active(int, int) const { return true; }
    __device__ __forceinline__ size_t krow(int t, int key) const { return t < nlat ? (size_t)(b * SEQ + 64 * (tlo + t) + key) : (size_t)(TL + b * CTXL + 64 * (t - nlat) + key); }
    __device__ __forceinline__ unsigned kofs() const { return (unsigned)WS_PB + 2u * (512 + 64 * kvh); }  __device__ __forceinline__ unsigned kpitch() const { return 2u * EV_LD; }
    __device__ __forceinline__ unsigned k2ofs() const { return 0u; }  __device__ __forceinline__ unsigned k2pitch() const { return 0u; }
    __device__ __forceinline__ unsigned vofs() const { return (unsigned)WS_PB + 2u * (640 + 64 * kvh); }  __device__ __forceinline__ unsigned vpitch() const { return 2u * EV_LD; }
    __device__ __forceinline__ unsigned trow(int t) const { return (unsigned)krow(t, 0); }
    __device__ __forceinline__ int qpos(int wid, int r) const { return 64 * j + 32 * (wid >> 2) + r; }
    __device__ __forceinline__ size_t qrow(int wid, int r) const { return ctxq ? (size_t)(TL + b * CTXL + qpos(wid, r)) : (size_t)(b * SEQ + qpos(wid, r)); }
    __device__ __forceinline__ const bf16_t* qptr(int wid, int r) const { return PB + qrow(wid, r) * EV_LD + 64 * (4 * kvh + (wid & 3)); }
    __device__ __forceinline__ unsigned char* optr(int wid, int r) const { return (unsigned char*)AO + qrow(wid, r) * 1024 + 64 * (4 * kvh + (wid & 3)); }
    __device__ __forceinline__ float m0(int wid) const { return sink[4 * kvh + (wid & 3)] * LOG2E; }
    __device__ __forceinline__ float l0() const { return 1.f; }
    __device__ __forceinline__ void prep(LAS unsigned char*) const {}
    __device__ __forceinline__ void adjust_tile(f32x16& P0, f32x16& P1, int t, int wid, int r32, int hi, float c2, const LAS unsigned char*, int) const {
        const int tt = tlo + t;
        if (t >= nlat || (tt > j - 2 && tt < j + 2)) {
#pragma unroll
            for (int r = 0; r < 16; ++r) { P0[r] *= c2; P1[r] *= c2; }
        } else { const int dq = qpos(wid, r32) - 64 * (tlo + t) - 4 * hi + 128;
#pragma unroll
            for (int r = 0; r < 16; ++r) { const int k0 = (r & 3) + 8 * (r >> 2);
                P0[r] = ((unsigned)(dq - k0) <= 256u) ? P0[r] * c2 : NEGBIG; P1[r] = ((unsigned)(dq - k0 - 32) <= 256u) ? P1[r] * c2 : NEGBIG; } }
    }
};
struct UNa {
    static constexpr int NKC = 8; static constexpr bool PLAIN = false; static constexpr bool SIDED = true;
    const bf16_t* PB; bf16_t* AO; const float* rpbh; int b, h, G; bool ctxq; int rlo, nlat;
    template <int NKS> __device__ __forceinline__ void qfix(bf16x8 (&)[NKS], int, int, int) const {}
    __device__ __forceinline__ void init() { int lo = 4 * G - 4; lo = lo < 0 ? 0 : (lo > 120 ? 120 : lo); int hi = 4 * G - 1; hi = hi < 0 ? 0 : (hi > 120 ? 120 : hi); rlo = lo; nlat = ctxq ? 0 : hi + 8 - lo; }
    __device__ __forceinline__ float c2() const { return 0.125f * LOG2E; }
    __device__ __forceinline__ int ntiles() const { return nlat + 4; }
    __device__ __forceinline__ int qgrow(int wid) const { return 4 * G + (wid >> 1); }
    __device__ __forceinline__ int r0w(int wid) const { int r0 = qgrow(wid) - 4; return r0 < 0 ? 0 : (r0 > 120 ? 120 : r0); }
    __device__ __forceinline__ bool active(int t, int wid) const { if (t >= nlat) return true; const int kr = rlo + t, r0 = r0w(wid); return kr >= r0 && kr < r0 + 8; }
    __device__ __forceinline__ size_t krow(int t, int key) const { return t < nlat ? (size_t)(b * SEQ + 64 * (rlo + t) + key) : (size_t)(TL + b * CTXL + 64 * (t - nlat) + key); }
    __device__ __forceinline__ unsigned kofs() const { return (unsigned)WS_PB + 2u * (1024 + 64 * h); }  __device__ __forceinline__ unsigned kpitch() const { return 2u * OD_LD; }
    __device__ __forceinline__ unsigned k2ofs() const { return 0u; }  __device__ __forceinline__ unsigned k2pitch() const { return 0u; }
    __device__ __forceinline__ unsigned vofs() const { return (unsigned)WS_PB + 2u * (2048 + 64 * h); }  __device__ __forceinline__ unsigned vpitch() const { return 2u * OD_LD; }
    __device__ __forceinline__ unsigned trow(int t) const { return (unsigned)krow(t, 0); }
    __device__ __forceinline__ size_t qrow(int wid, int r) const { return ctxq ? (size_t)(TL + b * CTXL + 32 * wid + r) : (size_t)(b * SEQ + 64 * qgrow(wid) + 32 * (wid & 1) + r); }
    __device__ __forceinline__ const bf16_t* qptr(int wid, int r) const { return PB + qrow(wid, r) * OD_LD + 64 * h; }
    __device__ __forceinline__ unsigned char* optr(int wid, int r) const { return (unsigned char*)AO + qrow(wid, r) * 1024 + 64 * h; }
    __device__ __forceinline__ float m0(int) const { return NEGBIG; }
    __device__ __forceinline__ float l0() const { return 0.f; }
    __device__ __forceinline__ void prep(LAS unsigned char* L) const {
        if (!ctxq) { LAS float* bt = (LAS float*)(L + OFF_BIAS); for (int i = opaque_tid(); i < 15 * 31; i += 512) bt[i] = rpbh[i] * LOG2E; }
    }
    __device__ __forceinline__ void adjust_tile(f32x16& P0, f32x16& P1, int t, int wid, int r32, int hi, float c2, const LAS unsigned char* L, int side) const {
        if (t >= nlat) {
#pragma unroll
            for (int r = 0; r < 16; ++r) { P0[r] *= c2; P1[r] *= c2; }
        } else { const int qc = 32 * (wid & 1) + r32; int c0 = qc - 8; c0 = c0 < 0 ? 0 : (c0 > 48 ? 48 : c0);
            const LAS float* bp = (const LAS float*)(L + OFF_BIAS) + (rlo + t - qgrow(wid) + 7) * 31 + (15 - qc + 4 * hi);
            const int kb = 4 * hi - c0;
#pragma unroll
            for (int r = 0; r < 16; ++r) { const int k0 = (r & 3) + 8 * (r >> 2);
                if (!(side == 2 && r < 12)) { const float b0 = bp[k0]; P0[r] = ((unsigned)(kb + k0) < 16u) ? P0[r] * c2 + b0 : NEGBIG; }
                if (!(side == 1 && r >= 4)) { const float b1 = bp[k0 + 32]; P1[r] = ((unsigned)(kb + k0 + 32) < 16u) ? P1[r] * c2 + b1 : NEGBIG; } } }
    }
};

__device__ __forceinline__ float fma_s(float a, float b, float c) { float r; asm("v_fma_f32 %0, %1, %2, %3" : "=v"(r) : "v"(a), "v"(b), "v"(c)); return r; }
__device__ __forceinline__ float max3f(float a, float b, float c) { float r; asm("v_max3_f32 %0, %1, %2, %3" : "=v"(r) : "v"(a), "v"(b), "v"(c)); return r; }
template <class U>
__device__ __forceinline__ void attn_unit(LAS unsigned char* L, unsigned char* wsbase, const U& u) {
    constexpr int NKC = U::NKC, NKS = NKC / 2;
    const int tid = opaque_tid(), lane = tid & 63, r32 = lane & 31, hi = lane >> 5; const int wid = __builtin_amdgcn_readfirstlane(tid >> 6);
    bf16x8 qr[NKS];
    float m = u.m0(wid), l = hi == 0 ? u.l0() : 0.f;
    f32x16 o[2];
#pragma unroll
    for (int r = 0; r < 16; ++r) { o[0][r] = 0.f; o[1][r] = 0.f; }
    const float c2 = u.c2();
    const int NT = u.ntiles();
    LAS float* wsf = (LAS float*)(L + OFF_WSF) + wid * 64;
    const LAS unsigned char* kbase = L + OFF_K + hi * KCS + r32 * 16;
    const LAS unsigned char* vbase = L + OFF_V + ((lane >> 4) & 1) * 32 + (lane & 3) * 8 + (4 * hi + ((lane & 15) >> 2)) * 64;
    const __amdgpu_buffer_rsrc_t rs = __builtin_amdgcn_make_buffer_rsrc((void*)wsbase, 0, 0x7fffffff, 0x00020000);
    const unsigned kvo = (unsigned)lane * u.kpitch(), kvo2 = (unsigned)lane * u.k2pitch(), vvo = (unsigned)(lane >> 2) * u.vpitch() + (unsigned)(lane & 3) * 16u;
    const unsigned kso = u.kofs() + 16u * wid, kso2 = u.k2ofs() + 16u * wid, vso = u.vofs() + 16u * (wid & 3) * u.vpitch() + 64u * (wid >> 2);
    const bool two = (NKC == 12) && (wid < 4);
#define ATT_DMAK(t) do { const int tc_ = (t) < NT ? (t) : NT - 1; const unsigned r0_ = u.trow(tc_); LAS unsigned char* kd_ = L + OFF_K + ((t) & 3) * KSLOT; \
        __builtin_amdgcn_raw_ptr_buffer_load_lds(rs, (LAS unsigned*)(kd_ + wid * KCS), 16, kvo, kso + r0_ * u.kpitch(), 0, 0); \
        if (two) __builtin_amdgcn_raw_ptr_buffer_load_lds(rs, (LAS unsigned*)(kd_ + (8 + wid) * KCS), 16, kvo2, kso2 + r0_ * u.k2pitch(), 0, 0); } while (0)
#define ATT_DMAV(t) do { const int tc_ = (t) < NT ? (t) : NT - 1; const unsigned r0_ = u.trow(tc_); \
        __builtin_amdgcn_raw_ptr_buffer_load_lds(rs, (LAS unsigned*)(L + OFF_V + ((t) & 3) * VSLOT + wid * 1024), 16, vvo, vso + r0_ * u.vpitch(), 0, 0); } while (0)
#define ATT_WAIT_BAR() do { if (two) asm volatile("s_waitcnt vmcnt(6)" ::: "memory"); else asm volatile("s_waitcnt vmcnt(4)" ::: "memory"); \
        __builtin_amdgcn_s_barrier(); asm volatile("" ::: "memory"); } while (0)
#define ATT_QKT(S0, S1, t) do { const LAS unsigned char* kb_ = kbase + ((t) & 3) * KSLOT; \
        _Pragma("unroll") for (int r = 0; r < 16; ++r) { S0[r] = 0.f; S1[r] = 0.f; } \
        _Pragma("unroll") for (int kh_ = 0; kh_ < 2; ++kh_) { bf16x8 kf0[NKS / 2], kf1[NKS / 2]; \
            _Pragma("unroll") for (int ks = 0; ks < NKS / 2; ++ks) { kf0[ks] = *(const LAS bf16x8*)(kb_ + (kh_ * (NKS / 2) + ks) * (2 * KCS)); kf1[ks] = *(const LAS bf16x8*)(kb_ + (kh_ * (NKS / 2) + ks) * (2 * KCS) + 512); } \
            _Pragma("unroll") for (int ks = 0; ks < NKS / 2; ++ks) { S0 = __builtin_amdgcn_mfma_f32_32x32x16_bf16(kf0[ks], qr[kh_ * (NKS / 2) + ks], S0, 0, 0, 0); S1 = __builtin_amdgcn_mfma_f32_32x32x16_bf16(kf1[ks], qr[kh_ * (NKS / 2) + ks], S1, 0, 0, 0); } } } while (0)
#define ATT_LIVE0(r, SIDE) (!((SIDE) == 2 && (r) < 12))
#define ATT_LIVE1(r, SIDE) (!((SIDE) == 1 && (r) >= 4))
#define ATT_SOFTMAX(P0, P1, T, SIDE) do { float rm; \
        if constexpr (U::PLAIN) { float a_ = max3f(P0[0], P1[0], P0[1]), b_ = max3f(P1[1], P0[2], P1[2]); \
            _Pragma("unroll") for (int r = 3; r < 15; r += 2) { a_ = max3f(a_, P0[r], P1[r]); b_ = max3f(b_, P0[r + 1], P1[r + 1]); } \
            rm = max3f(a_, b_, fmaxf(P0[15], P1[15])) * c2; } \
        else { u.adjust_tile(P0, P1, (T), wid, r32, hi, c2, L, (SIDE)); \
            if ((SIDE) == 0) { float a_ = max3f(P0[0], P1[0], P0[1]), b_ = max3f(P1[1], P0[2], P1[2]); \
                _Pragma("unroll") for (int r = 3; r < 15; r += 2) { a_ = max3f(a_, P0[r], P1[r]); b_ = max3f(b_, P0[r + 1], P1[r + 1]); } \
                rm = max3f(a_, b_, fmaxf(P0[15], P1[15])); } \
            else { float a_ = NEGBIG, b_ = NEGBIG; \
                _Pragma("unroll") for (int r = 0; r < 16; ++r) { if (ATT_LIVE0(r, SIDE)) a_ = fmaxf(a_, P0[r]); if (ATT_LIVE1(r, SIDE)) b_ = fmaxf(b_, P1[r]); } \
                rm = fmaxf(a_, b_); } } \
        { float ra, rb; pair32(rm, ra, rb); rm = fmaxf(ra, rb); } \
        const float mn = fmaxf(m, rm); alpha = __builtin_amdgcn_exp2f(m - mn); resc = __any(mn > m); m = mn; \
        float lsa = 0.f; const float nmn = -mn;       \
        if constexpr (U::PLAIN) { _Pragma("unroll") for (int r = 0; r < 16; ++r) { P0[r] = __builtin_amdgcn_exp2f(fma_s(P0[r], c2, nmn)); P1[r] = __builtin_amdgcn_exp2f(fma_s(P1[r], c2, nmn)); lsa += P0[r]; lsa += P1[r]; } } \
        else { _Pragma("unroll") for (int r = 0; r < 16; ++r) { \
                if (ATT_LIVE0(r, SIDE)) { P0[r] = __builtin_amdgcn_exp2f(P0[r] - mn); lsa += P0[r]; } else P0[r] = 0.f; \
                if (ATT_LIVE1(r, SIDE)) { P1[r] = __builtin_amdgcn_exp2f(P1[r] - mn); lsa += P1[r]; } else P1[r] = 0.f; } } \
        l = l * alpha + lsa; \
        _Pragma("unroll") for (int i = 0; i < 4; ++i) { if ((SIDE) != 2) pw[0][i] = cvtpk(P0[2 * i], P0[2 * i + 1]); pw[1][i] = cvtpk(P0[8 + 2 * i], P0[9 + 2 * i]); pw[2][i] = cvtpk(P1[2 * i], P1[2 * i + 1]); if ((SIDE) != 1) pw[3][i] = cvtpk(P1[8 + 2 * i], P1[9 + 2 * i]); } } while (0)
#define ATT_STEP(SC0, SC1, SN0, SN1, T, SIDE) do { const int t_ = (T); \
        ATT_DMAK(t_ + 3); ATT_DMAV(t_ + 2); \
        ATT_WAIT_BAR(); \
        const bool a_cur = u.active(t_, wid), a_nxt = (t_ + 1 < NT) && u.active(t_ + 1, wid); \
        float alpha = 1.f; bool resc = false; u32x4 pw[4]; \
        if (a_cur && a_nxt) { ATT_QKT(SN0, SN1, t_ + 1); ATT_SOFTMAX(SC0, SC1, t_, SIDE); } \
        else { if (a_nxt) ATT_QKT(SN0, SN1, t_ + 1); \
               if (a_cur) ATT_SOFTMAX(SC0, SC1, t_, SIDE); } \
        __builtin_amdgcn_sched_barrier(0); \
        if (a_cur) { \
            const LAS unsigned char* vb_ = vbase + (t_ & 3) * VSLOT; s16x4 vlo[2][4], vhi[2][4]; \
            _Pragma("unroll") for (int dh = 0; dh < 2; ++dh) _Pragma("unroll") for (int ks = 0; ks < 4; ++ks) { if (((SIDE) == 1 && ks == 3) || ((SIDE) == 2 && ks == 0)) continue; vlo[dh][ks] = vtr(vb_ + dh * 4096 + ks * 1024); vhi[dh][ks] = vtr(vb_ + dh * 4096 + ks * 1024 + 512); } \
            if (resc) { if (hi == 0) wsf[r32] = alpha; LDS_WAIT(); \
                _Pragma("unroll") for (int r = 0; r < 16; ++r) { const float f = wsf[crow(r, hi)]; o[0][r] *= f; o[1][r] *= f; } } \
            _Pragma("unroll") for (int dh = 0; dh < 2; ++dh) _Pragma("unroll") for (int ks = 0; ks < 4; ++ks) { if (((SIDE) == 1 && ks == 3) || ((SIDE) == 2 && ks == 0)) continue; \
                const s16x4 lo4 = vlo[dh][ks], hi4 = vhi[dh][ks]; const bf16x8 vf = {lo4[0], lo4[1], lo4[2], lo4[3], hi4[0], hi4[1], hi4[2], hi4[3]}; \
                o[dh] = __builtin_amdgcn_mfma_f32_32x32x16_bf16(__builtin_bit_cast(bf16x8, pw[ks]), vf, o[dh], 0, 0, 0); } } \
        LDS_WAIT(); __builtin_amdgcn_sched_barrier(0); } while (0)

    ATT_DMAK(0); ATT_DMAK(1); ATT_DMAV(0); ATT_DMAK(2); ATT_DMAV(1);
    { const bf16_t* qp = u.qptr(wid, r32);
#pragma unroll
      for (int ks = 0; ks < NKS; ++ks) qr[ks] = *(const bf16x8*)(qp + 16 * ks + 8 * hi); }
    u.prep(L);
    u.template qfix<NKS>(qr, wid, r32, hi);
    ATT_WAIT_BAR();
    f32x16 sA0, sA1, sB0, sB1;
#pragma unroll
    for (int r = 0; r < 16; ++r) { sA0[r] = 0.f; sA1[r] = 0.f; sB0[r] = 0.f; sB1[r] = 0.f; }
    if (u.active(0, wid)) ATT_QKT(sA0, sA1, 0);
    if constexpr (U::SIDED) { const int nl = u.nlat; int t = 0;
        if (wid & 1) { for (; t < nl; ++t) { ATT_STEP(sA0, sA1, sB0, sB1, t, 2); sA0 = sB0; sA1 = sB1; } }
        else { for (; t < nl; ++t) { ATT_STEP(sA0, sA1, sB0, sB1, t, 1); sA0 = sB0; sA1 = sB1; } }
        for (; t < NT; ++t) { ATT_STEP(sA0, sA1, sB0, sB1, t, 0); sA0 = sB0; sA1 = sB1; } }
    else { for (int t = 0; t < NT; ++t) { ATT_STEP(sA0, sA1, sB0, sB1, t, 0); sA0 = sB0; sA1 = sB1; } }
    asm volatile("s_waitcnt vmcnt(0)" ::: "memory");
#undef ATT_DMAK
#undef ATT_DMAV
#undef ATT_WAIT_BAR
#undef ATT_QKT
#undef ATT_SOFTMAX
#undef ATT_LIVE0
#undef ATT_LIVE1
#undef ATT_STEP
    { float la, lb; pair32(l, la, lb); l = la + lb; }
    if (hi == 0) wsf[32 + r32] = l;
    LDS_WAIT();
    LAS unsigned char* stg = L + OFF_OST + wid * 2048;
#pragma unroll
    for (int r = 0; r < 16; ++r) { const int orow = crow(r, hi); const float rl = __builtin_amdgcn_rcpf(wsf[32 + orow]);
        const unsigned w = __builtin_amdgcn_cvt_pk_fp8_f32(o[0][r] * rl, o[1][r] * rl, 0u, false);
        stg[orow * 64 + r32] = (unsigned char)(w & 0xffu); stg[orow * 64 + 32 + r32] = (unsigned char)((w >> 8) & 0xffu); }
    LDS_WAIT();
#pragma unroll
    for (int i = 0; i < 2; ++i) { const int row = i * 16 + (lane >> 2), ch = lane & 3; const u32x4 v = *(const LAS u32x4*)(stg + row * 64 + ch * 16); *(u32x4*)(u.optr(wid, row) + ch * 16) = v; }
    __syncthreads();
}
}

struct Args { const float* in[25]; float* out; unsigned char* ws; int ph_lo, ph_hi; };
enum InIdx { I_X = 0, I_C, I_CTX, I_CCTX, I_ADAW, I_ADAB, I_N1G, I_N2G, I_EVWIN, I_EVSINK, I_EVQNG, I_EVWUQ, I_EVKVNG, I_EVWUKV, I_EVWOUT, I_ODWIN, I_ODRPB, I_ODWOUT, I_RW, I_RB, I_W1, I_B1, I_W2, I_B2, I_FG };

struct Frame {
    LAS unsigned char* lds;
    int tid, lane, wave, vcu, G;
    float* out; unsigned char* ws;
};
__device__ __forceinline__ const float* inptr(const Frame& F, int i) {
    const volatile LAS unsigned* p = (const volatile LAS unsigned*)(F.lds + LDSCTL_OFF + 256) + 2 * i;
    const unsigned lo = __builtin_amdgcn_readfirstlane(p[0]), hi = __builtin_amdgcn_readfirstlane(p[1]);
    return (const float*)(const GAS float*)(((unsigned long long)hi << 32) | lo);
}
#define WSP(T, off) ((T*)(F.ws + (off)))
__device__ __forceinline__ void frame_tid(Frame& F) { F.tid = opaque_tid(); F.lane = F.tid & 63; F.wave = __builtin_amdgcn_readfirstlane(F.tid >> 6); }

__device__ __forceinline__ void tr_item(const float* W, int ldw, int K, int k0, int n0, bf16_t* WT, int dst_row0, LAS float* scr, int lane) {
    float wv[32];
#pragma unroll
    for (int i = 0; i < 32; ++i) wv[i] = W[(size_t)(k0 + 2 * i + (lane >> 5)) * ldw + n0 + (lane & 31)];
#pragma unroll
    for (int i = 0; i < 32; ++i) scr[(2 * i + (lane >> 5)) * 33 + (lane & 31)] = wv[i];
    LDS_WAIT(); asm volatile("" ::: "memory");
    const int c = lane & 7;
#pragma unroll
    for (int j = 0; j < 4; ++j) { const int n = (lane >> 3) + 8 * j; const LAS float* s = scr + (8 * c) * 33 + n;
        u32x4 o; o.x = pk2(s[0 * 33], s[1 * 33]); o.y = pk2(s[2 * 33], s[3 * 33]); o.z = pk2(s[4 * 33], s[5 * 33]); o.w = pk2(s[6 * 33], s[7 * 33]);
        *(u32x4*)(WT + (size_t)(dst_row0 + n) * K + k0 + 8 * c) = o; }
    LDS_WAIT(); asm volatile("" ::: "memory");
}

__device__ __forceinline__ void tr_item8(const float* W, int ldw, int K, int k0, int n0, unsigned char* WT8, int dst_row0, LAS float* scr, int lane, float scale) {
    float wv[32];
#pragma unroll
    for (int i = 0; i < 32; ++i) wv[i] = W[(size_t)(k0 + 2 * i + (lane >> 5)) * ldw + n0 + (lane & 31)];
#pragma unroll
    for (int i = 0; i < 32; ++i) scr[(2 * i + (lane >> 5)) * 33 + (lane & 31)] = wv[i] * scale;
    LDS_WAIT(); asm volatile("" ::: "memory");
    const int c = lane & 3;
#pragma unroll
    for (int j = 0; j < 2; ++j) { const int n = (lane >> 2) + 16 * j; const LAS float* s = scr + (16 * c) * 33 + n;
        u32x4 o; o.x = cvt4_fp8(s[0 * 33], s[1 * 33], s[2 * 33], s[3 * 33]); o.y = cvt4_fp8(s[4 * 33], s[5 * 33], s[6 * 33], s[7 * 33]);
        o.z = cvt4_fp8(s[8 * 33], s[9 * 33], s[10 * 33], s[11 * 33]); o.w = cvt4_fp8(s[12 * 33], s[13 * 33], s[14 * 33], s[15 * 33]);
        *(u32x4*)(WT8 + (size_t)(dst_row0 + n) * K + k0 + 16 * c) = o; }
    LDS_WAIT(); asm volatile("" ::: "memory");
}
__device__ __forceinline__ float silu_f(float c) { return c / (1.0f + __expf(-c)); }

__device__ __forceinline__ void pro_a(Frame& F) {
    frame_tid(F);
    const int gwm = F.wave * F.G + F.vcu, NGW = F.G * 8;
    for (int it = gwm; it < 4 * 96; it += NGW) {
        const int l = it / 96, col = (it % 96) * 64 + F.lane;
        float sv[5][16];
#pragma unroll
        for (int j = 0; j < 16; ++j) {
#pragma unroll
            for (int v = 0; v < 4; ++v) sv[v][j] = silu_f(inptr(F, I_C)[v * 1024 + 64 * j + F.lane]);
            sv[4][j] = silu_f(inptr(F, I_CCTX)[64 * j + F.lane]);
        }
        const float* W = inptr(F, I_ADAW) + (size_t)l * 1024 * 6144 + col;
        float acc[5] = {0.f, 0.f, 0.f, 0.f, 0.f};
#pragma unroll
        for (int j = 0; j < 16; ++j) {
            float wl[64];
#pragma unroll
            for (int ln = 0; ln < 64; ++ln) wl[ln] = W[(size_t)(64 * j + ln) * 6144];
#pragma unroll
            for (int ln = 0; ln < 64; ++ln) {
#pragma unroll
                for (int v = 0; v < 5; ++v) acc[v] += __builtin_bit_cast(float, __builtin_amdgcn_readlane(__builtin_bit_cast(int, sv[v][j]), ln)) * wl[ln];
            }
        }
        const float bb = inptr(F, I_ADAB)[l * 6144 + col];
        float* MOD = WSP(float, WS_MOD);
#pragma unroll
        for (int v = 0; v < 5; ++v) MOD[(size_t)(l * 5 + v) * 6144 + col] = acc[v] + bb;
    }
    { const int gt = blockIdx.x * 512 + F.tid;
      if (gt < 128 * 16) { const int pos = gt >> 4, i = gt & 15; const float inv = __builtin_amdgcn_exp2f(-((float)i / 16.0f) * 13.287712379549449f); const float a = (float)pos * inv; WSP(f32x2, WS_ROPE64)[gt] = (f32x2){__cosf(a), __sinf(a)}; }
      else if (gt < 128 * 16 + 128 * 8) { const int g2 = gt - 128 * 16, pos = g2 >> 3, i = g2 & 7; const float inv = __builtin_amdgcn_exp2f(-((float)i / 8.0f) * 13.287712379549449f); const float a = (float)pos * inv; WSP(f32x2, WS_ROPE32)[g2] = (f32x2){__cosf(a), __sinf(a)}; } }
    { const int nchunk = 2 * 224 * 64;
      for (int i = blockIdx.x * 512 + F.tid; i < nchunk; i += F.G * 512) { const int mi = i / (224 * 64), r = (i / 64) % 224, c = i % 64;
          *(u32x4*)(WSP(unsigned char, WS_WINE) + ((size_t)mi * 2048 + 1824 + r) * 1024 + 16 * c) = (u32x4){0u, 0u, 0u, 0u}; } }
    { bf16_t* RWT = WSP(bf16_t, WS_RWT);
      for (int i = blockIdx.x * 512 + F.tid; i < 4 * 32 * 1024; i += F.G * 512) { const int l = i >> 15, e = (i >> 10) & 31, k = i & 1023;
          const float v = inptr(F, I_RW)[((size_t)l * 1024 + k) * 32 + e]; const unsigned hi = f2bf(v); const unsigned lo = f2bf(v - __builtin_bit_cast(float, hi << 16));
          bf16_t* r = RWT + ((size_t)l * 256 + e) * H3_LD; r[k] = (bf16_t)hi; r[1024 + k] = (bf16_t)hi; r[2048 + k] = (bf16_t)lo; }
      const int nz = 4 * 224 * (H3_LD / 8);
      for (int i = blockIdx.x * 512 + F.tid; i < nz; i += F.G * 512) { const int l = i / (224 * (H3_LD / 8)), r = (i / (H3_LD / 8)) % 224, c = i % (H3_LD / 8);
          *(u32x4*)(RWT + ((size_t)l * 256 + 32 + r) * H3_LD + 8 * c) = (u32x4){0u, 0u, 0u, 0u}; } }
    LAS float* scr = (LAS float*)(F.lds + F.wave * 16384);
    constexpr int S0 = 2 * 16 * 57, S1 = S0 + 2 * 12 * 24, S2 = S1 + 2 * 4 * 32, S3 = S2 + 2 * 16 * 32, S4 = S3 + 2 * 16 * 96, S5 = S4 + 2 * 16 * 32, S6 = S5 + 128 * 16 * 64, S7 = S6 + 128 * 16 * 32;
    const int gw = F.vcu * 8 + F.wave;
    for (int it = gw; it < S7; it += NGW) {
        if (it < S0) { const int r = it, mi = r / (16 * 57), q = r % (16 * 57), kb = q / 57, nb = q % 57;
            tr_item8(inptr(F, I_EVWIN) + (size_t)mi * 1024 * EV_IN, EV_IN, 1024, 64 * kb, 32 * nb, WSP(unsigned char, WS_WINE) + (size_t)mi * 2048 * 1024, 32 * nb, scr, F.lane, W8_SCALE); }
        else if (it < S1) { const int r = it - S0, mi = r / (12 * 24), q = r % (12 * 24), kb = q / 24, nb = q % 24;
            tr_item(inptr(F, I_EVWUQ) + (size_t)mi * 768 * 768, 768, 768, 64 * kb, 32 * nb, WSP(bf16_t, WS_WUQ) + (size_t)mi * 768 * 768, 32 * nb, scr, F.lane); }
        else if (it < S2) { const int r = it - S1, mi = r / (4 * 32), q = r % (4 * 32), kb = q / 32, nb = q % 32;
            tr_item(inptr(F, I_EVWUKV) + (size_t)mi * 256 * 1024, 1024, 256, 64 * kb, 32 * nb, WSP(bf16_t, WS_WUKV) + (size_t)mi * 1024 * 256, 32 * nb, scr, F.lane); }
        else if (it < S3) { const int r = it - S2, mi = r / (16 * 32), q = r % (16 * 32), kb = q / 32, nb = q % 32;
            tr_item8(inptr(F, I_EVWOUT) + (size_t)mi * 1024 * 1024, 1024, 1024, 64 * kb, 32 * nb, WSP(unsigned char, WS_WOUTE) + (size_t)mi * 1024 * 1024, 32 * nb, scr, F.lane, W8_SCALE); }
        else if (it < S4) { const int r = it - S3, mi = r / (16 * 96), q = r % (16 * 96), kb = q / 96, nb = q % 96;
            tr_item8(inptr(F, I_ODWIN) + (size_t)mi * 1024 * 3072, 3072, 1024, 64 * kb, 32 * nb, WSP(unsigned char, WS_WINO) + (size_t)mi * 3072 * 1024, 32 * nb, scr, F.lane, W8_SCALE); }
        else if (it < S5) { const int r = it - S4, mi = r / (16 * 32), q = r % (16 * 32), kb = q / 32, nb = q % 32;
            tr_item8(inptr(F, I_ODWOUT) + (size_t)mi * 1024 * 1024, 1024, 1024, 64 * kb, 32 * nb, WSP(unsigned char, WS_WOUTO) + (size_t)mi * 1024 * 1024, 32 * nb, scr, F.lane, W8_SCALE); }
        else if (it < S6) { const int r = it - S5, mi = r / (16 * 64), q = r % (16 * 64), kb = q / 64, nb = q % 64;
            const int c0 = 32 * (nb & 31), drow = (c0 >> 7) * 256 + (nb >= 32 ? 128 : 0) + (c0 & 127);
            tr_item8(inptr(F, I_W1) + (size_t)mi * 1024 * 2048, 2048, 1024, 64 * kb, 32 * nb, WSP(unsigned char, WS_W1) + (size_t)mi * 2048 * 1024, drow, scr, F.lane, W8_SCALE); }
        else { const int r = it - S6, mi = r / (16 * 32), q = r % (16 * 32), kb = q / 32, nb = q % 32;
            tr_item8(inptr(F, I_W2) + (size_t)mi * 1024 * 1024, 1024, 1024, 64 * kb, 32 * nb, WSP(unsigned char, WS_W2) + (size_t)mi * 1024 * 1024, 32 * nb, scr, F.lane, W8_SCALE); }
    }
}

__device__ __forceinline__ int mod_bidx(int row) { return row < TL ? (row >> 13) : 4; }
__device__ __forceinline__ void norm_mod_store(const f32x4 (&v)[4], int lane, const float* g, const float* shift, const float* scale, unsigned char* hrow, f32x4 (*hf)[4] = nullptr) {
    float s = 0.f;
#pragma unroll
    for (int j = 0; j < 4; ++j) s += (v[j].x * v[j].x + v[j].y * v[j].y) + (v[j].z * v[j].z + v[j].w * v[j].w);
    const float rstd = 1.0f / sqrtf(wave_sum(s) * (1.0f / DM) + NORM_EPS);
#pragma unroll
    for (int j = 0; j < 4; ++j) { const int col = 4 * lane + 256 * j;
        const f32x4 gg = *(const f32x4*)(g + col), sh = *(const f32x4*)(shift + col), sc = *(const f32x4*)(scale + col);
        const f32x4 h = (v[j] * rstd) * gg * (sc + 1.0f) + sh;
        if (hf) (*hf)[j] = h;
        *(unsigned*)(hrow + col) = cvt4_fp8(h.x, h.y, h.z, h.w); }
}

__device__ __forceinline__ void norm_mod_store_r(const f32x4 (&v)[4], int lane, const f32x4 (&gg)[4], const f32x4 (&sh)[4], const f32x4 (&sc1)[4], unsigned char* hrow) {
    float s = 0.f;
#pragma unroll
    for (int j = 0; j < 4; ++j) s += (v[j].x * v[j].x + v[j].y * v[j].y) + (v[j].z * v[j].z + v[j].w * v[j].w);
    const float rstd = 1.0f / sqrtf(wave_sum(s) * (1.0f / DM) + NORM_EPS);
#pragma unroll
    for (int j = 0; j < 4; ++j) { const int col = 4 * lane + 256 * j;
        const f32x4 h = (v[j] * rstd) * gg[j] * sc1[j] + sh[j];
        *(unsigned*)(hrow + col) = cvt4_fp8(h.x, h.y, h.z, h.w); }
}

__device__ __forceinline__ void pro_b(Frame& F) {
    frame_tid(F);
    const int gw = F.vcu * 8 + F.wave, NGW = F.G * 8, lane = F.lane;
    const float* MOD = WSP(float, WS_MOD);
    f32x4 gg[4], sh[4], sc1[4], vn[4]; int cb = -1;
#pragma unroll
    for (int j = 0; j < 4; ++j) { gg[j] = *(const f32x4*)(inptr(F, I_N1G) + 4 * lane + 256 * j); sh[j] = gg[j]; sc1[j] = gg[j]; vn[j] = gg[j]; }
#define PB_SRC(r_) ((r_) < TL ? inptr(F, I_X) + (size_t)(r_) * DM : inptr(F, I_CTX) + (size_t)((r_) - TL) * DM)
    if (gw < TT) { const float* src = PB_SRC(gw);
#pragma unroll
        for (int j = 0; j < 4; ++j) vn[j] = *(const f32x4*)(src + 4 * lane + 256 * j); }
    for (int row = gw; row < TT; row += NGW) {
        f32x4 v[4];
#pragma unroll
        for (int j = 0; j < 4; ++j) v[j] = vn[j];
        if (row + NGW < TT) { const float* src = PB_SRC(row + NGW);
#pragma unroll
            for (int j = 0; j < 4; ++j) vn[j] = *(const f32x4*)(src + 4 * lane + 256 * j); }
        const int bi = mod_bidx(row);
        if (bi != cb) { cb = bi; const float* mb = MOD + (size_t)(0 * 5 + bi) * 6144;
#pragma unroll
            for (int j = 0; j < 4; ++j) { sh[j] = *(const f32x4*)(mb + 4 * lane + 256 * j); sc1[j] = *(const f32x4*)(mb + 1024 + 4 * lane + 256 * j) + 1.0f; } }
        bf16_t* xr = WSP(bf16_t, WS_XLC) + (size_t)row * DM;
#pragma unroll
        for (int j = 0; j < 4; ++j) *(u32x2*)(xr + 4 * lane + 256 * j) = xpk4(v[j]);
        norm_mod_store_r(v, lane, gg, sh, sc1, WSP(unsigned char, WS_HB) + (size_t)row * DM);
    }
#undef PB_SRC
}

__device__ __forceinline__ u32x4 shfl_xor4(u32x4 v, int m) { u32x4 r; r.x = __shfl_xor(v.x, m); r.y = __shfl_xor(v.y, m); r.z = __shfl_xor(v.z, m); r.w = __shfl_xor(v.w, m); return r; }
__device__ __forceinline__ float ssq8(u32x4 w) { float s = 0.f;
#pragma unroll
    for (int i = 0; i < 4; ++i) { const float a = bflo(w[i]), b = bfhi(w[i]); s += a * a + b * b; } return s; }
__device__ __forceinline__ u32x4 scale8(u32x4 w, float r, const float* g) { u32x4 o; const f32x4 g0 = *(const f32x4*)g, g1 = *(const f32x4*)(g + 4);
    o.x = pk2(bflo(w.x) * r * g0.x, bfhi(w.x) * r * g0.y); o.y = pk2(bflo(w.y) * r * g0.z, bfhi(w.y) * r * g0.w);
    o.z = pk2(bflo(w.z) * r * g1.x, bfhi(w.z) * r * g1.y); o.w = pk2(bflo(w.w) * r * g1.z, bfhi(w.w) * r * g1.w); return o; }

__device__ __forceinline__ u32x4 rope_chunk_r(u32x4 xw, u32x4 yw, const f32x2 (&tab)[8], bool first) {
    u32x4 o;
#pragma unroll
    for (int i = 0; i < 4; ++i) {
        const f32x2 cs0 = tab[2 * i], cs1 = tab[2 * i + 1];
        const float x0 = bflo(xw[i]), x1 = bfhi(xw[i]), y0 = bflo(yw[i]), y1 = bfhi(yw[i]);
        const float r0 = first ? x0 * cs0.x - y0 * cs0.y : x0 * cs0.x + y0 * cs0.y;
        const float r1 = first ? x1 * cs1.x - y1 * cs1.y : x1 * cs1.x + y1 * cs1.y;
        o[i] = pk2(r0, r1);
    }
    return o;
}
__device__ __forceinline__ u32x4 scale8_r(u32x4 w, float r, f32x4 g0, f32x4 g1) { u32x4 o;
    o.x = pk2(bflo(w.x) * r * g0.x, bfhi(w.x) * r * g0.y); o.y = pk2(bflo(w.y) * r * g0.z, bfhi(w.y) * r * g0.w);
    o.z = pk2(bflo(w.z) * r * g1.x, bfhi(w.z) * r * g1.y); o.w = pk2(bflo(w.w) * r * g1.z, bfhi(w.w) * r * g1.w); return o; }

__device__ __forceinline__ void e2_pass(Frame& F, int li) {
    frame_tid(F);
    const int gw = F.vcu * 8 + F.wave, NGW = F.G * 8, lane = F.lane;
    const float* gq = inptr(F, I_EVQNG) + li * 768; const float* gkv = inptr(F, I_EVKVNG) + li * 256;
    const f32x2* R64 = WSP(f32x2, WS_ROPE64); const f32x2* R32 = WSP(f32x2, WS_ROPE32);
    const int cw = lane & 7, seg = cw >> 1, c4 = (lane >= 32 && lane < 36) ? lane - 32 : 0;
    const float* gq1p = gq + (lane >= 32 ? 8 * (lane + 64) - 768 : 0); const float* gq2p = gq + 8 * (lane + 128) - 768; const float* gkvp = gkv + (lane < 32 ? 8 * lane : 0);
    const f32x4 gq1a = *(const f32x4*)gq1p, gq1b = *(const f32x4*)(gq1p + 4), gq2a = *(const f32x4*)gq2p, gq2b = *(const f32x4*)(gq2p + 4), gkva = *(const f32x4*)gkvp, gkvb = *(const f32x4*)(gkvp + 4);
    u32x4 wn[4]; f32x2 t64n[8], t32n[8];
#define E2_LOAD(r_) do { const bf16_t* pr_ = WSP(bf16_t, WS_PB) + (size_t)(r_) * EV_LD; \
        _Pragma("unroll") for (int j = 0; j < 4; ++j) wn[j] = *(const u32x4*)(pr_ + 8 * (lane + 64 * j)); \
        const int t_ = (r_) & (SEQ - 1), prow_ = t_ >> 6, pcol_ = t_ & 63; \
        const f32x2* a_ = R64 + ((seg < 2) ? prow_ : pcol_) * 16 + (cw & 1) * 8; const f32x2* b_ = R32 + ((c4 < 2) ? prow_ : pcol_) * 8; \
        _Pragma("unroll") for (int i = 0; i < 8; ++i) { t64n[i] = a_[i]; t32n[i] = b_[i]; } } while (0)
#pragma unroll
    for (int j = 0; j < 4; ++j) wn[j] = (u32x4){0u, 0u, 0u, 0u};
#pragma unroll
    for (int i = 0; i < 8; ++i) { t64n[i] = (f32x2){0.f, 0.f}; t32n[i] = (f32x2){0.f, 0.f}; }
    if (gw < TT) E2_LOAD(gw);
    for (int row = gw; row < TT; row += NGW) {
        bf16_t* pr = WSP(bf16_t, WS_PB) + (size_t)row * EV_LD;
        u32x4 w[4]; f32x2 t64[8], t32[8];
#pragma unroll
        for (int j = 0; j < 4; ++j) w[j] = wn[j];
#pragma unroll
        for (int i = 0; i < 8; ++i) { t64[i] = t64n[i]; t32[i] = t32n[i]; }
        if (row + NGW < TT) E2_LOAD(row + NGW);
        float sq = ssq8(w[2]) + (lane >= 32 ? ssq8(w[1]) : 0.f), skv = lane < 32 ? ssq8(w[3]) : 0.f;
        const float rq = 1.0f / sqrtf(wave_sum(sq) * (1.0f / 768.0f) + NORM_EPS), rkv = 1.0f / sqrtf(wave_sum(skv) * (1.0f / 256.0f) + NORM_EPS);
        const bool lat = row < TL;
        const u32x4 y0 = shfl_xor4(w[0], 2), y1 = shfl_xor4(w[1], 2), y3 = shfl_xor4(w[3], 1);
        if (lat) { w[0] = rope_chunk_r(w[0], y0, t64, (seg & 1) == 0); if (lane < 16) w[1] = rope_chunk_r(w[1], y1, t64, (seg & 1) == 0); }
        if (lane >= 32) w[1] = scale8_r(w[1], rq, gq1a, gq1b);
        w[2] = scale8_r(w[2], rq, gq2a, gq2b);
        if (lane < 32) w[3] = scale8_r(w[3], rkv, gkva, gkvb);
        else if (lane < 36 && lat) w[3] = rope_chunk_r(w[3], y3, t32, ((lane - 32) & 1) == 0);
        if (lat) *(u32x4*)(pr + 8 * lane) = w[0];
        if (lane >= 32 || (lat && lane < 16)) *(u32x4*)(pr + 8 * (lane + 64)) = w[1];
        *(u32x4*)(pr + 8 * (lane + 128)) = w[2];
        if (lane < 32 || (lat && lane < 36)) *(u32x4*)(pr + 8 * (lane + 192)) = w[3];
    }
#undef E2_LOAD
}
__device__ __forceinline__ void m1a_pass(Frame& F, int layer) {
    frame_tid(F);
    const int gw = F.vcu * 8 + F.wave, NGW = F.G * 8, lane = F.lane;
    const float* MOD = WSP(float, WS_MOD); const float* g2 = inptr(F, I_N2G) + layer * DM;
    f32x4 gg[4], sh[4], sc1[4], vn[4]; int cb = -1;
#pragma unroll
    for (int j = 0; j < 4; ++j) { gg[j] = *(const f32x4*)(g2 + 4 * lane + 256 * j); sh[j] = gg[j]; sc1[j] = gg[j]; vn[j] = gg[j]; }
    if (gw < TT) {
#pragma unroll
        for (int j = 0; j < 4; ++j) vn[j] = xun4(*(const u32x2*)(WSP(bf16_t, WS_XLC) + (size_t)gw * DM + 4 * lane + 256 * j)); }
    for (int row = gw; row < TT; row += NGW) {
        f32x4 v[4];
#pragma unroll
        for (int j = 0; j < 4; ++j) v[j] = vn[j];
        if (row + NGW < TT) {
#pragma unroll
            for (int j = 0; j < 4; ++j) vn[j] = xun4(*(const u32x2*)(WSP(bf16_t, WS_XLC) + (size_t)(row + NGW) * DM + 4 * lane + 256 * j)); }
        const int bi = mod_bidx(row);
        if (bi != cb) { cb = bi; const float* mb = MOD + (size_t)(layer * 5 + bi) * 6144;
#pragma unroll
            for (int j = 0; j < 4; ++j) { sh[j] = *(const f32x4*)(mb + 3 * 1024 + 4 * lane + 256 * j); sc1[j] = *(const f32x4*)(mb + 4 * 1024 + 4 * lane + 256 * j) + 1.0f; } }
        float s = 0.f;
#pragma unroll
        for (int j = 0; j < 4; ++j) s += (v[j].x * v[j].x + v[j].y * v[j].y) + (v[j].z * v[j].z + v[j].w * v[j].w);
        const float rstd = 1.0f / sqrtf(wave_sum(s) * (1.0f / DM) + NORM_EPS);
        bf16_t* hr = WSP(bf16_t, WS_PB) + (size_t)row * H3_LD;
#pragma unroll
        for (int j = 0; j < 4; ++j) { const int col = 4 * lane + 256 * j;
            const f32x4 h = (v[j] * rstd) * gg[j] * sc1[j] + sh[j];
            unsigned hi[4], lo[4];
#pragma unroll
            for (int i = 0; i < 4; ++i) { hi[i] = f2bf(h[i]); lo[i] = f2bf(h[i] - __builtin_bit_cast(float, hi[i] << 16)); }
            const u32x2 wh = {hi[0] | (hi[1] << 16), hi[2] | (hi[3] << 16)}, wl = {lo[0] | (lo[1] << 16), lo[2] | (lo[3] << 16)};
            *(u32x2*)(hr + col) = wh; *(u32x2*)(hr + 1024 + col) = wl;
            *(unsigned*)(WSP(unsigned char, WS_HB) + (size_t)row * DM + col) = cvt4_fp8(h[0], h[1], h[2], h[3]); }
    }
}
__device__ __forceinline__ void m1b_gemm(Frame& F, int layer) {
    pg8::RouterOrder S; S.A = (const char*)WSP(bf16_t, WS_PB); S.Bt = (const char*)(WSP(bf16_t, WS_RWT) + (size_t)layer * 256 * H3_LD); S.lda2 = H3_LD * 2; S.ldb2 = H3_LD * 2; S.nM = TT / 256; S.G = F.G; S.c = blockIdx.x;
    pg8::EpiLogits E{WSP(float, WS_LOGIT), WSP(float, WS_LOGIT12), inptr(F, I_RB) + layer * 32};
    pg8::gemm_phase<pg8::EpiLogits, pg8::RouterOrder>(F.lds, 1024, (size_t)H3_LD * 2, (size_t)H3_LD * 2, S, E);
}
__device__ __forceinline__ void m1c_pass(Frame& F) {
    frame_tid(F);
    const int lane = F.lane, blk = blockIdx.x, CH = (TT + F.G - 1) / F.G;
    const int r0 = blk * CH, r1 = (r0 + CH < TT) ? r0 + CH : TT;
    LAS int* hist = (LAS int*)(F.lds + LDSCTL_OFF + 512);
    if (F.tid < 32) hist[F.tid] = 0;
    __syncthreads();
    const int e = lane & 31, sub = lane >> 5;
    float n0 = 0.f, n1 = 0.f, n2 = 0.f;
    { const int row = r0 + 2 * F.wave + sub; const size_t li_ = (size_t)(row < r1 ? row : r1 - 1) * 32 + e;
      n0 = WSP(float, WS_LOGIT)[li_]; n1 = WSP(float, WS_LOGIT12)[li_]; n2 = WSP(float, WS_LOGIT12)[(size_t)TT * 32 + li_]; }
    for (int rbase = r0 + 2 * F.wave; rbase < r1; rbase += 16) {
        const int row = rbase + sub; const bool ok = row < r1;
        float logit = (n0 + n1) + n2;
        { const int rn = rbase + 16 + sub; const size_t li_ = (size_t)(rn < r1 ? rn : r1 - 1) * 32 + e;
          n0 = WSP(float, WS_LOGIT)[li_]; n1 = WSP(float, WS_LOGIT12)[li_]; n2 = WSP(float, WS_LOGIT12)[(size_t)TT * 32 + li_]; }
        float tv[4]; int ti[4];
#pragma unroll
        for (int k = 0; k < 4; ++k) {
            float bv = logit; int bi = e;
#pragma unroll
            for (int o = 16; o >= 1; o >>= 1) { const float ov = __shfl_xor(bv, o); const int oi = __shfl_xor(bi, o); if (ov > bv || (ov == bv && oi < bi)) { bv = ov; bi = oi; } }
            tv[k] = bv; ti[k] = bi; if (e == bi) logit = -3.0e38f;
        }
        const float w1 = __expf(tv[1] - tv[0]), w2 = __expf(tv[2] - tv[0]), w3 = __expf(tv[3] - tv[0]); const float inv = 1.0f / (1.0f + w1 + w2 + w3);
        if (e == 0 && ok) {
            *(int4*)(WSP(int, WS_TOPE) + (size_t)row * 4) = make_int4(ti[0], ti[1], ti[2], ti[3]);
            *(f32x4*)(WSP(float, WS_TOPG) + (size_t)row * 4) = (f32x4){inv, w1 * inv, w2 * inv, w3 * inv};
            atomicAdd((int*)(hist + ti[0]), 1); atomicAdd((int*)(hist + ti[1]), 1); atomicAdd((int*)(hist + ti[2]), 1); atomicAdd((int*)(hist + ti[3]), 1);
        }
    }
    __syncthreads();
    if (F.tid < 32) WSP(int, WS_HIST)[blk * 32 + F.tid] = hist[F.tid];
    __syncthreads();
}

__device__ __forceinline__ void m2_pass(Frame& F) {
    frame_tid(F);
    const int blk = blockIdx.x, CH = (TT + F.G - 1) / F.G;
    const int r0 = blk * CH, r1 = (r0 + CH < TT) ? r0 + CH : TT, nr = r1 > r0 ? r1 - r0 : 0;
    LAS int* tot = (LAS int*)(F.lds), *bef = tot + 32, *pst = tot + 64, *ntl = tot + 96;
    LAS int* te = (LAS int*)(F.lds + 1024);
    LAS float* tg = (LAS float*)(F.lds + 1024 + 32768);
    const int* HIST = WSP(int, WS_HIST);
    if (F.tid < 64) tot[F.tid] = 0;
    __syncthreads();
    for (int i = F.tid; i < F.G * 32; i += 512) { const int h = HIST[i]; atomicAdd((int*)(tot + (i & 31)), h); if ((i >> 5) < blk) atomicAdd((int*)(bef + (i & 31)), h); }
    for (int i = F.tid; i < nr * 4; i += 512) { te[i] = WSP(int, WS_TOPE)[(size_t)r0 * 4 + i]; tg[i] = WSP(float, WS_TOPG)[(size_t)r0 * 4 + i]; }
    __syncthreads();
    if (F.tid == 0) { int ps = 0; for (int e = 0; e < 32; ++e) { pst[e] = ps; ps += (tot[e] + 255) & ~255; } ntl[0] = ps >> 8; }
    __syncthreads();
    LAS int* cnt = (LAS int*)(F.lds + 1024 + 65536);
    const int nent = nr * 4, nch = (nent + 63) >> 6;
    int myrank[4] = {0, 0, 0, 0}, myex[4] = {-1, -1, -1, -1};
#pragma unroll
    for (int q = 0; q < 4; ++q) { const int c = F.wave + 8 * q;
        if (c < nch) { const int i = 64 * c + F.lane; const int ex = i < nent ? te[i] : -1; myex[q] = ex; int rk = 0, mine = 0;
            for (int e = 0; e < 32; ++e) { const unsigned long long m = __ballot(ex == e); if (ex == e) rk = __popcll(m & ((1ull << F.lane) - 1ull)); if (F.lane == e) mine = __popcll(m); }
            myrank[q] = rk; if (F.lane < 32) cnt[c * 32 + F.lane] = mine; } }
    __syncthreads();
#pragma unroll
    for (int q = 0; q < 4; ++q) { const int c = F.wave + 8 * q; const int i = 64 * c + F.lane;
        if (c < nch && i < nent) { const int ex = myex[q]; int before = 0; for (int c2 = 0; c2 < c; ++c2) before += cnt[c2 * 32 + ex];
            const int sl = pst[ex] + bef[ex] + before + myrank[q];
            WSP(int, WS_SLOT)[(size_t)r0 * 4 + i] = sl; WSP(float, WS_GSLOT)[sl] = tg[i]; WSP(int, WS_TOKSLOT)[sl] = r0 + (i >> 2); } }
    if (blk == 0) { const int nt = ntl[0]; int* TE = WSP(int, WS_TILEEXP);
        for (int tl = F.tid; tl < nt; tl += 512) { int e = 0; for (int q = 1; q < 32; ++q) if (pst[q] <= tl * 256) e = q; TE[tl] = e; }
        if (F.tid == 0) TE[1023] = nt;
        for (int e = 0; e < 32; ++e) { const int p0 = pst[e] + tot[e], p1 = pst[e] + ((tot[e] + 255) & ~255); for (int sidx = p0 + F.tid; sidx < p1; sidx += 512) WSP(int, WS_TOKSLOT)[sidx] = 0; } }
    __syncthreads();
}

__device__ __forceinline__ void m5_pass(Frame& F, int layer) {
    frame_tid(F);
    const int gw = F.vcu * 8 + F.wave, NGW = F.G * 8, lane = F.lane;
    const float* MOD = WSP(float, WS_MOD);
    const bool last = layer == 3; const int RL = last ? TL : TT;
    f32x4 gg[4], g2v[4], sh[4], sc1[4]; int cb = -1;
    { const float* gp = last ? inptr(F, I_FG) : inptr(F, I_N1G) + (layer + 1) * DM;
#pragma unroll
      for (int j = 0; j < 4; ++j) { gg[j] = *(const f32x4*)(gp + 4 * lane + 256 * j); g2v[j] = gg[j]; sh[j] = gg[j]; sc1[j] = gg[j]; } }
    int4 sC = make_int4(0, 0, 0, 0), sN = sC; f32x4 gC = {0.f, 0.f, 0.f, 0.f}, gN = gC;
    unsigned yw[4][4], ywn[4][4]; f32x4 xv[4], xvn[4];
#pragma unroll
    for (int j = 0; j < 4; ++j) { xv[j] = gg[j]; xvn[j] = gg[j];
#pragma unroll
        for (int k = 0; k < 4; ++k) { yw[j][k] = 0u; ywn[j][k] = 0u; } }
#define M5_SLOTS(S_, G_, r_) do { S_ = *(const int4*)(WSP(int, WS_SLOT) + (size_t)(r_) * 4); G_ = *(const f32x4*)(WSP(float, WS_TOPG) + (size_t)(r_) * 4); } while (0)
#define M5_DATA(Y_, X_, S_, r_) do { const int sl_[4] = {S_.x, S_.y, S_.z, S_.w}; \
        _Pragma("unroll") for (int j = 0; j < 4; ++j) { const int col = 4 * lane + 256 * j; \
            _Pragma("unroll") for (int k = 0; k < 4; ++k) Y_[j][k] = *(const unsigned*)(WSP(unsigned char, WS_XG) + (size_t)(col >> 6) * ((size_t)MAXSLOT * 64) + (size_t)sl_[k] * 64 + (col & 63)); \
            X_[j] = xun4(*(const u32x2*)(WSP(bf16_t, WS_XLC) + (size_t)(r_) * DM + col)); } } while (0)
    if (gw < RL) { M5_SLOTS(sC, gC, gw); M5_DATA(yw, xv, sC, gw); }
    if (gw + NGW < RL) M5_SLOTS(sN, gN, gw + NGW);
    for (int row = gw; row < RL; row += NGW) {
        const f32x4 gcur = gC;
        if (row + NGW < RL) { M5_DATA(ywn, xvn, sN, row + NGW); gC = gN; }
        if (row + 2 * NGW < RL) M5_SLOTS(sN, gN, row + 2 * NGW);
        const int bi = mod_bidx(row);
        if (bi != cb) { cb = bi; const float* mb = MOD + (size_t)(layer * 5 + bi) * 6144; const float* mn = MOD + (size_t)((last ? layer : layer + 1) * 5 + bi) * 6144;
#pragma unroll
            for (int j = 0; j < 4; ++j) { const int col = 4 * lane + 256 * j; g2v[j] = *(const f32x4*)(mb + 5 * 1024 + col); sh[j] = *(const f32x4*)(mn + col); sc1[j] = *(const f32x4*)(mn + 1024 + col) + 1.0f; } }
        const float gk[4] = {gcur.x * (1.0f / YS_SCALE), gcur.y * (1.0f / YS_SCALE), gcur.z * (1.0f / YS_SCALE), gcur.w * (1.0f / YS_SCALE)};
        bf16_t* xr = WSP(bf16_t, WS_XLC) + (size_t)row * DM;
        f32x4 v[4];
#pragma unroll
        for (int j = 0; j < 4; ++j) { f32x4 y = {0.f, 0.f, 0.f, 0.f};
#pragma unroll
            for (int k = 0; k < 4; ++k) { const unsigned w = yw[j][k];
                y += (f32x4){__builtin_amdgcn_cvt_f32_fp8(w, 0), __builtin_amdgcn_cvt_f32_fp8(w, 1), __builtin_amdgcn_cvt_f32_fp8(w, 2), __builtin_amdgcn_cvt_f32_fp8(w, 3)} * gk[k]; }
            v[j] = xv[j] + g2v[j] * y; }
        if (!last) {
#pragma unroll
            for (int j = 0; j < 4; ++j) *(u32x2*)(xr + 4 * lane + 256 * j) = xpk4(v[j]);
            norm_mod_store_r(v, lane, gg, sh, sc1, WSP(unsigned char, WS_HB) + (size_t)row * DM);
        } else {
            float s = 0.f;
#pragma unroll
            for (int j = 0; j < 4; ++j) s += (v[j].x * v[j].x + v[j].y * v[j].y) + (v[j].z * v[j].z + v[j].w * v[j].w);
            const float rstd = 1.0f / sqrtf(wave_sum(s) * (1.0f / DM) + NORM_EPS);
#pragma unroll
            for (int j = 0; j < 4; ++j) { const int col = 4 * lane + 256 * j; *(f32x4*)(F.out + (size_t)row * DM + col) = (v[j] * rstd) * gg[j]; }
        }
#pragma unroll
        for (int j = 0; j < 4; ++j) { xv[j] = xvn[j];
#pragma unroll
            for (int k = 0; k < 4; ++k) yw[j][k] = ywn[j][k]; }
    }
#undef M5_SLOTS
#undef M5_DATA
}

constexpr int NPH_PAIR = 22, NPH = 2 + 2 * NPH_PAIR;

__device__ __forceinline__ void moe_gemm1(Frame& F, int layer) {
    const int* TE = WSP(int, WS_TILEEXP);
    LAS int* tel = (LAS int*)(F.lds + LDSCTL_OFF + 4096);
    { const int tz = opaque_tid(); tel[tz] = TE[tz]; tel[512 + tz] = TE[512 + tz]; __syncthreads(); }
    pg8::MoeOrder S; S.A = (const char*)WSP(unsigned char, WS_HB); S.W = (const char*)(WSP(unsigned char, WS_W1) + (size_t)layer * 32 * 2048 * 1024); S.tile_exp = tel; S.tokslot = WSP(int, WS_TOKSLOT);
    S.lda2 = 1024; S.ldb2 = 1024; S.wstride = 2048u * 1024u; S.ntiles = __builtin_amdgcn_readfirstlane(TE[1023]); S.nN = 8; S.G = F.G; S.c = blockIdx.x;
    pg8::EpiSwiglu E{WSP(unsigned char, WS_HA), inptr(F, I_B1) + (size_t)layer * 32 * 2048};
    pg8::gemm_phase<pg8::EpiSwiglu, pg8::MoeOrder, true, true>(F.lds, 512, 1024, 1024, S, E);
}
__device__ __forceinline__ void moe_gemm2(Frame& F, int layer) {
    const int* TE = WSP(int, WS_TILEEXP);
    LAS int* tel = (LAS int*)(F.lds + LDSCTL_OFF + 4096);
    { const int tz = opaque_tid(); tel[tz] = TE[tz]; tel[512 + tz] = TE[512 + tz]; __syncthreads(); }
    pg8::MoeOrder S; S.A = (const char*)WSP(unsigned char, WS_HA); S.W = (const char*)(WSP(unsigned char, WS_W2) + (size_t)layer * 32 * 1024 * 1024); S.tile_exp = tel; S.tokslot = nullptr;
    S.lda2 = 1024; S.ldb2 = 1024; S.wstride = 1024u * 1024u; S.ntiles = __builtin_amdgcn_readfirstlane(TE[1023]); S.nN = 4; S.G = F.G; S.c = blockIdx.x;
    pg8::EpiGate E{WSP(unsigned char, WS_XG), inptr(F, I_B2) + (size_t)layer * 32 * 1024};
    pg8::gemm_phase<pg8::EpiGate, pg8::MoeOrder, true>(F.lds, 512, 1024, 1024, S, E);
}
__device__ __forceinline__ void dense_gemm_bf16(Frame& F, const bf16_t* A, size_t lda2, const bf16_t* Bt, int N, int K, bf16_t* O, int ldc) {
    pg8::DenseOrder S; S.init(A, lda2, Bt, (size_t)K * 2, TT, N, F.G, blockIdx.x);
    pg8::EpiBf16 E{O, ldc, 1.0f};
    pg8::gemm_phase<pg8::EpiBf16, pg8::DenseOrder>(F.lds, K, lda2, (size_t)K * 2, S, E);
}
__device__ __forceinline__ void dense_gemm_f8(Frame& F, const unsigned char* A8, const unsigned char* Bt8, int N, int K8, bf16_t* O, int ldc) {
    pg8::DenseOrder S; S.init(A8, (size_t)K8, Bt8, (size_t)K8, TT, N, F.G, blockIdx.x);
    pg8::EpiBf16 E{O, ldc, 1.0f / W8_SCALE};
    pg8::gemm_phase<pg8::EpiBf16, pg8::DenseOrder, true>(F.lds, K8 / 2, (size_t)K8, (size_t)K8, S, E);
}
__device__ __forceinline__ void outproj_gemm(Frame& F, const unsigned char* Bt8, int layer, int nrows) {
    pg8::DenseOrder S; S.init(WSP(unsigned char, WS_AO), 1024, Bt8, 1024, nrows, 1024, F.G, blockIdx.x);
    pg8::EpiResid E{WSP(bf16_t, WS_XLC), WSP(float, WS_MOD) + (size_t)layer * 5 * 6144 + 2 * 1024, 1.0f / W8_SCALE};
    pg8::gemm_phase<pg8::EpiResid, pg8::DenseOrder, true>(F.lds, 512, 1024, 1024, S, E);
}

__global__ void __launch_bounds__(512, 2) fwd(Args args) {
    extern __shared__ __attribute__((aligned(16))) unsigned char lds_raw[];
    Frame F;
    F.lds = (LAS unsigned char*)lds_raw;
    F.tid = threadIdx.x; F.lane = F.tid & 63; F.wave = __builtin_amdgcn_readfirstlane(F.tid >> 6);
    F.G = gridDim.x; { const int bx = blockIdx.x; F.vcu = (F.G % 8 == 0) ? (bx % 8) * (F.G / 8) + bx / 8 : bx; }
    F.out = args.out; F.ws = args.ws;
    volatile LAS unsigned* MISC = (volatile LAS unsigned*)(F.lds + LDSCTL_OFF);
    if (F.tid < 64) MISC[F.tid] = 0u;
    if (F.tid < 25) { const unsigned long long pv = ((const unsigned long long*)__builtin_amdgcn_kernarg_segment_ptr())[F.tid]; MISC[64 + 2 * F.tid] = (unsigned)pv; MISC[65 + 2 * F.tid] = (unsigned)(pv >> 32); }
    __syncthreads();
    unsigned* ctl = (unsigned*)(F.ws + WS_CTL);
#if !MK_PER_PHASE
    XcdBarrier bar = xcd_barrier_post(ctl + CW_BAR, MISC + 8);
#define GRID_BAR() xcd_barrier(bar)
#else
#define GRID_BAR() do { } while (0)
#endif
    const int lo = args.ph_lo, hi = args.ph_hi;
    int pid = 0;
    enum { CNT0 = __COUNTER__ + 1 };
#ifndef PHMASK
#define PHMASK 0xFFFFFFFFull
#endif
#ifndef REPMASK
#define REPMASK 0ull
#endif
#define PHASE_BEGIN { const int site_ = __COUNTER__ - CNT0; const int nrep_ = 1 + (int)(((unsigned long long)REPMASK >> site_) & 1ull); \
    if ((((unsigned long long)PHMASK >> site_) & 1ull) && lo <= pid && pid < hi) { for (int rep_ = 0; rep_ < nrep_; ++rep_) {
#define PHASE_END if (rep_ + 1 < nrep_ || pid + 1 < hi) GRID_BAR(); } } ++pid; }

    PHASE_BEGIN pro_a(F); PHASE_END
    PHASE_BEGIN pro_b(F); PHASE_END

    for (int lp = 0; lp < 2; ++lp) {
        { const int layer = 2 * lp, li = lp;
        PHASE_BEGIN dense_gemm_f8(F, WSP(unsigned char, WS_HB), WSP(unsigned char, WS_WINE) + (size_t)li * 2048 * 1024, 2048, 1024, WSP(bf16_t, WS_PB), EV_LD); PHASE_END
        PHASE_BEGIN e2_pass(F, li); PHASE_END
        PHASE_BEGIN
            dense_gemm_bf16(F, WSP(bf16_t, WS_PB) + 768, (size_t)EV_LD * 2, WSP(bf16_t, WS_WUQ) + (size_t)li * 768 * 768, 768, 768, WSP(bf16_t, WS_QB), 768);
            dense_gemm_bf16(F, WSP(bf16_t, WS_PB) + 1536, (size_t)EV_LD * 2, WSP(bf16_t, WS_WUKV) + (size_t)li * 1024 * 256, 1024, 256, WSP(bf16_t, WS_KVB), 1024);
        PHASE_END
        PHASE_BEGIN
            for (int rr_ = 0; rr_ < 1 + (int)(((unsigned long long)REPMASK >> 40) & 1ull); ++rr_)
            for (int u = F.vcu; u < 1024 + 32; u += F.G) {
                att::UMla U; U.QB = WSP(bf16_t, WS_QB); U.KVB = WSP(bf16_t, WS_KVB); U.PB = WSP(bf16_t, WS_PB); U.AO = WSP(bf16_t, WS_AO); U.R32 = WSP(f32x2, WS_ROPE32);
                if (u < 1024) { const int bh = u >> 5; U.b = bh >> 3; U.h = bh & 7; U.qblk = u & 31; U.ctxq = false; }
                else { const int v = u - 1024; U.b = v >> 3; U.h = v & 7; U.qblk = 0; U.ctxq = true; }
                att::attn_unit<att::UMla>(F.lds, F.ws, U);
            }
            for (int rr_ = 0; rr_ < 1 + (int)(((unsigned long long)REPMASK >> 41) & 1ull); ++rr_)
            for (int u = (F.vcu + F.G / 2) % F.G; u < 1024 + 32; u += F.G) {
                att::UWin U; U.PB = WSP(bf16_t, WS_PB); U.AO = WSP(bf16_t, WS_AO); U.sink = inptr(F, I_EVSINK) + li * 8;
                if (u < 1024) { U.b = u >> 8; U.kvh = (u >> 7) & 1; U.j = u & 127; U.ctxq = false; }
                else { const int v = u - 1024; U.b = v >> 3; U.kvh = (v >> 2) & 1; U.j = v & 3; U.ctxq = true; }
                U.init();
                att::attn_unit<att::UWin>(F.lds, F.ws, U);
            }
        PHASE_END
        PHASE_BEGIN outproj_gemm(F, WSP(unsigned char, WS_WOUTE) + (size_t)li * 1024 * 1024, layer, TT); PHASE_END
        PHASE_BEGIN m1a_pass(F, layer); PHASE_END
        PHASE_BEGIN m1b_gemm(F, layer); PHASE_END
        PHASE_BEGIN m1c_pass(F); PHASE_END
        PHASE_BEGIN m2_pass(F); PHASE_END
        PHASE_BEGIN moe_gemm1(F, layer); PHASE_END
        PHASE_BEGIN moe_gemm2(F, layer); PHASE_END
        PHASE_BEGIN m5_pass(F, layer); PHASE_END
        }
        { const int layer = 2 * lp + 1, li = lp;
        PHASE_BEGIN dense_gemm_f8(F, WSP(unsigned char, WS_HB), WSP(unsigned char, WS_WINO) + (size_t)li * 3072 * 1024, 3072, 1024, WSP(bf16_t, WS_PB), OD_LD); PHASE_END
        PHASE_BEGIN
            for (int u = F.vcu; u < 2048 + (layer == 3 ? 0 : 64); u += F.G) {
                att::UNa U; U.PB = WSP(bf16_t, WS_PB); U.AO = WSP(bf16_t, WS_AO);
                if (u < 2048) { U.b = u >> 9; U.h = (u >> 5) & 15; U.G = u & 31; U.ctxq = false; }
                else { const int v = u - 2048; U.b = v >> 4; U.h = v & 15; U.G = 0; U.ctxq = true; }
                U.rpbh = inptr(F, I_ODRPB) + (size_t)(li * 16 + U.h) * 15 * 31;
                U.init();
                att::attn_unit<att::UNa>(F.lds, F.ws, U);
            }
        PHASE_END
        PHASE_BEGIN outproj_gemm(F, WSP(unsigned char, WS_WOUTO) + (size_t)li * 1024 * 1024, layer, layer == 3 ? TL : TT); PHASE_END
        PHASE_BEGIN m1a_pass(F, layer); PHASE_END
        PHASE_BEGIN m1b_gemm(F, layer); PHASE_END
        PHASE_BEGIN m1c_pass(F); PHASE_END
        PHASE_BEGIN m2_pass(F); PHASE_END
        PHASE_BEGIN moe_gemm1(F, layer); PHASE_END
        PHASE_BEGIN moe_gemm2(F, layer); PHASE_END
        PHASE_BEGIN m5_pass(F, layer); PHASE_END
        }
    }
}


#if MK_CHECK
constexpr int CW_CHK = 8192;
constexpr size_t WS_CHK = 1968 * MiB;
constexpr size_t WS_CHK_CNT = WS_CHK + 136 * MiB;
constexpr int IDS_PER_PAIR = 26, ID_PROB = 53, NID = 54;
struct CArgs { const float* in[25]; float* out; unsigned char* ws; int layer, id; };
#define CWS(T, off) ((T*)(A.ws + (off)))
__device__ __forceinline__ unsigned hsh(unsigned x) { x ^= x >> 16; x *= 0x7feb352du; x ^= x >> 15; x *= 0x846ca68bu; x ^= x >> 16; return x; }
__device__ __forceinline__ float bfv(const bf16_t* p) { return __builtin_bit_cast(float, (unsigned)(*p) << 16); }
__device__ __forceinline__ float f8v(const unsigned char* p) { const unsigned b = *p; const unsigned e = (b >> 3) & 15u, m = b & 7u; const float v = e ? __builtin_bit_cast(float, ((e + 120u) << 23) | (m << 20)) : (float)m * 0.001953125f; return (b & 128u) ? -v : v; }
__device__ __forceinline__ float rbf(float a) { return __builtin_bit_cast(float, f2bf(a) << 16); }
__device__ __forceinline__ void chk_acc(const CArgs& A, float e2, float r2) {
    __shared__ float sh[2][8];
    e2 = wave_sum(e2); r2 = wave_sum(r2);
    const int w = threadIdx.x >> 6;
    if ((threadIdx.x & 63) == 0) { sh[0][w] = e2; sh[1][w] = r2; }
    __syncthreads();
    if (threadIdx.x == 0) { float a = 0.f, b = 0.f; for (int i = 0; i < (int)(blockDim.x >> 6); ++i) { a += sh[0][i]; b += sh[1][i]; }
        float* acc = (float*)(A.ws + WS_CTL) + CW_CHK + 2 * A.id; atomicAdd(acc, a); atomicAdd(acc + 1, b); }
    __syncthreads();
}
__device__ __forceinline__ void sincos_d(float a, float& s, float& c) {
    double x = (double)a; const double tp = 6.283185307179586476925; double k = __builtin_rint(x / tp); double r = x - k * tp; double r2 = r * r;
    double sp = r, cp = 1.0, ts = r, tc = 1.0;
#pragma unroll
    for (int i = 1; i < 14; ++i) { tc *= -r2 / (double)((2 * i - 1) * (2 * i)); cp += tc; ts *= -r2 / (double)((2 * i) * (2 * i + 1)); sp += ts; }
    s = (float)sp; c = (float)cp;
}
__device__ __forceinline__ float invfreq(int i, int half) { return __builtin_amdgcn_exp2f(-((float)i / (float)half) * 13.287712379549449f); }
__device__ __forceinline__ float nsilu(float c) { return c / (1.0f + __expf(-c)); }
__device__ float naive_mod(const CArgs& A, int layer, int bidx, int n) {
    const float* cv = bidx < 4 ? A.in[I_C] + bidx * 1024 : A.in[I_CCTX]; const float* W = A.in[I_ADAW] + (size_t)layer * 1024 * 6144 + n;
    float acc = 0.f; for (int k = 0; k < 1024; ++k) acc += nsilu(cv[k]) * W[(size_t)k * 6144];
    return acc + A.in[I_ADAB][layer * 6144 + n];
}
__device__ __forceinline__ int srow(unsigned s) { return (s & 3) == 0 ? TL + (int)(hsh(s * 3 + 1) % TC) : (int)(hsh(s * 3 + 1) % TL); }
__global__ void chk_mark(CArgs A) { if (threadIdx.x == 0) ((float*)(A.ws + WS_CTL))[CW_CHK + 2 * A.id + 1] = 1.0f; }

__global__ void chk_gemm(CArgs A, const bf16_t* X, int ldx, const float* W, int ldw, int K, int ncol, const bf16_t* O, int ldo) {
    const int row = srow(blockIdx.x); const int col = (int)((hsh(blockIdx.x * 977 + 5) + 7u * threadIdx.x) % (unsigned)ncol);
    float ref = 0.f; for (int k = 0; k < K; ++k) ref += (ldx ? bfv(X + (size_t)row * ldx + k) : f8v((const unsigned char*)X + (size_t)row * 1024 + k)) * W[(size_t)k * ldw + col];
    const float got = bfv(O + (size_t)row * ldo + col);
    chk_acc(A, (got - ref) * (got - ref), ref * ref);
}
__global__ void chk_e2(CArgs A) {
    __shared__ float P[EV_IN]; __shared__ float red[2];
    const int li = A.layer >> 1, row = srow(blockIdx.x), t = threadIdx.x;
    const float* W = A.in[I_EVWIN] + (size_t)li * 1024 * EV_IN; const unsigned char* h = CWS(unsigned char, WS_HB) + (size_t)row * DM;
    for (int c = t; c < EV_IN; c += 256) { float a = 0.f; for (int k = 0; k < 1024; ++k) a += f8v(h + k) * W[(size_t)k * EV_IN + c]; P[c] = rbf(a); }
    __syncthreads();
    if (t == 0) { float a = 0.f; for (int c = 768; c < 1536; ++c) a += P[c] * P[c]; red[0] = 1.0f / sqrtf(a / 768.0f + NORM_EPS); float b = 0.f; for (int c = 1536; c < 1792; ++c) b += P[c] * P[c]; red[1] = 1.0f / sqrtf(b / 256.0f + NORM_EPS); }
    __syncthreads();
    const bool lat = row < TL; const int tt = row & (SEQ - 1), prow = tt >> 6, pcol = tt & 63;
    float e2 = 0.f, r2 = 0.f;
    for (int c = t; c < EV_IN; c += 256) {
        float ref = P[c];
        if (c < 640 && lat) { const int d = c & 63, dd = d & 31, i = dd & 15; const bool first = dd < 16; const float y = P[first ? c + 16 : c - 16];
            float sn, cs; sincos_d((float)((d < 32) ? prow : pcol) * invfreq(i, 16), sn, cs); ref = first ? P[c] * cs - y * sn : P[c] * cs + y * sn; }
        else if (c >= 768 && c < 1536) ref = P[c] * red[0] * A.in[I_EVQNG][li * 768 + c - 768];
        else if (c >= 1536 && c < 1792) ref = P[c] * red[1] * A.in[I_EVKVNG][li * 256 + c - 1536];
        else if (c >= 1792 && lat) { const int d = c - 1792, dd = d & 15, i = dd & 7; const bool first = dd < 8; const float y = P[first ? c + 8 : c - 8];
            float sn, cs; sincos_d((float)((d < 16) ? prow : pcol) * invfreq(i, 8), sn, cs); ref = first ? P[c] * cs - y * sn : P[c] * cs + y * sn; }
        const float got = bfv(CWS(bf16_t, WS_PB) + (size_t)row * EV_LD + c);
        e2 += (got - ref) * (got - ref); r2 += ref * ref;
    }
    chk_acc(A, e2, r2);
}
__global__ void chk_e4(CArgs A) {
    __shared__ float Q[768];
    const int li = A.layer >> 1, row = (int)(hsh(blockIdx.x * 3 + 1) % TL), t = threadIdx.x;
    const float* W = A.in[I_EVWUQ] + (size_t)li * 768 * 768; const bf16_t* x = CWS(bf16_t, WS_PB) + (size_t)row * EV_LD + 768;
    for (int c = t; c < 768; c += 256) { float a = 0.f; for (int k = 0; k < 768; ++k) a += bfv(x + k) * W[(size_t)k * 768 + c]; Q[c] = rbf(a); }
    __syncthreads();
    const int tt = row & (SEQ - 1), prow = tt >> 6, pcol = tt & 63;
    float e2 = 0.f, r2 = 0.f;
    for (int c = t; c < 768; c += 256) { const int d = c % 96; float ref = Q[c];
        if (d >= 64) { const int dr = d - 64, dd = dr & 15, i = dd & 7; const bool first = dd < 8; const float y = Q[first ? c + 8 : c - 8];
            float sn, cs; sincos_d((float)((dr < 16) ? prow : pcol) * invfreq(i, 8), sn, cs); ref = first ? Q[c] * cs - y * sn : Q[c] * cs + y * sn; }
        const float got = bfv(CWS(bf16_t, WS_QB) + (size_t)row * 768 + c); e2 += (got - ref) * (got - ref); r2 += ref * ref; }
    chk_acc(A, e2, r2);
}
__global__ void chk_attn(CArgs A, int kind, int ctxq) {
    __shared__ float sc[8448]; __shared__ float redm[4], reds[4], qs[96];
    const int li = A.layer >> 1, t = threadIdx.x; const unsigned s = blockIdx.x;
    const int b = hsh(s * 7 + 1) % NB, head = hsh(s * 7 + 2) % (kind == 2 ? 16 : 8);
    const int pos = ctxq ? hsh(s * 7 + 3) % CTXL : ((s & 7) == 0 ? (hsh(s) % 200) : (s & 7) == 1 ? SEQ - 1 - (hsh(s) % 200) : hsh(s * 7 + 3) % SEQ);
    const size_t qrow = ctxq ? (size_t)(TL + b * CTXL + pos) : (size_t)(b * SEQ + pos);
    int nlat = 0, wlo = 0, r = pos >> 6, c = pos & 63, r0 = 0, c0 = 0;
    if (!ctxq) {
        if (kind == 0) { wlo = pos - 128 < 0 ? 0 : pos - 128; const int whi = pos + 128 > SEQ - 1 ? SEQ - 1 : pos + 128; nlat = whi - wlo + 1; }
        else if (kind == 1) nlat = SEQ;
        else { r0 = r - 4; r0 = r0 < 0 ? 0 : (r0 > 120 ? 120 : r0); c0 = c - 8; c0 = c0 < 0 ? 0 : (c0 > 48 ? 48 : c0); nlat = 128; }
    }
    const int nk = nlat + CTXL;
    const bf16_t* PB = CWS(bf16_t, WS_PB); const bf16_t* KVB = CWS(bf16_t, WS_KVB);
    const int pld = kind == 2 ? OD_LD : EV_LD, dqk = kind == 1 ? 96 : 64;
    const bf16_t* q = kind == 1 ? CWS(bf16_t, WS_QB) + qrow * 768 + 96 * head : PB + qrow * pld + 64 * head;
    const float scale = kind == 1 ? 0.10206207261596577f : 0.125f;
    const bool has_sink = kind == 0; const float sinkv = has_sink ? A.in[I_EVSINK][li * 8 + head] : 0.f;
    const float* rp = A.in[I_ODRPB] + (size_t)(li * 16 + head) * 15 * 31;
    if (t < dqk) qs[t] = bfv(q + t);
    __syncthreads();
    if (kind == 1 && !ctxq) { float rv = 0.f;
        if (t >= 64 && t < 96) { const int dr = t - 64, dd = dr & 15, i = dd & 7; const bool first = dd < 8; const float y = qs[first ? t + 8 : t - 8];
            float sn, cs; sincos_d((float)((dr < 16) ? r : c) * invfreq(i, 8), sn, cs); rv = rbf(first ? qs[t] * cs - y * sn : qs[t] * cs + y * sn); }
        __syncthreads();
        if (t >= 64 && t < 96) qs[t] = rv;
        __syncthreads(); }
#define KROW(i) ((i) >= nlat ? (size_t)(TL + b * CTXL + ((i) - nlat)) : kind == 0 ? (size_t)(b * SEQ + wlo + (i)) : kind == 1 ? (size_t)(b * SEQ + (i)) : (size_t)(b * SEQ + (r0 + ((i) >> 4)) * 64 + c0 + ((i) & 15)))
    float mx = has_sink ? sinkv : -3e38f;
    for (int i = t; i < nk; i += 256) { const size_t kr = KROW(i); float a = 0.f;
        if (kind == 0) { const bf16_t* k = PB + kr * EV_LD + 512 + 64 * (head >> 2); for (int d = 0; d < 64; ++d) a += qs[d] * bfv(k + d); }
        else if (kind == 1) { const bf16_t* k = KVB + kr * 1024 + 128 * head; for (int d = 0; d < 64; ++d) a += qs[d] * bfv(k + d); const bf16_t* k2 = PB + kr * EV_LD + 1792; for (int d = 0; d < 32; ++d) a += qs[64 + d] * bfv(k2 + d); }
        else { const bf16_t* k = PB + kr * OD_LD + 1024 + 64 * head; for (int d = 0; d < 64; ++d) a += qs[d] * bfv(k + d); }
        a *= scale;
        if (kind == 2 && i < nlat) { const int kr_ = r0 + (i >> 4), kc_ = c0 + (i & 15); a += rp[(kr_ - r + 7) * 31 + (kc_ - c + 15)]; }
        sc[i] = a; mx = fmaxf(mx, a); }
    for (int o = 1; o < 64; o <<= 1) mx = fmaxf(mx, __shfl_xor(mx, o));
    if ((t & 63) == 0) redm[t >> 6] = mx;
    __syncthreads();
    mx = fmaxf(fmaxf(redm[0], redm[1]), fmaxf(redm[2], redm[3]));
    float sm = 0.f;
    for (int i = t; i < nk; i += 256) { const float p = __expf(sc[i] - mx); sc[i] = p; sm += p; }
    sm = wave_sum(sm);
    if ((t & 63) == 0) reds[t >> 6] = sm;
    __syncthreads();
    sm = reds[0] + reds[1] + reds[2] + reds[3] + (has_sink ? __expf(sinkv - mx) : 0.f);
    float e2 = 0.f, r2 = 0.f;
    if (t < 64) { float o = 0.f;
        for (int i = 0; i < nk; ++i) { const size_t kr = KROW(i); const bf16_t* v = kind == 0 ? PB + kr * EV_LD + 640 + 64 * (head >> 2) : kind == 1 ? KVB + kr * 1024 + 128 * head + 64 : PB + kr * OD_LD + 2048 + 64 * head; o += sc[i] * bfv(v + t); }
        o /= sm; const unsigned char* got = CWS(unsigned char, WS_AO) + qrow * 1024 + (kind == 1 ? 512 : 0) + 64 * head; const float g = f8v(got + t); e2 = (g - o) * (g - o); r2 = o * o; }
#undef KROW
    chk_acc(A, e2, r2);
}
__global__ void chk_outproj(CArgs A, const float* W) {
    const int row = A.layer == 3 ? (int)(hsh(blockIdx.x * 3 + 1) % TL) : srow(blockIdx.x), c = (int)((hsh(blockIdx.x * 977 + 5) + 7u * threadIdx.x) % 1024u);
    float a = 0.f; for (int k = 0; k < 1024; ++k) a += f8v(CWS(unsigned char, WS_AO) + (size_t)row * 1024 + k) * W[(size_t)k * 1024 + c];
    const float gate = naive_mod(A, A.layer, row < TL ? (row >> 13) : 4, 2 * 1024 + c);
    const float ref = CWS(float, WS_CHK)[(size_t)row * DM + c] + gate * a, got = CWS(float, WS_XLC)[(size_t)row * DM + c];
    chk_acc(A, (got - ref) * (got - ref), (gate * a) * (gate * a));
}
__global__ void chk_norm_router(CArgs A, int which, const bf16_t* hbuf, int hld) {
    __shared__ float hv[1024]; __shared__ float red[4]; __shared__ float lg[32]; __shared__ int ste[4]; __shared__ float stv[4];
    const int row = srow(blockIdx.x), t = threadIdx.x, bidx = row < TL ? (row >> 13) : 4;
    const float* x = CWS(float, WS_XLC) + (size_t)row * DM;
    float s = 0.f; for (int c = t; c < 1024; c += 256) s += x[c] * x[c];
    s = wave_sum(s); if ((t & 63) == 0) red[t >> 6] = s; __syncthreads();
    const float rstd = 1.0f / sqrtf((red[0] + red[1] + red[2] + red[3]) / 1024.0f + NORM_EPS);
    const float* g = (which == 0 ? A.in[I_N1G] : A.in[I_N2G]) + A.layer * DM;
    float e2 = 0.f, r2 = 0.f;
    for (int c = t; c < 1024; c += 256) { const float sh = naive_mod(A, A.layer, bidx, which * 1024 + c), scl = naive_mod(A, A.layer, bidx, (which + 1) * 1024 + c);
        const float h = x[c] * rstd * g[c] * (1.0f + scl) + sh; hv[c] = h; const float got = hld ? bfv(hbuf + (size_t)row * hld + c) : f8v((const unsigned char*)hbuf + (size_t)row * DM + c); e2 += (got - h) * (got - h); r2 += h * h; }
    __syncthreads();
    if (which == 3) {
        if (t < 32) { const float* rw = A.in[I_RW] + (size_t)A.layer * 1024 * 32; float a = 0.f; for (int k = 0; k < 1024; ++k) a += hv[k] * rw[k * 32 + t]; lg[t] = a + A.in[I_RB][A.layer * 32 + t]; }
        __syncthreads();
        if (t == 0) { unsigned used = 0u;
            for (int k = 0; k < 4; ++k) { float bv = -3e38f; int bi = 0; for (int e = 0; e < 32; ++e) if (!((used >> e) & 1u) && lg[e] > bv) { bv = lg[e]; bi = e; } used |= 1u << bi; ste[k] = bi; stv[k] = bv; }
            float den = 0.f; for (int k = 0; k < 4; ++k) den += __expf(stv[k] - stv[0]);
            for (int k = 0; k < 4; ++k) { const float gr = __expf(stv[k] - stv[0]) / den; const int ge = CWS(int, WS_TOPE)[(size_t)row * 4 + k]; const float gg = CWS(float, WS_TOPG)[(size_t)row * 4 + k];
                const float d = (ge == ste[k]) ? (gg - gr) : 1.0f; e2 += 1000.f * d * d; r2 += 1000.f * gr * gr; } }
    }
    chk_acc(A, e2, r2);
}
__global__ void chk_slots_count(CArgs A) {
    const int i = blockIdx.x * 256 + threadIdx.x; if (i < TT * 4) { const int sl = CWS(int, WS_SLOT)[i]; if (sl >= 0 && sl < MAXSLOT) atomicAdd(CWS(int, WS_CHK_CNT) + sl, 1); else atomicAdd((float*)(A.ws + WS_CTL) + CW_CHK + 2 * A.id, 1.0f); }
}
__global__ void chk_slots(CArgs A) {
    const int i = blockIdx.x * 256 + threadIdx.x; float e2 = 0.f, r2 = 0.f;
    if (i < MAXSLOT) { const int c = CWS(int, WS_CHK_CNT)[i]; if (c > 1) e2 += 1.f; }
    if (i < 8192) { const unsigned a = hsh(i * 5 + 3) % (unsigned)(TT * 4); const int row = a >> 2, sl = CWS(int, WS_SLOT)[a], e = CWS(int, WS_TOPE)[a];
        if (CWS(int, WS_TILEEXP)[sl >> 8] != e) e2 += 1.f;
        if (CWS(float, WS_GSLOT)[sl] != CWS(float, WS_TOPG)[a]) e2 += 1.f;
        if (CWS(int, WS_TOKSLOT)[sl] != row) e2 += 1.f; r2 += 1.f; }
    chk_acc(A, e2, r2);
}
__global__ void chk_moe(CArgs A, int which) {
    const unsigned a = hsh(blockIdx.x * 5 + 3) % (unsigned)(TT * 4); const int sl = CWS(int, WS_SLOT)[a], e = CWS(int, WS_TILEEXP)[sl >> 8];
    const int c = (int)((hsh(blockIdx.x * 977 + 5) + 7u * threadIdx.x) % 1024u);
    float ref, got;
    if (which == 0) { const float* W = A.in[I_W1] + ((size_t)A.layer * 32 + e) * 1024 * 2048; const unsigned char* x = CWS(unsigned char, WS_HB) + (size_t)(a >> 2) * DM; float g = 0.f, l = 0.f;
        for (int k = 0; k < 1024; ++k) { const float xv = f8v(x + k); g += xv * W[(size_t)k * 2048 + c]; l += xv * W[(size_t)k * 2048 + 1024 + c]; }
        g += A.in[I_B1][((size_t)A.layer * 32 + e) * 2048 + c]; l += A.in[I_B1][((size_t)A.layer * 32 + e) * 2048 + 1024 + c];
        g = fminf(g, 7.f); l = fminf(fmaxf(l, -7.f), 7.f); ref = g / (1.0f + __expf(-1.702f * g)) * (l + 1.0f); got = f8v(CWS(unsigned char, WS_HA) + (size_t)sl * DM + c); }
    else { const float* W = A.in[I_W2] + ((size_t)A.layer * 32 + e) * 1024 * 1024; const unsigned char* x = CWS(unsigned char, WS_HA) + (size_t)sl * DM; float y = 0.f;
        for (int k = 0; k < 1024; ++k) y += f8v(x + k) * W[(size_t)k * 1024 + c];
        ref = y + A.in[I_B2][((size_t)A.layer * 32 + e) * 1024 + c]; got = f8v(CWS(unsigned char, WS_XG) + (size_t)sl * DM + c) * (1.0f / YS_SCALE); }
    chk_acc(A, (got - ref) * (got - ref), ref * ref);
}
__global__ void chk_combine(CArgs A) {
    const int row = srow(blockIdx.x), c = (int)((hsh(blockIdx.x * 977 + 5) + 7u * threadIdx.x) % 1024u);
    float y = 0.f; for (int k = 0; k < 4; ++k) y += CWS(float, WS_TOPG)[(size_t)row * 4 + k] * (1.0f / YS_SCALE) * f8v(CWS(unsigned char, WS_XG) + (size_t)CWS(int, WS_SLOT)[(size_t)row * 4 + k] * DM + c);
    const float gate = naive_mod(A, A.layer, row < TL ? (row >> 13) : 4, 5 * 1024 + c);
    const float ref = CWS(float, WS_CHK)[(size_t)row * DM + c] + gate * y, got = CWS(float, WS_XLC)[(size_t)row * DM + c];
    chk_acc(A, (got - ref) * (got - ref), (gate * y) * (gate * y));
}
__global__ void chk_report(CArgs A) {
    if (threadIdx.x == 0 && blockIdx.x == 0) { const float* acc = (const float*)(A.ws + WS_CTL) + CW_CHK; int bad = 0, bad2 = 0;
        for (int id = NID - 1; id >= 1; --id) { const int q = (id - 1) % IDS_PER_PAIR + 1; const float tol = (id == ID_PROB || (q >= 6 && q <= 10) || q == 18 || q == 19 || q == 20 || q == 1 || q == 2 || q == 17 || q == 13 || q == 14 || q == 16 || q == 23 || q == 24 || q == 26) ? 0.1f : 0.03f;
            const float e2 = acc[2 * id], r2 = acc[2 * id + 1]; if (r2 <= 0.f || !(e2 <= tol * tol * r2)) { bad2 = bad; bad = id; } }
        if (bad) A.out[0] = 1000.0f * (float)bad;
        if (bad2) A.out[1] = 1000.0f * (float)bad2; }
}
static void chk_before(int p, const Args& a, hipStream_t st) {
    const int q = p < 2 ? -1 : (p - 2) % NPH_PAIR;
    if (q == 8 || q == 18) (void)hipMemsetAsync(a.ws + WS_CHK_CNT, 0, (size_t)MAXSLOT * 4, st);
    if (q == 4 || q == 11 || q == 14 || q == 21) (void)hipMemcpyAsync(a.ws + WS_CHK, a.ws + WS_XLC, (size_t)TT * DM * 4, hipMemcpyDeviceToDevice, st);
}
static void chk_after(int p, const Args& a, hipStream_t st) {
    CArgs A{}; for (int i = 0; i < 25; ++i) A.in[i] = a.in[i]; A.out = a.out; A.ws = a.ws;
    const int lp = p < 2 ? 0 : (p - 2) / NPH_PAIR, q = p < 2 ? -1 : (p - 2) % NPH_PAIR, base = IDS_PER_PAIR * lp;
    unsigned char* ws = a.ws; const int le = 2 * lp, lod = 2 * lp + 1;
#define CK(idv, layerv, kern, grid, ...) do { A.id = base + (idv); A.layer = (layerv); hipLaunchKernelGGL(kern, dim3(grid), dim3(256), 0, st, A, ##__VA_ARGS__); } while (0)
#define CK0(idv, layerv, kern, grid) do { A.id = base + (idv); A.layer = (layerv); hipLaunchKernelGGL(kern, dim3(grid), dim3(256), 0, st, A); } while (0)
    if (p == 1) { A.id = ID_PROB; A.layer = 0; hipLaunchKernelGGL(chk_norm_router, dim3(48), dim3(256), 0, st, A, 0, (const bf16_t*)(ws + WS_HB), 0); }
    if (q == 0) CK(1, le, chk_gemm, 64, (const bf16_t*)(ws + WS_HB), 0, a.in[I_EVWIN] + (size_t)lp * 1024 * EV_IN, (int)EV_IN, 1024, (int)EV_IN, (const bf16_t*)(ws + WS_PB), (int)EV_LD);
    if (q == 1) CK0(2, le, chk_e2, 48);
    if (q == 2) { CK(3, le, chk_gemm, 64, (const bf16_t*)(ws + WS_PB) + 768, (int)EV_LD, a.in[I_EVWUQ] + (size_t)lp * 768 * 768, 768, 768, 768, (const bf16_t*)(ws + WS_QB), 768);
                  CK(4, le, chk_gemm, 64, (const bf16_t*)(ws + WS_PB) + 1536, (int)EV_LD, a.in[I_EVWUKV] + (size_t)lp * 256 * 1024, 1024, 256, 1024, (const bf16_t*)(ws + WS_KVB), 1024);
                  CK0(5, le, chk_mark, 1); }
    if (q == 3) { CK(6, le, chk_attn, 96, 0, 0); CK(7, le, chk_attn, 48, 1, 0); CK(8, le, chk_attn, 32, 0, 1); CK(9, le, chk_attn, 32, 1, 1); }
    if (q == 4) CK(10, le, chk_outproj, 48, a.in[I_EVWOUT] + (size_t)lp * 1024 * 1024);
    if (q == 7) CK(11, le, chk_norm_router, 48, 3, (const bf16_t*)(ws + WS_PB), (int)H3_LD);
    if (q == 8) { CK0(12, le, chk_slots_count, (TT * 4 + 255) / 256); CK0(12, le, chk_slots, MAXSLOT / 256); }
    if (q == 9) CK(13, le, chk_moe, 64, 0);
    if (q == 10) CK(14, le, chk_moe, 64, 1);
    if (q == 11) { CK0(15, le, chk_combine, 64); CK(16, le + 1, chk_norm_router, 48, 0, (const bf16_t*)(ws + WS_HB), 0); }
    if (q == 12) CK(17, lod, chk_gemm, 64, (const bf16_t*)(ws + WS_HB), 0, a.in[I_ODWIN] + (size_t)lp * 1024 * 3072, 3072, 1024, 3072, (const bf16_t*)(ws + WS_PB), (int)OD_LD);
    if (q == 13) { CK(18, lod, chk_attn, 96, 2, 0); CK(19, lod, chk_attn, 32, 2, 1); }
    if (q == 14) CK(20, lod, chk_outproj, 48, a.in[I_ODWOUT] + (size_t)lp * 1024 * 1024);
    if (q == 17) CK(21, lod, chk_norm_router, 48, 3, (const bf16_t*)(ws + WS_PB), (int)H3_LD);
    if (q == 18) { CK0(22, lod, chk_slots_count, (TT * 4 + 255) / 256); CK0(22, lod, chk_slots, MAXSLOT / 256); }
    if (q == 19) CK(23, lod, chk_moe, 64, 0);
    if (q == 20) CK(24, lod, chk_moe, 64, 1);
    if (q == 21) { if (lod != 3) { CK0(25, lod, chk_combine, 64); CK(26, lod + 1, chk_norm_router, 48, 0, (const bf16_t*)(ws + WS_HB), 0); } else { CK0(25, lod, chk_mark, 1); CK0(26, lod, chk_mark, 1); } }
    if (p == NPH - 1) { A.id = 0; hipLaunchKernelGGL(chk_report, dim3(1), dim3(64), 0, st, A); }
#undef CK
#undef CK0
}
#endif

extern "C" void kernel_launch(void* const* d_in, const int* in_sizes, int n_in, void* d_out, int out_size, void* d_ws, size_t ws_size, hipStream_t stream) {
    static int grid = 0;
    if (grid == 0) {
        if (n_in != 25 || out_size != TL * DM || ws_size < WS_END) { fprintf(stderr, "kernel_launch: unexpected shapes (n_in %d, out %d, ws %zu < %zu); nothing launched\n", n_in, out_size, ws_size, (size_t)WS_END); grid = -1; return; }
        int dev = 0, cus = 0, per_cu = 0;
        if (hipGetDevice(&dev) != hipSuccess || hipDeviceGetAttribute(&cus, hipDeviceAttributeMultiprocessorCount, dev) != hipSuccess) { grid = -1; return; }
        if (hipFuncSetAttribute((const void*)fwd, hipFuncAttributeMaxDynamicSharedMemorySize, LDS_BYTES) != hipSuccess) { fprintf(stderr, "kernel_launch: hipFuncSetAttribute failed\n"); grid = -1; return; }
        if (hipOccupancyMaxActiveBlocksPerMultiprocessor(&per_cu, (const void*)fwd, 512, LDS_BYTES) != hipSuccess || per_cu < 1) { fprintf(stderr, "kernel_launch: occupancy query says %d blocks per CU\n", per_cu); }
        (void)hipGetLastError();
        grid = cus;
    }
    if (grid < 0) return;
    (void)hipMemsetAsync((char*)d_ws + WS_CTL, 0, CTL_ZERO_BYTES, stream);
    Args a{};
    for (int i = 0; i < 25; ++i) a.in[i] = (const float*)d_in[i];
    a.out = (float*)d_out; a.ws = (unsigned char*)d_ws;
#if MK_PER_PHASE
    for (int p = 0; p < NPH; ++p) {
#if MK_CHECK
        chk_before(p, a, stream);
#endif
        a.ph_lo = p; a.ph_hi = p + 1; hipLaunchKernelGGL(fwd, dim3(grid), dim3(512), LDS_BYTES, stream, a);
#if MK_CHECK
        chk_after(p, a, stream);
#endif
    }
#else
    a.ph_lo = 0; a.ph_hi = NPH;
    hipLaunchKernelGGL(fwd, dim3(grid), dim3(512), LDS_BYTES, stream, a);
#endif
    const hipError_t le = hipPeekAtLastError();
    if (le != hipSuccess) fprintf(stderr, "kernel_launch: launch failed: %s\n", hipGetErrorName(le));
}
```

```cpp
#include <hip/hip_runtime.h>
#include <cstdio>
#include <cstdint>

#ifndef MK_CHECK
#define MK_CHECK 0
#endif
#ifndef MK_PER_PHASE
#define MK_PER_PHASE MK_CHECK
#endif

#define LAS __attribute__((address_space(3)))
#define GAS __attribute__((address_space(1)))
typedef unsigned short bf16_t;
typedef short bf16x8 __attribute__((ext_vector_type(8)));
typedef short s16x4 __attribute__((ext_vector_type(4)));
typedef float f32x2 __attribute__((ext_vector_type(2)));
typedef float f32x4 __attribute__((ext_vector_type(4)));
typedef float f32x16 __attribute__((ext_vector_type(16)));
typedef unsigned u32x2 __attribute__((ext_vector_type(2)));
typedef unsigned u32x4 __attribute__((ext_vector_type(4)));

constexpr int DM = 1024, NB = 4, SEQ = 8192, TL = NB * SEQ, CTXL = 256, TC = NB * CTXL, TT = TL + TC;
constexpr int EV_LD = 2048, OD_LD = 3072;
constexpr int EV_IN = 1824;
constexpr int NEXP = 32, DEXP = 1024;
constexpr int MAXSLOT = 143360, MAXTILE = 560;
constexpr float NORM_EPS = 1e-6f;
constexpr float LOG2E = 1.4426950408889634f;

constexpr size_t MiB = 1u << 20;
constexpr size_t WS_CTL = 0, CTL_ZERO_BYTES = 1 * MiB;
constexpr size_t WS_MOD = 1 * MiB;
constexpr size_t WS_ROPE64 = 1 * MiB + 512 * 1024;
constexpr size_t WS_ROPE32 = WS_ROPE64 + 16384;
constexpr size_t WS_TOPE = 2 * MiB;
constexpr size_t WS_TOPG = WS_TOPE + 540672;
constexpr size_t WS_SLOT = WS_TOPG + 540672;
constexpr size_t WS_HIST = WS_SLOT + 540672;
constexpr size_t WS_TILEEXP = WS_HIST + 131072;
constexpr size_t WS_GSLOT = WS_TILEEXP + 4096;
constexpr size_t WS_TOKSLOT = WS_GSLOT + (size_t)MAXSLOT * 4;
static_assert(WS_TOKSLOT + (size_t)MAXSLOT * 4 <= 6 * MiB, "route map");
constexpr size_t WS_WINE = 6 * MiB, WS_WUQ = 14 * MiB, WS_WUKV = 17 * MiB, WS_WOUTE = 18 * MiB, WS_WINO = 22 * MiB, WS_WOUTO = 34 * MiB;
constexpr size_t WS_W1 = 38 * MiB, WS_W2 = 550 * MiB;
constexpr size_t WS_XLC = 806 * MiB, WS_HB = 938 * MiB, WS_PB = 1004 * MiB, WS_QB = 1202 * MiB, WS_KVB = 1252 * MiB, WS_AO = 1318 * MiB;
constexpr size_t WS_XG = 1384 * MiB, WS_HA = 1664 * MiB, WS_RWT = 1944 * MiB, WS_LOGIT = 1952 * MiB, WS_END = 1960 * MiB;
constexpr size_t WS_LOGIT12 = WS_XG + 160 * MiB;
constexpr int H3_LD = 3072;
constexpr int CW_BAR = 4096;

constexpr int ARENA_BYTES = 131072;
constexpr int LDSCTL_OFF = ARENA_BYTES;
constexpr int LDS_BYTES = 147456;

__device__ __forceinline__ unsigned f2bf(float f) { unsigned u = __builtin_bit_cast(unsigned, f); return (u + 0x7fffu + ((u >> 16) & 1u)) >> 16; }
__device__ __forceinline__ unsigned pk2(float lo, float hi) { return f2bf(lo) | (f2bf(hi) << 16); }
__device__ __forceinline__ f32x4 xun4(u32x2 w) { return (f32x4){__builtin_bit_cast(float, w.x << 16), __builtin_bit_cast(float, w.x & 0xffff0000u), __builtin_bit_cast(float, w.y << 16), __builtin_bit_cast(float, w.y & 0xffff0000u)}; }
__device__ __forceinline__ u32x2 xpk4(f32x4 v) { return (u32x2){pk2(v.x, v.y), pk2(v.z, v.w)}; }
__device__ __forceinline__ float bflo(unsigned w) { return __builtin_bit_cast(float, w << 16); }
__device__ __forceinline__ float bfhi(unsigned w) { return __builtin_bit_cast(float, w & 0xffff0000u); }
__device__ __forceinline__ float wave_sum(float v) {
#pragma unroll
    for (int o = 1; o < 64; o <<= 1) v += __shfl_xor(v, o);
    return v;
}
#define LDS_WAIT() asm volatile("s_waitcnt lgkmcnt(0)" ::: "memory")
__device__ __forceinline__ unsigned cvt4_fp8(float a, float b, float c, float d) { unsigned w = 0u; w = __builtin_amdgcn_cvt_pk_fp8_f32(a, b, w, false); w = __builtin_amdgcn_cvt_pk_fp8_f32(c, d, w, true); return w; }
__device__ __forceinline__ void swap16(unsigned& a, unsigned& b) { asm volatile("s_nop 1\n\tv_permlane16_swap_b32 %0, %1\n\ts_nop 1" : "+v"(a), "+v"(b)); }
constexpr float YS_SCALE = 16.0f;
constexpr float W8_SCALE = 32.0f;
__device__ __forceinline__ int opaque_tid() { int t = threadIdx.x; asm volatile("" : "+v"(t)); return t; }

#define XB_TMO      128
#define XB_XCNT(j)  (256  + 64 * (j))
#define XB_XSUB(j)  (1280 + 64 * (j))
#define XB_XGEN(j)  (2304 + 64 * (j))
#define XB_TOP      3328
#define XB_TOPGEN   3392
#define XCD_BAR_WORDS 3456
#define XB_SPIN_CAP (1u << 18)

__device__ __forceinline__ unsigned xb_ld(unsigned* p)              { return __hip_atomic_load(p, __ATOMIC_RELAXED, __HIP_MEMORY_SCOPE_AGENT); }
__device__ __forceinline__ unsigned xb_add(unsigned* p, unsigned v) { return __hip_atomic_fetch_add(p, v, __ATOMIC_RELAXED, __HIP_MEMORY_SCOPE_AGENT); }
__device__ __forceinline__ unsigned xb_xcc_id() { return (unsigned)__builtin_amdgcn_s_getreg((3 << 11) | 20) & 0xFu; }
#define XB_SPIN(cond, bar) do { unsigned _sp = 0; while (cond) { __builtin_amdgcn_s_sleep(1); \
    if ((++_sp & 255u) == 0u) { if (xb_ld(&(bar)[XB_TMO])) break; if (_sp > XB_SPIN_CAP) { atomicAdd(&(bar)[XB_TMO], 1u); break; } } } } while (0)

struct XcdBarrier { unsigned* bar; unsigned x; volatile LAS unsigned* st; };

__device__ __forceinline__ XcdBarrier xcd_barrier_post(unsigned* bar, volatile LAS unsigned* st) {
    XcdBarrier b; b.bar = bar; b.x = xb_xcc_id(); b.st = st;
    if (threadIdx.x == 0) (void)xb_add(&bar[XB_XCNT(b.x)], 1u);
    return b;
}
__device__ __forceinline__ void xcd_barrier_complete(unsigned* bar, unsigned x, unsigned& nloc, unsigned& nx) {
    const unsigned G = gridDim.x * gridDim.y * gridDim.z;
    unsigned sum, cnt, mine, sp = 0u;
    for (;;) {
        sum = 0u; cnt = 0u; mine = 0u;
#pragma unroll
        for (unsigned j = 0; j < 16; ++j) { const unsigned c = xb_ld(&bar[XB_XCNT(j)]); sum += c; cnt += (c > 0u) ? 1u : 0u; mine = (j == x) ? c : mine; }
        if (sum == G) break;
        __builtin_amdgcn_s_sleep(1);
        if ((++sp & 255u) == 0u) { if (xb_ld(&bar[XB_TMO])) break; if (sp > XB_SPIN_CAP) { atomicAdd(&bar[XB_TMO], 1u); break; } }
    }
    nloc = mine > 0u ? mine : 1u; nx = cnt > 0u ? cnt : 1u;
}
__device__ __forceinline__ void xcd_barrier(const XcdBarrier& b) {
    asm volatile("s_waitcnt vmcnt(0)" ::: "memory");
    __syncthreads();
    if (threadIdx.x == 0) {
        unsigned* bar = b.bar;
        __builtin_amdgcn_s_waitcnt(0);
        unsigned nloc = b.st[0], nx = b.st[1];
        if (nloc == 0u) { xcd_barrier_complete(bar, b.x, nloc, nx); b.st[0] = nloc; b.st[1] = nx; }
        const unsigned old = xb_add(&bar[XB_XSUB(b.x)], 1u);
        const unsigned gen = old / nloc;
        if (old + 1u == (gen + 1u) * nloc) {
            __builtin_amdgcn_fence(__ATOMIC_RELEASE, "agent");
            asm volatile("s_waitcnt vmcnt(0)" ::: "memory");
            const unsigned og = xb_add(&bar[XB_TOP], 1u);
            const unsigned tg = og / nx;
            if (og + 1u == (tg + 1u) * nx) xb_add(&bar[XB_TOPGEN], 1u);
            else XB_SPIN(xb_ld(&bar[XB_TOPGEN]) == tg, bar);
            __builtin_amdgcn_fence(__ATOMIC_ACQUIRE, "agent");
            xb_add(&bar[XB_XGEN(b.x)], 1u);
            asm volatile("s_waitcnt vmcnt(0)" ::: "memory");
        } else {
            XB_SPIN(xb_ld(&bar[XB_XGEN(b.x)]) == gen, bar);
            __builtin_amdgcn_fence(__ATOMIC_ACQUIRE, "agent");
            asm volatile("s_waitcnt vmcnt(0)" ::: "memory");
        }
    }
    __syncthreads();
}

namespace pg8 {
constexpr int BM = 256, BK = 64, HALF = 128, HTB = HALF * BK * 2, STAGE_BYTES = 8 * HTB, NXCD = 8, WGM = 8;
__host__ __device__ __forceinline__ int lds_byte(int r, int c) { const int st = (r >> 4) * 2 + (c >> 5), rr = r & 15, cc = c & 31, ob = rr * 64 + cc * 2; return st * 1024 + (ob ^ (((ob >> 9) & 1) << 5)); }
__host__ __device__ __forceinline__ void stage_rc(int b, int& R, int& C) { const int st = b / 1024, sb = b % 1024, swz = sb ^ (((sb >> 9) & 1) << 5); R = (st >> 1) * 16 + swz / 64; C = (st & 1) * 32 + (swz % 64) / 2; }
__host__ __device__ __forceinline__ int perm32(int rho) { const int n = rho >> 4, i = rho & 15; return 8 * (i >> 2) + 4 * n + (i & 3); }

typedef int v4i_t __attribute__((ext_vector_type(4)));
typedef int v8i_t __attribute__((ext_vector_type(8)));
struct Unit { unsigned a, b; int pm, pn, aux; };

struct DenseOrder {
    const char* A; const char* Bt; unsigned lda2, ldb2; int nM, nN, nwg, G, c;
    __device__ __forceinline__ const void* baseA() const { return A; }
    __device__ __forceinline__ const void* baseB() const { return Bt; }
    __device__ __forceinline__ const int* gather() const { return nullptr; }
    __device__ __forceinline__ void init(const void* A_, size_t lda_bytes, const void* Bt_, size_t ldb_bytes, int M, int N, int G_, int c_) { A = (const char*)A_; Bt = (const char*)Bt_; lda2 = (unsigned)lda_bytes; ldb2 = (unsigned)ldb_bytes; nM = M / BM; nN = N / BM; nwg = nM * nN; G = G_; c = c_; }
    __device__ __forceinline__ bool next(int i, Unit& u) const {
        const long L = (long)i * G + c; if (L >= nwg) return false;
        int wgid = (int)L; { const int q = nwg / NXCD, r = nwg % NXCD, xcd = wgid % NXCD, off = wgid / NXCD; wgid = (xcd < r ? xcd * (q + 1) : r * (q + 1) + (xcd - r) * q) + off; }
        const int nig = WGM * nN, gid = wgid / nig, fm = gid * WGM, gsz = (nM - fm) < WGM ? (nM - fm) : WGM;
        u.pm = fm + ((wgid % nig) % gsz); u.pn = (wgid % nig) / gsz; u.aux = 0;
        u.a = (unsigned)u.pm * BM * lda2; u.b = (unsigned)u.pn * BM * ldb2; return true;
    }
};
struct RouterOrder {
    const char* A; const char* Bt; unsigned lda2, ldb2; int nM, G, c;
    __device__ __forceinline__ const void* baseA() const { return A; }
    __device__ __forceinline__ const void* baseB() const { return Bt; }
    __device__ __forceinline__ const int* gather() const { return nullptr; }
    __device__ __forceinline__ bool next(int i, Unit& u) const {
        const int L = i * G + c; if (L >= nM * 3) return false;
        u.pm = L / 3; u.aux = L - 3 * u.pm; u.pn = 0;
        u.a = (unsigned)u.pm * BM * lda2 + (u.aux == 1 ? 2048u : 0u); u.b = (unsigned)u.aux * 2048u; return true;
    }
};
struct MoeOrder {
    const char* A; const char* W; const LAS int* tile_exp; const int* tokslot; unsigned lda2, ldb2, wstride; int ntiles, nN, G, c;
    __device__ __forceinline__ const void* baseA() const { return A; }
    __device__ __forceinline__ const void* baseB() const { return W; }
    __device__ __forceinline__ const int* gather() const { return tokslot; }
    __device__ __forceinline__ bool next(int i, Unit& u) const {
        const int tpr = G / nN, tpx = tpr >> 3, x = c & 7, j = c >> 3;
        int tile, pn;
        if ((G & 7) == 0 && tpx * 8 == tpr && tpx > 0) { tile = i * tpr + x * tpx + j / nN; pn = j % nN; }
        else { const long L = (long)i * G + c; tile = (int)(L / nN); pn = (int)(L % nN); }
        if (tile >= ntiles) return false;
        const int e = __builtin_amdgcn_readfirstlane(tile_exp[tile]);
        u.pm = tile; u.pn = pn; u.aux = e; u.a = (unsigned)tile * BM * lda2; u.b = (unsigned)e * wstride + (unsigned)pn * BM * ldb2; return true;
    }
};

__device__ __forceinline__ unsigned cvt_pk_bf16(float lo, float hi) { unsigned r; asm volatile("v_cvt_pk_bf16_f32 %0, %1, %2" : "=v"(r) : "v"(lo), "v"(hi)); return r; }

struct EpiBf16 {
    static constexpr bool PERM = true; static constexpr bool WIDE16 = false;
    bf16_t* O; int ldc; float sc;
    struct Pre {}; static constexpr bool HAS_BIAS = false; static constexpr bool HALFN = false;
    __device__ __forceinline__ void operator()(const f32x4 (&acc)[2][2][4][2], const Unit& u, int wr, int wc, int fr, int fq, const Pre& pre) const {
        const int row0 = u.pm * BM + wr * 64 + fr, col0 = u.pn * BM + wc * 32 + 8 * fq;
#pragma unroll
        for (int ai = 0; ai < 2; ++ai)
#pragma unroll
            for (int m = 0; m < 4; ++m) { bf16_t* rowp = O + (size_t)(row0 + ai * HALF + m * 16) * ldc + col0;
#pragma unroll
                for (int bj = 0; bj < 2; ++bj) { const f32x4 v0 = acc[ai][bj][m][0] * sc, v1 = acc[ai][bj][m][1] * sc;
                    u32x4 w; w.x = cvt_pk_bf16(v0[0], v0[1]); w.y = cvt_pk_bf16(v0[2], v0[3]); w.z = cvt_pk_bf16(v1[0], v1[1]); w.w = cvt_pk_bf16(v1[2], v1[3]);
                    *(u32x4*)(rowp + bj * HALF) = w; } }
    }
};
struct EpiResid {
    static constexpr bool PERM = true; static constexpr bool WIDE16 = false;
    bf16_t* X; const float* modl; float sc;
    struct Pre {}; static constexpr bool HAS_BIAS = false; static constexpr bool HALFN = false;
    __device__ __forceinline__ void operator()(const f32x4 (&acc)[2][2][4][2], const Unit& u, int wr, int wc, int fr, int fq, const Pre& pre) const {
        const int row0 = u.pm * BM + wr * 64 + fr, col0 = u.pn * BM + wc * 32 + 8 * fq;
        const int bidx = u.pm < 128 ? (u.pm >> 5) : 4;
        const float* gp = modl + (size_t)bidx * 6144 + col0;
        f32x4 gv[2][2];
#pragma unroll
        for (int bj = 0; bj < 2; ++bj)
#pragma unroll
            for (int n = 0; n < 2; ++n) gv[bj][n] = *(const f32x4*)(gp + bj * HALF + 4 * n) * sc;
        u32x4 xc[2], xn[2];
        { const bf16_t* rowp = X + (size_t)row0 * DM + col0; xc[0] = *(const u32x4*)rowp; xc[1] = *(const u32x4*)(rowp + HALF); xn[0] = xc[0]; xn[1] = xc[1]; }
#pragma unroll
        for (int g = 0; g < 8; ++g) { const int ai = g >> 2, m = g & 3;
            bf16_t* rowp = X + (size_t)(row0 + ai * HALF + m * 16) * DM + col0;
            if (g < 7) { const bf16_t* nrow = X + (size_t)(row0 + ((g + 1) >> 2) * HALF + ((g + 1) & 3) * 16) * DM + col0; xn[0] = *(const u32x4*)nrow; xn[1] = *(const u32x4*)(nrow + HALF); }
            asm volatile("" ::: "memory");
#pragma unroll
            for (int bj = 0; bj < 2; ++bj) { const u32x4 w = xc[bj];
                const f32x4 a = xun4((u32x2){w.x, w.y}) + gv[bj][0] * acc[ai][bj][m][0], b = xun4((u32x2){w.z, w.w}) + gv[bj][1] * acc[ai][bj][m][1];
                const u32x2 pa = xpk4(a), pb = xpk4(b);
                *(u32x4*)(rowp + bj * HALF) = (u32x4){pa.x, pa.y, pb.x, pb.y}; }
            asm volatile("" ::: "memory");
            xc[0] = xn[0]; xc[1] = xn[1]; }
    }
};
struct EpiLogits {
    static constexpr bool PERM = false; static constexpr bool WIDE16 = false;
    float* LG0; float* LG12; const float* rb;
    struct Pre {}; static constexpr bool HAS_BIAS = false; static constexpr bool HALFN = true;
    __device__ __forceinline__ void operator()(const f32x4 (&acc)[2][2][4][2], const Unit& u, int wr, int wc, int fr, int fq, const Pre& pre) const {
        if (wc != 0) return;
        const int row0 = u.pm * BM + wr * 64 + fr;
        float* LG = u.aux == 0 ? LG0 : LG12 + (size_t)(u.aux - 1) * TT * 32;
        const float bs = u.aux == 0 ? 1.0f : 0.0f;
        const f32x4 b0 = *(const f32x4*)(rb + 4 * fq) * bs, b1 = *(const f32x4*)(rb + 16 + 4 * fq) * bs;
#pragma unroll
        for (int ai = 0; ai < 2; ++ai)
#pragma unroll
            for (int m = 0; m < 4; ++m) { float* rowp = LG + (size_t)(row0 + ai * HALF + m * 16) * 32 + 4 * fq;
                *(f32x4*)rowp = acc[ai][0][m][0] + b0; *(f32x4*)(rowp + 16) = acc[ai][0][m][1] + b1; }
    }
};
struct EpiSwiglu {
    static constexpr bool PERM = true; static constexpr bool WIDE16 = false;
    unsigned char* O; const float* b1l;
    struct Pre { const LAS float* b; };
    static constexpr bool HAS_BIAS = true; static constexpr bool HALFN = false;
    __device__ __forceinline__ float bias_of(const Unit& u, int i) const { return b1l[(size_t)u.aux * 2048 + (i < 128 ? u.pn * HALF + i : 1024 + u.pn * HALF + (i - 128))]; }
    __device__ __forceinline__ void operator()(const f32x4 (&acc)[2][2][4][2], const Unit& u, int wr, int wc, int fr, int fq, const Pre& pre) const {
        const int row0 = u.pm * BM + wr * 64 + fr, cg = u.pn * HALF + wc * 32 + 8 * fq;
        f32x4 bg[2], bl[2];
#pragma unroll
        for (int n = 0; n < 2; ++n) { bg[n] = *(const LAS f32x4*)(pre.b + wc * 32 + 8 * fq + 4 * n); bl[n] = *(const LAS f32x4*)(pre.b + 128 + wc * 32 + 8 * fq + 4 * n) + 1.0f; }
#pragma unroll
        for (int ai = 0; ai < 2; ++ai)
#pragma unroll
            for (int mp = 0; mp < 2; ++mp) { unsigned wx[2], wy[2];
#pragma unroll
                for (int mm = 0; mm < 2; ++mm) { const int m = 2 * mp + mm; f32x4 r[2];
#pragma unroll
                    for (int n = 0; n < 2; ++n) { const f32x4 k4 = {1.0f / W8_SCALE, 1.0f / W8_SCALE, 1.0f / W8_SCALE, 1.0f / W8_SCALE};
                        f32x4 g = __builtin_elementwise_fma(acc[ai][0][m][n], k4, bg[n]), l = __builtin_elementwise_fma(acc[ai][1][m][n], k4, bl[n]);
#pragma unroll
                        for (int j = 0; j < 4; ++j) { g[j] = fminf(g[j], 7.0f); l[j] = fminf(fmaxf(l[j], -6.0f), 8.0f); }
                        f32x4 t = g * (-1.702f * LOG2E);
#pragma unroll
                        for (int j = 0; j < 4; ++j) t[j] = __builtin_amdgcn_exp2f(t[j]);
                        t = t + 1.0f;
#pragma unroll
                        for (int j = 0; j < 4; ++j) t[j] = __builtin_amdgcn_rcpf(t[j]);
                        r[n] = (g * t) * l; }
                    wx[mm] = cvt4_fp8(r[0][0], r[0][1], r[0][2], r[0][3]); wy[mm] = cvt4_fp8(r[1][0], r[1][1], r[1][2], r[1][3]); }
                swap16(wx[0], wx[1]); swap16(wy[0], wy[1]);
                unsigned char* rowp = O + (size_t)(row0 + ai * HALF + (2 * mp + (fq & 1)) * 16) * DEXP + (cg - 8 * (fq & 1));
                *(u32x4*)rowp = (u32x4){wx[0], wy[0], wx[1], wy[1]}; }
    }
};
struct EpiGate {
    static constexpr bool PERM = true; static constexpr bool WIDE16 = true;
    unsigned char* O; const float* b2l;
    struct Pre { const LAS float* b; };
    static constexpr bool HAS_BIAS = true; static constexpr bool HALFN = false;
    __device__ __forceinline__ float bias_of(const Unit& u, int i) const { return b2l[(size_t)u.aux * 1024 + u.pn * BM + i]; }
    __device__ __forceinline__ void operator()(const f32x4 (&acc)[2][2][4][2], const Unit& u, int wr, int wc, int fr, int fq, const Pre& pre) const {
        const int row0 = u.pm * BM + wr * 64 + fr, col0 = u.pn * BM + wc * 64 + 16 * fq;
        f32x4 bv[2][2];
#pragma unroll
        for (int bj = 0; bj < 2; ++bj)
#pragma unroll
            for (int n = 0; n < 2; ++n) bv[bj][n] = *(const LAS f32x4*)(pre.b + wc * 64 + 16 * fq + 8 * bj + 4 * n) * YS_SCALE;
#pragma unroll
        for (int ai = 0; ai < 2; ++ai)
#pragma unroll
            for (int m = 0; m < 4; ++m) { unsigned char* rowp = O + (size_t)(col0 >> 6) * ((size_t)MAXSLOT * 64) + (size_t)(row0 + ai * HALF + m * 16) * 64 + (col0 & 63);
                u32x4 w;
                { const f32x4 v = acc[ai][0][m][0] * (YS_SCALE / W8_SCALE) + bv[0][0]; w.x = cvt4_fp8(v[0], v[1], v[2], v[3]); }
                { const f32x4 v = acc[ai][0][m][1] * (YS_SCALE / W8_SCALE) + bv[0][1]; w.y = cvt4_fp8(v[0], v[1], v[2], v[3]); }
                { const f32x4 v = acc[ai][1][m][0] * (YS_SCALE / W8_SCALE) + bv[1][0]; w.z = cvt4_fp8(v[0], v[1], v[2], v[3]); }
                { const f32x4 v = acc[ai][1][m][1] * (YS_SCALE / W8_SCALE) + bv[1][1]; w.w = cvt4_fp8(v[0], v[1], v[2], v[3]); }
                *(u32x4*)rowp = w; }
    }
};

template <class Epi, class Sched, bool FP8 = false, bool GATHER = false>
__device__ __forceinline__ void gemm_phase(LAS unsigned char* lds, const int K, const size_t lda2, const size_t ldb2, const Sched& S, const Epi& E) {
    const int tid = opaque_tid(), wid = __builtin_amdgcn_readfirstlane(tid >> 6), lane = tid & 63, wr = wid >> 2, wc = wid & 3, fr = lane & 15, fq = lane >> 4;
    int nt = K / BK; asm volatile("" : "+s"(nt));
    unsigned voffA[2], voffB[2];
#pragma unroll
    for (int i = 0; i < 2; ++i) { int R, C; stage_rc(tid * 16 + i * 8192, R, C); int Rb = Epi::PERM ? ((R & ~31) + perm32(R & 31)) : R;
        if constexpr (Epi::WIDE16) Rb = (Rb >> 5) * 64 + ((Rb >> 3) & 3) * 16 + (Rb & 7);
        voffA[i] = (unsigned)(R * (unsigned)lda2 + C * 2u); voffB[i] = (unsigned)(Rb * (unsigned)ldb2 + C * 2u); }
    const unsigned kstep = (unsigned)(BK * 2);
    const unsigned hstepA = (unsigned)(HALF * lda2), hstepB = (unsigned)((Epi::WIDE16 ? 8 : HALF) * ldb2);
    const unsigned ldsw = (unsigned)wid * 1024u;
    const int aoff = lds_byte(wr * 64 + fr, fq * 8), boff = lds_byte(wc * 32 + fr, fq * 8);
    const __amdgpu_buffer_rsrc_t rsA = __builtin_amdgcn_make_buffer_rsrc((void*)S.baseA(), 0, 0x7fffffff, 0x00020000);
    const __amdgpu_buffer_rsrc_t rsB = __builtin_amdgcn_make_buffer_rsrc((void*)S.baseB(), 0, 0x7fffffff, 0x00020000);
#define PG8_SA(b, h) (((b) * 2 + (h)) * HTB)
#define PG8_SB(b, h) ((4 + (b) * 2 + (h)) * HTB)
#define PG8_STAGE(bufoff, rs, soff, voff) do { _Pragma("unroll") for (int _i = 0; _i < 2; ++_i) \
        __builtin_amdgcn_raw_ptr_buffer_load_lds(rs, (LAS unsigned*)(lds + (bufoff) + ldsw + _i * 8192), 16, (voff)[_i], (soff), 0, 0); } while (0)
#define PG8_STAGEA(b, h, aoffs, koff, nx) do { if constexpr (GATHER) { _Pragma("unroll") for (int _i = 0; _i < 2; ++_i) \
            __builtin_amdgcn_raw_ptr_buffer_load_lds(rsA, (LAS unsigned*)(lds + PG8_SA(b, h) + ldsw + _i * 8192), 16, (nx) ? ngvo[h][_i] : gvo[h][_i], (koff), 0, 0); } \
        else PG8_STAGE(PG8_SA(b, h), rsA, (aoffs) + (h) * hstepA, voffA); } while (0)
#define PG8_RD8(off) __builtin_shufflevector(*(const LAS v4i_t*)(lds + (off)), *(const LAS v4i_t*)(lds + (off) + 1024), 0, 1, 2, 3, 4, 5, 6, 7)
#define PG8_LDA(dst, b, h) do { if constexpr (FP8) { _Pragma("unroll") for (int m = 0; m < 4; ++m) dst##8[m] = PG8_RD8(PG8_SA(b, h) + aoff + m * 2048); } \
        else { _Pragma("unroll") for (int m = 0; m < 4; ++m) _Pragma("unroll") for (int k = 0; k < 2; ++k) dst[m][k] = *(const LAS bf16x8*)(lds + PG8_SA(b, h) + aoff + m * 2048 + k * 1024); } } while (0)
#define PG8_LDB(dst, b, h) do { if constexpr (FP8) { _Pragma("unroll") for (int n = 0; n < 2; ++n) dst##8[n] = PG8_RD8(PG8_SB(b, h) + boff + n * 2048); } \
        else { _Pragma("unroll") for (int n = 0; n < 2; ++n) _Pragma("unroll") for (int k = 0; k < 2; ++k) dst[n][k] = *(const LAS bf16x8*)(lds + PG8_SB(b, h) + boff + n * 2048 + k * 1024); } } while (0)
#define PG8_MMA(ai, bj, At, Bt, Z) do { __builtin_amdgcn_s_setprio(1); \
        if (Z) { _Pragma("unroll") for (int m = 0; m < 4; ++m) _Pragma("unroll") for (int n = 0; n < 2; ++n) { \
            if constexpr (FP8) asm volatile("s_nop 1\n\tv_mfma_scale_f32_16x16x128_f8f6f4 %0, %1, %2, 0, %3, %3 op_sel_hi:[0,0,0]" : "=&v"(acc[ai][bj][m][n]) : "v"(Bt##8[n]), "v"(At##8[m]), "v"(sc1)); \
            else { acc[ai][bj][m][n] = __builtin_amdgcn_mfma_f32_16x16x32_bf16(Bt[n][0], At[m][0], (f32x4){0.f, 0.f, 0.f, 0.f}, 0, 0, 0); \
                   acc[ai][bj][m][n] = __builtin_amdgcn_mfma_f32_16x16x32_bf16(Bt[n][1], At[m][1], acc[ai][bj][m][n], 0, 0, 0); } } } \
        else { _Pragma("unroll") for (int m = 0; m < 4; ++m) _Pragma("unroll") for (int n = 0; n < 2; ++n) { \
            if constexpr (FP8) asm volatile("s_nop 1\n\tv_mfma_scale_f32_16x16x128_f8f6f4 %0, %1, %2, %0, %3, %3 op_sel_hi:[0,0,0]" : "+v"(acc[ai][bj][m][n]) : "v"(Bt##8[n]), "v"(At##8[m]), "v"(sc1)); \
            else { _Pragma("unroll") for (int k = 0; k < 2; ++k) acc[ai][bj][m][n] = __builtin_amdgcn_mfma_f32_16x16x32_bf16(Bt[n][k], At[m][k], acc[ai][bj][m][n], 0, 0, 0); } } } \
        __builtin_amdgcn_s_setprio(0); } while (0)
#define PG8_WAIT_V(n) asm volatile("s_waitcnt vmcnt(" #n ")" ::: "memory")
#define PG8_WAIT_L(n) asm volatile("s_waitcnt lgkmcnt(" #n ")" ::: "memory")
#define PG8_BAR __builtin_amdgcn_s_barrier()
#define PG8_SCHED __builtin_amdgcn_sched_barrier(0)
    Unit cur, nxt; int ui = 0; typename Epi::Pre pre;
    if (!S.next(0, cur)) return;
    f32x4 acc[2][2][4][2];
#pragma unroll
    for (int a = 0; a < 2; ++a)
#pragma unroll
        for (int b = 0; b < 2; ++b)
#pragma unroll
            for (int m = 0; m < 4; ++m)
#pragma unroll
                for (int n = 0; n < 2; ++n) acc[a][b][m][n] = (f32x4){0.f, 0.f, 0.f, 0.f};
    bf16x8 At[4][2], B0[2][2], B1[2][2];
    v8i_t At8[4], B08[2], B18[2];
    int sc1 = 0x7f7f7f7f; asm volatile("" : "+v"(sc1));
    unsigned cA = cur.a, cB = cur.b;
    unsigned gvo[2][2] = {{0u, 0u}, {0u, 0u}}, ngvo[2][2] = {{0u, 0u}, {0u, 0u}};
    int gR[2], gC[2];
#pragma unroll
    for (int i = 0; i < 2; ++i) stage_rc(tid * 16 + i * 8192, gR[i], gC[i]);
#define PG8_GLOAD(dst, pm_) do { if constexpr (GATHER) { const int* tb_ = S.gather() + (pm_) * BM; \
        _Pragma("unroll") for (int h_ = 0; h_ < 2; ++h_) _Pragma("unroll") for (int i_ = 0; i_ < 2; ++i_) dst[h_][i_] = (unsigned)tb_[h_ * HALF + gR[i_]] * (unsigned)lda2 + (unsigned)gC[i_] * 2u; } } while (0)
    PG8_GLOAD(gvo, cur.pm);
#define PG8_STAGEB1(b, boffs) do { if constexpr (!Epi::HALFN) PG8_STAGE(PG8_SB(b, 1), rsB, (boffs) + hstepB, voffB); } while (0)
#define PG8_WAIT_VS() do { if constexpr (Epi::HALFN) PG8_WAIT_V(6); else PG8_WAIT_V(8); } while (0)
    PG8_STAGE(PG8_SB(0, 0), rsB, cB, voffB); PG8_STAGEB1(0, cB); PG8_STAGEA(0, 0, cA, 0u, false); PG8_STAGEA(0, 1, cA, 0u, false);
    if (wr == 1) PG8_BAR;
    PG8_WAIT_V(2); PG8_BAR;
    PG8_STAGE(PG8_SB(1, 0), rsB, cB + kstep, voffB); PG8_STAGEA(1, 0, cA + kstep, kstep, false); PG8_STAGEB1(1, cB + kstep);
    if constexpr (Epi::HALFN) PG8_WAIT_V(4); else PG8_WAIT_V(6);
    PG8_BAR;
    for (;;) {
        const bool has_next = S.next(ui + 1, nxt);
        const unsigned nA = has_next ? nxt.a : cA, nB = has_next ? nxt.b : cB;
        LAS int* gl = (LAS int*)(lds + LDSCTL_OFF + 8192) + (ui & 1) * 256;
        for (int t = 0; t < nt; t += 2) {
            const bool last = (t == nt - 2), z0 = (t == 0);
            const bool livew = !Epi::HALFN || wc == 0;
            int gstage = 0;
            if constexpr (GATHER) {
                if (t == 0 && has_next) { int tz = threadIdx.x; asm volatile("" : "+v"(tz)); gstage = S.gather()[nxt.pm * BM + (tz & 255)]; }
                if (last) { if (has_next) { _Pragma("unroll") for (int h_ = 0; h_ < 2; ++h_) _Pragma("unroll") for (int i_ = 0; i_ < 2; ++i_) ngvo[h_][i_] = (unsigned)gl[h_ * HALF + gR[i_]] * (unsigned)lda2 + (unsigned)gC[i_] * 2u; }
                            else { _Pragma("unroll") for (int h_ = 0; h_ < 2; ++h_) _Pragma("unroll") for (int i_ = 0; i_ < 2; ++i_) ngvo[h_][i_] = gvo[h_][i_]; } } }
            float bstage = 0.f;
            if constexpr (Epi::HAS_BIAS) { if (last) { int tz = threadIdx.x; asm volatile("" : "+v"(tz)); bstage = E.bias_of(cur, tz & 255); } }
            const unsigned a1 = cA + (unsigned)(t + 1) * kstep, k1 = (unsigned)(t + 1) * kstep;
            const unsigned a2 = last ? nA : cA + (unsigned)(t + 2) * kstep, b2 = last ? nB : cB + (unsigned)(t + 2) * kstep, k2 = last ? 0u : (unsigned)(t + 2) * kstep;
            const unsigned a3 = a2 + kstep, b3 = b2 + kstep, k3 = k2 + kstep;
            if (livew) { PG8_LDB(B0, 0, 0); if constexpr (!Epi::HALFN) PG8_LDB(B1, 0, 1); PG8_SCHED; PG8_LDA(At, 0, 0); } PG8_STAGEA(1, 1, a1, k1, false);
            PG8_WAIT_VS(); PG8_WAIT_L(0); PG8_BAR; if (livew) PG8_MMA(0, 0, At, B0, z0); if constexpr (!Epi::HALFN) PG8_MMA(0, 1, At, B1, z0); PG8_BAR; PG8_SCHED;
            if (livew) PG8_LDA(At, 0, 1); PG8_STAGE(PG8_SB(0, 0), rsB, b2, voffB); PG8_STAGEB1(0, b2); PG8_STAGEA(0, 0, a2, k2, last);
            PG8_WAIT_VS(); PG8_WAIT_L(0); PG8_BAR; if (livew) PG8_MMA(1, 0, At, B0, z0); if constexpr (!Epi::HALFN) PG8_MMA(1, 1, At, B1, z0); PG8_BAR; PG8_SCHED;
            if constexpr (Epi::HAS_BIAS) { if (last) { int tz = threadIdx.x; asm volatile("" : "+v"(tz)); if (tz < 256) ((LAS float*)(lds + LDSCTL_OFF + 2048 + (ui & 1) * 1024))[tz] = bstage; } }
            if (livew) { PG8_LDB(B0, 1, 0); if constexpr (!Epi::HALFN) PG8_LDB(B1, 1, 1); PG8_SCHED; PG8_LDA(At, 1, 0); } PG8_STAGEA(0, 1, a2, k2, last);
            PG8_WAIT_VS(); PG8_WAIT_L(0); PG8_BAR; if (livew) PG8_MMA(0, 0, At, B0, false); if constexpr (!Epi::HALFN) PG8_MMA(0, 1, At, B1, false); PG8_BAR; PG8_SCHED;
            if (livew) PG8_LDA(At, 1, 1); PG8_STAGE(PG8_SB(1, 0), rsB, b3, voffB); PG8_STAGEB1(1, b3); PG8_STAGEA(1, 0, a3, k3, last);
            PG8_WAIT_VS(); PG8_WAIT_L(0); PG8_BAR; if (livew) PG8_MMA(1, 0, At, B0, false); if constexpr (!Epi::HALFN) PG8_MMA(1, 1, At, B1, false); PG8_BAR; PG8_SCHED;
            if constexpr (GATHER) { if (t == 0 && has_next) { int tz = threadIdx.x; asm volatile("" : "+v"(tz)); if (tz < 256) gl[tz] = gstage; } }
        }
        if constexpr (FP8) asm volatile("s_nop 15\n\ts_nop 7" ::: "memory");
        if (wr == 0) PG8_BAR;
        { int tz = threadIdx.x; asm volatile("" : "+v"(tz)); const int ln = tz & 63;
          if constexpr (Epi::HAS_BIAS) pre.b = (const LAS float*)(lds + LDSCTL_OFF + 2048 + (ui & 1) * 1024);
          E(acc, cur, wr, wc, ln & 15, ln >> 4, pre); }
        if (!has_next) break;
        cur = nxt; cA = nA; cB = nB; ++ui;
        if constexpr (GATHER) { _Pragma("unroll") for (int h_ = 0; h_ < 2; ++h_) _Pragma("unroll") for (int i_ = 0; i_ < 2; ++i_) gvo[h_][i_] = ngvo[h_][i_]; }
        if (wr == 1) PG8_BAR;
    }
    PG8_WAIT_V(0);
    PG8_BAR;
#undef PG8_SA
#undef PG8_SB
#undef PG8_STAGE
#undef PG8_STAGEA
#undef PG8_GLOAD
#undef PG8_LDA
#undef PG8_LDB
#undef PG8_MMA
#undef PG8_RD8
#undef PG8_WAIT_V
#undef PG8_WAIT_L
#undef PG8_BAR
#undef PG8_SCHED
}
}

__device__ __forceinline__ u32x4 rope_chunk(u32x4 xw, u32x4 yw, const f32x2* tab, bool first) {
    u32x4 o;
#pragma unroll
    for (int i = 0; i < 4; ++i) {
        const f32x2 cs0 = tab[2 * i], cs1 = tab[2 * i + 1];
        const float x0 = bflo(xw[i]), x1 = bfhi(xw[i]), y0 = bflo(yw[i]), y1 = bfhi(yw[i]);
        const float r0 = first ? x0 * cs0.x - y0 * cs0.y : x0 * cs0.x + y0 * cs0.y;
        const float r1 = first ? x1 * cs1.x - y1 * cs1.y : x1 * cs1.x + y1 * cs1.y;
        o[i] = pk2(r0, r1);
    }
    return o;
}

namespace att {
constexpr int KCS = 1040;
constexpr int KSLOT = 12544, VSLOT = 8192;
constexpr int OFF_K = 0, OFF_V = 4 * KSLOT, OFF_WSF = OFF_V + 4 * VSLOT, OFF_OST = OFF_WSF + 2048, OFF_BIAS = OFF_OST + 32768, ATT_LDS = OFF_BIAS + 2048;
static_assert(ATT_LDS <= ARENA_BYTES, "attention LDS map");
__device__ __forceinline__ int crow(int r, int hi) { return (r & 3) + 8 * (r >> 2) + 4 * hi; }
__device__ __forceinline__ unsigned cvtpk(float lo, float hi) { typedef __bf16 bf16x2_t __attribute__((ext_vector_type(2))); f32x2 v = {lo, hi}; bf16x2_t b = __builtin_convertvector(v, bf16x2_t); return __builtin_bit_cast(unsigned, b); }
__device__ __forceinline__ s16x4 vtr(const LAS unsigned char* p) { return __builtin_bit_cast(s16x4, __builtin_amdgcn_ds_read_tr16_b64_v4i16((LAS s16x4*)p)); }
constexpr float NEGBIG = -1e30f;
__device__ __forceinline__ void pair32(float x, float& a, float& b) {
    unsigned u = __builtin_bit_cast(unsigned, x), v = u;
    asm volatile("s_nop 1\n\tv_permlane32_swap_b32 %0, %1\n\ts_nop 1" : "+v"(u), "+v"(v));
    a = __builtin_bit_cast(float, u); b = __builtin_bit_cast(float, v);
}

__device__ __forceinline__ unsigned xlane32(unsigned x, bool lo) {
    unsigned u = x, v = x;
    asm volatile("s_nop 1\n\tv_permlane32_swap_b32 %0, %1\n\ts_nop 1" : "+v"(u), "+v"(v));
    return lo ? v : u;
}
struct UMla {
    static constexpr int NKC = 12; static constexpr bool PLAIN = true; static constexpr bool SIDED = false;
    const bf16_t* QB; const bf16_t* KVB; const bf16_t* PB; bf16_t* AO; const f32x2* R32; int b, h, qblk; bool ctxq;
    template <int NKS> __device__ __forceinline__ void qfix(bf16x8 (&qr)[NKS], int wid, int r32, int hi) const {
        if (ctxq) return;
        const int t = 256 * qblk + 32 * wid + r32, prow = t >> 6, pcol = t & 63;
#pragma unroll
        for (int f = 0; f < 2; ++f) { const u32x4 own = __builtin_bit_cast(u32x4, qr[4 + f]); u32x4 oth;
            oth.x = xlane32(own.x, hi == 0); oth.y = xlane32(own.y, hi == 0); oth.z = xlane32(own.z, hi == 0); oth.w = xlane32(own.w, hi == 0);
            qr[4 + f] = __builtin_bit_cast(bf16x8, rope_chunk(own, oth, R32 + (f == 0 ? prow : pcol) * 8, hi == 0)); }
    }
    __device__ __forceinline__ float c2() const { return 0.10206207261596577f * LOG2E; }
    __device__ __forceinline__ int ntiles() const { return ctxq ? 4 : 132; }
    __device__ __forceinline__ bool active(int, int) const { return true; }
    __device__ __forceinline__ size_t krow(int t, int key) const { return ctxq ? (size_t)(TL + b * CTXL + 64 * t + key) : (t < 128 ? (size_t)(b * SEQ + 64 * t + key) : (size_t)(TL + b * CTXL + 64 * (t - 128) + key)); }
    __device__ __forceinline__ unsigned kofs() const { return (unsigned)WS_KVB + 256u * h; }  __device__ __forceinline__ unsigned kpitch() const { return 2048u; }
    __device__ __forceinline__ unsigned k2ofs() const { return (unsigned)WS_PB + 3584u; }     __device__ __forceinline__ unsigned k2pitch() const { return 2u * EV_LD; }
    __device__ __forceinline__ unsigned vofs() const { return (unsigned)WS_KVB + 256u * h + 128u; } __device__ __forceinline__ unsigned vpitch() const { return 2048u; }
    __device__ __forceinline__ unsigned trow(int t) const { return (unsigned)krow(t, 0); }
    __device__ __forceinline__ size_t qrow(int wid, int r) const { return ctxq ? (size_t)(TL + b * CTXL + 32 * wid + r) : (size_t)(b * SEQ + 256 * qblk + 32 * wid + r); }
    __device__ __forceinline__ const bf16_t* qptr(int wid, int r) const { return QB + qrow(wid, r) * 768 + 96 * h; }
    __device__ __forceinline__ unsigned char* optr(int wid, int r) const { return (unsigned char*)AO + qrow(wid, r) * 1024 + 512 + 64 * h; }
    __device__ __forceinline__ float m0(int) const { return NEGBIG; }
    __device__ __forceinline__ float l0() const { return 0.f; }
    __device__ __forceinline__ void prep(LAS unsigned char*) const {}
    __device__ __forceinline__ float adjust(int, int, int, int, float s, const LAS unsigned char*) const { return s; }
};
struct UWin {
    static constexpr int NKC = 8; static constexpr bool PLAIN = false; static constexpr bool SIDED = false;
    const bf16_t* PB; bf16_t* AO; const float* sink; int b, kvh, j; bool ctxq; int tlo, nlat;
    template <int NKS> __device__ __forceinline__ void qfix(bf16x8 (&)[NKS], int, int, int) const {}
    __device__ __forceinline__ void init() { tlo = j - 2 < 0 ? 0 : j - 2; const int thi = j + 2 > 127 ? 127 : j + 2; nlat = ctxq ? 0 : thi - tlo + 1; }
    __device__ __forceinline__ float c2() const { return 0.125f * LOG2E; }
    __device__ __forceinline__ int ntiles() const { return nlat + 4; }
    __device__ __forceinline__ bool active(int, int) const { return true; }
    __device__ __forceinline__ size_t krow(int t, int key) const { return t < nlat ? (size_t)(b * SEQ + 64 * (tlo + t) + key) : (size_t)(TL + b * CTXL + 64 * (t - nlat) + key); }
    __device__ __forceinline__ unsigned kofs() const { return (unsigned)WS_PB + 2u * (512 + 64 * kvh); }  __device__ __forceinline__ unsigned kpitch() const { return 2u * EV_LD; }
    __device__ __forceinline__ unsigned k2ofs() const { return 0u; }  __device__ __forceinline__ unsigned k2pitch() const { return 0u; }
    __device__ __forceinline__ unsigned vofs() const { return (unsigned)WS_PB + 2u * (640 + 64 * kvh); }  __device__ __forceinline__ unsigned vpitch() const { return 2u * EV_LD; }
    __device__ __forceinline__ unsigned trow(int t) const { return (unsigned)krow(t, 0); }
    __device__ __forceinline__ int qpos(int wid, int r) const { return 64 * j + 32 * (wid >> 2) + r; }
    __device__ __forceinline__ size_t qrow(int wid, int r) const { return ctxq ? (size_t)(TL + b * CTXL + qpos(wid, r)) : (size_t)(b * SEQ + qpos(wid, r)); }
    __device__ __forceinline__ const bf16_t* qptr(int wid, int r) const { return PB + qrow(wid, r) * EV_LD + 64 * (4 * kvh + (wid & 3)); }
    __device__ __forceinline__ unsigned char* optr(int wid, int r) const { return (unsigned char*)AO + qrow(wid, r) * 1024 + 64 * (4 * kvh + (wid & 3)); }
    __device__ __forceinline__ float m0(int wid) const { return sink[4 * kvh + (wid & 3)] * LOG2E; }
    __device__ __forceinline__ float l0() const { return 1.f; }
    __device__ __forceinline__ void prep(LAS unsigned char*) const {}
    __device__ __forceinline__ void adjust_tile(f32x16& P0, f32x16& P1, int t, int wid, int r32, int hi, float c2, const LAS unsigned char*, int) const {
        const int tt = tlo + t;
        if (t >= nlat || (tt > j - 2 && tt < j + 2)) {
#pragma unroll
            for (int r = 0; r < 16; ++r) { P0[r] *= c2; P1[r] *= c2; }
        } else { const int dq = qpos(wid, r32) - 64 * (tlo + t) - 4 * hi + 128;
#pragma unroll
            for (int r = 0; r < 16; ++r) { const int k0 = (r & 3) + 8 * (r >> 2);
                P0[r] = ((unsigned)(dq - k0) <= 256u) ? P0[r] * c2 : NEGBIG; P1[r] = ((unsigned)(dq - k0 - 32) <= 256u) ? P1[r] * c2 : NEGBIG; } }
    }
};
struct UNa {
    static constexpr int NKC = 8; static constexpr bool PLAIN = false; static constexpr bool SIDED = true;
    const bf16_t* PB; bf16_t* AO; const float* rpbh; int b, h, G; bool ctxq; int rlo, nlat;
    template <int NKS> __device__ __forceinline__ void qfix(bf16x8 (&)[NKS], int, int, int) const {}
    __device__ __forceinline__ void init() { int lo = 4 * G - 4; lo = lo < 0 ? 0 : (lo > 120 ? 120 : lo); int hi = 4 * G - 1; hi = hi < 0 ? 0 : (hi > 120 ? 120 : hi); rlo = lo; nlat = ctxq ? 0 : hi + 8 - lo; }
    __device__ __forceinline__ float c2() const { return 0.125f * LOG2E; }
    __device__ __forceinline__ int ntiles() const { return nlat + 4; }
    __device__ __forceinline__ int qgrow(int wid) const { return 4 * G + (wid >> 1); }
    __device__ __forceinline__ int r0w(int wid) const { int r0 = qgrow(wid) - 4; return r0 < 0 ? 0 : (r0 > 120 ? 120 : r0); }
    __device__ __forceinline__ bool active(int t, int wid) const { if (t >= nlat) return true; const int kr = rlo + t, r0 = r0w(wid); return kr >= r0 && kr < r0 + 8; }
    __device__ __forceinline__ size_t krow(int t, int key) const { return t < nlat ? (size_t)(b * SEQ + 64 * (rlo + t) + key) : (size_t)(TL + b * CTXL + 64 * (t - nlat) + key); }
    __device__ __forceinline__ unsigned kofs() const { return (unsigned)WS_PB + 2u * (1024 + 64 * h); }  __device__ __forceinline__ unsigned kpitch() const { return 2u * OD_LD; }
    __device__ __forceinline__ unsigned k2ofs() const { return 0u; }  __device__ __forceinline__ unsigned k2pitch() const { return 0u; }
    __device__ __forceinline__ unsigned vofs() const { return (unsigned)WS_PB + 2u * (2048 + 64 * h); }  __device__ __forceinline__ unsigned vpitch() const { return 2u * OD_LD; }
    __device__ __forceinline__ unsigned trow(int t) const { return (unsigned)krow(t, 0); }
    __device__ __forceinline__ size_t qrow(int wid, int r) const { return ctxq ? (size_t)(TL + b * CTXL + 32 * wid + r) : (size_t)(b * SEQ + 64 * qgrow(wid) + 32 * (wid & 1) + r); }
    __device__ __forceinline__ const bf16_t* qptr(int wid, int r) const { return PB + qrow(wid, r) * OD_LD + 64 * h; }
    __device__ __forceinline__ unsigned char* optr(int wid, int r) const { return (unsigned char*)AO + qrow(wid, r) * 1024 + 64 * h; }
    __device__ __forceinline__ float m0(int) const { return NEGBIG; }
    __device__ __forceinline__ float l0() const { return 0.f; }
    __device__ __forceinline__ void prep(LAS unsigned char* L) const {
        if (!ctxq) { LAS float* bt = (LAS float*)(L + OFF_BIAS); for (int i = opaque_tid(); i < 15 * 31; i += 512) bt[i] = rpbh[i] * LOG2E; }
    }
    __device__ __forceinline__ void adjust_tile(f32x16& P0, f32x16& P1, int t, int wid, int r32, int hi, float c2, const LAS unsigned char* L, int side) const {
        if (t >= nlat) {
#pragma unroll
            for (int r = 0; r < 16; ++r) { P0[r] *= c2; P1[r] *= c2; }
        } else { const int qc = 32 * (wid & 1) + r32; int c0 = qc - 8; c0 = c0 < 0 ? 0 : (c0 > 48 ? 48 : c0);
            const LAS float* bp = (const LAS float*)(L + OFF_BIAS) + (rlo + t - qgrow(wid) + 7) * 31 + (15 - qc + 4 * hi);
            const int kb = 4 * hi - c0;
#pragma unroll
            for (int r = 0; r < 16; ++r) { const int k0 = (r & 3) + 8 * (r >> 2);
                if (!(side == 2 && r < 12)) { const float b0 = bp[k0]; P0[r] = ((unsigned)(kb + k0) < 16u) ? P0[r] * c2 + b0 : NEGBIG; }
                if (!(side == 1 && r >= 4)) { const float b1 = bp[k0 + 32]; P1[r] = ((unsigned)(kb + k0 + 32) < 16u) ? P1[r] * c2 + b1 : NEGBIG; } } }
    }
};

__device__ __forceinline__ float fma_s(float a, float b, float c) { float r; asm("v_fma_f32 %0, %1, %2, %3" : "=v"(r) : "v"(a), "v"(b), "v"(c)); return r; }
__device__ __forceinline__ float max3f(float a, float b, float c) { float r; asm("v_max3_f32 %0, %1, %2, %3" : "=v"(r) : "v"(a), "v"(b), "v"(c)); return r; }
template <class U>
__device__ __forceinline__ void attn_unit(LAS unsigned char* L, unsigned char* wsbase, const U& u) {
    constexpr int NKC = U::NKC, NKS = NKC / 2;
    const int tid = opaque_tid(), lane = tid & 63, r32 = lane & 31, hi = lane >> 5; const int wid = __builtin_amdgcn_readfirstlane(tid >> 6);
    bf16x8 qr[NKS];
    float m = u.m0(wid), l = hi == 0 ? u.l0() : 0.f;
    f32x16 o[2];
#pragma unroll
    for (int r = 0; r < 16; ++r) { o[0][r] = 0.f; o[1][r] = 0.f; }
    const float c2 = u.c2();
    const int NT = u.ntiles();
    LAS float* wsf = (LAS float*)(L + OFF_WSF) + wid * 64;
    const LAS unsigned char* kbase = L + OFF_K + hi * KCS + r32 * 16;
    const LAS unsigned char* vbase = L + OFF_V + ((lane >> 4) & 1) * 32 + (lane & 3) * 8 + (4 * hi + ((lane & 15) >> 2)) * 64;
    const __amdgpu_buffer_rsrc_t rs = __builtin_amdgcn_make_buffer_rsrc((void*)wsbase, 0, 0x7fffffff, 0x00020000);
    const unsigned kvo = (unsigned)lane * u.kpitch(), kvo2 = (unsigned)lane * u.k2pitch(), vvo = (unsigned)(lane >> 2) * u.vpitch() + (unsigned)(lane & 3) * 16u;
    const unsigned kso = u.kofs() + 16u * wid, kso2 = u.k2ofs() + 16u * wid, vso = u.vofs() + 16u * (wid & 3) * u.vpitch() + 64u * (wid >> 2);
    const bool two = (NKC == 12) && (wid < 4);
#define ATT_DMAK(t) do { const int tc_ = (t) < NT ? (t) : NT - 1; const unsigned r0_ = u.trow(tc_); LAS unsigned char* kd_ = L + OFF_K + ((t) & 3) * KSLOT; \
        __builtin_amdgcn_raw_ptr_buffer_load_lds(rs, (LAS unsigned*)(kd_ + wid * KCS), 16, kvo, kso + r0_ * u.kpitch(), 0, 0); \
        if (two) __builtin_amdgcn_raw_ptr_buffer_load_lds(rs, (LAS unsigned*)(kd_ + (8 + wid) * KCS), 16, kvo2, kso2 + r0_ * u.k2pitch(), 0, 0); } while (0)
#define ATT_DMAV(t) do { const int tc_ = (t) < NT ? (t) : NT - 1; const unsigned r0_ = u.trow(tc_); \
        __builtin_amdgcn_raw_ptr_buffer_load_lds(rs, (LAS unsigned*)(L + OFF_V + ((t) & 3) * VSLOT + wid * 1024), 16, vvo, vso + r0_ * u.vpitch(), 0, 0); } while (0)
#define ATT_WAIT_BAR() do { if (two) asm volatile("s_waitcnt vmcnt(6)" ::: "memory"); else asm volatile("s_waitcnt vmcnt(4)" ::: "memory"); \
        __builtin_amdgcn_s_barrier(); asm volatile("" ::: "memory"); } while (0)
#define ATT_QKT(S0, S1, t) do { const LAS unsigned char* kb_ = kbase + ((t) & 3) * KSLOT; \
        _Pragma("unroll") for (int r = 0; r < 16; ++r) { S0[r] = 0.f; S1[r] = 0.f; } \
        _Pragma("unroll") for (int kh_ = 0; kh_ < 2; ++kh_) { bf16x8 kf0[NKS / 2], kf1[NKS / 2]; \
            _Pragma("unroll") for (int ks = 0; ks < NKS / 2; ++ks) { kf0[ks] = *(const LAS bf16x8*)(kb_ + (kh_ * (NKS / 2) + ks) * (2 * KCS)); kf1[ks] = *(const LAS bf16x8*)(kb_ + (kh_ * (NKS / 2) + ks) * (2 * KCS) + 512); } \
            _Pragma("unroll") for (int ks = 0; ks < NKS / 2; ++ks) { S0 = __builtin_amdgcn_mfma_f32_32x32x16_bf16(kf0[ks], qr[kh_ * (NKS / 2) + ks], S0, 0, 0, 0); S1 = __builtin_amdgcn_mfma_f32_32x32x16_bf16(kf1[ks], qr[kh_ * (NKS / 2) + ks], S1, 0, 0, 0); } } } while (0)
#define ATT_LIVE0(r, SIDE) (!((SIDE) == 2 && (r) < 12))
#define ATT_LIVE1(r, SIDE) (!((SIDE) == 1 && (r) >= 4))
#define ATT_SOFTMAX(P0, P1, T, SIDE) do { float rm; \
        if constexpr (U::PLAIN) { float a_ = max3f(P0[0], P1[0], P0[1]), b_ = max3f(P1[1], P0[2], P1[2]); \
            _Pragma("unroll") for (int r = 3; r < 15; r += 2) { a_ = max3f(a_, P0[r], P1[r]); b_ = max3f(b_, P0[r + 1], P1[r + 1]); } \
            rm = max3f(a_, b_, fmaxf(P0[15], P1[15])) * c2; } \
        else { u.adjust_tile(P0, P1, (T), wid, r32, hi, c2, L, (SIDE)); \
            if ((SIDE) == 0) { float a_ = max3f(P0[0], P1[0], P0[1]), b_ = max3f(P1[1], P0[2], P1[2]); \
                _Pragma("unroll") for (int r = 3; r < 15; r += 2) { a_ = max3f(a_, P0[r], P1[r]); b_ = max3f(b_, P0[r + 1], P1[r + 1]); } \
                rm = max3f(a_, b_, fmaxf(P0[15], P1[15])); } \
            else { float a_ = NEGBIG, b_ = NEGBIG; \
                _Pragma("unroll") for (int r = 0; r < 16; ++r) { if (ATT_LIVE0(r, SIDE)) a_ = fmaxf(a_, P0[r]); if (ATT_LIVE1(r, SIDE)) b_ = fmaxf(b_, P1[r]); } \
                rm = fmaxf(a_, b_); } } \
        { float ra, rb; pair32(rm, ra, rb); rm = fmaxf(ra, rb); } \
        const float mn = fmaxf(m, rm); alpha = __builtin_amdgcn_exp2f(m - mn); resc = __any(mn > m); m = mn; \
        float lsa = 0.f; const float nmn = -mn;       \
        if constexpr (U::PLAIN) { _Pragma("unroll") for (int r = 0; r < 16; ++r) { P0[r] = __builtin_amdgcn_exp2f(fma_s(P0[r], c2, nmn)); P1[r] = __builtin_amdgcn_exp2f(fma_s(P1[r], c2, nmn)); lsa += P0[r]; lsa += P1[r]; } } \
        else { _Pragma("unroll") for (int r = 0; r < 16; ++r) { \
                if (ATT_LIVE0(r, SIDE)) { P0[r] = __builtin_amdgcn_exp2f(P0[r] - mn); lsa += P0[r]; } else P0[r] = 0.f; \
                if (ATT_LIVE1(r, SIDE)) { P1[r] = __builtin_amdgcn_exp2f(P1[r] - mn); lsa += P1[r]; } else P1[r] = 0.f; } } \
        l = l * alpha + lsa; \
        _Pragma("unroll") for (int i = 0; i < 4; ++i) { if ((SIDE) != 2) pw[0][i] = cvtpk(P0[2 * i], P0[2 * i + 1]); pw[1][i] = cvtpk(P0[8 + 2 * i], P0[9 + 2 * i]); pw[2][i] = cvtpk(P1[2 * i], P1[2 * i + 1]); if ((SIDE) != 1) pw[3][i] = cvtpk(P1[8 + 2 * i], P1[9 + 2 * i]); } } while (0)
#define ATT_STEP(SC0, SC1, SN0, SN1, T, SIDE) do { const int t_ = (T); \
        ATT_DMAK(t_ + 3); ATT_DMAV(t_ + 2); \
        ATT_WAIT_BAR(); \
        const bool a_cur = u.active(t_, wid), a_nxt = (t_ + 1 < NT) && u.active(t_ + 1, wid); \
        float alpha = 1.f; bool resc = false; u32x4 pw[4]; \
        if (a_cur && a_nxt) { ATT_QKT(SN0, SN1, t_ + 1); ATT_SOFTMAX(SC0, SC1, t_, SIDE); } \
        else { if (a_nxt) ATT_QKT(SN0, SN1, t_ + 1); \
               if (a_cur) ATT_SOFTMAX(SC0, SC1, t_, SIDE); } \
        __builtin_amdgcn_sched_barrier(0); \
        if (a_cur) { \
            const LAS unsigned char* vb_ = vbase + (t_ & 3) * VSLOT; s16x4 vlo[2][4], vhi[2][4]; \
            _Pragma("unroll") for (int dh = 0; dh < 2; ++dh) _Pragma("unroll") for (int ks = 0; ks < 4; ++ks) { if (((SIDE) == 1 && ks == 3) || ((SIDE) == 2 && ks == 0)) continue; vlo[dh][ks] = vtr(vb_ + dh * 4096 + ks * 1024); vhi[dh][ks] = vtr(vb_ + dh * 4096 + ks * 1024 + 512); } \
            if (resc) { if (hi == 0) wsf[r32] = alpha; LDS_WAIT(); \
                _Pragma("unroll") for (int r = 0; r < 16; ++r) { const float f = wsf[crow(r, hi)]; o[0][r] *= f; o[1][r] *= f; } } \
            _Pragma("unroll") for (int dh = 0; dh < 2; ++dh) _Pragma("unroll") for (int ks = 0; ks < 4; ++ks) { if (((SIDE) == 1 && ks == 3) || ((SIDE) == 2 && ks == 0)) continue; \
                const s16x4 lo4 = vlo[dh][ks], hi4 = vhi[dh][ks]; const bf16x8 vf = {lo4[0], lo4[1], lo4[2], lo4[3], hi4[0], hi4[1], hi4[2], hi4[3]}; \
                o[dh] = __builtin_amdgcn_mfma_f32_32x32x16_bf16(__builtin_bit_cast(bf16x8, pw[ks]), vf, o[dh], 0, 0, 0); } } \
        LDS_WAIT(); __builtin_amdgcn_sched_barrier(0); } while (0)

    ATT_DMAK(0); ATT_DMAK(1); ATT_DMAV(0); ATT_DMAK(2); ATT_DMAV(1);
    { const bf16_t* qp = u.qptr(wid, r32);
#pragma unroll
      for (int ks = 0; ks < NKS; ++ks) qr[ks] = *(const bf16x8*)(qp + 16 * ks + 8 * hi); }
    u.prep(L);
    u.template qfix<NKS>(qr, wid, r32, hi);
    ATT_WAIT_BAR();
    f32x16 sA0, sA1, sB0, sB1;
#pragma unroll
    for (int r = 0; r < 16; ++r) { sA0[r] = 0.f; sA1[r] = 0.f; sB0[r] = 0.f; sB1[r] = 0.f; }
    if (u.active(0, wid)) ATT_QKT(sA0, sA1, 0);
    if constexpr (U::SIDED) { const int nl = u.nlat; int t = 0;
        if (wid & 1) { for (; t < nl; ++t) { ATT_STEP(sA0, sA1, sB0, sB1, t, 2); sA0 = sB0; sA1 = sB1; } }
        else { for (; t < nl; ++t) { ATT_STEP(sA0, sA1, sB0, sB1, t, 1); sA0 = sB0; sA1 = sB1; } }
        for (; t < NT; ++t) { ATT_STEP(sA0, sA1, sB0, sB1, t, 0); sA0 = sB0; sA1 = sB1; } }
    else { for (int t = 0; t < NT; ++t) { ATT_STEP(sA0, sA1, sB0, sB1, t, 0); sA0 = sB0; sA1 = sB1; } }
    asm volatile("s_waitcnt vmcnt(0)" ::: "memory");
#undef ATT_DMAK
#undef ATT_DMAV
#undef ATT_WAIT_BAR
#undef ATT_QKT
#undef ATT_SOFTMAX
#undef ATT_LIVE0
#undef ATT_LIVE1
#undef ATT_STEP
    { float la, lb; pair32(l, la, lb); l = la + lb; }
    if (hi == 0) wsf[32 + r32] = l;
    LDS_WAIT();
    LAS unsigned char* stg = L + OFF_OST + wid * 2048;
#pragma unroll
    for (int r = 0; r < 16; ++r) { const int orow = crow(r, hi); const float rl = __builtin_amdgcn_rcpf(wsf[32 + orow]);
        const unsigned w = __builtin_amdgcn_cvt_pk_fp8_f32(o[0][r] * rl, o[1][r] * rl, 0u, false);
        stg[orow * 64 + r32] = (unsigned char)(w & 0xffu); stg[orow * 64 + 32 + r32] = (unsigned char)((w >> 8) & 0xffu); }
    LDS_WAIT();
#pragma unroll
    for (int i = 0; i < 2; ++i) { const int row = i * 16 + (lane >> 2), ch = lane & 3; const u32x4 v = *(const LAS u32x4*)(stg + row * 64 + ch * 16); *(u32x4*)(u.optr(wid, row) + ch * 16) = v; }
    __syncthreads();
}
}

struct Args { const float* in[25]; float* out; unsigned char* ws; int ph_lo, ph_hi; };
enum InIdx { I_X = 0, I_C, I_CTX, I_CCTX, I_ADAW, I_ADAB, I_N1G, I_N2G, I_EVWIN, I_EVSINK, I_EVQNG, I_EVWUQ, I_EVKVNG, I_EVWUKV, I_EVWOUT, I_ODWIN, I_ODRPB, I_ODWOUT, I_RW, I_RB, I_W1, I_B1, I_W2, I_B2, I_FG };

struct Frame {
    LAS unsigned char* lds;
    int tid, lane, wave, vcu, G;
    float* out; unsigned char* ws;
};
__device__ __forceinline__ const float* inptr(const Frame& F, int i) {
    const volatile LAS unsigned* p = (const volatile LAS unsigned*)(F.lds + LDSCTL_OFF + 256) + 2 * i;
    const unsigned lo = __builtin_amdgcn_readfirstlane(p[0]), hi = __builtin_amdgcn_readfirstlane(p[1]);
    return (const float*)(const GAS float*)(((unsigned long long)hi << 32) | lo);
}
#define WSP(T, off) ((T*)(F.ws + (off)))
__device__ __forceinline__ void frame_tid(Frame& F) { F.tid = opaque_tid(); F.lane = F.tid & 63; F.wave = __builtin_amdgcn_readfirstlane(F.tid >> 6); }

__device__ __forceinline__ void tr_item(const float* W, int ldw, int K, int k0, int n0, bf16_t* WT, int dst_row0, LAS float* scr, int lane) {
    float wv[32];
#pragma unroll
    for (int i = 0; i < 32; ++i) wv[i] = W[(size_t)(k0 + 2 * i + (lane >> 5)) * ldw + n0 + (lane & 31)];
#pragma unroll
    for (int i = 0; i < 32; ++i) scr[(2 * i + (lane >> 5)) * 33 + (lane & 31)] = wv[i];
    LDS_WAIT(); asm volatile("" ::: "memory");
    const int c = lane & 7;
#pragma unroll
    for (int j = 0; j < 4; ++j) { const int n = (lane >> 3) + 8 * j; const LAS float* s = scr + (8 * c) * 33 + n;
        u32x4 o; o.x = pk2(s[0 * 33], s[1 * 33]); o.y = pk2(s[2 * 33], s[3 * 33]); o.z = pk2(s[4 * 33], s[5 * 33]); o.w = pk2(s[6 * 33], s[7 * 33]);
        *(u32x4*)(WT + (size_t)(dst_row0 + n) * K + k0 + 8 * c) = o; }
    LDS_WAIT(); asm volatile("" ::: "memory");
}

__device__ __forceinline__ void tr_item8(const float* W, int ldw, int K, int k0, int n0, unsigned char* WT8, int dst_row0, LAS float* scr, int lane, float scale) {
    float wv[32];
#pragma unroll
    for (int i = 0; i < 32; ++i) wv[i] = W[(size_t)(k0 + 2 * i + (lane >> 5)) * ldw + n0 + (lane & 31)];
#pragma unroll
    for (int i = 0; i < 32; ++i) scr[(2 * i + (lane >> 5)) * 33 + (lane & 31)] = wv[i] * scale;
    LDS_WAIT(); asm volatile("" ::: "memory");
    const int c = lane & 3;
#pragma unroll
    for (int j = 0; j < 2; ++j) { const int n = (lane >> 2) + 16 * j; const LAS float* s = scr + (16 * c) * 33 + n;
        u32x4 o; o.x = cvt4_fp8(s[0 * 33], s[1 * 33], s[2 * 33], s[3 * 33]); o.y = cvt4_fp8(s[4 * 33], s[5 * 33], s[6 * 33], s[7 * 33]);
        o.z = cvt4_fp8(s[8 * 33], s[9 * 33], s[10 * 33], s[11 * 33]); o.w = cvt4_fp8(s[12 * 33], s[13 * 33], s[14 * 33], s[15 * 33]);
        *(u32x4*)(WT8 + (size_t)(dst_row0 + n) * K + k0 + 16 * c) = o; }
    LDS_WAIT(); asm volatile("" ::: "memory");
}
__device__ __forceinline__ float silu_f(float c) { return c / (1.0f + __expf(-c)); }

__device__ __forceinline__ void pro_a(Frame& F) {
    frame_tid(F);
    const int gwm = F.wave * F.G + F.vcu, NGW = F.G * 8;
    for (int it = gwm; it < 4 * 96; it += NGW) {
        const int l = it / 96, col = (it % 96) * 64 + F.lane;
        float sv[5][16];
#pragma unroll
        for (int j = 0; j < 16; ++j) {
#pragma unroll
            for (int v = 0; v < 4; ++v) sv[v][j] = silu_f(inptr(F, I_C)[v * 1024 + 64 * j + F.lane]);
            sv[4][j] = silu_f(inptr(F, I_CCTX)[64 * j + F.lane]);
        }
        const float* W = inptr(F, I_ADAW) + (size_t)l * 1024 * 6144 + col;
        float acc[5] = {0.f, 0.f, 0.f, 0.f, 0.f};
#pragma unroll
        for (int j = 0; j < 16; ++j) {
            float wl[64];
#pragma unroll
            for (int ln = 0; ln < 64; ++ln) wl[ln] = W[(size_t)(64 * j + ln) * 6144];
#pragma unroll
            for (int ln = 0; ln < 64; ++ln) {
#pragma unroll
                for (int v = 0; v < 5; ++v) acc[v] += __builtin_bit_cast(float, __builtin_amdgcn_readlane(__builtin_bit_cast(int, sv[v][j]), ln)) * wl[ln];
            }
        }
        const float bb = inptr(F, I_ADAB)[l * 6144 + col];
        float* MOD = WSP(float, WS_MOD);
#pragma unroll
        for (int v = 0; v < 5; ++v) MOD[(size_t)(l * 5 + v) * 6144 + col] = acc[v] + bb;
    }
    { const int gt = blockIdx.x * 512 + F.tid;
      if (gt < 128 * 16) { const int pos = gt >> 4, i = gt & 15; const float inv = __builtin_amdgcn_exp2f(-((float)i / 16.0f) * 13.287712379549449f); const float a = (float)pos * inv; WSP(f32x2, WS_ROPE64)[gt] = (f32x2){__cosf(a), __sinf(a)}; }
      else if (gt < 128 * 16 + 128 * 8) { const int g2 = gt - 128 * 16, pos = g2 >> 3, i = g2 & 7; const float inv = __builtin_amdgcn_exp2f(-((float)i / 8.0f) * 13.287712379549449f); const float a = (float)pos * inv; WSP(f32x2, WS_ROPE32)[g2] = (f32x2){__cosf(a), __sinf(a)}; } }
    { const int nchunk = 2 * 224 * 64;
      for (int i = blockIdx.x * 512 + F.tid; i < nchunk; i += F.G * 512) { const int mi = i / (224 * 64), r = (i / 64) % 224, c = i % 64;
          *(u32x4*)(WSP(unsigned char, WS_WINE) + ((size_t)mi * 2048 + 1824 + r) * 1024 + 16 * c) = (u32x4){0u, 0u, 0u, 0u}; } }
    { bf16_t* RWT = WSP(bf16_t, WS_RWT);
      for (int i = blockIdx.x * 512 + F.tid; i < 4 * 32 * 1024; i += F.G * 512) { const int l = i >> 15, e = (i >> 10) & 31, k = i & 1023;
          const float v = inptr(F, I_RW)[((size_t)l * 1024 + k) * 32 + e]; const unsigned hi = f2bf(v); const unsigned lo = f2bf(v - __builtin_bit_cast(float, hi << 16));
          bf16_t* r = RWT + ((size_t)l * 256 + e) * H3_LD; r[k] = (bf16_t)hi; r[1024 + k] = (bf16_t)hi; r[2048 + k] = (bf16_t)lo; }
      const int nz = 4 * 224 * (H3_LD / 8);
      for (int i = blockIdx.x * 512 + F.tid; i < nz; i += F.G * 512) { const int l = i / (224 * (H3_LD / 8)), r = (i / (H3_LD / 8)) % 224, c = i % (H3_LD / 8);
          *(u32x4*)(RWT + ((size_t)l * 256 + 32 + r) * H3_LD + 8 * c) = (u32x4){0u, 0u, 0u, 0u}; } }
    LAS float* scr = (LAS float*)(F.lds + F.wave * 16384);
    constexpr int S0 = 2 * 16 * 57, S1 = S0 + 2 * 12 * 24, S2 = S1 + 2 * 4 * 32, S3 = S2 + 2 * 16 * 32, S4 = S3 + 2 * 16 * 96, S5 = S4 + 2 * 16 * 32, S6 = S5 + 128 * 16 * 64, S7 = S6 + 128 * 16 * 32;
    const int gw = F.vcu * 8 + F.wave;
    for (int it = gw; it < S7; it += NGW) {
        if (it < S0) { const int r = it, mi = r / (16 * 57), q = r % (16 * 57), kb = q / 57, nb = q % 57;
            tr_item8(inptr(F, I_EVWIN) + (size_t)mi * 1024 * EV_IN, EV_IN, 1024, 64 * kb, 32 * nb, WSP(unsigned char, WS_WINE) + (size_t)mi * 2048 * 1024, 32 * nb, scr, F.lane, W8_SCALE); }
        else if (it < S1) { const int r = it - S0, mi = r / (12 * 24), q = r % (12 * 24), kb = q / 24, nb = q % 24;
            tr_item(inptr(F, I_EVWUQ) + (size_t)mi * 768 * 768, 768, 768, 64 * kb, 32 * nb, WSP(bf16_t, WS_WUQ) + (size_t)mi * 768 * 768, 32 * nb, scr, F.lane); }
        else if (it < S2) { const int r = it - S1, mi = r / (4 * 32), q = r % (4 * 32), kb = q / 32, nb = q % 32;
            tr_item(inptr(F, I_EVWUKV) + (size_t)mi * 256 * 1024, 1024, 256, 64 * kb, 32 * nb, WSP(bf16_t, WS_WUKV) + (size_t)mi * 1024 * 256, 32 * nb, scr, F.lane); }
        else if (it < S3) { const int r = it - S2, mi = r / (16 * 32), q = r % (16 * 32), kb = q / 32, nb = q % 32;
            tr_item8(inptr(F, I_EVWOUT) + (size_t)mi * 1024 * 1024, 1024, 1024, 64 * kb, 32 * nb, WSP(unsigned char, WS_WOUTE) + (size_t)mi * 1024 * 1024, 32 * nb, scr, F.lane, W8_SCALE); }
        else if (it < S4) { const int r = it - S3, mi = r / (16 * 96), q = r % (16 * 96), kb = q / 96, nb = q % 96;
            tr_item8(inptr(F, I_ODWIN) + (size_t)mi * 1024 * 3072, 3072, 1024, 64 * kb, 32 * nb, WSP(unsigned char, WS_WINO) + (size_t)mi * 3072 * 1024, 32 * nb, scr, F.lane, W8_SCALE); }
        else if (it < S5) { const int r = it - S4, mi = r / (16 * 32), q = r % (16 * 32), kb = q / 32, nb = q % 32;
            tr_item8(inptr(F, I_ODWOUT) + (size_t)mi * 1024 * 1024, 1024, 1024, 64 * kb, 32 * nb, WSP(unsigned char, WS_WOUTO) + (size_t)mi * 1024 * 1024, 32 * nb, scr, F.lane, W8_SCALE); }
        else if (it < S6) { const int r = it - S5, mi = r / (16 * 64), q = r % (16 * 64), kb = q / 64, nb = q % 64;
            const int c0 = 32 * (nb & 31), drow = (c0 >> 7) * 256 + (nb >= 32 ? 128 : 0) + (c0 & 127);
            tr_item8(inptr(F, I_W1) + (size_t)mi * 1024 * 2048, 2048, 1024, 64 * kb, 32 * nb, WSP(unsigned char, WS_W1) + (size_t)mi * 2048 * 1024, drow, scr, F.lane, W8_SCALE); }
        else { const int r = it - S6, mi = r / (16 * 32), q = r % (16 * 32), kb = q / 32, nb = q % 32;
            tr_item8(inptr(F, I_W2) + (size_t)mi * 1024 * 1024, 1024, 1024, 64 * kb, 32 * nb, WSP(unsigned char, WS_W2) + (size_t)mi * 1024 * 1024, 32 * nb, scr, F.lane, W8_SCALE); }
    }
}

__device__ __forceinline__ int mod_bidx(int row) { return row < TL ? (row >> 13) : 4; }
__device__ __forceinline__ void norm_mod_store(const f32x4 (&v)[4], int lane, const float* g, const float* shift, const float* scale, unsigned char* hrow, f32x4 (*hf)[4] = nullptr) {
    float s = 0.f;
#pragma unroll
    for (int j = 0; j < 4; ++j) s += (v[j].x * v[j].x + v[j].y * v[j].y) + (v[j].z * v[j].z + v[j].w * v[j].w);
    const float rstd = 1.0f / sqrtf(wave_sum(s) * (1.0f / DM) + NORM_EPS);
#pragma unroll
    for (int j = 0; j < 4; ++j) { const int col = 4 * lane + 256 * j;
        const f32x4 gg = *(const f32x4*)(g + col), sh = *(const f32x4*)(shift + col), sc = *(const f32x4*)(scale + col);
        const f32x4 h = (v[j] * rstd) * gg * (sc + 1.0f) + sh;
        if (hf) (*hf)[j] = h;
        *(unsigned*)(hrow + col) = cvt4_fp8(h.x, h.y, h.z, h.w); }
}

__device__ __forceinline__ void norm_mod_store_r(const f32x4 (&v)[4], int lane, const f32x4 (&gg)[4], const f32x4 (&sh)[4], const f32x4 (&sc1)[4], unsigned char* hrow) {
    float s = 0.f;
#pragma unroll
    for (int j = 0; j < 4; ++j) s += (v[j].x * v[j].x + v[j].y * v[j].y) + (v[j].z * v[j].z + v[j].w * v[j].w);
    const float rstd = 1.0f / sqrtf(wave_sum(s) * (1.0f / DM) + NORM_EPS);
#pragma unroll
    for (int j = 0; j < 4; ++j) { const int col = 4 * lane + 256 * j;
        const f32x4 h = (v[j] * rstd) * gg[j] * sc1[j] + sh[j];
        *(unsigned*)(hrow + col) = cvt4_fp8(h.x, h.y, h.z, h.w); }
}

__device__ __forceinline__ void pro_b(Frame& F) {
    frame_tid(F);
    const int gw = F.vcu * 8 + F.wave, NGW = F.G * 8, lane = F.lane;
    const float* MOD = WSP(float, WS_MOD);
    f32x4 gg[4], sh[4], sc1[4], vn[4]; int cb = -1;
#pragma unroll
    for (int j = 0; j < 4; ++j) { gg[j] = *(const f32x4*)(inptr(F, I_N1G) + 4 * lane + 256 * j); sh[j] = gg[j]; sc1[j] = gg[j]; vn[j] = gg[j]; }
#define PB_SRC(r_) ((r_) < TL ? inptr(F, I_X) + (size_t)(r_) * DM : inptr(F, I_CTX) + (size_t)((r_) - TL) * DM)
    if (gw < TT) { const float* src = PB_SRC(gw);
#pragma unroll
        for (int j = 0; j < 4; ++j) vn[j] = *(const f32x4*)(src + 4 * lane + 256 * j); }
    for (int row = gw; row < TT; row += NGW) {
        f32x4 v[4];
#pragma unroll
        for (int j = 0; j < 4; ++j) v[j] = vn[j];
        if (row + NGW < TT) { const float* src = PB_SRC(row + NGW);
#pragma unroll
            for (int j = 0; j < 4; ++j) vn[j] = *(const f32x4*)(src + 4 * lane + 256 * j); }
        const int bi = mod_bidx(row);
        if (bi != cb) { cb = bi; const float* mb = MOD + (size_t)(0 * 5 + bi) * 6144;
#pragma unroll
            for (int j = 0; j < 4; ++j) { sh[j] = *(const f32x4*)(mb + 4 * lane + 256 * j); sc1[j] = *(const f32x4*)(mb + 1024 + 4 * lane + 256 * j) + 1.0f; } }
        bf16_t* xr = WSP(bf16_t, WS_XLC) + (size_t)row * DM;
#pragma unroll
        for (int j = 0; j < 4; ++j) *(u32x2*)(xr + 4 * lane + 256 * j) = xpk4(v[j]);
        norm_mod_store_r(v, lane, gg, sh, sc1, WSP(unsigned char, WS_HB) + (size_t)row * DM);
    }
#undef PB_SRC
}

__device__ __forceinline__ u32x4 shfl_xor4(u32x4 v, int m) { u32x4 r; r.x = __shfl_xor(v.x, m); r.y = __shfl_xor(v.y, m); r.z = __shfl_xor(v.z, m); r.w = __shfl_xor(v.w, m); return r; }
__device__ __forceinline__ float ssq8(u32x4 w) { float s = 0.f;
#pragma unroll
    for (int i = 0; i < 4; ++i) { const float a = bflo(w[i]), b = bfhi(w[i]); s += a * a + b * b; } return s; }
__device__ __forceinline__ u32x4 scale8(u32x4 w, float r, const float* g) { u32x4 o; const f32x4 g0 = *(const f32x4*)g, g1 = *(const f32x4*)(g + 4);
    o.x = pk2(bflo(w.x) * r * g0.x, bfhi(w.x) * r * g0.y); o.y = pk2(bflo(w.y) * r * g0.z, bfhi(w.y) * r * g0.w);
    o.z = pk2(bflo(w.z) * r * g1.x, bfhi(w.z) * r * g1.y); o.w = pk2(bflo(w.w) * r * g1.z, bfhi(w.w) * r * g1.w); return o; }

__device__ __forceinline__ u32x4 rope_chunk_r(u32x4 xw, u32x4 yw, const f32x2 (&tab)[8], bool first) {
    u32x4 o;
#pragma unroll
    for (int i = 0; i < 4; ++i) {
        const f32x2 cs0 = tab[2 * i], cs1 = tab[2 * i + 1];
        const float x0 = bflo(xw[i]), x1 = bfhi(xw[i]), y0 = bflo(yw[i]), y1 = bfhi(yw[i]);
        const float r0 = first ? x0 * cs0.x - y0 * cs0.y : x0 * cs0.x + y0 * cs0.y;
        const float r1 = first ? x1 * cs1.x - y1 * cs1.y : x1 * cs1.x + y1 * cs1.y;
        o[i] = pk2(r0, r1);
    }
    return o;
}
__device__ __forceinline__ u32x4 scale8_r(u32x4 w, float r, f32x4 g0, f32x4 g1) { u32x4 o;
    o.x = pk2(bflo(w.x) * r * g0.x, bfhi(w.x) * r * g0.y); o.y = pk2(bflo(w.y) * r * g0.z, bfhi(w.y) * r * g0.w);
    o.z = pk2(bflo(w.z) * r * g1.x, bfhi(w.z) * r * g1.y); o.w = pk2(bflo(w.w) * r * g1.z, bfhi(w.w) * r * g1.w); return o; }

__device__ __forceinline__ void e2_pass(Frame& F, int li) {
    frame_tid(F);
    const int gw = F.vcu * 8 + F.wave, NGW = F.G * 8, lane = F.lane;
    const float* gq = inptr(F, I_EVQNG) + li * 768; const float* gkv = inptr(F, I_EVKVNG) + li * 256;
    const f32x2* R64 = WSP(f32x2, WS_ROPE64); const f32x2* R32 = WSP(f32x2, WS_ROPE32);
    const int cw = lane & 7, seg = cw >> 1, c4 = (lane >= 32 && lane < 36) ? lane - 32 : 0;
    const float* gq1p = gq + (lane >= 32 ? 8 * (lane + 64) - 768 : 0); const float* gq2p = gq + 8 * (lane + 128) - 768; const float* gkvp = gkv + (lane < 32 ? 8 * lane : 0);
    const f32x4 gq1a = *(const f32x4*)gq1p, gq1b = *(const f32x4*)(gq1p + 4), gq2a = *(const f32x4*)gq2p, gq2b = *(const f32x4*)(gq2p + 4), gkva = *(const f32x4*)gkvp, gkvb = *(const f32x4*)(gkvp + 4);
    u32x4 wn[4]; f32x2 t64n[8], t32n[8];
#define E2_LOAD(r_) do { const bf16_t* pr_ = WSP(bf16_t, WS_PB) + (size_t)(r_) * EV_LD; \
        _Pragma("unroll") for (int j = 0; j < 4; ++j) wn[j] = *(const u32x4*)(pr_ + 8 * (lane + 64 * j)); \
        const int t_ = (r_) & (SEQ - 1), prow_ = t_ >> 6, pcol_ = t_ & 63; \
        const f32x2* a_ = R64 + ((seg < 2) ? prow_ : pcol_) * 16 + (cw & 1) * 8; const f32x2* b_ = R32 + ((c4 < 2) ? prow_ : pcol_) * 8; \
        _Pragma("unroll") for (int i = 0; i < 8; ++i) { t64n[i] = a_[i]; t32n[i] = b_[i]; } } while (0)
#pragma unroll
    for (int j = 0; j < 4; ++j) wn[j] = (u32x4){0u, 0u, 0u, 0u};
#pragma unroll
    for (int i = 0; i < 8; ++i) { t64n[i] = (f32x2){0.f, 0.f}; t32n[i] = (f32x2){0.f, 0.f}; }
    if (gw < TT) E2_LOAD(gw);
    for (int row = gw; row < TT; row += NGW) {
        bf16_t* pr = WSP(bf16_t, WS_PB) + (size_t)row * EV_LD;
        u32x4 w[4]; f32x2 t64[8], t32[8];
#pragma unroll
        for (int j = 0; j < 4; ++j) w[j] = wn[j];
#pragma unroll
        for (int i = 0; i < 8; ++i) { t64[i] = t64n[i]; t32[i] = t32n[i]; }
        if (row + NGW < TT) E2_LOAD(row + NGW);
        float sq = ssq8(w[2]) + (lane >= 32 ? ssq8(w[1]) : 0.f), skv = lane < 32 ? ssq8(w[3]) : 0.f;
        const float rq = 1.0f / sqrtf(wave_sum(sq) * (1.0f / 768.0f) + NORM_EPS), rkv = 1.0f / sqrtf(wave_sum(skv) * (1.0f / 256.0f) + NORM_EPS);
        const bool lat = row < TL;
        const u32x4 y0 = shfl_xor4(w[0], 2), y1 = shfl_xor4(w[1], 2), y3 = shfl_xor4(w[3], 1);
        if (lat) { w[0] = rope_chunk_r(w[0], y0, t64, (seg & 1) == 0); if (lane < 16) w[1] = rope_chunk_r(w[1], y1, t64, (seg & 1) == 0); }
        if (lane >= 32) w[1] = scale8_r(w[1], rq, gq1a, gq1b);
        w[2] = scale8_r(w[2], rq, gq2a, gq2b);
        if (lane < 32) w[3] = scale8_r(w[3], rkv, gkva, gkvb);
        else if (lane < 36 && lat) w[3] = rope_chunk_r(w[3], y3, t32, ((lane - 32) & 1) == 0);
        if (lat) *(u32x4*)(pr + 8 * lane) = w[0];
        if (lane >= 32 || (lat && lane < 16)) *(u32x4*)(pr + 8 * (lane + 64)) = w[1];
        *(u32x4*)(pr + 8 * (lane + 128)) = w[2];
        if (lane < 32 || (lat && lane < 36)) *(u32x4*)(pr + 8 * (lane + 192)) = w[3];
    }
#undef E2_LOAD
}
__device__ __forceinline__ void m1a_pass(Frame& F, int layer) {
    frame_tid(F);
    const int gw = F.vcu * 8 + F.wave, NGW = F.G * 8, lane = F.lane;
    const float* MOD = WSP(float, WS_MOD); const float* g2 = inptr(F, I_N2G) + layer * DM;
    f32x4 gg[4], sh[4], sc1[4], vn[4]; int cb = -1;
#pragma unroll
    for (int j = 0; j < 4; ++j) { gg[j] = *(const f32x4*)(g2 + 4 * lane + 256 * j); sh[j] = gg[j]; sc1[j] = gg[j]; vn[j] = gg[j]; }
    if (gw < TT) {
#pragma unroll
        for (int j = 0; j < 4; ++j) vn[j] = xun4(*(const u32x2*)(WSP(bf16_t, WS_XLC) + (size_t)gw * DM + 4 * lane + 256 * j)); }
    for (int row = gw; row < TT; row += NGW) {
        f32x4 v[4];
#pragma unroll
        for (int j = 0; j < 4; ++j) v[j] = vn[j];
        if (row + NGW < TT) {
#pragma unroll
            for (int j = 0; j < 4; ++j) vn[j] = xun4(*(const u32x2*)(WSP(bf16_t, WS_XLC) + (size_t)(row + NGW) * DM + 4 * lane + 256 * j)); }
        const int bi = mod_bidx(row);
        if (bi != cb) { cb = bi; const float* mb = MOD + (size_t)(layer * 5 + bi) * 6144;
#pragma unroll
            for (int j = 0; j < 4; ++j) { sh[j] = *(const f32x4*)(mb + 3 * 1024 + 4 * lane + 256 * j); sc1[j] = *(const f32x4*)(mb + 4 * 1024 + 4 * lane + 256 * j) + 1.0f; } }
        float s = 0.f;
#pragma unroll
        for (int j = 0; j < 4; ++j) s += (v[j].x * v[j].x + v[j].y * v[j].y) + (v[j].z * v[j].z + v[j].w * v[j].w);
        const float rstd = 1.0f / sqrtf(wave_sum(s) * (1.0f / DM) + NORM_EPS);
        bf16_t* hr = WSP(bf16_t, WS_PB) + (size_t)row * H3_LD;
#pragma unroll
        for (int j = 0; j < 4; ++j) { const int col = 4 * lane + 256 * j;
            const f32x4 h = (v[j] * rstd) * gg[j] * sc1[j] + sh[j];
            unsigned hi[4], lo[4];
#pragma unroll
            for (int i = 0; i < 4; ++i) { hi[i] = f2bf(h[i]); lo[i] = f2bf(h[i] - __builtin_bit_cast(float, hi[i] << 16)); }
            const u32x2 wh = {hi[0] | (hi[1] << 16), hi[2] | (hi[3] << 16)}, wl = {lo[0] | (lo[1] << 16), lo[2] | (lo[3] << 16)};
            *(u32x2*)(hr + col) = wh; *(u32x2*)(hr + 1024 + col) = wl;
            *(unsigned*)(WSP(unsigned char, WS_HB) + (size_t)row * DM + col) = cvt4_fp8(h[0], h[1], h[2], h[3]); }
    }
}
__device__ __forceinline__ void m1b_gemm(Frame& F, int layer) {
    pg8::RouterOrder S; S.A = (const char*)WSP(bf16_t, WS_PB); S.Bt = (const char*)(WSP(bf16_t, WS_RWT) + (size_t)layer * 256 * H3_LD); S.lda2 = H3_LD * 2; S.ldb2 = H3_LD * 2; S.nM = TT / 256; S.G = F.G; S.c = blockIdx.x;
    pg8::EpiLogits E{WSP(float, WS_LOGIT), WSP(float, WS_LOGIT12), inptr(F, I_RB) + layer * 32};
    pg8::gemm_phase<pg8::EpiLogits, pg8::RouterOrder>(F.lds, 1024, (size_t)H3_LD * 2, (size_t)H3_LD * 2, S, E);
}
__device__ __forceinline__ void m1c_pass(Frame& F) {
    frame_tid(F);
    const int lane = F.lane, blk = blockIdx.x, CH = (TT + F.G - 1) / F.G;
    const int r0 = blk * CH, r1 = (r0 + CH < TT) ? r0 + CH : TT;
    LAS int* hist = (LAS int*)(F.lds + LDSCTL_OFF + 512);
    if (F.tid < 32) hist[F.tid] = 0;
    __syncthreads();
    const int e = lane & 31, sub = lane >> 5;
    float n0 = 0.f, n1 = 0.f, n2 = 0.f;
    { const int row = r0 + 2 * F.wave + sub; const size_t li_ = (size_t)(row < r1 ? row : r1 - 1) * 32 + e;
      n0 = WSP(float, WS_LOGIT)[li_]; n1 = WSP(float, WS_LOGIT12)[li_]; n2 = WSP(float, WS_LOGIT12)[(size_t)TT * 32 + li_]; }
    for (int rbase = r0 + 2 * F.wave; rbase < r1; rbase += 16) {
        const int row = rbase + sub; const bool ok = row < r1;
        float logit = (n0 + n1) + n2;
        { const int rn = rbase + 16 + sub; const size_t li_ = (size_t)(rn < r1 ? rn : r1 - 1) * 32 + e;
          n0 = WSP(float, WS_LOGIT)[li_]; n1 = WSP(float, WS_LOGIT12)[li_]; n2 = WSP(float, WS_LOGIT12)[(size_t)TT * 32 + li_]; }
        float tv[4]; int ti[4];
#pragma unroll
        for (int k = 0; k < 4; ++k) {
            float bv = logit; int bi = e;
#pragma unroll
            for (int o = 16; o >= 1; o >>= 1) { const float ov = __shfl_xor(bv, o); const int oi = __shfl_xor(bi, o); if (ov > bv || (ov == bv && oi < bi)) { bv = ov; bi = oi; } }
            tv[k] = bv; ti[k] = bi; if (e == bi) logit = -3.0e38f;
        }
        const float w1 = __expf(tv[1] - tv[0]), w2 = __expf(tv[2] - tv[0]), w3 = __expf(tv[3] - tv[0]); const float inv = 1.0f / (1.0f + w1 + w2 + w3);
        if (e == 0 && ok) {
            *(int4*)(WSP(int, WS_TOPE) + (size_t)row * 4) = make_int4(ti[0], ti[1], ti[2], ti[3]);
            *(f32x4*)(WSP(float, WS_TOPG) + (size_t)row * 4) = (f32x4){inv, w1 * inv, w2 * inv, w3 * inv};
            atomicAdd((int*)(hist + ti[0]), 1); atomicAdd((int*)(hist + ti[1]), 1); atomicAdd((int*)(hist + ti[2]), 1); atomicAdd((int*)(hist + ti[3]), 1);
        }
    }
    __syncthreads();
    if (F.tid < 32) WSP(int, WS_HIST)[blk * 32 + F.tid] = hist[F.tid];
    __syncthreads();
}

__device__ __forceinline__ void m2_pass(Frame& F) {
    frame_tid(F);
    const int blk = blockIdx.x, CH = (TT + F.G - 1) / F.G;
    const int r0 = blk * CH, r1 = (r0 + CH < TT) ? r0 + CH : TT, nr = r1 > r0 ? r1 - r0 : 0;
    LAS int* tot = (LAS int*)(F.lds), *bef = tot + 32, *pst = tot + 64, *ntl = tot + 96;
    LAS int* te = (LAS int*)(F.lds + 1024);
    LAS float* tg = (LAS float*)(F.lds + 1024 + 32768);
    const int* HIST = WSP(int, WS_HIST);
    if (F.tid < 64) tot[F.tid] = 0;
    __syncthreads();
    for (int i = F.tid; i < F.G * 32; i += 512) { const int h = HIST[i]; atomicAdd((int*)(tot + (i & 31)), h); if ((i >> 5) < blk) atomicAdd((int*)(bef + (i & 31)), h); }
    for (int i = F.tid; i < nr * 4; i += 512) { te[i] = WSP(int, WS_TOPE)[(size_t)r0 * 4 + i]; tg[i] = WSP(float, WS_TOPG)[(size_t)r0 * 4 + i]; }
    __syncthreads();
    if (F.tid == 0) { int ps = 0; for (int e = 0; e < 32; ++e) { pst[e] = ps; ps += (tot[e] + 255) & ~255; } ntl[0] = ps >> 8; }
    __syncthreads();
    LAS int* cnt = (LAS int*)(F.lds + 1024 + 65536);
    const int nent = nr * 4, nch = (nent + 63) >> 6;
    int myrank[4] = {0, 0, 0, 0}, myex[4] = {-1, -1, -1, -1};
#pragma unroll
    for (int q = 0; q < 4; ++q) { const int c = F.wave + 8 * q;
        if (c < nch) { const int i = 64 * c + F.lane; const int ex = i < nent ? te[i] : -1; myex[q] = ex; int rk = 0, mine = 0;
            for (int e = 0; e < 32; ++e) { const unsigned long long m = __ballot(ex == e); if (ex == e) rk = __popcll(m & ((1ull << F.lane) - 1ull)); if (F.lane == e) mine = __popcll(m); }
            myrank[q] = rk; if (F.lane < 32) cnt[c * 32 + F.lane] = mine; } }
    __syncthreads();
#pragma unroll
    for (int q = 0; q < 4; ++q) { const int c = F.wave + 8 * q; const int i = 64 * c + F.lane;
        if (c < nch && i < nent) { const int ex = myex[q]; int before = 0; for (int c2 = 0; c2 < c; ++c2) before += cnt[c2 * 32 + ex];
            const int sl = pst[ex] + bef[ex] + before + myrank[q];
            WSP(int, WS_SLOT)[(size_t)r0 * 4 + i] = sl; WSP(float, WS_GSLOT)[sl] = tg[i]; WSP(int, WS_TOKSLOT)[sl] = r0 + (i >> 2); } }
    if (blk == 0) { const int nt = ntl[0]; int* TE = WSP(int, WS_TILEEXP);
        for (int tl = F.tid; tl < nt; tl += 512) { int e = 0; for (int q = 1; q < 32; ++q) if (pst[q] <= tl * 256) e = q; TE[tl] = e; }
        if (F.tid == 0) TE[1023] = nt;
        for (int e = 0; e < 32; ++e) { const int p0 = pst[e] + tot[e], p1 = pst[e] + ((tot[e] + 255) & ~255); for (int sidx = p0 + F.tid; sidx < p1; sidx += 512) WSP(int, WS_TOKSLOT)[sidx] = 0; } }
    __syncthreads();
}

__device__ __forceinline__ void m5_pass(Frame& F, int layer) {
    frame_tid(F);
    const int gw = F.vcu * 8 + F.wave, NGW = F.G * 8, lane = F.lane;
    const float* MOD = WSP(float, WS_MOD);
    const bool last = layer == 3; const int RL = last ? TL : TT;
    f32x4 gg[4], g2v[4], sh[4], sc1[4]; int cb = -1;
    { const float* gp = last ? inptr(F, I_FG) : inptr(F, I_N1G) + (layer + 1) * DM;
#pragma unroll
      for (int j = 0; j < 4; ++j) { gg[j] = *(const f32x4*)(gp + 4 * lane + 256 * j); g2v[j] = gg[j]; sh[j] = gg[j]; sc1[j] = gg[j]; } }
    int4 sC = make_int4(0, 0, 0, 0), sN = sC; f32x4 gC = {0.f, 0.f, 0.f, 0.f}, gN = gC;
    unsigned yw[4][4], ywn[4][4]; f32x4 xv[4], xvn[4];
#pragma unroll
    for (int j = 0; j < 4; ++j) { xv[j] = gg[j]; xvn[j] = gg[j];
#pragma unroll
        for (int k = 0; k < 4; ++k) { yw[j][k] = 0u; ywn[j][k] = 0u; } }
#define M5_SLOTS(S_, G_, r_) do { S_ = *(const int4*)(WSP(int, WS_SLOT) + (size_t)(r_) * 4); G_ = *(const f32x4*)(WSP(float, WS_TOPG) + (size_t)(r_) * 4); } while (0)
#define M5_DATA(Y_, X_, S_, r_) do { const int sl_[4] = {S_.x, S_.y, S_.z, S_.w}; \
        _Pragma("unroll") for (int j = 0; j < 4; ++j) { const int col = 4 * lane + 256 * j; \
            _Pragma("unroll") for (int k = 0; k < 4; ++k) Y_[j][k] = *(const unsigned*)(WSP(unsigned char, WS_XG) + (size_t)(col >> 6) * ((size_t)MAXSLOT * 64) + (size_t)sl_[k] * 64 + (col & 63)); \
            X_[j] = xun4(*(const u32x2*)(WSP(bf16_t, WS_XLC) + (size_t)(r_) * DM + col)); } } while (0)
    if (gw < RL) { M5_SLOTS(sC, gC, gw); M5_DATA(yw, xv, sC, gw); }
    if (gw + NGW < RL) M5_SLOTS(sN, gN, gw + NGW);
    for (int row = gw; row < RL; row += NGW) {
        const f32x4 gcur = gC;
        if (row + NGW < RL) { M5_DATA(ywn, xvn, sN, row + NGW); gC = gN; }
        if (row + 2 * NGW < RL) M5_SLOTS(sN, gN, row + 2 * NGW);
        const int bi = mod_bidx(row);
        if (bi != cb) { cb = bi; const float* mb = MOD + (size_t)(layer * 5 + bi) * 6144; const float* mn = MOD + (size_t)((last ? layer : layer + 1) * 5 + bi) * 6144;
#pragma unroll
            for (int j = 0; j < 4; ++j) { const int col = 4 * lane + 256 * j; g2v[j] = *(const f32x4*)(mb + 5 * 1024 + col); sh[j] = *(const f32x4*)(mn + col); sc1[j] = *(const f32x4*)(mn + 1024 + col) + 1.0f; } }
        const float gk[4] = {gcur.x * (1.0f / YS_SCALE), gcur.y * (1.0f / YS_SCALE), gcur.z * (1.0f / YS_SCALE), gcur.w * (1.0f / YS_SCALE)};
        bf16_t* xr = WSP(bf16_t, WS_XLC) + (size_t)row * DM;
        f32x4 v[4];
#pragma unroll
        for (int j = 0; j < 4; ++j) { f32x4 y = {0.f, 0.f, 0.f, 0.f};
#pragma unroll
            for (int k = 0; k < 4; ++k) { const unsigned w = yw[j][k];
                y += (f32x4){__builtin_amdgcn_cvt_f32_fp8(w, 0), __builtin_amdgcn_cvt_f32_fp8(w, 1), __builtin_amdgcn_cvt_f32_fp8(w, 2), __builtin_amdgcn_cvt_f32_fp8(w, 3)} * gk[k]; }
            v[j] = xv[j] + g2v[j] * y; }
        if (!last) {
#pragma unroll
            for (int j = 0; j < 4; ++j) *(u32x2*)(xr + 4 * lane + 256 * j) = xpk4(v[j]);
            norm_mod_store_r(v, lane, gg, sh, sc1, WSP(unsigned char, WS_HB) + (size_t)row * DM);
        } else {
            float s = 0.f;
#pragma unroll
            for (int j = 0; j < 4; ++j) s += (v[j].x * v[j].x + v[j].y * v[j].y) + (v[j].z * v[j].z + v[j].w * v[j].w);
            const float rstd = 1.0f / sqrtf(wave_sum(s) * (1.0f / DM) + NORM_EPS);
#pragma unroll
            for (int j = 0; j < 4; ++j) { const int col = 4 * lane + 256 * j; *(f32x4*)(F.out + (size_t)row * DM + col) = (v[j] * rstd) * gg[j]; }
        }
#pragma unroll
        for (int j = 0; j < 4; ++j) { xv[j] = xvn[j];
#pragma unroll
            for (int k = 0; k < 4; ++k) yw[j][k] = ywn[j][k]; }
    }
#undef M5_SLOTS
#undef M5_DATA
}

constexpr int NPH_PAIR = 22, NPH = 2 + 2 * NPH_PAIR;

__device__ __forceinline__ void moe_gemm1(Frame& F, int layer) {
    const int* TE = WSP(int, WS_TILEEXP);
    LAS int* tel = (LAS int*)(F.lds + LDSCTL_OFF + 4096);
    { const int tz = opaque_tid(); tel[tz] = TE[tz]; tel[512 + tz] = TE[512 + tz]; __syncthreads(); }
    pg8::MoeOrder S; S.A = (const char*)WSP(unsigned char, WS_HB); S.W = (const char*)(WSP(unsigned char, WS_W1) + (size_t)layer * 32 * 2048 * 1024); S.tile_exp = tel; S.tokslot = WSP(int, WS_TOKSLOT);
    S.lda2 = 1024; S.ldb2 = 1024; S.wstride = 2048u * 1024u; S.ntiles = __builtin_amdgcn_readfirstlane(TE[1023]); S.nN = 8; S.G = F.G; S.c = blockIdx.x;
    pg8::EpiSwiglu E{WSP(unsigned char, WS_HA), inptr(F, I_B1) + (size_t)layer * 32 * 2048};
    pg8::gemm_phase<pg8::EpiSwiglu, pg8::MoeOrder, true, true>(F.lds, 512, 1024, 1024, S, E);
}
__device__ __forceinline__ void moe_gemm2(Frame& F, int layer) {
    const int* TE = WSP(int, WS_TILEEXP);
    LAS int* tel = (LAS int*)(F.lds + LDSCTL_OFF + 4096);
    { const int tz = opaque_tid(); tel[tz] = TE[tz]; tel[512 + tz] = TE[512 + tz]; __syncthreads(); }
    pg8::MoeOrder S; S.A = (const char*)WSP(unsigned char, WS_HA); S.W = (const char*)(WSP(unsigned char, WS_W2) + (size_t)layer * 32 * 1024 * 1024); S.tile_exp = tel; S.tokslot = nullptr;
    S.lda2 = 1024; S.ldb2 = 1024; S.wstride = 1024u * 1024u; S.ntiles = __builtin_amdgcn_readfirstlane(TE[1023]); S.nN = 4; S.G = F.G; S.c = blockIdx.x;
    pg8::EpiGate E{WSP(unsigned char, WS_XG), inptr(F, I_B2) + (size_t)layer * 32 * 1024};
    pg8::gemm_phase<pg8::EpiGate, pg8::MoeOrder, true>(F.lds, 512, 1024, 1024, S, E);
}
__device__ __forceinline__ void dense_gemm_bf16(Frame& F, const bf16_t* A, size_t lda2, const bf16_t* Bt, int N, int K, bf16_t* O, int ldc) {
    pg8::DenseOrder S; S.init(A, lda2, Bt, (size_t)K * 2, TT, N, F.G, blockIdx.x);
    pg8::EpiBf16 E{O, ldc, 1.0f};
    pg8::gemm_phase<pg8::EpiBf16, pg8::DenseOrder>(F.lds, K, lda2, (size_t)K * 2, S, E);
}
__device__ __forceinline__ void dense_gemm_f8(Frame& F, const unsigned char* A8, const unsigned char* Bt8, int N, int K8, bf16_t* O, int ldc) {
    pg8::DenseOrder S; S.init(A8, (size_t)K8, Bt8, (size_t)K8, TT, N, F.G, blockIdx.x);
    pg8::EpiBf16 E{O, ldc, 1.0f / W8_SCALE};
    pg8::gemm_phase<pg8::EpiBf16, pg8::DenseOrder, true>(F.lds, K8 / 2, (size_t)K8, (size_t)K8, S, E);
}
__device__ __forceinline__ void outproj_gemm(Frame& F, const unsigned char* Bt8, int layer, int nrows) {
    pg8::DenseOrder S; S.init(WSP(unsigned char, WS_AO), 1024, Bt8, 1024, nrows, 1024, F.G, blockIdx.x);
    pg8::EpiResid E{WSP(bf16_t, WS_XLC), WSP(float, WS_MOD) + (size_t)layer * 5 * 6144 + 2 * 1024, 1.0f / W8_SCALE};
    pg8::gemm_phase<pg8::EpiResid, pg8::DenseOrder, true>(F.lds, 512, 1024, 1024, S, E);
}

__global__ void __launch_bounds__(512, 2) fwd(Args args) {
    extern __shared__ __attribute__((aligned(16))) unsigned char lds_raw[];
    Frame F;
    F.lds = (LAS unsigned char*)lds_raw;
    F.tid = threadIdx.x; F.lane = F.tid & 63; F.wave = __builtin_amdgcn_readfirstlane(F.tid >> 6);
    F.G = gridDim.x; { const int bx = blockIdx.x; F.vcu = (F.G % 8 == 0) ? (bx % 8) * (F.G / 8) + bx / 8 : bx; }
    F.out = args.out; F.ws = args.ws;
    volatile LAS unsigned* MISC = (volatile LAS unsigned*)(F.lds + LDSCTL_OFF);
    if (F.tid < 64) MISC[F.tid] = 0u;
    if (F.tid < 25) { const unsigned long long pv = ((const unsigned long long*)__builtin_amdgcn_kernarg_segment_ptr())[F.tid]; MISC[64 + 2 * F.tid] = (unsigned)pv; MISC[65 + 2 * F.tid] = (unsigned)(pv >> 32); }
    __syncthreads();
    unsigned* ctl = (unsigned*)(F.ws + WS_CTL);
#if !MK_PER_PHASE
    XcdBarrier bar = xcd_barrier_post(ctl + CW_BAR, MISC + 8);
#define GRID_BAR() xcd_barrier(bar)
#else
#define GRID_BAR() do { } while (0)
#endif
    const int lo = args.ph_lo, hi = args.ph_hi;
    int pid = 0;
    enum { CNT0 = __COUNTER__ + 1 };
#ifndef PHMASK
#define PHMASK 0xFFFFFFFFull
#endif
#ifndef REPMASK
#define REPMASK 0ull
#endif
#define PHASE_BEGIN { const int site_ = __COUNTER__ - CNT0; const int nrep_ = 1 + (int)(((unsigned long long)REPMASK >> site_) & 1ull); \
    if ((((unsigned long long)PHMASK >> site_) & 1ull) && lo <= pid && pid < hi) { for (int rep_ = 0; rep_ < nrep_; ++rep_) {
#define PHASE_END if (rep_ + 1 < nrep_ || pid + 1 < hi) GRID_BAR(); } } ++pid; }

    PHASE_BEGIN pro_a(F); PHASE_END
    PHASE_BEGIN pro_b(F); PHASE_END

    for (int lp = 0; lp < 2; ++lp) {
        { const int layer = 2 * lp, li = lp;
        PHASE_BEGIN dense_gemm_f8(F, WSP(unsigned char, WS_HB), WSP(unsigned char, WS_WINE) + (size_t)li * 2048 * 1024, 2048, 1024, WSP(bf16_t, WS_PB), EV_LD); PHASE_END
        PHASE_BEGIN e2_pass(F, li); PHASE_END
        PHASE_BEGIN
            dense_gemm_bf16(F, WSP(bf16_t, WS_PB) + 768, (size_t)EV_LD * 2, WSP(bf16_t, WS_WUQ) + (size_t)li * 768 * 768, 768, 768, WSP(bf16_t, WS_QB), 768);
            dense_gemm_bf16(F, WSP(bf16_t, WS_PB) + 1536, (size_t)EV_LD * 2, WSP(bf16_t, WS_WUKV) + (size_t)li * 1024 * 256, 1024, 256, WSP(bf16_t, WS_KVB), 1024);
        PHASE_END
        PHASE_BEGIN
            for (int rr_ = 0; rr_ < 1 + (int)(((unsigned long long)REPMASK >> 40) & 1ull); ++rr_)
            for (int u = F.vcu; u < 1024 + 32; u += F.G) {
                att::UMla U; U.QB = WSP(bf16_t, WS_QB); U.KVB = WSP(bf16_t, WS_KVB); U.PB = WSP(bf16_t, WS_PB); U.AO = WSP(bf16_t, WS_AO); U.R32 = WSP(f32x2, WS_ROPE32);
                if (u < 1024) { const int bh = u >> 5; U.b = bh >> 3; U.h = bh & 7; U.qblk = u & 31; U.ctxq = false; }
                else { const int v = u - 1024; U.b = v >> 3; U.h = v & 7; U.qblk = 0; U.ctxq = true; }
                att::attn_unit<att::UMla>(F.lds, F.ws, U);
            }
            for (int rr_ = 0; rr_ < 1 + (int)(((unsigned long long)REPMASK >> 41) & 1ull); ++rr_)
            for (int u = (F.vcu + F.G / 2) % F.G; u < 1024 + 32; u += F.G) {
                att::UWin U; U.PB = WSP(bf16_t, WS_PB); U.AO = WSP(bf16_t, WS_AO); U.sink = inptr(F, I_EVSINK) + li * 8;
                if (u < 1024) { U.b = u >> 8; U.kvh = (u >> 7) & 1; U.j = u & 127; U.ctxq = false; }
                else { const int v = u - 1024; U.b = v >> 3; U.kvh = (v >> 2) & 1; U.j = v & 3; U.ctxq = true; }
                U.init();
                att::attn_unit<att::UWin>(F.lds, F.ws, U);
            }
        PHASE_END
        PHASE_BEGIN outproj_gemm(F, WSP(unsigned char, WS_WOUTE) + (size_t)li * 1024 * 1024, layer, TT); PHASE_END
        PHASE_BEGIN m1a_pass(F, layer); PHASE_END
        PHASE_BEGIN m1b_gemm(F, layer); PHASE_END
        PHASE_BEGIN m1c_pass(F); PHASE_END
        PHASE_BEGIN m2_pass(F); PHASE_END
        PHASE_BEGIN moe_gemm1(F, layer); PHASE_END
        PHASE_BEGIN moe_gemm2(F, layer); PHASE_END
        PHASE_BEGIN m5_pass(F, layer); PHASE_END
        }
        { const int layer = 2 * lp + 1, li = lp;
        PHASE_BEGIN dense_gemm_f8(F, WSP(unsigned char, WS_HB), WSP(unsigned char, WS_WINO) + (size_t)li * 3072 * 1024, 3072, 1024, WSP(bf16_t, WS_PB), OD_LD); PHASE_END
        PHASE_BEGIN
            for (int u = F.vcu; u < 2048 + (layer == 3 ? 0 : 64); u += F.G) {
                att::UNa U; U.PB = WSP(bf16_t, WS_PB); U.AO = WSP(bf16_t, WS_AO);
                if (u < 2048) { U.b = u >> 9; U.h = (u >> 5) & 15; U.G = u & 31; U.ctxq = false; }
                else { const int v = u - 2048; U.b = v >> 4; U.h = v & 15; U.G = 0; U.ctxq = true; }
                U.rpbh = inptr(F, I_ODRPB) + (size_t)(li * 16 + U.h) * 15 * 31;
                U.init();
                att::attn_unit<att::UNa>(F.lds, F.ws, U);
            }
        PHASE_END
        PHASE_BEGIN outproj_gemm(F, WSP(unsigned char, WS_WOUTO) + (size_t)li * 1024 * 1024, layer, layer == 3 ? TL : TT); PHASE_END
        PHASE_BEGIN m1a_pass(F, layer); PHASE_END
        PHASE_BEGIN m1b_gemm(F, layer); PHASE_END
        PHASE_BEGIN m1c_pass(F); PHASE_END
        PHASE_BEGIN m2_pass(F); PHASE_END
        PHASE_BEGIN moe_gemm1(F, layer); PHASE_END
        PHASE_BEGIN moe_gemm2(F, layer); PHASE_END
        PHASE_BEGIN m5_pass(F, layer); PHASE_END
        }
    }
}


#if MK_CHECK
constexpr int CW_CHK = 8192;
constexpr size_t WS_CHK = 1968 * MiB;
constexpr size_t WS_CHK_CNT = WS_CHK + 136 * MiB;
constexpr int IDS_PER_PAIR = 26, ID_PROB = 53, NID = 54;
struct CArgs { const float* in[25]; float* out; unsigned char* ws; int layer, id; };
#define CWS(T, off) ((T*)(A.ws + (off)))
__device__ __forceinline__ unsigned hsh(unsigned x) { x ^= x >> 16; x *= 0x7feb352du; x ^= x >> 15; x *= 0x846ca68bu; x ^= x >> 16; return x; }
__device__ __forceinline__ float bfv(const bf16_t* p) { return __builtin_bit_cast(float, (unsigned)(*p) << 16); }
__device__ __forceinline__ float f8v(const unsigned char* p) { const unsigned b = *p; const unsigned e = (b >> 3) & 15u, m = b & 7u; const float v = e ? __builtin_bit_cast(float, ((e + 120u) << 23) | (m << 20)) : (float)m * 0.001953125f; return (b & 128u) ? -v : v; }
__device__ __forceinline__ float rbf(float a) { return __builtin_bit_cast(float, f2bf(a) << 16); }
__device__ __forceinline__ void chk_acc(const CArgs& A, float e2, float r2) {
    __shared__ float sh[2][8];
    e2 = wave_sum(e2); r2 = wave_sum(r2);
    const int w = threadIdx.x >> 6;
    if ((threadIdx.x & 63) == 0) { sh[0][w] = e2; sh[1][w] = r2; }
    __syncthreads();
    if (threadIdx.x == 0) { float a = 0.f, b = 0.f; for (int i = 0; i < (int)(blockDim.x >> 6); ++i) { a += sh[0][i]; b += sh[1][i]; }
        float* acc = (float*)(A.ws + WS_CTL) + CW_CHK + 2 * A.id; atomicAdd(acc, a); atomicAdd(acc + 1, b); }
    __syncthreads();
}
__device__ __forceinline__ void sincos_d(float a, float& s, float& c) {
    double x = (double)a; const double tp = 6.283185307179586476925; double k = __builtin_rint(x / tp); double r = x - k * tp; double r2 = r * r;
    double sp = r, cp = 1.0, ts = r, tc = 1.0;
#pragma unroll
    for (int i = 1; i < 14; ++i) { tc *= -r2 / (double)((2 * i - 1) * (2 * i)); cp += tc; ts *= -r2 / (double)((2 * i) * (2 * i + 1)); sp += ts; }
    s = (float)sp; c = (float)cp;
}
__device__ __forceinline__ float invfreq(int i, int half) { return __builtin_amdgcn_exp2f(-((float)i / (float)half) * 13.287712379549449f); }
__device__ __forceinline__ float nsilu(float c) { return c / (1.0f + __expf(-c)); }
__device__ float naive_mod(const CArgs& A, int layer, int bidx, int n) {
    const float* cv = bidx < 4 ? A.in[I_C] + bidx * 1024 : A.in[I_CCTX]; const float* W = A.in[I_ADAW] + (size_t)layer * 1024 * 6144 + n;
    float acc = 0.f; for (int k = 0; k < 1024; ++k) acc += nsilu(cv[k]) * W[(size_t)k * 6144];
    return acc + A.in[I_ADAB][layer * 6144 + n];
}
__device__ __forceinline__ int srow(unsigned s) { return (s & 3) == 0 ? TL + (int)(hsh(s * 3 + 1) % TC) : (int)(hsh(s * 3 + 1) % TL); }
__global__ void chk_mark(CArgs A) { if (threadIdx.x == 0) ((float*)(A.ws + WS_CTL))[CW_CHK + 2 * A.id + 1] = 1.0f; }

__global__ void chk_gemm(CArgs A, const bf16_t* X, int ldx, const float* W, int ldw, int K, int ncol, const bf16_t* O, int ldo) {
    const int row = srow(blockIdx.x); const int col = (int)((hsh(blockIdx.x * 977 + 5) + 7u * threadIdx.x) % (unsigned)ncol);
    float ref = 0.f; for (int k = 0; k < K; ++k) ref += (ldx ? bfv(X + (size_t)row * ldx + k) : f8v((const unsigned char*)X + (size_t)row * 1024 + k)) * W[(size_t)k * ldw + col];
    const float got = bfv(O + (size_t)row * ldo + col);
    chk_acc(A, (got - ref) * (got - ref), ref * ref);
}
__global__ void chk_e2(CArgs A) {
    __shared__ float P[EV_IN]; __shared__ float red[2];
    const int li = A.layer >> 1, row = srow(blockIdx.x), t = threadIdx.x;
    const float* W = A.in[I_EVWIN] + (size_t)li * 1024 * EV_IN; const unsigned char* h = CWS(unsigned char, WS_HB) + (size_t)row * DM;
    for (int c = t; c < EV_IN; c += 256) { float a = 0.f; for (int k = 0; k < 1024; ++k) a += f8v(h + k) * W[(size_t)k * EV_IN + c]; P[c] = rbf(a); }
    __syncthreads();
    if (t == 0) { float a = 0.f; for (int c = 768; c < 1536; ++c) a += P[c] * P[c]; red[0] = 1.0f / sqrtf(a / 768.0f + NORM_EPS); float b = 0.f; for (int c = 1536; c < 1792; ++c) b += P[c] * P[c]; red[1] = 1.0f / sqrtf(b / 256.0f + NORM_EPS); }
    __syncthreads();
    const bool lat = row < TL; const int tt = row & (SEQ - 1), prow = tt >> 6, pcol = tt & 63;
    float e2 = 0.f, r2 = 0.f;
    for (int c = t; c < EV_IN; c += 256) {
        float ref = P[c];
        if (c < 640 && lat) { const int d = c & 63, dd = d & 31, i = dd & 15; const bool first = dd < 16; const float y = P[first ? c + 16 : c - 16];
            float sn, cs; sincos_d((float)((d < 32) ? prow : pcol) * invfreq(i, 16), sn, cs); ref = first ? P[c] * cs - y * sn : P[c] * cs + y * sn; }
        else if (c >= 768 && c < 1536) ref = P[c] * red[0] * A.in[I_EVQNG][li * 768 + c - 768];
        else if (c >= 1536 && c < 1792) ref = P[c] * red[1] * A.in[I_EVKVNG][li * 256 + c - 1536];
        else if (c >= 1792 && lat) { const int d = c - 1792, dd = d & 15, i = dd & 7; const bool first = dd < 8; const float y = P[first ? c + 8 : c - 8];
            float sn, cs; sincos_d((float)((d < 16) ? prow : pcol) * invfreq(i, 8), sn, cs); ref = first ? P[c] * cs - y * sn : P[c] * cs + y * sn; }
        const float got = bfv(CWS(bf16_t, WS_PB) + (size_t)row * EV_LD + c);
        e2 += (got - ref) * (got - ref); r2 += ref * ref;
    }
    chk_acc(A, e2, r2);
}
__global__ void chk_e4(CArgs A) {
    __shared__ float Q[768];
    const int li = A.layer >> 1, row = (int)(hsh(blockIdx.x * 3 + 1) % TL), t = threadIdx.x;
    const float* W = A.in[I_EVWUQ] + (size_t)li * 768 * 768; const bf16_t* x = CWS(bf16_t, WS_PB) + (size_t)row * EV_LD + 768;
    for (int c = t; c < 768; c += 256) { float a = 0.f; for (int k = 0; k < 768; ++k) a += bfv(x + k) * W[(size_t)k * 768 + c]; Q[c] = rbf(a); }
    __syncthreads();
    const int tt = row & (SEQ - 1), prow = tt >> 6, pcol = tt & 63;
    float e2 = 0.f, r2 = 0.f;
    for (int c = t; c < 768; c += 256) { const int d = c % 96; float ref = Q[c];
        if (d >= 64) { const int dr = d - 64, dd = dr & 15, i = dd & 7; const bool first = dd < 8; const float y = Q[first ? c + 8 : c - 8];
            float sn, cs; sincos_d((float)((dr < 16) ? prow : pcol) * invfreq(i, 8), sn, cs); ref = first ? Q[c] * cs - y * sn : Q[c] * cs + y * sn; }
        const float got = bfv(CWS(bf16_t, WS_QB) + (size_t)row * 768 + c); e2 += (got - ref) * (got - ref); r2 += ref * ref; }
    chk_acc(A, e2, r2);
}
__global__ void chk_attn(CArgs A, int kind, int ctxq) {
    __shared__ float sc[8448]; __shared__ float redm[4], reds[4], qs[96];
    const int li = A.layer >> 1, t = threadIdx.x; const unsigned s = blockIdx.x;
    const int b = hsh(s * 7 + 1) % NB, head = hsh(s * 7 + 2) % (kind == 2 ? 16 : 8);
    const int pos = ctxq ? hsh(s * 7 + 3) % CTXL : ((s & 7) == 0 ? (hsh(s) % 200) : (s & 7) == 1 ? SEQ - 1 - (hsh(s) % 200) : hsh(s * 7 + 3) % SEQ);
    const size_t qrow = ctxq ? (size_t)(TL + b * CTXL + pos) : (size_t)(b * SEQ + pos);
    int nlat = 0, wlo = 0, r = pos >> 6, c = pos & 63, r0 = 0, c0 = 0;
    if (!ctxq) {
        if (kind == 0) { wlo = pos - 128 < 0 ? 0 : pos - 128; const int whi = pos + 128 > SEQ - 1 ? SEQ - 1 : pos + 128; nlat = whi - wlo + 1; }
        else if (kind == 1) nlat = SEQ;
        else { r0 = r - 4; r0 = r0 < 0 ? 0 : (r0 > 120 ? 120 : r0); c0 = c - 8; c0 = c0 < 0 ? 0 : (c0 > 48 ? 48 : c0); nlat = 128; }
    }
    const int nk = nlat + CTXL;
    const bf16_t* PB = CWS(bf16_t, WS_PB); const bf16_t* KVB = CWS(bf16_t, WS_KVB);
    const int pld = kind == 2 ? OD_LD : EV_LD, dqk = kind == 1 ? 96 : 64;
    const bf16_t* q = kind == 1 ? CWS(bf16_t, WS_QB) + qrow * 768 + 96 * head : PB + qrow * pld + 64 * head;
    const float scale = kind == 1 ? 0.10206207261596577f : 0.125f;
    const bool has_sink = kind == 0; const float sinkv = has_sink ? A.in[I_EVSINK][li * 8 + head] : 0.f;
    const float* rp = A.in[I_ODRPB] + (size_t)(li * 16 + head) * 15 * 31;
    if (t < dqk) qs[t] = bfv(q + t);
    __syncthreads();
    if (kind == 1 && !ctxq) { float rv = 0.f;
        if (t >= 64 && t < 96) { const int dr = t - 64, dd = dr & 15, i = dd & 7; const bool first = dd < 8; const float y = qs[first ? t + 8 : t - 8];
            float sn, cs; sincos_d((float)((dr < 16) ? r : c) * invfreq(i, 8), sn, cs); rv = rbf(first ? qs[t] * cs - y * sn : qs[t] * cs + y * sn); }
        __syncthreads();
        if (t >= 64 && t < 96) qs[t] = rv;
        __syncthreads(); }
#define KROW(i) ((i) >= nlat ? (size_t)(TL + b * CTXL + ((i) - nlat)) : kind == 0 ? (size_t)(b * SEQ + wlo + (i)) : kind == 1 ? (size_t)(b * SEQ + (i)) : (size_t)(b * SEQ + (r0 + ((i) >> 4)) * 64 + c0 + ((i) & 15)))
    float mx = has_sink ? sinkv : -3e38f;
    for (int i = t; i < nk; i += 256) { const size_t kr = KROW(i); float a = 0.f;
        if (kind == 0) { const bf16_t* k = PB + kr * EV_LD + 512 + 64 * (head >> 2); for (int d = 0; d < 64; ++d) a += qs[d] * bfv(k + d); }
        else if (kind == 1) { const bf16_t* k = KVB + kr * 1024 + 128 * head; for (int d = 0; d < 64; ++d) a += qs[d] * bfv(k + d); const bf16_t* k2 = PB + kr * EV_LD + 1792; for (int d = 0; d < 32; ++d) a += qs[64 + d] * bfv(k2 + d); }
        else { const bf16_t* k = PB + kr * OD_LD + 1024 + 64 * head; for (int d = 0; d < 64; ++d) a += qs[d] * bfv(k + d); }
        a *= scale;
        if (kind == 2 && i < nlat) { const int kr_ = r0 + (i >> 4), kc_ = c0 + (i & 15); a += rp[(kr_ - r + 7) * 31 + (kc_ - c + 15)]; }
        sc[i] = a; mx = fmaxf(mx, a); }
    for (int o = 1; o < 64; o <<= 1) mx = fmaxf(mx, __shfl_xor(mx, o));
    if ((t & 63) == 0) redm[t >> 6] = mx;
    __syncthreads();
    mx = fmaxf(fmaxf(redm[0], redm[1]), fmaxf(redm[2], redm[3]));
    float sm = 0.f;
    for (int i = t; i < nk; i += 256) { const float p = __expf(sc[i] - mx); sc[i] = p; sm += p; }
    sm = wave_sum(sm);
    if ((t & 63) == 0) reds[t >> 6] = sm;
    __syncthreads();
    sm = reds[0] + reds[1] + reds[2] + reds[3] + (has_sink ? __expf(sinkv - mx) : 0.f);
    float e2 = 0.f, r2 = 0.f;
    if (t < 64) { float o = 0.f;
        for (int i = 0; i < nk; ++i) { const size_t kr = KROW(i); const bf16_t* v = kind == 0 ? PB + kr * EV_LD + 640 + 64 * (head >> 2) : kind == 1 ? KVB + kr * 1024 + 128 * head + 64 : PB + kr * OD_LD + 2048 + 64 * head; o += sc[i] * bfv(v + t); }
        o /= sm; const unsigned char* got = CWS(unsigned char, WS_AO) + qrow * 1024 + (kind == 1 ? 512 : 0) + 64 * head; const float g = f8v(got + t); e2 = (g - o) * (g - o); r2 = o * o; }
#undef KROW
    chk_acc(A, e2, r2);
}
__global__ void chk_outproj(CArgs A, const float* W) {
    const int row = A.layer == 3 ? (int)(hsh(blockIdx.x * 3 + 1) % TL) : srow(blockIdx.x), c = (int)((hsh(blockIdx.x * 977 + 5) + 7u * threadIdx.x) % 1024u);
    float a = 0.f; for (int k = 0; k < 1024; ++k) a += f8v(CWS(unsigned char, WS_AO) + (size_t)row * 1024 + k) * W[(size_t)k * 1024 + c];
    const float gate = naive_mod(A, A.layer, row < TL ? (row >> 13) : 4, 2 * 1024 + c);
    const float ref = CWS(float, WS_CHK)[(size_t)row * DM + c] + gate * a, got = CWS(float, WS_XLC)[(size_t)row * DM + c];
    chk_acc(A, (got - ref) * (got - ref), (gate * a) * (gate * a));
}
__global__ void chk_norm_router(CArgs A, int which, const bf16_t* hbuf, int hld) {
    __shared__ float hv[1024]; __shared__ float red[4]; __shared__ float lg[32]; __shared__ int ste[4]; __shared__ float stv[4];
    const int row = srow(blockIdx.x), t = threadIdx.x, bidx = row < TL ? (row >> 13) : 4;
    const float* x = CWS(float, WS_XLC) + (size_t)row * DM;
    float s = 0.f; for (int c = t; c < 1024; c += 256) s += x[c] * x[c];
    s = wave_sum(s); if ((t & 63) == 0) red[t >> 6] = s; __syncthreads();
    const float rstd = 1.0f / sqrtf((red[0] + red[1] + red[2] + red[3]) / 1024.0f + NORM_EPS);
    const float* g = (which == 0 ? A.in[I_N1G] : A.in[I_N2G]) + A.layer * DM;
    float e2 = 0.f, r2 = 0.f;
    for (int c = t; c < 1024; c += 256) { const float sh = naive_mod(A, A.layer, bidx, which * 1024 + c), scl = naive_mod(A, A.layer, bidx, (which + 1) * 1024 + c);
        const float h = x[c] * rstd * g[c] * (1.0f + scl) + sh; hv[c] = h; const float got = hld ? bfv(hbuf + (size_t)row * hld + c) : f8v((const unsigned char*)hbuf + (size_t)row * DM + c); e2 += (got - h) * (got - h); r2 += h * h; }
    __syncthreads();
    if (which == 3) {
        if (t < 32) { const float* rw = A.in[I_RW] + (size_t)A.layer * 1024 * 32; float a = 0.f; for (int k = 0; k < 1024; ++k) a += hv[k] * rw[k * 32 + t]; lg[t] = a + A.in[I_RB][A.layer * 32 + t]; }
        __syncthreads();
        if (t == 0) { unsigned used = 0u;
            for (int k = 0; k < 4; ++k) { float bv = -3e38f; int bi = 0; for (int e = 0; e < 32; ++e) if (!((used >> e) & 1u) && lg[e] > bv) { bv = lg[e]; bi = e; } used |= 1u << bi; ste[k] = bi; stv[k] = bv; }
            float den = 0.f; for (int k = 0; k < 4; ++k) den += __expf(stv[k] - stv[0]);
            for (int k = 0; k < 4; ++k) { const float gr = __expf(stv[k] - stv[0]) / den; const int ge = CWS(int, WS_TOPE)[(size_t)row * 4 + k]; const float gg = CWS(float, WS_TOPG)[(size_t)row * 4 + k];
                const float d = (ge == ste[k]) ? (gg - gr) : 1.0f; e2 += 1000.f * d * d; r2 += 1000.f * gr * gr; } }
    }
    chk_acc(A, e2, r2);
}
__global__ void chk_slots_count(CArgs A) {
    const int i = blockIdx.x * 256 + threadIdx.x; if (i < TT * 4) { const int sl = CWS(int, WS_SLOT)[i]; if (sl >= 0 && sl < MAXSLOT) atomicAdd(CWS(int, WS_CHK_CNT) + sl, 1); else atomicAdd((float*)(A.ws + WS_CTL) + CW_CHK + 2 * A.id, 1.0f); }
}
__global__ void chk_slots(CArgs A) {
    const int i = blockIdx.x * 256 + threadIdx.x; float e2 = 0.f, r2 = 0.f;
    if (i < MAXSLOT) { const int c = CWS(int, WS_CHK_CNT)[i]; if (c > 1) e2 += 1.f; }
    if (i < 8192) { const unsigned a = hsh(i * 5 + 3) % (unsigned)(TT * 4); const int row = a >> 2, sl = CWS(int, WS_SLOT)[a], e = CWS(int, WS_TOPE)[a];
        if (CWS(int, WS_TILEEXP)[sl >> 8] != e) e2 += 1.f;
        if (CWS(float, WS_GSLOT)[sl] != CWS(float, WS_TOPG)[a]) e2 += 1.f;
        if (CWS(int, WS_TOKSLOT)[sl] != row) e2 += 1.f; r2 += 1.f; }
    chk_acc(A, e2, r2);
}
__global__ void chk_moe(CArgs A, int which) {
    const unsigned a = hsh(blockIdx.x * 5 + 3) % (unsigned)(TT * 4); const int sl = CWS(int, WS_SLOT)[a], e = CWS(int, WS_TILEEXP)[sl >> 8];
    const int c = (int)((hsh(blockIdx.x * 977 + 5) + 7u * threadIdx.x) % 1024u);
    float ref, got;
    if (which == 0) { const float* W = A.in[I_W1] + ((size_t)A.layer * 32 + e) * 1024 * 2048; const unsigned char* x = CWS(unsigned char, WS_HB) + (size_t)(a >> 2) * DM; float g = 0.f, l = 0.f;
        for (int k = 0; k < 1024; ++k) { const float xv = f8v(x + k); g += xv * W[(size_t)k * 2048 + c]; l += xv * W[(size_t)k * 2048 + 1024 + c]; }
        g += A.in[I_B1][((size_t)A.layer * 32 + e) * 2048 + c]; l += A.in[I_B1][((size_t)A.layer * 32 + e) * 2048 + 1024 + c];
        g = fminf(g, 7.f); l = fminf(fmaxf(l, -7.f), 7.f); ref = g / (1.0f + __expf(-1.702f * g)) * (l + 1.0f); got = f8v(CWS(unsigned char, WS_HA) + (size_t)sl * DM + c); }
    else { const float* W = A.in[I_W2] + ((size_t)A.layer * 32 + e) * 1024 * 1024; const unsigned char* x = CWS(unsigned char, WS_HA) + (size_t)sl * DM; float y = 0.f;
        for (int k = 0; k < 1024; ++k) y += f8v(x + k) * W[(size_t)k * 1024 + c];
        ref = y + A.in[I_B2][((size_t)A.layer * 32 + e) * 1024 + c]; got = f8v(CWS(unsigned char, WS_XG) + (size_t)sl * DM + c) * (1.0f / YS_SCALE); }
    chk_acc(A, (got - ref) * (got - ref), ref * ref);
}
__global__ void chk_combine(CArgs A) {
    const int row = srow(blockIdx.x), c = (int)((hsh(blockIdx.x * 977 + 5) + 7u * threadIdx.x) % 1024u);
    float y = 0.f; for (int k = 0; k < 4; ++k) y += CWS(float, WS_TOPG)[(size_t)row * 4 + k] * (1.0f / YS_SCALE) * f8v(CWS(unsigned char, WS_XG) + (size_t)CWS(int, WS_SLOT)[(size_t)row * 4 + k] * DM + c);
    const float gate = naive_mod(A, A.layer, row < TL ? (row >> 13) : 4, 5 * 1024 + c);
    const float ref = CWS(float, WS_CHK)[(size_t)row * DM + c] + gate * y, got = CWS(float, WS_XLC)[(size_t)row * DM + c];
    chk_acc(A, (got - ref) * (got - ref), (gate * y) * (gate * y));
}
__global__ void chk_report(CArgs A) {
    if (threadIdx.x == 0 && blockIdx.x == 0) { const float* acc = (const float*)(A.ws + WS_CTL) + CW_CHK; int bad = 0, bad2 = 0;
        for (int id = NID - 1; id >= 1; --id) { const int q = (id - 1) % IDS_PER_PAIR + 1; const float tol = (id == ID_PROB || (q >= 6 && q <= 10) || q == 18 || q == 19 || q == 20 || q == 1 || q == 2 || q == 17 || q == 13 || q == 14 || q == 16 || q == 23 || q == 24 || q == 26) ? 0.1f : 0.03f;
            const float e2 = acc[2 * id], r2 = acc[2 * id + 1]; if (r2 <= 0.f || !(e2 <= tol * tol * r2)) { bad2 = bad; bad = id; } }
        if (bad) A.out[0] = 1000.0f * (float)bad;
        if (bad2) A.out[1] = 1000.0f * (float)bad2; }
}
static void chk_before(int p, const Args& a, hipStream_t st) {
    const int q = p < 2 ? -1 : (p - 2) % NPH_PAIR;
    if (q == 8 || q == 18) (void)hipMemsetAsync(a.ws + WS_CHK_CNT, 0, (size_t)MAXSLOT * 4, st);
    if (q == 4 || q == 11 || q == 14 || q == 21) (void)hipMemcpyAsync(a.ws + WS_CHK, a.ws + WS_XLC, (size_t)TT * DM * 4, hipMemcpyDeviceToDevice, st);
}
static void chk_after(int p, const Args& a, hipStream_t st) {
    CArgs A{}; for (int i = 0; i < 25; ++i) A.in[i] = a.in[i]; A.out = a.out; A.ws = a.ws;
    const int lp = p < 2 ? 0 : (p - 2) / NPH_PAIR, q = p < 2 ? -1 : (p - 2) % NPH_PAIR, base = IDS_PER_PAIR * lp;
    unsigned char* ws = a.ws; const int le = 2 * lp, lod = 2 * lp + 1;
#define CK(idv, layerv, kern, grid, ...) do { A.id = base + (idv); A.layer = (layerv); hipLaunchKernelGGL(kern, dim3(grid), dim3(256), 0, st, A, ##__VA_ARGS__); } while (0)
#define CK0(idv, layerv, kern, grid) do { A.id = base + (idv); A.layer = (layerv); hipLaunchKernelGGL(kern, dim3(grid), dim3(256), 0, st, A); } while (0)
    if (p == 1) { A.id = ID_PROB; A.layer = 0; hipLaunchKernelGGL(chk_norm_router, dim3(48), dim3(256), 0, st, A, 0, (const bf16_t*)(ws + WS_HB), 0); }
    if (q == 0) CK(1, le, chk_gemm, 64, (const bf16_t*)(ws + WS_HB), 0, a.in[I_EVWIN] + (size_t)lp * 1024 * EV_IN, (int)EV_IN, 1024, (int)EV_IN, (const bf16_t*)(ws + WS_PB), (int)EV_LD);
    if (q == 1) CK0(2, le, chk_e2, 48);
    if (q == 2) { CK(3, le, chk_gemm, 64, (const bf16_t*)(ws + WS_PB) + 768, (int)EV_LD, a.in[I_EVWUQ] + (size_t)lp * 768 * 768, 768, 768, 768, (const bf16_t*)(ws + WS_QB), 768);
                  CK(4, le, chk_gemm, 64, (const bf16_t*)(ws + WS_PB) + 1536, (int)EV_LD, a.in[I_EVWUKV] + (size_t)lp * 256 * 1024, 1024, 256, 1024, (const bf16_t*)(ws + WS_KVB), 1024);
                  CK0(5, le, chk_mark, 1); }
    if (q == 3) { CK(6, le, chk_attn, 96, 0, 0); CK(7, le, chk_attn, 48, 1, 0); CK(8, le, chk_attn, 32, 0, 1); CK(9, le, chk_attn, 32, 1, 1); }
    if (q == 4) CK(10, le, chk_outproj, 48, a.in[I_EVWOUT] + (size_t)lp * 1024 * 1024);
    if (q == 7) CK(11, le, chk_norm_router, 48, 3, (const bf16_t*)(ws + WS_PB), (int)H3_LD);
    if (q == 8) { CK0(12, le, chk_slots_count, (TT * 4 + 255) / 256); CK0(12, le, chk_slots, MAXSLOT / 256); }
    if (q == 9) CK(13, le, chk_moe, 64, 0);
    if (q == 10) CK(14, le, chk_moe, 64, 1);
    if (q == 11) { CK0(15, le, chk_combine, 64); CK(16, le + 1, chk_norm_router, 48, 0, (const bf16_t*)(ws + WS_HB), 0); }
    if (q == 12) CK(17, lod, chk_gemm, 64, (const bf16_t*)(ws + WS_HB), 0, a.in[I_ODWIN] + (size_t)lp * 1024 * 3072, 3072, 1024, 3072, (const bf16_t*)(ws + WS_PB), (int)OD_LD);
    if (q == 13) { CK(18, lod, chk_attn, 96, 2, 0); CK(19, lod, chk_attn, 32, 2, 1); }
    if (q == 14) CK(20, lod, chk_outproj, 48, a.in[I_ODWOUT] + (size_t)lp * 1024 * 1024);
    if (q == 17) CK(21, lod, chk_norm_router, 48, 3, (const bf16_t*)(ws + WS_PB), (int)H3_LD);
    if (q == 18) { CK0(22, lod, chk_slots_count, (TT * 4 + 255) / 256); CK0(22, lod, chk_slots, MAXSLOT / 256); }
    if (q == 19) CK(23, lod, chk_moe, 64, 0);
    if (q == 20) CK(24, lod, chk_moe, 64, 1);
    if (q == 21) { if (lod != 3) { CK0(25, lod, chk_combine, 64); CK(26, lod + 1, chk_norm_router, 48, 0, (const bf16_t*)(ws + WS_HB), 0); } else { CK0(25, lod, chk_mark, 1); CK0(26, lod, chk_mark, 1); } }
    if (p == NPH - 1) { A.id = 0; hipLaunchKernelGGL(chk_report, dim3(1), dim3(64), 0, st, A); }
#undef CK
#undef CK0
}
#endif

extern "C" void kernel_launch(void* const* d_in, const int* in_sizes, int n_in, void* d_out, int out_size, void* d_ws, size_t ws_size, hipStream_t stream) {
    static int grid = 0;
    if (grid == 0) {
        if (n_in != 25 || out_size != TL * DM || ws_size < WS_END) { fprintf(stderr, "kernel_launch: unexpected shapes (n_in %d, out %d, ws %zu < %zu); nothing launched\n", n_in, out_size, ws_size, (size_t)WS_END); grid = -1; return; }
        int dev = 0, cus = 0, per_cu = 0;
        if (hipGetDevice(&dev) != hipSuccess || hipDeviceGetAttribute(&cus, hipDeviceAttributeMultiprocessorCount, dev) != hipSuccess) { grid = -1; return; }
        if (hipFuncSetAttribute((const void*)fwd, hipFuncAttributeMaxDynamicSharedMemorySize, LDS_BYTES) != hipSuccess) { fprintf(stderr, "kernel_launch: hipFuncSetAttribute failed\n"); grid = -1; return; }
        if (hipOccupancyMaxActiveBlocksPerMultiprocessor(&per_cu, (const void*)fwd, 512, LDS_BYTES) != hipSuccess || per_cu < 1) { fprintf(stderr, "kernel_launch: occupancy query says %d blocks per CU\n", per_cu); }
        (void)hipGetLastError();
        grid = cus;
    }
    if (grid < 0) return;
    (void)hipMemsetAsync((char*)d_ws + WS_CTL, 0, CTL_ZERO_BYTES, stream);
    Args a{};
    for (int i = 0; i < 25; ++i) a.in[i] = (const float*)d_in[i];
    a.out = (float*)d_out; a.ws = (unsigned char*)d_ws;
#if MK_PER_PHASE
    for (int p = 0; p < NPH; ++p) {
#if MK_CHECK
        chk_before(p, a, stream);
#endif
        a.ph_lo = p; a.ph_hi = p + 1; hipLaunchKernelGGL(fwd, dim3(grid), dim3(512), LDS_BYTES, stream, a);
#if MK_CHECK
        chk_after(p, a, stream);
#endif
    }
#else
    a.ph_lo = 0; a.ph_hi = NPH;
    hipLaunchKernelGGL(fwd, dim3(grid), dim3(512), LDS_BYTES, stream, a);
#endif
    const hipError_t le = hipPeekAtLastError();
    if (le != hipSuccess) fprintf(stderr, "kernel_launch: launch failed: %s\n", hipGetErrorName(le));
}
```
